# Optimizing an MI355X kernel written in HIP

```python
import math
import jax, jax.numpy as jnp
from jax import lax
import numpy as np

D_MODEL = 1024
BATCH = 16
SEQ = 2048
DEPTH = 1

D_RNN = 1024
LRU_BLOCKS = 8
LRU_BW = D_RNN // LRU_BLOCKS
CONV_W = 4
LRU_C = 8.0
N_HEADS = 8
HEAD_DIM = 64
ATT_QK = N_HEADS * 2 * HEAD_DIM
ATT_V = N_HEADS * 2 * HEAD_DIM
Q_BLOCK = 128
N_EXPERTS = 64
TOP_K = 8
N_GROUPS = 8
TOPK_GROUPS = 4
D_EXPERT = 256
D_SHARED = 256
ROUTED_SCALE = 2.5
MOE_BLOCK = 128
EPS = 1e-6
W_IN = 2 * D_RNN + 2 * ATT_QK + ATT_V + 2 * D_MODEL

kernel_name = "hybrid_rglru_diffattn_moe_block"


def rms_norm(x, g):
    xf = x.astype(jnp.float32)
    y = xf * lax.rsqrt(jnp.mean(xf * xf, axis=-1, keepdims=True) + EPS)
    return (y * g).astype(x.dtype)


def modulate(h, shift, scale):
    return h * (1.0 + scale) + shift


def lambda_init(layer):
    return 0.8 - 0.6 * math.exp(-0.3 * layer)


def causal_dwconv(x, w, b):
    y = lax.conv_general_dilated(
        x, w[:, None, :].astype(x.dtype), window_strides=(1,),
        padding=[(CONV_W - 1, 0)], dimension_numbers=("NWC", "WIO", "NWC"),
        feature_group_count=x.shape[-1])
    return y + b


def rg_lru(x, wa, ba, wx, bx, lam):
    B, S, C = x.shape
    xb = x.reshape(B, S, LRU_BLOCKS, LRU_BW)
    r = jax.nn.sigmoid(jnp.einsum("bsnc,ncd->bsnd", xb, wa) + ba).reshape(B, S, C)
    i = jax.nn.sigmoid(jnp.einsum("bsnc,ncd->bsnd", xb, wx) + bx).reshape(B, S, C)
    log_a = (-LRU_C * jax.nn.softplus(-lam) * r).astype(jnp.float32)
    a = jnp.exp(log_a)
    mult = jnp.sqrt(-jnp.expm1(2.0 * log_a))
    first = (jnp.arange(S) == 0)[None, :, None]
    mult = jnp.where(first, 1.0, mult)
    u = mult * (i * x).astype(jnp.float32)

    def combine(lhs, rhs):
        a1, b1 = lhs
        a2, b2 = rhs
        return a1 * a2, a2 * b1 + b2

    _, h = lax.associative_scan(combine, (a, u), axis=1)
    return h.astype(x.dtype)


def diff_attention(q, k, v, lam):
    B, S = q.shape[0], q.shape[1]
    n_blk = S // Q_BLOCK
    scale = HEAD_DIM ** -0.5
    slopes = jnp.exp2(-8.0 * jnp.arange(1, N_HEADS + 1, dtype=jnp.float32) / N_HEADS)
    qb = q.reshape(B, n_blk, Q_BLOCK, N_HEADS, 2, HEAD_DIM).transpose(1, 0, 2, 3, 4, 5)
    pos_k = jnp.arange(S)

    def one_block(args):
        qi, bi = args
        pos_q = bi * Q_BLOCK + jnp.arange(Q_BLOCK)
        s = jnp.einsum("bqhmd,bkhmd->bhmqk", qi, k).astype(jnp.float32) * scale
        dist = (pos_q[:, None] - pos_k[None, :]).astype(jnp.float32)
        bias = -slopes[:, None, None, None] * dist
        s = jnp.where(dist >= 0, s + bias, -jnp.inf)
        p = jax.nn.softmax(s, axis=-1)
        attn = p[:, :, 0] - lam * p[:, :, 1]
        return jnp.einsum("bhqk,bkhe->bqhe", attn.astype(v.dtype), v)

    o = lax.map(one_block, (qb, jnp.arange(n_blk)))
    return o.transpose(1, 0, 2, 3, 4).reshape(B, S, N_HEADS, 2 * HEAD_DIM)


def hybrid_mixer(h, w_in, conv_w, conv_b, lru_wa, lru_ba, lru_wx, lru_bx, lru_lambda,
                 lam_q1, lam_k1, lam_q2, lam_k2, g_subln, w_proj_rnn, w_proj_att, w_out,
                 lam_init):
    B, S, _ = h.shape
    proj = h @ w_in
    cuts = [int(s) for s in np.cumsum([D_RNN, D_RNN, ATT_QK, ATT_QK, ATT_V, D_MODEL])]
    xr, gr, q, k, v, ga, gb = jnp.split(proj, cuts, axis=-1)
    xr = causal_dwconv(xr, conv_w, conv_b)
    yr = rg_lru(xr, lru_wa, lru_ba, lru_wx, lru_bx, lru_lambda) * jax.nn.gelu(gr)
    ya = yr @ w_proj_rnn
    q = q.reshape(B, S, N_HEADS, 2, HEAD_DIM)
    k = k.reshape(B, S, N_HEADS, 2, HEAD_DIM)
    v = v.reshape(B, S, N_HEADS, 2 * HEAD_DIM)
    lam = (jnp.exp(jnp.sum(lam_q1 * lam_k1)) - jnp.exp(jnp.sum(lam_q2 * lam_k2)) + lam_init)
    o = diff_attention(q, k, v, lam.astype(jnp.float32))
    o = rms_norm(o, g_subln) * (1.0 - lam_init)
    yb = o.reshape(B, S, ATT_V) @ w_proj_att
    merged = jax.nn.sigmoid(ga) * ya + jax.nn.sigmoid(gb) * yb
    return merged @ w_out


def moe_ffn(xf, w_router, e_bias, w1_e, w3_e, w2_e, w1_s, w3_s, w2_s):
    T, D = xf.shape
    scores = jax.nn.sigmoid((xf @ w_router).astype(jnp.float32))
    choice = scores + e_bias.astype(jnp.float32)
    per_g = N_EXPERTS // N_GROUPS
    grp_score = lax.top_k(choice.reshape(T, N_GROUPS, per_g), 2)[0].sum(-1)
    _, top_g = lax.top_k(grp_score, TOPK_GROUPS)
    gmask = jax.nn.one_hot(top_g, N_GROUPS, dtype=jnp.float32).sum(1) > 0
    choice = jnp.where(jnp.repeat(gmask, per_g, axis=1), choice, -jnp.inf)
    _, top_e = lax.top_k(choice, TOP_K)
    wts = jnp.take_along_axis(scores, top_e, axis=1)
    wts = wts / (wts.sum(-1, keepdims=True) + 1e-20) * ROUTED_SCALE

    A = T * TOP_K
    flat_e = top_e.reshape(A)
    order = jnp.argsort(flat_e)
    sorted_e = flat_e[order]
    counts = jnp.bincount(flat_e, length=N_EXPERTS)
    padded = (counts + MOE_BLOCK - 1) // MOE_BLOCK * MOE_BLOCK
    p_end = jnp.cumsum(padded)
    p_start = p_end - padded
    s_start = jnp.cumsum(counts) - counts
    dest = p_start[sorted_e] + (jnp.arange(A) - s_start[sorted_e])
    P = A + N_EXPERTS * MOE_BLOCK
    n_blocks = P // MOE_BLOCK
    slot_tok = jnp.full((P,), T, dtype=jnp.int32).at[dest].set((order // TOP_K).astype(jnp.int32))
    slot_w = jnp.zeros((P,), jnp.float32).at[dest].set(wts.reshape(A)[order])
    block_e = jnp.minimum(jnp.searchsorted(p_end, jnp.arange(n_blocks) * MOE_BLOCK, side="right"),
                          N_EXPERTS - 1)
    x_pad = jnp.concatenate([xf, jnp.zeros((1, D), xf.dtype)], axis=0)

    def body(acc, blk):
        tok, wt, e = blk
        xb = x_pad[tok]
        hb = jax.nn.silu(xb @ w1_e[e]) * (xb @ w3_e[e])
        yb = (hb @ w2_e[e]) * wt[:, None].astype(xb.dtype)
        return acc.at[tok].add(yb.astype(acc.dtype)), None

    acc0 = jnp.zeros((T + 1, D), xf.dtype)
    acc, _ = lax.scan(body, acc0, (slot_tok.reshape(n_blocks, MOE_BLOCK),
                                   slot_w.reshape(n_blocks, MOE_BLOCK), block_e))
    shared = (jax.nn.silu(xf @ w1_s) * (xf @ w3_s)) @ w2_s
    return acc[:T] + shared


def setup_inputs(seed: int = 0) -> dict:
    key = jax.random.key(seed)
    ks = iter(jax.random.split(key, 48))
    L, D = DEPTH, D_MODEL

    def nrm(shape, fan_in):
        return jax.random.normal(next(ks), shape, jnp.float32) * fan_in ** -0.5

    def gain(shape):
        return 1.0 + 0.05 * jax.random.normal(next(ks), shape, jnp.float32)

    def small(shape, s=0.02):
        return s * jax.random.normal(next(ks), shape, jnp.float32)

    x = jax.random.normal(next(ks), (BATCH, SEQ, D), jnp.float32)
    c = jax.random.normal(next(ks), (BATCH, D), jnp.float32)
    w_ada = nrm((L, D, 6 * D), D)
    b_ada = small((L, 6 * D))
    g_pre_mix = gain((L, D))
    w_in = nrm((L, D, W_IN), D)
    conv_w = nrm((L, CONV_W, D_RNN), CONV_W)
    conv_b = small((L, D_RNN))
    lru_wa = nrm((L, LRU_BLOCKS, LRU_BW, LRU_BW), LRU_BW)
    lru_ba = small((L, LRU_BLOCKS, LRU_BW))
    lru_wx = nrm((L, LRU_BLOCKS, LRU_BW, LRU_BW), LRU_BW)
    lru_bx = small((L, LRU_BLOCKS, LRU_BW))
    a0 = jax.random.uniform(next(ks), (L, D_RNN), jnp.float32, minval=0.9, maxval=0.999)
    lru_lambda = jnp.log(a0) - jnp.log1p(-a0)
    lam_q1 = small((L, HEAD_DIM), 0.1)
    lam_k1 = small((L, HEAD_DIM), 0.1)
    lam_q2 = small((L, HEAD_DIM), 0.1)
    lam_k2 = small((L, HEAD_DIM), 0.1)
    g_subln = gain((L, 2 * HEAD_DIM))
    w_proj_rnn = nrm((L, D_RNN, D), D_RNN)
    w_proj_att = nrm((L, ATT_V, D), ATT_V)
    w_out = nrm((L, D, D), D)
    g_post_mix = gain((L, D))
    g_pre_ffn = gain((L, D))
    w_router = nrm((L, D, N_EXPERTS), D)
    e_bias = small((L, N_EXPERTS), 0.01)
    w1_e = nrm((L, N_EXPERTS, D, D_EXPERT), D)
    w3_e = nrm((L, N_EXPERTS, D, D_EXPERT), D)
    w2_e = nrm((L, N_EXPERTS, D_EXPERT, D), D_EXPERT)
    w1_s = nrm((L, D, D_SHARED), D)
    w3_s = nrm((L, D, D_SHARED), D)
    w2_s = nrm((L, D_SHARED, D), D_SHARED)
    g_post_ffn = gain((L, D))
    return {"x": x, "c": c, "w_ada": w_ada, "b_ada": b_ada, "g_pre_mix": g_pre_mix,
            "w_in": w_in, "conv_w": conv_w, "conv_b": conv_b, "lru_wa": lru_wa,
            "lru_ba": lru_ba, "lru_wx": lru_wx, "lru_bx": lru_bx, "lru_lambda": lru_lambda,
            "lam_q1": lam_q1, "lam_k1": lam_k1, "lam_q2": lam_q2, "lam_k2": lam_k2,
            "g_subln": g_subln, "w_proj_rnn": w_proj_rnn, "w_proj_att": w_proj_att,
            "w_out": w_out, "g_post_mix": g_post_mix, "g_pre_ffn": g_pre_ffn,
            "w_router": w_router, "e_bias": e_bias, "w1_e": w1_e, "w3_e": w3_e,
            "w2_e": w2_e, "w1_s": w1_s, "w3_s": w3_s, "w2_s": w2_s, "g_post_ffn": g_post_ffn}


def reference(x, c, w_ada, b_ada, g_pre_mix, w_in, conv_w, conv_b, lru_wa, lru_ba, lru_wx,
              lru_bx, lru_lambda, lam_q1, lam_k1, lam_q2, lam_k2, g_subln, w_proj_rnn,
              w_proj_att, w_out, g_post_mix, g_pre_ffn, w_router, e_bias, w1_e, w3_e, w2_e,
              w1_s, w3_s, w2_s, g_post_ffn):
    B, S, D = x.shape
    cond = jax.nn.silu(c)
    for l in range(DEPTH):
        mod = cond @ w_ada[l] + b_ada[l]
        sh1, sc1, gt1, sh2, sc2, gt2 = [m[:, None, :] for m in jnp.split(mod, 6, axis=-1)]
        h = modulate(rms_norm(x, g_pre_mix[l]), sh1, sc1)
        y = hybrid_mixer(h, w_in[l], conv_w[l], conv_b[l], lru_wa[l], lru_ba[l], lru_wx[l],
                         lru_bx[l], lru_lambda[l], lam_q1[l], lam_k1[l], lam_q2[l], lam_k2[l],
                         g_subln[l], w_proj_rnn[l], w_proj_att[l], w_out[l], lambda_init(l))
        x = x + gt1 * rms_norm(y, g_post_mix[l])
        h = modulate(rms_norm(x, g_pre_ffn[l]), sh2, sc2)
        y = moe_ffn(h.reshape(B * S, D), w_router[l], e_bias[l], w1_e[l], w3_e[l], w2_e[l],
                    w1_s[l], w3_s[l], w2_s[l]).reshape(B, S, D)
        x = x + gt2 * rms_norm(y, g_post_ffn[l])
    return x
```

```cpp
#include <hip/hip_runtime.h>
#include <hip/hip_bf16.h>
#include <cstdio>
#include <cstdint>
#include <cmath>

#ifndef MK_N_LAUNCHES
#define MK_N_LAUNCHES 1
#endif

constexpr int BATCH = 16, SEQ = 2048, D = 1024, T = BATCH * SEQ;
constexpr int W_IN = 7 * 1024;
constexpr int NEXP = 64, TOPK = 8, DEXP = 256;
constexpr int NCH = 4, TC = T / NCH;
constexpr float EPS = 1e-6f;
constexpr float LOG2E = 1.4426950408889634f;
constexpr float LAM_INIT = 0.2f;

namespace pg8 {
#define PG8_LAS __attribute__((address_space(3)))
typedef unsigned short bf16_t;
typedef short bf16x8 __attribute__((ext_vector_type(8)));
typedef float f32x4 __attribute__((ext_vector_type(4)));
typedef unsigned u32x4 __attribute__((ext_vector_type(4)));
constexpr int BM = 256, BK = 64, HALF = 128, HTB = HALF * BK * 2, STAGE_BYTES = 8 * HTB, NXCD = 8, WGM = 8;

__host__ __device__ __forceinline__ int lds_byte(int r, int c) { const int st = (r >> 4) * 2 + (c >> 5), rr = r & 15, cc = c & 31, ob = rr * 64 + cc * 2; return st * 1024 + (ob ^ (((ob >> 9) & 1) << 5)); }
__host__ __device__ __forceinline__ void stage_rc(int b, int& R, int& C) { const int st = b / 1024, sb = b % 1024, swz = sb ^ (((sb >> 9) & 1) << 5); R = (st >> 1) * 16 + swz / 64; C = (st & 1) * 32 + (swz % 64) / 2; }
__host__ __device__ __forceinline__ int perm32(int rho) { const int n = rho >> 4, i = rho & 15; return 8 * (i >> 2) + 4 * n + (i & 3); }

struct Unit { int pm, pn, z, e; };

__device__ __forceinline__ unsigned cvt_pk_bf16(float lo, float hi) { unsigned r; asm volatile("v_cvt_pk_bf16_f32 %0, %1, %2" : "=v"(r) : "v"(lo), "v"(hi)); return r; }
__device__ __forceinline__ float sigm(float x) { return __builtin_amdgcn_rcpf(1.0f + __builtin_amdgcn_exp2f(-LOG2E * x)); }
__device__ __forceinline__ float gelu_t(float x) { const float u = 0.7978845608028654f * (x + 0.044715f * x * x * x); return x * sigm(2.0f * u); }
__device__ __forceinline__ float bflo(unsigned w) { return __uint_as_float(w << 16); }
__device__ __forceinline__ float bfhi(unsigned w) { return __uint_as_float(w & 0xffff0000u); }

template <class Epi, class Sched, bool ALIGN_EPI, bool GATHER>
__device__ __forceinline__ void gemm_phase(PG8_LAS unsigned char* lds, const int tid, const int K, const Sched& S, const Epi& E) {
    const int wid = __builtin_amdgcn_readfirstlane(tid >> 6), lane = tid & 63, wr = wid >> 2, wc = wid & 3, fr = lane & 15, fq = lane >> 4;
    const int nt = K / BK;
    unsigned voffA[2], voffB[2];
#pragma unroll
    for (int i = 0; i < 2; ++i) { int R, C; stage_rc(tid * 16 + i * 8192, R, C); const int Rb = Epi::PERM ? ((R & ~31) + perm32(R & 31)) : R;
        voffA[i] = (unsigned)(R * K + C) * 2u; voffB[i] = (unsigned)(Rb * K + C) * 2u; }
    const size_t kstep = (size_t)(BK * 2);
    const size_t hstep = (size_t)HALF * K * 2;
    const unsigned ldsw = (unsigned)wid * 1024u;
    const int aoff = lds_byte(wr * 64 + fr, fq * 8), boff = lds_byte(wc * 32 + fr, fq * 8);
#define PG8_SA(b, h) (((b) * 2 + (h)) * HTB)
#define PG8_SB(b, h) ((4 + (b) * 2 + (h)) * HTB)
#define PG8_STAGE(bufoff, gbase, voff) do { _Pragma("unroll") for (int _i = 0; _i < 2; ++_i) \
        __builtin_amdgcn_global_load_lds((const unsigned*)((const char*)(gbase) + (voff)[_i]), (PG8_LAS unsigned*)(lds + (bufoff) + ldsw + _i * 8192), 16, 0, 0); } while (0)
#define PG8_STAGE_A(bufoff, p, h, VG) do { if constexpr (GATHER) { PG8_STAGE(bufoff, p, VG[h]); } else { PG8_STAGE(bufoff, (p) + (h) * hstep, voffA); } } while (0)
#define PG8_LDA(dst, b, h) do { _Pragma("unroll") for (int m = 0; m < 4; ++m) _Pragma("unroll") for (int k = 0; k < 2; ++k) dst[m][k] = *(const PG8_LAS bf16x8*)(lds + PG8_SA(b, h) + aoff + m * 2048 + k * 1024); } while (0)
#define PG8_LDB(dst, b, h) do { _Pragma("unroll") for (int n = 0; n < 2; ++n) _Pragma("unroll") for (int k = 0; k < 2; ++k) dst[n][k] = *(const PG8_LAS bf16x8*)(lds + PG8_SB(b, h) + boff + n * 2048 + k * 1024); } while (0)
#define PG8_MMA(ai, bj, At, Bt) do { __builtin_amdgcn_s_setprio(1); _Pragma("unroll") for (int m = 0; m < 4; ++m) _Pragma("unroll") for (int n = 0; n < 2; ++n) _Pragma("unroll") for (int k = 0; k < 2; ++k) \
        acc[ai][bj][m][n] = __builtin_amdgcn_mfma_f32_16x16x32_bf16(Bt[n][k], At[m][k], acc[ai][bj][m][n], 0, 0, 0); __builtin_amdgcn_s_setprio(0); } while (0)
#define PG8_WAIT_V(n) asm volatile("s_waitcnt vmcnt(" #n ")" ::: "memory")
#define PG8_WAIT_L(n) asm volatile("s_waitcnt lgkmcnt(" #n ")" ::: "memory")
#define PG8_BAR __builtin_amdgcn_s_barrier()
#define PG8_SCHED __builtin_amdgcn_sched_barrier(0)
#define PG8_LOADVG(VG, ui_) do { if constexpr (GATHER) { _Pragma("unroll") for (int h_ = 0; h_ < 2; ++h_) _Pragma("unroll") for (int i_ = 0; i_ < 2; ++i_) \
        { int R_, C_; stage_rc(tid * 16 + i_ * 8192, R_, C_); VG[h_][i_] = ((unsigned)S.tok((ui_), h_ * HALF + R_) * (unsigned)K + (unsigned)C_) * 2u; } } } while (0)
    Unit cur, nxt; int ui = 0;
    if (!S.next(0, cur)) return;
    f32x4 acc[2][2][4][2];
#pragma unroll
    for (int a = 0; a < 2; ++a)
#pragma unroll
        for (int b = 0; b < 2; ++b)
#pragma unroll
            for (int m = 0; m < 4; ++m)
#pragma unroll
                for (int n = 0; n < 2; ++n) acc[a][b][m][n] = (f32x4){0.f, 0.f, 0.f, 0.f};
    bf16x8 At[4][2], B0[2][2], B1[2][2];
    unsigned vgc[2][2];
#pragma unroll
    for (int h_ = 0; h_ < 2; ++h_)
#pragma unroll
        for (int i_ = 0; i_ < 2; ++i_) vgc[h_][i_] = 0u;
    PG8_LOADVG(vgc, 0);
    const char *cA, *cB; S.bases(cur, cA, cB);
    PG8_STAGE(PG8_SB(0, 0), cB, voffB); PG8_STAGE(PG8_SB(0, 1), cB + hstep, voffB); PG8_STAGE_A(PG8_SA(0, 0), cA, 0, vgc); PG8_STAGE_A(PG8_SA(0, 1), cA, 1, vgc);
    if (wr == 1) PG8_BAR;
    PG8_WAIT_V(2); PG8_BAR;
    PG8_STAGE(PG8_SB(1, 0), cB + kstep, voffB); PG8_STAGE_A(PG8_SA(1, 0), cA + kstep, 0, vgc); PG8_STAGE(PG8_SB(1, 1), cB + hstep + kstep, voffB);
    PG8_WAIT_V(6); PG8_BAR;
    for (;;) {
        const bool has_next = S.next(ui + 1, nxt);
        const char *nA = cA, *nB = cB;
        if (has_next) S.bases(nxt, nA, nB);
        for (int t = 0; t < nt; t += 2) {
            const bool last = (t == nt - 2);
            const char* a1 = cA + (size_t)(t + 1) * kstep;
            const char* a2 = last ? nA : cA + (size_t)(t + 2) * kstep; const char* b2 = last ? nB : cB + (size_t)(t + 2) * kstep;
            const char* a3 = a2 + kstep; const char* b3 = b2 + kstep;
            unsigned vgs[2][2];
#pragma unroll
            for (int h_ = 0; h_ < 2; ++h_)
#pragma unroll
                for (int i_ = 0; i_ < 2; ++i_) vgs[h_][i_] = vgc[h_][i_];
            if (last && has_next) PG8_LOADVG(vgs, ui + 1);
            PG8_LDB(B0, 0, 0); PG8_LDB(B1, 0, 1); PG8_SCHED; PG8_LDA(At, 0, 0); PG8_STAGE_A(PG8_SA(1, 1), a1, 1, vgc);
            PG8_WAIT_V(8); PG8_WAIT_L(0); PG8_BAR; PG8_MMA(0, 0, At, B0); PG8_MMA(0, 1, At, B1); PG8_BAR; PG8_SCHED;
            PG8_LDA(At, 0, 1); PG8_STAGE(PG8_SB(0, 0), b2, voffB); PG8_STAGE(PG8_SB(0, 1), b2 + hstep, voffB); PG8_STAGE_A(PG8_SA(0, 0), a2, 0, vgs);
            PG8_WAIT_V(8); PG8_WAIT_L(0); PG8_BAR; PG8_MMA(1, 0, At, B0); PG8_MMA(1, 1, At, B1); PG8_BAR; PG8_SCHED;
            PG8_LDB(B0, 1, 0); PG8_LDB(B1, 1, 1); PG8_SCHED; PG8_LDA(At, 1, 0); PG8_STAGE_A(PG8_SA(0, 1), a2, 1, vgs);
            PG8_WAIT_V(8); PG8_WAIT_L(0); PG8_BAR; PG8_MMA(0, 0, At, B0); PG8_MMA(0, 1, At, B1); PG8_BAR; PG8_SCHED;
            PG8_LDA(At, 1, 1); PG8_STAGE(PG8_SB(1, 0), b3, voffB); PG8_STAGE(PG8_SB(1, 1), b3 + hstep, voffB); PG8_STAGE_A(PG8_SA(1, 0), a3, 0, vgs);
            PG8_WAIT_V(8); PG8_WAIT_L(0); PG8_BAR; PG8_MMA(1, 0, At, B0); PG8_MMA(1, 1, At, B1); PG8_BAR; PG8_SCHED;
        }
        if constexpr (ALIGN_EPI) { if (wr == 0) PG8_BAR; }
        E(acc, cur, wr, wc, fr, fq);
        if (!has_next) break;
#pragma unroll
        for (int a = 0; a < 2; ++a)
#pragma unroll
            for (int b = 0; b < 2; ++b)
#pragma unroll
                for (int m = 0; m < 4; ++m)
#pragma unroll
                    for (int n = 0; n < 2; ++n) acc[a][b][m][n] = (f32x4){0.f, 0.f, 0.f, 0.f};
        cur = nxt; cA = nA; cB = nB; ++ui;
        PG8_LOADVG(vgc, ui);
        if constexpr (ALIGN_EPI) { if (wr == 1) PG8_BAR; }
    }
    PG8_WAIT_V(0);
    if constexpr (!ALIGN_EPI) { if (wr == 0) PG8_BAR; }
    PG8_BAR;
#undef PG8_SA
#undef PG8_SB
#undef PG8_STAGE
#undef PG8_STAGE_A
#undef PG8_LDA
#undef PG8_LDB
#undef PG8_MMA
#undef PG8_WAIT_V
#undef PG8_WAIT_L
#undef PG8_BAR
#undef PG8_SCHED
#undef PG8_LOADVG
}
}

namespace attn_body {
using bf16=__hip_bfloat16;
using bf16x8=__attribute__((ext_vector_type(8)))short;
using s16x4=__attribute__((ext_vector_type(4)))short;
using f32x16=__attribute__((ext_vector_type(16)))float;
using u32x4=__attribute__((ext_vector_type(4)))unsigned;
constexpr int NHEAD=16,SEQ=2048,D=64,DM=NHEAD*D;
constexpr int NW=8,QBLK=32,QB=QBLK*NW,KVBLK=64,NQB=SEQ/QB;
__device__ __forceinline__ int crow(int r,int hi){return (r&3)+8*(r>>2)+4*hi;}
#define SBAR() __builtin_amdgcn_sched_barrier(0)
__device__ __forceinline__ void cmask(f32x16&p0,f32x16&p1,int jb,int qrel,int hi){
  const float NEG=-INFINITY; const int dq=qrel-(64*jb+4*hi);
  #pragma unroll
  for(int r=0;r<16;++r){const int kc=(r&3)+8*(r>>2); if(kc>dq)p0[r]=NEG; if(kc+32>dq)p1[r]=NEG;}
}
__device__ __forceinline__ void cinit(f32x16&p0,f32x16&p1,float sl2,float nv){
  #pragma unroll
  for(int r=0;r<16;++r){const float c=(float)((r&3)+8*(r>>2)); p0[r]=__builtin_fmaf(sl2,c,nv); p1[r]=__builtin_fmaf(sl2,c+32.0f,nv);}
}
#define CI_C(r) ((float)(((r)&3)+8*((r)>>2)))

constexpr int NSLOT=3, SLOTB=8192;
constexpr int LDS_K=0, LDS_V=NSLOT*SLOTB, LDS_WS=2*NSLOT*SLOTB, LDS_OST=LDS_WS+NW*64*4, LDS_BYTES=LDS_OST+NW*4096;
constexpr float C2=0.125f*1.4426950408889634f;
__device__ __forceinline__ void glds16(const void*gsrc,unsigned lds_dst){unsigned keep;
  asm volatile("s_mov_b32 %0, m0\n\ts_mov_b32 m0, %2\n\ts_nop 0\n\tglobal_load_lds_dwordx4 %1, off\n\ts_mov_b32 m0, %0":"=&s"(keep):"v"(gsrc),"s"(lds_dst):"memory");}
__device__ __forceinline__ float max3f(float a,float b,float c){float r;asm("v_max3_f32 %0, %1, %2, %3":"=v"(r):"v"(a),"v"(b),"v"(c));return r;}
__device__ __forceinline__ float max2f(float a,float b){float r;asm("v_max_f32_e32 %0, %1, %2":"=v"(r):"v"(a),"v"(b));return r;}
__device__ __forceinline__ float fadd_s(float a,float b){float r;asm("v_add_f32_e32 %0, %1, %2":"=v"(r):"v"(a),"v"(b));return r;}
__device__ __forceinline__ float fsub_s(float a,float b){float r;asm("v_sub_f32_e32 %0, %1, %2":"=v"(r):"v"(a),"v"(b));return r;}
typedef float f32x2_t __attribute__((ext_vector_type(2))); typedef __bf16 bf16x2_t __attribute__((ext_vector_type(2)));
__device__ __forceinline__ unsigned cvtpk_s(float lo,float hi){f32x2_t v={lo,hi};bf16x2_t b=__builtin_convertvector(v,bf16x2_t);return __builtin_bit_cast(unsigned,b);}
#define WAIT_BAR(N) asm volatile("s_waitcnt vmcnt(" #N ") lgkmcnt(0)\n\ts_barrier":::"memory")

__device__ __forceinline__ void qkt(f32x16&p0,f32x16&p1,const char*Kslot,const bf16x8*qr,int r32,int hi){
  const char*kb=Kslot+hi*1024+r32*16;
  #pragma unroll
  for(int d0=0;d0<4;++d0){
    const bf16x8 b0=*reinterpret_cast<const bf16x8*>(kb+d0*2048);
    const bf16x8 b1=*reinterpret_cast<const bf16x8*>(kb+d0*2048+512);
    p0=__builtin_amdgcn_mfma_f32_32x32x16_bf16(b0,qr[d0],p0,0,0,0);p1=__builtin_amdgcn_mfma_f32_32x32x16_bf16(b1,qr[d0],p1,0,0,0);}
}
typedef __attribute__((address_space(3))) const char* lds_cptr;
typedef short v4i16_t __attribute__((ext_vector_type(4)));
__device__ __forceinline__ void kload8(bf16x8*kf,lds_cptr kp){
  kf[0]=*(const __attribute__((address_space(3))) bf16x8*)(kp);      kf[1]=*(const __attribute__((address_space(3))) bf16x8*)(kp+512);
  kf[2]=*(const __attribute__((address_space(3))) bf16x8*)(kp+2048); kf[3]=*(const __attribute__((address_space(3))) bf16x8*)(kp+2560);
  kf[4]=*(const __attribute__((address_space(3))) bf16x8*)(kp+4096); kf[5]=*(const __attribute__((address_space(3))) bf16x8*)(kp+4608);
  kf[6]=*(const __attribute__((address_space(3))) bf16x8*)(kp+6144); kf[7]=*(const __attribute__((address_space(3))) bf16x8*)(kp+6656);
}
__device__ __forceinline__ void kload2(bf16x8*kf,lds_cptr kp,int j){ kf[2*j]=*(const __attribute__((address_space(3))) bf16x8*)(kp+j*2048); kf[2*j+1]=*(const __attribute__((address_space(3))) bf16x8*)(kp+j*2048+512); }
__device__ __forceinline__ s16x4 vtr(lds_cptr p){ return __builtin_bit_cast(s16x4,__builtin_amdgcn_ds_read_tr16_b64_v4i16((__attribute__((address_space(3))) v4i16_t*)p)); }
__device__ __forceinline__ float rowmax(const f32x16&p0,const f32x16&p1){
  float a=max3f(p0[0],p0[1],p1[0]),b=max3f(p0[2],p0[3],p1[1]);a=max3f(a,p1[2],p1[3]);
  #pragma unroll
  for(int r=4;r<16;r+=4){a=max3f(a,p0[r],p0[r+1]);b=max3f(b,p0[r+2],p0[r+3]);a=max3f(a,p1[r],p1[r+1]);b=max3f(b,p1[r+2],p1[r+3]);}
  const float m=max2f(a,b);
  auto rr=__builtin_amdgcn_permlane32_swap(__float_as_uint(m),__float_as_uint(m),false,false);
  return max2f(__uint_as_float(rr[0]),__uint_as_float(rr[1]));
}
__device__ __forceinline__ void pv(f32x16*o,int vb,bf16x8 pa0,bf16x8 pa1,bf16x8 pa2,bf16x8 pa3){
  #pragma unroll
  for(int d0=0;d0<2;++d0){s16x4 lo[4],hi[4];
    #pragma unroll
    for(int ks=0;ks<4;++ks){
      asm volatile("ds_read_b64_tr_b16 %0,%1 offset:%c2":"=&v"(lo[ks]):"v"(vb),"i"(d0*4096+ks*1024):"memory");
      asm volatile("ds_read_b64_tr_b16 %0,%1 offset:%c2":"=&v"(hi[ks]):"v"(vb),"i"(d0*4096+ks*1024+512):"memory");}
    asm volatile("s_waitcnt lgkmcnt(0)":::"memory");SBAR();
    #define PK(k) (bf16x8){lo[k][0],lo[k][1],lo[k][2],lo[k][3],hi[k][0],hi[k][1],hi[k][2],hi[k][3]}
    o[d0]=__builtin_amdgcn_mfma_f32_32x32x16_bf16(pa0,PK(0),o[d0],0,0,0);
    o[d0]=__builtin_amdgcn_mfma_f32_32x32x16_bf16(pa1,PK(1),o[d0],0,0,0);
    o[d0]=__builtin_amdgcn_mfma_f32_32x32x16_bf16(pa2,PK(2),o[d0],0,0,0);
    o[d0]=__builtin_amdgcn_mfma_f32_32x32x16_bf16(pa3,PK(3),o[d0],0,0,0);
    #undef PK
  }
}
#define ATTN_STORE16(p,v) (*(u32x4*)(p)=(v))
template<int THRL> __device__ __forceinline__ void attn_unit(const int tid,int b,int hq,int hk,int hv,int qb,float sl2,const bf16*Q,const bf16*__restrict__ K,const bf16*__restrict__ V,bf16*O,char*shm){
  const int lane=tid&63,r32=lane&31,hi=lane>>5; const int wid=__builtin_amdgcn_readfirstlane(tid>>6);
  const long rowbase=(long)b*SEQ; const int q0=qb*QB;
  const bf16*Qw=Q+(rowbase+q0+wid*QBLK)*DM+hq*D;
  const bf16*Kh=K+rowbase*DM+hk*D,*Vh=V+rowbase*DM+hv*D;
  const unsigned lds0=(unsigned)(uintptr_t)shm;
  float*wsf=(float*)(shm+LDS_WS)+wid*64;
  const bf16*ksrc=Kh+(long)lane*DM+wid*8;
  const bf16*vsrc=Vh+(long)(16*(wid&3)+(lane>>2))*DM+(wid>>2)*32+(lane&3)*8;
  const unsigned kdst=lds0+LDS_K+wid*1024, vdst=lds0+LDS_V+wid*1024;
  #define DMA_K(t,slot) glds16(ksrc+(long)(t)*KVBLK*DM,(unsigned)__builtin_amdgcn_readfirstlane(kdst+(slot)))
  #define DMA_V(t,slot) glds16(vsrc+(long)(t)*KVBLK*DM,(unsigned)__builtin_amdgcn_readfirstlane(vdst+(slot)))
  const int vb0=(int)(lds0+LDS_V)+((lane>>4)&1)*32+(lane&3)*8+(4*hi+((lane&15)>>2))*64;
  const char*Kbase=shm+LDS_K; bf16x8 kf[8];
  const lds_cptr shm3=(lds_cptr)shm; const lds_cptr kp0=shm3+LDS_K+hi*1024+r32*16; const lds_cptr vp0=shm3+LDS_V+((lane>>4)&1)*32+(lane&3)*8+(4*hi+((lane&15)>>2))*64;
  const int NT=(q0+QB)/KVBLK;
  DMA_K(0,0);DMA_V(0,0);DMA_K(1,SLOTB);
  bf16x8 qr[4];
  #pragma unroll
  for(int d0=0;d0<4;++d0)qr[d0]=*reinterpret_cast<const bf16x8*>(&Qw[(long)r32*DM+d0*16+hi*8]);
  const float tb0=sl2*(float)(4*hi);
  float mhat=0.f,l_reg=0.f;f32x16 o[2];o[0]=f32x16{};o[1]=f32x16{};
  const int qrel=wid*QBLK+r32;
  #define CMASK(P0,P1,t) do{int jb_=(t)-(NT-4); if(jb_>=0)cmask(P0,P1,jb_,qrel,hi);}while(0)
  #define NVAL(tt) (__builtin_fmaf(sl2,(float)(64*(tt)),tb0)-mhat)
  bool resc=false;
  #define START(P0,P1) do{ const float rm=rowmax(P0,P1); resc=false; \
    { const float dl=rm; mhat=fadd_s(mhat,dl); \
      _Pragma("unroll") for(int r=0;r<16;++r){P0[r]=fsub_s(P0[r],dl);P1[r]=fsub_s(P1[r],dl);} } \
    _Pragma("unroll") for(int r=0;r<16;++r)P0[r]=__builtin_amdgcn_exp2f(P0[r]); }while(0)
  #define RESC() do{ if(resc){ asm volatile("s_waitcnt lgkmcnt(0)":::"memory"); \
      _Pragma("unroll") for(int d_=0;d_<2;++d_) _Pragma("unroll") for(int r=0;r<16;++r)o[d_][r]*=wsf[crow(r,hi)]; } }while(0)
  f32x16 pA0,pA1,pB0,pB1;
  int sl_prev=0,sl_cur=0,sl_next=SLOTB;
  #define ROT() do{sl_prev=sl_cur;sl_cur=sl_next;sl_next=(sl_next==(NSLOT-1)*SLOTB)?0:sl_next+SLOTB;}while(0)
  DMA_K(2,2*SLOTB);
  WAIT_BAR(3);
  cinit(pA0,pA1,sl2,tb0);
  qkt(pA0,pA1,Kbase,qr,r32,hi);asm volatile("s_nop 15\n\ts_nop 7":"+v"(pA0),"+v"(pA1));CMASK(pA0,pA1,0);
  START(pA0,pA1);
  _Pragma("unroll") for(int r=0;r<16;++r)pA1[r]=__builtin_amdgcn_exp2f(pA1[r]);
  WAIT_BAR(0);
  DMA_K(3,0);DMA_V(1,SLOTB);
  ROT();
  kload8(kf,kp0+sl_cur);
  WAIT_BAR(2);
  s16x4 vlo[8],vhi[8]; u32x4 pw0,pw1,pw2,pw3;
  #define PKW(P,B) cvtpk_s(P[B],P[B+1])
  #define PAF(k) __builtin_bit_cast(bf16x8,pw##k)
  #define VFR(i) (bf16x8){vlo[i][0],vlo[i][1],vlo[i][2],vlo[i][3],vhi[i][0],vhi[i][1],vhi[i][2],vhi[i][3]}
  #define PIN(x) asm volatile("":"+v"(x))
  #define MX3(a,b,c) __builtin_fmaxf(__builtin_fmaxf((a),(b)),(c))
  #define GAPA(MF,A0,A1,A2,A3,W0,W1,PW) do{ MF; sacc+=A0; sacc+=A1; sacc+=A2; sacc+=A3; PIN(sacc); W0; W1; PIN(PW); SBAR(); }while(0)
  #define EX(v) __builtin_amdgcn_exp2f(v)
  #define GAPB(MF,X,B,Y,OFS) do{ MF; X[B]=EX(X[B]); X[B+1]=EX(X[B+1]); X[B+2]=EX(X[B+2]); X[B+3]=EX(X[B+3]); PIN(X); \
    SBAR(); }while(0)
  #define VRD(i) do{ vlo[i]=vtr(vp_+(((i)>>2)*4096+((i)&3)*1024)); vhi[i]=vtr(vp_+(((i)>>2)*4096+((i)&3)*1024+512)); }while(0)
  #define KRD(G,j) do{ if(G){ kload2(kf,kp0+sl_next,j); SBAR(); } }while(0)
  #define STEP(C0,C1,P0,P1,t,GK,GV,GL) do{ cinit(C0,C1,sl2,NVAL(t)); SBAR(); \
    const lds_cptr vp_=vp0+sl_prev; \
    VRD(0); SBAR(); float sacc=(P0[0]+P0[1]); \
    GAPA(C0=__builtin_amdgcn_mfma_f32_32x32x16_bf16(kf[0],qr[0],C0,0,0,0), P0[2],P0[3],P0[4],P0[5],     pw0[0]=PKW(P0,0), pw0[1]=PKW(P0,2), pw0); \
    VRD(4); SBAR(); GAPA(C1=__builtin_amdgcn_mfma_f32_32x32x16_bf16(kf[1],qr[0],C1,0,0,0), P0[6],P0[7],P0[8],P0[9],     pw0[2]=PKW(P0,4), pw0[3]=PKW(P0,6), pw0); \
    VRD(1); SBAR(); GAPA(C0=__builtin_amdgcn_mfma_f32_32x32x16_bf16(kf[2],qr[1],C0,0,0,0),   P0[10],P0[11],P0[12],P0[13], pw1[0]=PKW(P0,8), pw1[1]=PKW(P0,10), pw1); \
    VRD(5); SBAR(); GAPA(C1=__builtin_amdgcn_mfma_f32_32x32x16_bf16(kf[3],qr[1],C1,0,0,0),   P0[14],P0[15],P1[0],P1[1],   pw1[2]=PKW(P0,12),pw1[3]=PKW(P0,14), pw1); \
    VRD(2); SBAR(); GAPA(C0=__builtin_amdgcn_mfma_f32_32x32x16_bf16(kf[4],qr[2],C0,0,0,0),   P1[2],P1[3],P1[4],P1[5],     pw2[0]=PKW(P1,0), pw2[1]=PKW(P1,2), pw2); \
    VRD(6); SBAR(); GAPA(C1=__builtin_amdgcn_mfma_f32_32x32x16_bf16(kf[5],qr[2],C1,0,0,0),   P1[6],P1[7],P1[8],P1[9],     pw2[2]=PKW(P1,4), pw2[3]=PKW(P1,6), pw2); \
    VRD(3); SBAR(); GAPA(C0=__builtin_amdgcn_mfma_f32_32x32x16_bf16(kf[6],qr[3],C0,0,0,0),   P1[10],P1[11],P1[12],P1[13], pw3[0]=PKW(P1,8), pw3[1]=PKW(P1,10), pw3); \
    VRD(7); SBAR(); GAPA(C1=__builtin_amdgcn_mfma_f32_32x32x16_bf16(kf[7],qr[3],C1,0,0,0),   P1[14],P1[15],0.f,0.f,       pw3[2]=PKW(P1,12),pw3[3]=PKW(P1,14), pw3); \
    l_reg+=sacc; \
    if(GK){DMA_K((t)+3,sl_cur);} if(GV){DMA_V((t)+1,sl_next);} \
    CMASK(C0,C1,t); \
    { float a=MX3(C0[0],C0[1],C1[0]),b=MX3(C0[2],C0[3],C1[1]); a=MX3(a,C1[2],C1[3]); \
      _Pragma("unroll") for(int r=4;r<16;r+=4){a=MX3(a,C0[r],C0[r+1]);b=MX3(b,C0[r+2],C0[r+3]);a=MX3(a,C1[r],C1[r+1]);b=MX3(b,C1[r+2],C1[r+3]);} \
      float rm=__builtin_fmaxf(a,b); { auto rr=__builtin_amdgcn_permlane32_swap(__float_as_uint(rm),__float_as_uint(rm),false,false); rm=__builtin_fmaxf(__uint_as_float(rr[0]),__uint_as_float(rr[1])); } \
      resc=false; \
      if(__builtin_expect(__any(rm>(float)THRL),0)){ const float dl=__builtin_fmaxf(rm,0.f); mhat+=dl; \
        _Pragma("unroll") for(int r=0;r<16;++r){C0[r]-=dl;C1[r]-=dl;} \
        const float f=__builtin_amdgcn_exp2f(-dl); l_reg*=f; if(hi==0)wsf[r32]=f; resc=true; } \
      } \
    SBAR(); \
    GAPB(o[0]=__builtin_amdgcn_mfma_f32_32x32x16_bf16(PAF(0),VFR(0),o[0],0,0,0), C0,0,P0,0.0f); \
    GAPB(o[1]=__builtin_amdgcn_mfma_f32_32x32x16_bf16(PAF(0),VFR(4),o[1],0,0,0), C0,4,P0,0.0f); \
    KRD(GL,0); GAPB(o[0]=__builtin_amdgcn_mfma_f32_32x32x16_bf16(PAF(1),VFR(1),o[0],0,0,0), C0,8,P0,0.0f); \
    KRD(GL,1); GAPB(o[1]=__builtin_amdgcn_mfma_f32_32x32x16_bf16(PAF(1),VFR(5),o[1],0,0,0), C0,12,P0,0.0f); \
    KRD(GL,2); GAPB(o[0]=__builtin_amdgcn_mfma_f32_32x32x16_bf16(PAF(2),VFR(2),o[0],0,0,0), C1,0,P1,32.0f); \
    KRD(GL,3); GAPB(o[1]=__builtin_amdgcn_mfma_f32_32x32x16_bf16(PAF(2),VFR(6),o[1],0,0,0), C1,4,P1,32.0f); \
    GAPB(o[0]=__builtin_amdgcn_mfma_f32_32x32x16_bf16(PAF(3),VFR(3),o[0],0,0,0), C1,8,P1,32.0f); \
    GAPB(o[1]=__builtin_amdgcn_mfma_f32_32x32x16_bf16(PAF(3),VFR(7),o[1],0,0,0), C1,12,P1,32.0f); \
    }while(0)
  int t=1;
  #undef CMASK
  #define CMASK(P0,P1,t) do{}while(0)
  for(;t+5<NT;t+=2){
    STEP(pB0,pB1,pA0,pA1,t,true,true,true);     WAIT_BAR(2); RESC(); ROT();
    STEP(pA0,pA1,pB0,pB1,t+1,true,true,true);   WAIT_BAR(2); RESC(); ROT();
  }
  #undef CMASK
  #define CMASK(P0,P1,t) do{int jb_=(t)-(NT-4); if(jb_>=0)cmask(P0,P1,jb_,qrel,hi);}while(0)
  #define ENDW(tt) do{ if((tt)+3<NT){WAIT_BAR(2);} else if((tt)+2<NT){WAIT_BAR(1);} else {WAIT_BAR(0);} }while(0)
  for(;t+1<NT;t+=2){
    STEP(pB0,pB1,pA0,pA1,t,(t+3<NT),(t+1<NT),(t+1<NT));       ENDW(t);   RESC(); ROT();
    STEP(pA0,pA1,pB0,pB1,t+1,(t+4<NT),(t+2<NT),(t+2<NT));     ENDW(t+1); RESC(); ROT();
  }
  STEP(pB0,pB1,pA0,pA1,NT-1,false,false,false); RESC();
  { float sacc=pB0[0]+pB0[1]; _Pragma("unroll") for(int r=2;r<16;++r)sacc+=pB0[r]; _Pragma("unroll") for(int r=0;r<16;++r)sacc+=pB1[r]; l_reg+=sacc;
    pw0=(u32x4){PKW(pB0,0),PKW(pB0,2),PKW(pB0,4),PKW(pB0,6)};pw1=(u32x4){PKW(pB0,8),PKW(pB0,10),PKW(pB0,12),PKW(pB0,14)};pw2=(u32x4){PKW(pB1,0),PKW(pB1,2),PKW(pB1,4),PKW(pB1,6)};pw3=(u32x4){PKW(pB1,8),PKW(pB1,10),PKW(pB1,12),PKW(pB1,14)};
    SBAR(); pv(o,vb0+sl_cur,PAF(0),PAF(1),PAF(2),PAF(3)); }
  #undef PKW
  #undef PAF
  #undef VFR
  #undef PIN
  #undef MX3
  #undef GAPA
  #undef GAPB
  #undef EX
  #undef VRD
  #undef KRD
  #undef STEP
  #undef ENDW
  {auto rr=__builtin_amdgcn_permlane32_swap(__float_as_uint(l_reg),__float_as_uint(l_reg),false,false);l_reg=__uint_as_float(rr[0])+__uint_as_float(rr[1]);}
  if(hi==0)wsf[32+r32]=l_reg;asm volatile("s_waitcnt lgkmcnt(0)":::"memory");
  float rli[16];
  #pragma unroll
  for(int r=0;r<16;++r)rli[r]=__builtin_amdgcn_rcpf(wsf[32+crow(r,hi)]);
  bf16*Ow=O+(rowbase+q0+wid*QBLK)*DM+hv*D;
  { bf16*stg=(bf16*)(shm+LDS_OST)+wid*2048;
    #pragma unroll
    for(int r=0;r<16;++r){const int orow=crow(r,hi);
      #pragma unroll
      for(int d0=0;d0<2;++d0)stg[orow*64+d0*32+r32]=__float2bfloat16(o[d0][r]*rli[r]);}
    asm volatile("s_waitcnt lgkmcnt(0)":::"memory");
    #pragma unroll
    for(int i=0;i<4;++i){const int row=i*8+(lane>>3),ch=lane&7; const u32x4 v=*(const u32x4*)(stg+row*64+ch*8); ATTN_STORE16(Ow+(long)row*DM+ch*8,v);} }
  asm volatile("s_waitcnt lgkmcnt(0)\n\ts_barrier":::"memory");
  #undef DMA_K
  #undef DMA_V
  #undef CMASK
  #undef NVAL
  #undef START
  #undef RESC
  #undef ROT
}
constexpr int ATTN_LDS_BYTES=LDS_BYTES;
#undef SBAR
#undef WAIT_BAR
}

constexpr int NWAVES = 8;
constexpr int N_LAUNCHES = MK_N_LAUNCHES;
constexpr int N_PHASES = 9 + 2 * NCH + 1;
constexpr bool PER_PHASE = (MK_N_LAUNCHES != 1);

constexpr size_t MiB = 1u << 20;
constexpr size_t ACT = (size_t)T * D * 2;
constexpr size_t WS_CTL = 0, CTL_ZERO_BYTES = 65536;
constexpr size_t WS_MOD = 1 * MiB;
constexpr size_t WS_WIN = 2 * MiB;
constexpr size_t WS_WR = 16 * MiB, WS_WA = 18 * MiB, WS_WO = 20 * MiB;
constexpr size_t WS_LW = 22 * MiB;
constexpr size_t WS_H = 24 * MiB;
constexpr size_t WS_XR = WS_H + ACT;
constexpr size_t WS_GR = WS_XR + ACT;
constexpr size_t WS_Q = WS_GR + ACT;
constexpr size_t WS_K = WS_Q + ACT;
constexpr size_t WS_V = WS_K + ACT;
constexpr size_t WS_O1 = WS_V + ACT;
constexpr size_t WS_END = WS_O1 + ACT;
static_assert(WS_END <= 512 * MiB, "ws map");
constexpr size_t WS_W13 = WS_GR;
constexpr size_t WS_W2 = WS_O1;
constexpr size_t WS_W13S = WS_O1 + 32 * MiB;
constexpr size_t WS_W2S = WS_O1 + 33 * MiB;
constexpr size_t WS_LIST = WS_O1 + 34 * MiB;
constexpr size_t WS_WTS = WS_O1 + 42 * MiB;
constexpr size_t WS_RDEST = WS_O1 + 43 * MiB;
constexpr size_t WS_RWT = WS_O1 + 44 * MiB;
constexpr int MAXRT = TC * TOPK / 256 + NEXP + TC / 256;
constexpr int MAXROWS = MAXRT * 256;
constexpr size_t WS_HB = WS_XR;
constexpr size_t WS_SLOT = WS_Q;
constexpr size_t WS_Y = WS_Q;
static_assert(WS_SLOT + (size_t)(TC * 9) * D * 2 <= WS_O1 && (size_t)MAXROWS * 512 <= ACT, "moe map");
constexpr int CW_TMO = 0;
constexpr int CW_BAR = 4096;
constexpr int CW_CNT = 8192;

constexpr int RING_BYTES = 139264;
constexpr int MISC_OFF = RING_BYTES;
constexpr int LDS_BYTES = 155648;
constexpr int MI_BARST = 0;
constexpr int MI_CNT = 64;
constexpr int MI_TBASE = 128;
constexpr int MI_TILE_E = 256;
constexpr int MI_TOK = 1024;
constexpr int MI_WORDS = 4096;

#define GAS __attribute__((address_space(1)))
#define LAS __attribute__((address_space(3)))
typedef unsigned short bf16;
typedef unsigned v4u __attribute__((ext_vector_type(4)));
typedef unsigned v2u __attribute__((ext_vector_type(2)));
typedef float f32x4 __attribute__((ext_vector_type(4)));
typedef float f32x16 __attribute__((ext_vector_type(16)));
typedef short bf16x8 __attribute__((ext_vector_type(8)));
typedef GAS unsigned gu32;
#define RLX_AGENT __ATOMIC_RELAXED, __HIP_MEMORY_SCOPE_AGENT
#define LDS_WAIT() asm volatile("s_waitcnt lgkmcnt(0)" ::: "memory")
#define VM_WAIT() asm volatile("s_waitcnt vmcnt(0)" ::: "memory")
__device__ __forceinline__ unsigned f2bf(float f) { unsigned u = __builtin_bit_cast(unsigned, f); return (u + 0x7fffu + ((u >> 16) & 1u)) >> 16; }
__device__ __forceinline__ unsigned pk2(float lo, float hi) { return f2bf(lo) | (f2bf(hi) << 16); }
__device__ __forceinline__ float bf2f(unsigned h) { return __uint_as_float(h << 16); }
using pg8::bflo; using pg8::bfhi; using pg8::sigm;

#define XB_TMO      128
#define XB_XCNT(j)  (256  + 64 * (j))
#define XB_XSUB(j)  (1280 + 64 * (j))
#define XB_XGEN(j)  (2304 + 64 * (j))
#define XB_TOP      3328
#define XB_TOPGEN   3392
#define XCD_BAR_WORDS 3456
#define XB_SPIN_CAP (1u << 18)
__device__ __forceinline__ unsigned xb_ld(unsigned* p)              { return __hip_atomic_load(p, __ATOMIC_RELAXED, __HIP_MEMORY_SCOPE_AGENT); }
__device__ __forceinline__ unsigned xb_add(unsigned* p, unsigned v) { return __hip_atomic_fetch_add(p, v, __ATOMIC_RELAXED, __HIP_MEMORY_SCOPE_AGENT); }
__device__ __forceinline__ unsigned xb_xcc_id() { return (unsigned)__builtin_amdgcn_s_getreg((3 << 11) | 20) & 0xFu; }
#define XB_SPIN(cond, bar) do { unsigned _sp = 0; while (cond) { __builtin_amdgcn_s_sleep(1); \
    if ((++_sp & 255u) == 0u) { if (xb_ld(&(bar)[XB_TMO])) break; if (_sp > XB_SPIN_CAP) { atomicAdd(&(bar)[XB_TMO], 1u); break; } } } } while (0)
struct XcdBarrier { unsigned* bar; unsigned x; volatile LAS unsigned* st; };
__device__ __forceinline__ XcdBarrier xcd_barrier_post(unsigned* bar, volatile LAS unsigned* st) {
    XcdBarrier b; b.bar = bar; b.x = xb_xcc_id(); b.st = st;
    if (threadIdx.x == 0) (void)xb_add(&bar[XB_XCNT(b.x)], 1u);
    return b;
}
__device__ __forceinline__ void xcd_barrier_complete(unsigned* bar, unsigned x, unsigned& nloc, unsigned& nx) {
    const unsigned G = gridDim.x * gridDim.y * gridDim.z;
    unsigned sum, cnt, mine, sp = 0u;
    for (;;) {
        sum = 0u; cnt = 0u; mine = 0u;
#pragma unroll
        for (unsigned j = 0; j < 16; ++j) { const unsigned c = xb_ld(&bar[XB_XCNT(j)]); sum += c; cnt += (c > 0u) ? 1u : 0u; mine = (j == x) ? c : mine; }
        if (sum == G) break;
        __builtin_amdgcn_s_sleep(1);
        if ((++sp & 255u) == 0u) { if (xb_ld(&bar[XB_TMO])) break; if (sp > XB_SPIN_CAP) { atomicAdd(&bar[XB_TMO], 1u); break; } }
    }
    nloc = mine > 0u ? mine : 1u; nx = cnt > 0u ? cnt : 1u;
}
__device__ __forceinline__ void xcd_barrier(const XcdBarrier& b) {
    asm volatile("s_waitcnt vmcnt(0)" ::: "memory");
    __syncthreads();
    if (threadIdx.x == 0) {
        unsigned* bar = b.bar; asm volatile("" : "+s"(bar));
        __builtin_amdgcn_s_waitcnt(0);
        unsigned nloc = b.st[0], nx = b.st[1];
        if (nloc == 0u) { xcd_barrier_complete(bar, b.x, nloc, nx); b.st[0] = nloc; b.st[1] = nx; }
        const unsigned old = xb_add(&bar[XB_XSUB(b.x)], 1u);
        const unsigned gen = old / nloc;
        if (old + 1u == (gen + 1u) * nloc) {
            __builtin_amdgcn_fence(__ATOMIC_RELEASE, "agent");
            asm volatile("s_waitcnt vmcnt(0)" ::: "memory");
            const unsigned og = xb_add(&bar[XB_TOP], 1u);
            const unsigned tg = og / nx;
            if (og + 1u == (tg + 1u) * nx) xb_add(&bar[XB_TOPGEN], 1u);
            else XB_SPIN(xb_ld(&bar[XB_TOPGEN]) == tg, bar);
            __builtin_amdgcn_fence(__ATOMIC_ACQUIRE, "agent");
            xb_add(&bar[XB_XGEN(b.x)], 1u);
            asm volatile("s_waitcnt vmcnt(0)" ::: "memory");
        } else {
            XB_SPIN(xb_ld(&bar[XB_XGEN(b.x)]) == gen, bar);
            __builtin_amdgcn_fence(__ATOMIC_ACQUIRE, "agent");
            asm volatile("s_waitcnt vmcnt(0)" ::: "memory");
        }
    }
    __syncthreads();
}

struct Frame {
    LAS unsigned char* lds;
    volatile LAS int* MI;
    gu32* ctl;
    int tid, lane, wave, vcu, G;
    float* out;
    unsigned char* ws;
};
struct Args { const float* in[32]; float* out; unsigned char* ws; int ph_lo, ph_hi; };
__device__ __forceinline__ float wave_sum(float v) {
#pragma unroll
    for (int o = 1; o < 64; o <<= 1) v += __shfl_xor(v, o);
    return v;
}

__device__ __forceinline__ void transpose_item(const float* W, int K, int N, bf16* WT, int kb, int n0, int drow0, LAS float* scr, int lane) {
    const int k0 = 64 * kb;
#pragma unroll 8
    for (int i = 0; i < 32; ++i) { const int kk = 2 * i + (lane >> 5); scr[kk * 33 + (lane & 31)] = W[(size_t)(k0 + kk) * N + n0 + (lane & 31)]; }
    LDS_WAIT(); asm volatile("" ::: "memory");
    const int c = lane & 7;
#pragma unroll
    for (int j = 0; j < 4; ++j) { const int n = (lane >> 3) + 8 * j; const LAS float* s = scr + (8 * c) * 33 + n;
        v4u o; o.x = pk2(s[0 * 33], s[1 * 33]); o.y = pk2(s[2 * 33], s[3 * 33]); o.z = pk2(s[4 * 33], s[5 * 33]); o.w = pk2(s[6 * 33], s[7 * 33]);
        *(GAS v4u*)(WT + (size_t)(drow0 + n) * K + k0 + 8 * c) = o; }
    LDS_WAIT(); asm volatile("" ::: "memory");
}

__device__ __forceinline__ void p0_phase(Frame& F, const Args& A) {
    unsigned char* ws = F.ws;
    LAS float* sc = (LAS float*)F.lds;
    for (int i = F.tid; i < BATCH * D; i += NWAVES * 64) { const int b = i >> 10, k = i & 1023; const float v = A.in[1][i]; sc[k * 16 + b] = v * sigm(v); }
    __syncthreads();
    const int gw = F.vcu * NWAVES + F.wave, NGW = F.G * NWAVES;
    for (int task = gw; task < 6 * D / 16; task += NGW) {
        const int col = task * 16 + (F.lane & 15), kq = F.lane >> 4;
        float acc[16];
#pragma unroll
        for (int b = 0; b < 16; ++b) acc[b] = 0.f;
        const float* wp = A.in[2] + (size_t)(256 * kq) * (6 * D) + col;
        const LAS f32x4* sp = (const LAS f32x4*)(sc + (256 * kq) * 16);
#pragma unroll 4
        for (int kk = 0; kk < 256; ++kk) { const float w = wp[(size_t)kk * (6 * D)];
#pragma unroll
            for (int q = 0; q < 4; ++q) { const f32x4 s = sp[kk * 4 + q]; acc[4 * q + 0] += w * s.x; acc[4 * q + 1] += w * s.y; acc[4 * q + 2] += w * s.z; acc[4 * q + 3] += w * s.w; } }
#pragma unroll
        for (int b = 0; b < 16; ++b) { acc[b] += __shfl_xor(acc[b], 16); acc[b] += __shfl_xor(acc[b], 32); }
        if (F.lane < 16) { const float bb = A.in[3][col]; float* mod = (float*)(ws + WS_MOD);
#pragma unroll
            for (int b = 0; b < 16; ++b) mod[b * (6 * D) + col] = acc[b] + bb; }
    }
    __syncthreads();
    LAS float* scr = (LAS float*)(F.lds + F.wave * 16384);
    constexpr int I_IN = 16 * (W_IN / 32), I_SQ = 16 * 32, I_LW = 16 * 8;
    constexpr int NITEMS = I_IN + 3 * I_SQ + I_LW;
    for (int it = gw; it < NITEMS; it += NGW) {
        int r = it;
        if (r < I_IN) { transpose_item(A.in[5], D, W_IN, (bf16*)(ws + WS_WIN), r / (W_IN / 32), 32 * (r % (W_IN / 32)), 32 * (r % (W_IN / 32)), scr, F.lane); continue; } r -= I_IN;
        if (r < I_SQ) { transpose_item(A.in[18], D, D, (bf16*)(ws + WS_WR), r / 32, 32 * (r % 32), 32 * (r % 32), scr, F.lane); continue; } r -= I_SQ;
        if (r < I_SQ) { transpose_item(A.in[19], D, D, (bf16*)(ws + WS_WA), r / 32, 32 * (r % 32), 32 * (r % 32), scr, F.lane); continue; } r -= I_SQ;
        if (r < I_SQ) { transpose_item(A.in[20], D, D, (bf16*)(ws + WS_WO), r / 32, 32 * (r % 32), 32 * (r % 32), scr, F.lane); continue; } r -= I_SQ;
        { const int mat = r >> 3, q = r & 7, gate = mat >> 3, n = mat & 7;
          const float* W = (gate ? A.in[10] : A.in[8]) + (size_t)n * 128 * 128;
          transpose_item(W, 128, 128, (bf16*)(ws + WS_LW) + (size_t)(n * 2 + gate) * 128 * 128, q >> 2, 32 * (q & 3), 32 * (q & 3), scr, F.lane); }
    }
}

__device__ __forceinline__ void p1_phase(Frame& F, const Args& A) {
    const int gw = F.vcu * NWAVES + F.wave, NGW = F.G * NWAVES;
    const float* mod = (const float*)(F.ws + WS_MOD);
    bf16* H = (bf16*)(F.ws + WS_H);
    for (int grp = gw; grp < T / 16; grp += NGW) {
        const int b = (grp * 16) / SEQ;
        f32x4 g[4], sc[4], sh[4];
#pragma unroll
        for (int j = 0; j < 4; ++j) { const int c = 4 * F.lane + 256 * j; g[j] = *(const f32x4*)(A.in[4] + c); sh[j] = *(const f32x4*)(mod + b * 6 * D + c); sc[j] = *(const f32x4*)(mod + b * 6 * D + D + c);
            g[j] = g[j] * (sc[j] + 1.0f); }
        for (int rr = 0; rr < 16; ++rr) {
            const size_t m = (size_t)grp * 16 + rr;
            const GAS f32x4* xr = (const GAS f32x4*)(A.in[0] + m * D) + F.lane;
            f32x4 v[4]; float s = 0.f;
#pragma unroll
            for (int j = 0; j < 4; ++j) { v[j] = xr[64 * j]; s += (v[j].x * v[j].x + v[j].y * v[j].y) + (v[j].z * v[j].z + v[j].w * v[j].w); }
            const float rstd = 1.f / sqrtf(wave_sum(s) * (1.f / D) + EPS);
            GAS v2u* o8 = (GAS v2u*)(H + m * D) + F.lane;
#pragma unroll
            for (int j = 0; j < 4; ++j) { const f32x4 y = v[j] * rstd * g[j] + sh[j]; v2u w; w.x = pk2(y.x, y.y); w.y = pk2(y.z, y.w); o8[64 * j] = w; }
        }
    }
}

struct DenseOrder {
    const char* A; const char* Bt; int nM, nN, nwg, G, c; size_t tstep;
    __device__ __forceinline__ void init(const void* A_, const void* Bt_, int M, int N, int K, int G_, int c_) { A = (const char*)A_; Bt = (const char*)Bt_; nM = M / 256; nN = N / 256; nwg = nM * nN; G = G_; c = c_; tstep = (size_t)256 * K * 2; }
    __device__ __forceinline__ bool next(int i, pg8::Unit& u) const {
        const long L = (long)i * G + c; if (L >= nwg) return false;
        int wgid = (int)L; { const int q = nwg / 8, r = nwg % 8, xcd = wgid % 8, off = wgid / 8; wgid = (xcd < r ? xcd * (q + 1) : r * (q + 1) + (xcd - r) * q) + off; }
        const int nig = 8 * nN, gid = wgid / nig, fm = gid * 8, gsz = (nM - fm) < 8 ? (nM - fm) : 8;
        u.pm = fm + ((wgid % nig) % gsz); u.pn = (wgid % nig) / gsz; u.z = 0; u.e = 0; return true;
    }
    __device__ __forceinline__ void bases(const pg8::Unit& u, const char*& a, const char*& b) const { a = A + (size_t)u.pm * tstep; b = Bt + (size_t)u.pn * tstep; }
    __device__ __forceinline__ int tok(int, int) const { return 0; }
};
struct MergeOrder {
    DenseOrder d; const char *A1, *B1;
    __device__ __forceinline__ bool next(int i, pg8::Unit& u) const { if (!d.next(i >> 1, u)) return false; u.z = i & 1; return true; }
    __device__ __forceinline__ void bases(const pg8::Unit& u, const char*& a, const char*& b) const { a = (u.z ? A1 : d.A) + (size_t)u.pm * d.tstep; b = (u.z ? B1 : d.Bt) + (size_t)u.pn * d.tstep; }
    __device__ __forceinline__ int tok(int, int) const { return 0; }
};
typedef pg8::f32x4 acc_t[2][2][4][2];
struct EpiProj {
    static constexpr bool PERM = true;
    bf16* ws5; bf16* dout2;
    __device__ __forceinline__ void operator()(const acc_t& acc, const pg8::Unit& u, int wr, int wc, int fr, int fq) const {
        const int t = u.pn >> 2, colt = (u.pn & 3) * 256;
        bf16* base = (t < 5) ? ws5 + (size_t)t * T * D : dout2 + (size_t)(t - 5) * T * D;
        const int row0 = u.pm * 256 + wr * 64 + fr, col0 = colt + wc * 32 + 8 * fq;
#pragma unroll
        for (int ai = 0; ai < 2; ++ai)
#pragma unroll
            for (int m = 0; m < 4; ++m) { bf16* rowp = base + (size_t)(row0 + ai * 128 + m * 16) * D + col0;
#pragma unroll
                for (int bj = 0; bj < 2; ++bj) { pg8::f32x4 v0 = acc[ai][bj][m][0], v1 = acc[ai][bj][m][1];
                    if (t == 1) { for (int i = 0; i < 4; ++i) { v0[i] = pg8::gelu_t(v0[i]); v1[i] = pg8::gelu_t(v1[i]); } }
                    else if (t == 2) { v0 = v0 * attn_body::C2; v1 = v1 * attn_body::C2; }
                    else if (t >= 5) { for (int i = 0; i < 4; ++i) { v0[i] = sigm(v0[i]); v1[i] = sigm(v1[i]); } }
                    v4u w; w.x = pg8::cvt_pk_bf16(v0[0], v0[1]); w.y = pg8::cvt_pk_bf16(v0[2], v0[3]); w.z = pg8::cvt_pk_bf16(v1[0], v1[1]); w.w = pg8::cvt_pk_bf16(v1[2], v1[3]);
                    *(v4u*)(rowp + bj * 128) = w; } }
    }
};
struct EpiGate {
    static constexpr bool PERM = true;
    const bf16* GA; const bf16* GB; bf16* YA; bf16* MG;
    __device__ __forceinline__ void operator()(const acc_t& acc, const pg8::Unit& u, int wr, int wc, int fr, int fq) const {
        const int row0 = u.pm * 256 + wr * 64 + fr, col0 = u.pn * 256 + wc * 32 + 8 * fq;
        const bf16* G = u.z ? GB : GA; bf16* O = u.z ? MG : YA;
#pragma unroll
        for (int ai = 0; ai < 2; ++ai)
#pragma unroll
            for (int m = 0; m < 4; ++m) { const size_t off = (size_t)(row0 + ai * 128 + m * 16) * D + col0;
#pragma unroll
                for (int bj = 0; bj < 2; ++bj) { const v4u g = *(const v4u*)(G + off + bj * 128); pg8::f32x4 v0 = acc[ai][bj][m][0], v1 = acc[ai][bj][m][1];
                    v0[0] *= bflo(g.x); v0[1] *= bfhi(g.x); v0[2] *= bflo(g.y); v0[3] *= bfhi(g.y); v1[0] *= bflo(g.z); v1[1] *= bfhi(g.z); v1[2] *= bflo(g.w); v1[3] *= bfhi(g.w);
                    if (u.z) { const v4u y = *(const v4u*)(YA + off + bj * 128);
                        v0[0] += bflo(y.x); v0[1] += bfhi(y.x); v0[2] += bflo(y.y); v0[3] += bfhi(y.y); v1[0] += bflo(y.z); v1[1] += bfhi(y.z); v1[2] += bflo(y.w); v1[3] += bfhi(y.w); }
                    v4u w; w.x = pg8::cvt_pk_bf16(v0[0], v0[1]); w.y = pg8::cvt_pk_bf16(v0[2], v0[3]); w.z = pg8::cvt_pk_bf16(v1[0], v1[1]); w.w = pg8::cvt_pk_bf16(v1[2], v1[3]);
                    *(v4u*)(O + off + bj * 128) = w; }
                asm volatile("" ::: "memory"); }
    }
};
struct EpiF32 {
    static constexpr bool PERM = true;
    float* Y;
    __device__ __forceinline__ void operator()(const acc_t& acc, const pg8::Unit& u, int wr, int wc, int fr, int fq) const {
        const int row0 = u.pm * 256 + wr * 64 + fr, col0 = u.pn * 256 + wc * 32 + 8 * fq;
#pragma unroll
        for (int ai = 0; ai < 2; ++ai)
#pragma unroll
            for (int m = 0; m < 4; ++m) { float* rowp = Y + (size_t)(row0 + ai * 128 + m * 16) * D + col0;
#pragma unroll
                for (int bj = 0; bj < 2; ++bj) { *(pg8::f32x4*)(rowp + bj * 128) = acc[ai][bj][m][0]; *(pg8::f32x4*)(rowp + bj * 128 + 4) = acc[ai][bj][m][1]; } }
    }
};

__device__ __forceinline__ void lru_phase(Frame& F, const Args& A) {
    unsigned char* ws = F.ws;
    const bf16* XR = (const bf16*)(ws + WS_XR); bf16* GR = (bf16*)(ws + WS_GR);
    LAS unsigned char* AT = F.lds;
    LAS unsigned char* BT = F.lds + 34816;
    LAS float* AA = (LAS float*)(F.lds + 69632);
    LAS float* UU = (LAS float*)(F.lds + 102400);
    LAS float* SM = (LAS float*)(F.lds + 135168);
    const int tid = F.tid, lane = F.lane, w = F.wave, hi = lane >> 5, l31 = lane & 31;
    for (int item = F.vcu; item < BATCH * 16; item += F.G) {
        const int b = item >> 4, n = (item >> 1) & 7, half = item & 1;
        __syncthreads();
        { const bf16* LW = (const bf16*)(ws + WS_LW) + (size_t)n * 2 * 128 * 128;
#pragma unroll
          for (int p = 0; p < 4; ++p) { const int q = tid + 512 * p, row = q >> 4, pc = q & 15; const int gate = row >> 6, d = 64 * half + (row & 63);
              const v4u v = *(const v4u*)(LW + ((size_t)gate * 128 + d) * 128 + pc * 8); *(LAS v4u*)(BT + row * 272 + pc * 16) = v; } }
        const int c8 = (tid & 15) * 8, cg0 = 128 * n + c8;
        const int tg = w & 3, cg = w >> 2, lc = 32 * cg + l31, chg = 128 * n + 64 * half + lc;
        const float ba_c = A.in[9][chg], bx_c = A.in[11][chg];
        const float lam = A.in[12][chg]; const float sp8 = 8.0f * log1pf(expf(-lam));
        const int sc_c = tid & 63, seg = tid >> 6;
        float hcarry = 0.f;
        for (int ck = 0; ck < SEQ / 128; ++ck) {
            const int t0 = 128 * ck;
#pragma unroll 1
            for (int p = 0; p < 4; ++p) {
                const int q = tid + 512 * p, tok = q >> 4, t = t0 + tok;
                float xc[8];
                { const f32x4 c0 = *(const f32x4*)(A.in[7] + cg0), c1 = *(const f32x4*)(A.in[7] + cg0 + 4);
                  xc[0] = c0.x; xc[1] = c0.y; xc[2] = c0.z; xc[3] = c0.w; xc[4] = c1.x; xc[5] = c1.y; xc[6] = c1.z; xc[7] = c1.w; }
#pragma unroll
                for (int k = 0; k < 4; ++k) { const int ts = t - 3 + k;
                    if (ts >= 0) { const v4u v = *(const v4u*)(XR + ((size_t)b * SEQ + ts) * D + cg0);
                        const f32x4 w0 = *(const f32x4*)(A.in[6] + k * D + cg0), w1 = *(const f32x4*)(A.in[6] + k * D + cg0 + 4);
                        xc[0] += w0.x * bflo(v.x); xc[1] += w0.y * bfhi(v.x); xc[2] += w0.z * bflo(v.y); xc[3] += w0.w * bfhi(v.y);
                        xc[4] += w1.x * bflo(v.z); xc[5] += w1.y * bfhi(v.z); xc[6] += w1.z * bflo(v.w); xc[7] += w1.w * bfhi(v.w); } }
                v4u o; o.x = pk2(xc[0], xc[1]); o.y = pk2(xc[2], xc[3]); o.z = pk2(xc[4], xc[5]); o.w = pk2(xc[6], xc[7]);
                *(LAS v4u*)(AT + tok * 272 + c8 * 2) = o;
            }
            __syncthreads();
            { f32x16 accR = f32x16{}, accI = f32x16{};
#pragma unroll
              for (int ks = 0; ks < 8; ++ks) {
                  const bf16x8 a = *(const LAS bf16x8*)(AT + (32 * tg + l31) * 272 + (16 * ks + 8 * hi) * 2);
                  const bf16x8 bR = *(const LAS bf16x8*)(BT + (32 * cg + l31) * 272 + (16 * ks + 8 * hi) * 2);
                  const bf16x8 bI = *(const LAS bf16x8*)(BT + (64 + 32 * cg + l31) * 272 + (16 * ks + 8 * hi) * 2);
                  accR = __builtin_amdgcn_mfma_f32_32x32x16_bf16(a, bR, accR, 0, 0, 0);
                  accI = __builtin_amdgcn_mfma_f32_32x32x16_bf16(a, bI, accI, 0, 0, 0); }
#pragma unroll
              for (int r = 0; r < 16; ++r) {
                  const int tok = 32 * tg + (r & 3) + 8 * (r >> 2) + 4 * hi;
                  const float rg = sigm(accR[r] + ba_c), ig = sigm(accI[r] + bx_c);
                  const float la2 = -sp8 * rg * LOG2E;
                  const float a = __builtin_amdgcn_exp2f(la2);
                  float mult = sqrtf(fmaxf(1.0f - __builtin_amdgcn_exp2f(2.0f * la2), 0.f));
                  if (t0 + tok == 0) mult = 1.0f;
                  const float xcv = bf2f(*(const LAS unsigned short*)(AT + tok * 272 + (64 * half + lc) * 2));
                  AA[tok * 64 + lc] = a; UU[tok * 64 + lc] = mult * ig * xcv; } }
            __syncthreads();
            float hl[16], pl[16];
            { float h = 0.f, P = 1.f;
#pragma unroll
              for (int j = 0; j < 16; ++j) { const float a = AA[(16 * seg + j) * 64 + sc_c], u = UU[(16 * seg + j) * 64 + sc_c]; h = a * h + u; P = P * a; hl[j] = h; pl[j] = P; }
              SM[(seg * 64 + sc_c) * 2] = P; SM[(seg * 64 + sc_c) * 2 + 1] = h; }
            __syncthreads();
            { float cin = hcarry, tot = hcarry;
#pragma unroll
              for (int s = 0; s < 8; ++s) { const float Ps = SM[(s * 64 + sc_c) * 2], hs = SM[(s * 64 + sc_c) * 2 + 1]; tot = Ps * tot + hs; if (s < seg) cin = tot; }
              hcarry = tot;
              bf16* gp = GR + ((size_t)b * SEQ + t0 + 16 * seg) * D + 128 * n + 64 * half + sc_c;
#pragma unroll
              for (int j = 0; j < 16; ++j) { const float hv = hl[j] + pl[j] * cin; const float g = bf2f(gp[(size_t)j * D]); gp[(size_t)j * D] = (bf16)f2bf(hv * g); } }
        }
    }
    __syncthreads();
}

__device__ __forceinline__ void p5_phase(Frame& F, const Args& A) {
    const int gw = F.vcu * NWAVES + F.wave, NGW = F.G * NWAVES;
    float d1 = A.in[13][F.lane] * A.in[14][F.lane], d2 = A.in[15][F.lane] * A.in[16][F.lane];
    const float lam = expf(wave_sum(d1)) - expf(wave_sum(d2)) + LAM_INIT;
    bf16* O0 = (bf16*)(F.ws + WS_H); const bf16* O1 = (const bf16*)(F.ws + WS_O1);
    float g[16];
#pragma unroll
    for (int i = 0; i < 16; ++i) g[i] = A.in[17][(16 * F.lane + i) & 127] * (1.0f - LAM_INIT);
    for (int m = gw; m < T; m += NGW) {
        const v4u a0 = *(const v4u*)(O0 + (size_t)m * D + 16 * F.lane), a1 = *(const v4u*)(O0 + (size_t)m * D + 16 * F.lane + 8);
        const v4u b0 = *(const v4u*)(O1 + (size_t)m * D + 16 * F.lane), b1 = *(const v4u*)(O1 + (size_t)m * D + 16 * F.lane + 8);
        float o[16];
        o[0] = bflo(a0.x) - lam * bflo(b0.x); o[1] = bfhi(a0.x) - lam * bfhi(b0.x); o[2] = bflo(a0.y) - lam * bflo(b0.y); o[3] = bfhi(a0.y) - lam * bfhi(b0.y);
        o[4] = bflo(a0.z) - lam * bflo(b0.z); o[5] = bfhi(a0.z) - lam * bfhi(b0.z); o[6] = bflo(a0.w) - lam * bflo(b0.w); o[7] = bfhi(a0.w) - lam * bfhi(b0.w);
        o[8] = bflo(a1.x) - lam * bflo(b1.x); o[9] = bfhi(a1.x) - lam * bfhi(b1.x); o[10] = bflo(a1.y) - lam * bflo(b1.y); o[11] = bfhi(a1.y) - lam * bfhi(b1.y);
        o[12] = bflo(a1.z) - lam * bflo(b1.z); o[13] = bfhi(a1.z) - lam * bfhi(b1.z); o[14] = bflo(a1.w) - lam * bflo(b1.w); o[15] = bfhi(a1.w) - lam * bfhi(b1.w);
        float s = 0.f;
#pragma unroll
        for (int i = 0; i < 16; ++i) s += o[i] * o[i];
        s += __shfl_xor(s, 1); s += __shfl_xor(s, 2); s += __shfl_xor(s, 4);
        const float rstd = 1.f / sqrtf(s * (1.f / 128.f) + EPS);
        v4u w0, w1;
        w0.x = pk2(o[0] * rstd * g[0], o[1] * rstd * g[1]); w0.y = pk2(o[2] * rstd * g[2], o[3] * rstd * g[3]); w0.z = pk2(o[4] * rstd * g[4], o[5] * rstd * g[5]); w0.w = pk2(o[6] * rstd * g[6], o[7] * rstd * g[7]);
        w1.x = pk2(o[8] * rstd * g[8], o[9] * rstd * g[9]); w1.y = pk2(o[10] * rstd * g[10], o[11] * rstd * g[11]); w1.z = pk2(o[12] * rstd * g[12], o[13] * rstd * g[13]); w1.w = pk2(o[14] * rstd * g[14], o[15] * rstd * g[15]);
        *(v4u*)(O0 + (size_t)m * D + 16 * F.lane) = w0; *(v4u*)(O0 + (size_t)m * D + 16 * F.lane + 8) = w1;
    }
}

__device__ __forceinline__ void p8_phase(Frame& F, const Args& A) {
    unsigned char* ws = F.ws;
    const float* mod = (const float*)(ws + WS_MOD); const float* Y = (const float*)(ws + WS_Y);
    bf16* H2 = (bf16*)(ws + WS_H);
    LAS float* tile = (LAS float*)F.lds;
    LAS float* red = (LAS float*)F.lds;
    LAS int* cntl = (LAS int*)(F.lds + 135168);
    const int tid = F.tid, lane = F.lane, w = F.wave, hi = lane >> 5, l31 = lane & 31;
    int* lists = (int*)(ws + WS_LIST); float* wts = (float*)(ws + WS_WTS);
    for (int tl = F.vcu; tl < T / 32; tl += F.G) {
        const int tok0 = tl * 32, b = tok0 / SEQ, chunk = tok0 / TC;
        if (tid < 64) cntl[tid] = 0;
        for (int rr = 0; rr < 4; ++rr) {
            const size_t m = (size_t)tok0 + w * 4 + rr;
            f32x4 y[4], x[4]; float s = 0.f;
#pragma unroll
            for (int j = 0; j < 4; ++j) { y[j] = *((const f32x4*)(Y + m * D) + lane + 64 * j); x[j] = *((const f32x4*)(A.in[0] + m * D) + lane + 64 * j); s += (y[j].x * y[j].x + y[j].y * y[j].y) + (y[j].z * y[j].z + y[j].w * y[j].w); }
            const float rstd = 1.f / sqrtf(wave_sum(s) * (1.f / D) + EPS);
            float s2 = 0.f;
#pragma unroll
            for (int j = 0; j < 4; ++j) { const int c = 4 * lane + 256 * j; const f32x4 gp = *(const f32x4*)(A.in[21] + c), gt = *(const f32x4*)(mod + b * 6 * D + 2 * D + c);
                x[j] = x[j] + gt * (y[j] * rstd * gp); *((f32x4*)(F.out + m * D) + lane + 64 * j) = x[j]; s2 += (x[j].x * x[j].x + x[j].y * x[j].y) + (x[j].z * x[j].z + x[j].w * x[j].w); }
            const float rstd2 = 1.f / sqrtf(wave_sum(s2) * (1.f / D) + EPS);
#pragma unroll
            for (int j = 0; j < 4; ++j) { const int c = 4 * lane + 256 * j; const f32x4 gf = *(const f32x4*)(A.in[22] + c), sh = *(const f32x4*)(mod + b * 6 * D + 3 * D + c), sc = *(const f32x4*)(mod + b * 6 * D + 4 * D + c);
                const f32x4 h = (x[j] * rstd2 * gf) * (sc + 1.0f) + sh;
                v2u o; o.x = pk2(h.x, h.y); o.y = pk2(h.z, h.w); *((GAS v2u*)(H2 + m * D) + lane + 64 * j) = o;
                LAS float* tp = tile + (w * 4 + rr) * 1025 + c; tp[0] = h.x; tp[1] = h.y; tp[2] = h.z; tp[3] = h.w; }
        }
        __syncthreads();
        f32x16 acc0 = f32x16{}, acc1 = f32x16{};
        { const float* wrp = A.in[23] + (size_t)(128 * w + hi) * NEXP + l31; const LAS float* tp = tile + l31 * 1025 + 128 * w + hi;
#pragma unroll 8
          for (int ks = 0; ks < 64; ++ks) { const float a = tp[2 * ks]; const float b0 = wrp[(size_t)(2 * ks) * NEXP], b1 = wrp[(size_t)(2 * ks) * NEXP + 32];
              acc0 = __builtin_amdgcn_mfma_f32_32x32x2f32(a, b0, acc0, 0, 0, 0); acc1 = __builtin_amdgcn_mfma_f32_32x32x2f32(a, b1, acc1, 0, 0, 0); } }
        __syncthreads();
#pragma unroll
        for (int r = 0; r < 16; ++r) { const int tk = (r & 3) + 8 * (r >> 2) + 4 * hi; red[(w * 32 + tk) * 64 + l31] = acc0[r]; red[(w * 32 + tk) * 64 + 32 + l31] = acc1[r]; }
        __syncthreads();
        int sel_e[4], sel_lp[4], sel_slot[4]; float sel_wt[4];
        const float eb = A.in[24][lane];
#pragma unroll
        for (int q = 0; q < 4; ++q) {
            const int tk = 4 * w + q; float lg = 0.f;
#pragma unroll
            for (int ww = 0; ww < 8; ++ww) lg += red[(ww * 32 + tk) * 64 + lane];
            const float score = 1.0f / (1.0f + expf(-lg)); const float ch = score + eb;
            float m1 = ch; m1 = fmaxf(m1, __shfl_xor(m1, 1)); m1 = fmaxf(m1, __shfl_xor(m1, 2)); m1 = fmaxf(m1, __shfl_xor(m1, 4));
            const unsigned long long eq = __ballot(ch == m1); const int gsh = lane & ~7; const unsigned ge = (unsigned)((eq >> gsh) & 0xffull);
            const int first = gsh + __builtin_ctz(ge);
            float m2 = (lane == first) ? -INFINITY : ch; m2 = fmaxf(m2, __shfl_xor(m2, 1)); m2 = fmaxf(m2, __shfl_xor(m2, 2)); m2 = fmaxf(m2, __shfl_xor(m2, 4));
            const float gs = m1 + m2; const int g = lane >> 3;
            int grank = 0;
#pragma unroll
            for (int gg = 0; gg < 8; ++gg) { const float og = __shfl(gs, gg * 8); grank += (og > gs || (og == gs && gg < g)) ? 1 : 0; }
            const float v = (grank < 4) ? ch : -INFINITY;
            int rank = 0;
#pragma unroll
            for (int ee = 0; ee < 64; ++ee) { const float ov = __shfl(v, ee); rank += (ov > v || (ov == v && ee < lane)) ? 1 : 0; }
            const bool sel = rank < TOPK;
            const float wsum = wave_sum(sel ? score : 0.f);
            sel_e[q] = sel ? lane : -1; sel_slot[q] = (tok0 + tk) * 8 + rank; sel_wt[q] = score / (wsum + 1e-20f) * 2.5f;
            sel_lp[q] = sel ? atomicAdd((int*)&cntl[lane], 1) : 0;
        }
        __syncthreads();
        if (tid < 64) { const int c = cntl[tid]; cntl[64 + tid] = c ? (int)__hip_atomic_fetch_add((unsigned*)(F.ctl + CW_CNT + chunk * 64 + tid), (unsigned)c, RLX_AGENT) : 0; }
        __syncthreads();
#pragma unroll
        for (int q = 0; q < 4; ++q) if (sel_e[q] >= 0) { const int pos = cntl[64 + lane] + sel_lp[q]; lists[((size_t)chunk * 64 + lane) * TC + pos] = sel_slot[q]; wts[sel_slot[q]] = sel_wt[q]; }
        __syncthreads();
    }
    __syncthreads();
    LAS float* scr = (LAS float*)(F.lds + w * 16384);
    const int gw = F.vcu * NWAVES + w, NGW = F.G * NWAVES;
    constexpr int I13 = 16 * 8, I2 = 4 * 32, PER_E = 2 * I13 + I2;
    for (int it = gw; it < (NEXP + 1) * PER_E; it += NGW) {
        const int e = it / PER_E; int r = it % PER_E;
        const bool sh = (e == NEXP);
        if (r < 2 * I13) { const int w3 = r / I13; r %= I13; const int kb = r >> 3, n0 = 32 * (r & 7);
            const float* W = sh ? (w3 ? A.in[29] : A.in[28]) : ((w3 ? A.in[26] : A.in[25]) + (size_t)e * D * DEXP);
            bf16* WT = sh ? (bf16*)(ws + WS_W13S) : (bf16*)(ws + WS_W13) + (size_t)e * 512 * D;
            transpose_item(W, D, DEXP, WT, kb, n0, (n0 >> 7) * 256 + (w3 ? 128 : 0) + (n0 & 127), scr, lane); }
        else { r -= 2 * I13; const int kb = r >> 5, n0 = 32 * (r & 31);
            const float* W = sh ? A.in[30] : A.in[27] + (size_t)e * DEXP * D;
            bf16* WT = sh ? (bf16*)(ws + WS_W2S) : (bf16*)(ws + WS_W2) + (size_t)e * D * DEXP;
            transpose_item(W, DEXP, D, WT, kb, n0, n0, scr, lane); }
    }
}

__device__ __forceinline__ int moe_tables(Frame& F, int chunk) {
    __syncthreads();
    if (F.tid < 64) F.MI[MI_CNT + F.tid] = (int)__hip_atomic_load(F.ctl + CW_CNT + chunk * 64 + F.tid, RLX_AGENT);
    __syncthreads();
    if (F.tid == 0) { int s = 0; for (int e = 0; e < NEXP; ++e) { F.MI[MI_TBASE + e] = s; s += (F.MI[MI_CNT + e] + 255) >> 8; } F.MI[MI_TBASE + NEXP] = s; }
    __syncthreads();
    if (F.tid < 64) { const int b0 = F.MI[MI_TBASE + F.tid], b1 = F.MI[MI_TBASE + F.tid + 1]; for (int j = b0; j < b1; ++j) F.MI[MI_TILE_E + j] = F.tid; }
    __syncthreads();
    return F.MI[MI_TBASE + NEXP];
}
struct UpOrder {
    const char* ws; volatile LAS int* MI; int nrt_r, nrt, G, c;
    __device__ __forceinline__ bool next(int i, pg8::Unit& u) const { const int L = i * G + c; if (L >= 2 * nrt) return false; u.pm = L >> 1; u.pn = L & 1; u.z = 0;
        u.e = (u.pm < nrt_r) ? __builtin_amdgcn_readfirstlane(MI[MI_TILE_E + u.pm]) : NEXP; return true; }
    __device__ __forceinline__ void bases(const pg8::Unit& u, const char*& a, const char*& b) const { a = ws + WS_H; b = (u.e < NEXP ? ws + WS_W13 + (size_t)u.e * 512 * D * 2 : ws + WS_W13S) + (size_t)u.pn * 256 * D * 2; }
    __device__ __forceinline__ int tok(int ui, int row) const { return MI[MI_TOK + ui * 256 + row]; }
};
struct EpiSwiglu {
    static constexpr bool PERM = true;
    bf16* HB;
    __device__ __forceinline__ void operator()(const acc_t& acc, const pg8::Unit& u, int wr, int wc, int fr, int fq) const {
        const int row0 = u.pm * 256 + wr * 64 + fr, col0 = u.pn * 128 + wc * 32 + 8 * fq;
#pragma unroll
        for (int ai = 0; ai < 2; ++ai)
#pragma unroll
            for (int m = 0; m < 4; ++m) { bf16* rowp = HB + (size_t)(row0 + ai * 128 + m * 16) * DEXP + col0;
                float v[8];
#pragma unroll
                for (int n = 0; n < 2; ++n)
#pragma unroll
                    for (int i = 0; i < 4; ++i) { const float a = acc[ai][0][m][n][i], g = acc[ai][1][m][n][i]; v[4 * n + i] = a * sigm(a) * g; }
                v4u w; w.x = pg8::cvt_pk_bf16(v[0], v[1]); w.y = pg8::cvt_pk_bf16(v[2], v[3]); w.z = pg8::cvt_pk_bf16(v[4], v[5]); w.w = pg8::cvt_pk_bf16(v[6], v[7]);
                *(v4u*)rowp = w; asm volatile("" ::: "memory"); }
    }
};
struct DownOrder {
    const char* ws; volatile LAS int* MI; int nrt_r, nrt, G, c;
    __device__ __forceinline__ bool next(int i, pg8::Unit& u) const { const int L = i * G + c; if (L >= 4 * nrt) return false; u.pm = L >> 2; u.pn = L & 3; u.z = 0;
        u.e = (u.pm < nrt_r) ? __builtin_amdgcn_readfirstlane(MI[MI_TILE_E + u.pm]) : NEXP; return true; }
    __device__ __forceinline__ void bases(const pg8::Unit& u, const char*& a, const char*& b) const { a = ws + WS_HB + (size_t)u.pm * 256 * DEXP * 2; b = (u.e < NEXP ? ws + WS_W2 + (size_t)u.e * D * DEXP * 2 : ws + WS_W2S) + (size_t)u.pn * 256 * DEXP * 2; }
    __device__ __forceinline__ int tok(int, int) const { return 0; }
};
struct EpiScatter {
    static constexpr bool PERM = true;
    bf16* SL; const int* rdest; const float* rwt;
    __device__ __forceinline__ void operator()(const acc_t& acc, const pg8::Unit& u, int wr, int wc, int fr, int fq) const {
        const int row0 = u.pm * 256 + wr * 64 + fr, col0 = u.pn * 256 + wc * 32 + 8 * fq;
#pragma unroll
        for (int ai = 0; ai < 2; ++ai)
#pragma unroll
            for (int m = 0; m < 4; ++m) { const int r = row0 + ai * 128 + m * 16; const int dest = rdest[r]; const float wt = rwt[r];
                if (dest >= 0) { bf16* rowp = SL + (size_t)dest * D + col0;
#pragma unroll
                    for (int bj = 0; bj < 2; ++bj) { const pg8::f32x4 v0 = acc[ai][bj][m][0] * wt, v1 = acc[ai][bj][m][1] * wt;
                        v4u w; w.x = pg8::cvt_pk_bf16(v0[0], v0[1]); w.y = pg8::cvt_pk_bf16(v0[2], v0[3]); w.z = pg8::cvt_pk_bf16(v1[0], v1[1]); w.w = pg8::cvt_pk_bf16(v1[2], v1[3]);
                        *(v4u*)(rowp + bj * 128) = w; } }
                if (m & 1) asm volatile("" ::: "memory"); }
    }
};
__device__ __forceinline__ void moe_up(Frame& F, int chunk) {
    unsigned char* ws = F.ws;
    const int nrt_r = moe_tables(F, chunk), nrt = nrt_r + TC / 256;
    const int* lists = (const int*)(ws + WS_LIST); const float* wts = (const float*)(ws + WS_WTS);
    int* rdest = (int*)(ws + WS_RDEST); float* rwt = (float*)(ws + WS_RWT);
#pragma unroll 1
    for (int i = 0; i < 4; ++i) { const int L = i * F.G + F.vcu; if (L >= 2 * nrt) break; const int rt = L >> 1, ct = L & 1;
        if (F.tid < 256) { const int r = F.tid; int tokn, dest; float wt;
            if (rt < nrt_r) { const int e = F.MI[MI_TILE_E + rt]; const int idx = (rt - F.MI[MI_TBASE + e]) * 256 + r;
                if (idx < F.MI[MI_CNT + e]) { const int slot = lists[((size_t)chunk * 64 + e) * TC + idx]; tokn = slot >> 3; dest = slot - chunk * TC * 8; wt = wts[slot]; }
                else { tokn = chunk * TC; dest = -1; wt = 0.f; } }
            else { tokn = chunk * TC + (rt - nrt_r) * 256 + r; dest = TC * 8 + (rt - nrt_r) * 256 + r; wt = 1.0f; }
            F.MI[MI_TOK + i * 256 + r] = tokn;
            if (ct == 0) { rdest[rt * 256 + r] = dest; rwt[rt * 256 + r] = wt; } } }
    __syncthreads();
    UpOrder S{(const char*)ws, F.MI, nrt_r, nrt, F.G, F.vcu};
    EpiSwiglu E{(bf16*)(ws + WS_HB)};
    int Kk = D; asm volatile("" : "+s"(Kk));
    pg8::gemm_phase<EpiSwiglu, UpOrder, true, true>(F.lds, F.tid, Kk, S, E);
}
__device__ __forceinline__ void moe_down(Frame& F, int chunk) {
    unsigned char* ws = F.ws;
    const int nrt_r = moe_tables(F, chunk), nrt = nrt_r + TC / 256;
    DownOrder S{(const char*)ws, F.MI, nrt_r, nrt, F.G, F.vcu};
    EpiScatter E{(bf16*)(ws + WS_SLOT), (const int*)(ws + WS_RDEST), (const float*)(ws + WS_RWT)};
    int Kk = DEXP; asm volatile("" : "+s"(Kk));
    pg8::gemm_phase<EpiScatter, DownOrder, true, false>(F.lds, F.tid, Kk, S, E);
}
__device__ __forceinline__ void moe_combine(Frame& F, const Args& A, int chunk, bool poison) {
    unsigned char* ws = F.ws;
    const float* mod = (const float*)(ws + WS_MOD); const bf16* SL = (const bf16*)(ws + WS_SLOT);
    const int gw = F.vcu * NWAVES + F.wave, NGW = F.G * NWAVES;
    for (int tl = gw; tl < TC; tl += NGW) {
        const size_t m = (size_t)chunk * TC + tl; const int b = (int)(m / SEQ);
        f32x4 y[4];
#pragma unroll
        for (int j = 0; j < 4; ++j) y[j] = (f32x4){0.f, 0.f, 0.f, 0.f};
#pragma unroll
        for (int k = 0; k < 9; ++k) { const bf16* rp = SL + (size_t)(k < 8 ? tl * 8 + k : TC * 8 + tl) * D;
#pragma unroll
            for (int j = 0; j < 4; ++j) { const v2u v = *((const v2u*)rp + F.lane + 64 * j); y[j].x += bflo(v.x); y[j].y += bfhi(v.x); y[j].z += bflo(v.y); y[j].w += bfhi(v.y); } }
        float s = 0.f;
#pragma unroll
        for (int j = 0; j < 4; ++j) s += (y[j].x * y[j].x + y[j].y * y[j].y) + (y[j].z * y[j].z + y[j].w * y[j].w);
        const float rstd = 1.f / sqrtf(wave_sum(s) * (1.f / D) + EPS);
#pragma unroll
        for (int j = 0; j < 4; ++j) { const int c = 4 * F.lane + 256 * j; const f32x4 gp = *(const f32x4*)(A.in[31] + c), gt = *(const f32x4*)(mod + b * 6 * D + 5 * D + c);
            f32x4* op = (f32x4*)(F.out + m * D) + F.lane + 64 * j; f32x4 o = *op + gt * (y[j] * rstd * gp);
            if (poison) { const float q = __builtin_nanf(""); o = (f32x4){q, q, q, q}; }
            *op = o; }
    }
}

__device__ __forceinline__ void attn_phase(Frame& F, char* lds_generic) {
    const attn_body::bf16* Q = (const attn_body::bf16*)(F.ws + WS_Q); const attn_body::bf16* K = (const attn_body::bf16*)(F.ws + WS_K); const attn_body::bf16* V = (const attn_body::bf16*)(F.ws + WS_V);
    const int nhu = (BATCH * 32 - F.vcu + F.G - 1) / F.G;
#pragma unroll 1
    for (int it = 0; it < nhu * 8; ++it) {
        const int hu = F.vcu + (it >> 3) * F.G, qb = 7 - (it & 7);
        const int b = hu >> 5, h = (hu >> 2) & 7, m = (hu >> 1) & 1, j = hu & 1;
        const float sl2 = exp2f(-(float)(h + 1)) * LOG2E;
        attn_body::bf16* O = (attn_body::bf16*)(F.ws + (m ? WS_O1 : WS_H));
        attn_body::attn_unit<8>(F.tid, b, 2 * h + m, 2 * h + m, 2 * h + j, qb, sl2, Q, K, V, O, lds_generic);
    }
}

__global__ void __launch_bounds__(NWAVES * 64, 2) hybrid_fwd(Args args) {
    extern __shared__ __attribute__((aligned(16))) unsigned char lds[];
    Frame F;
    F.lds = (LAS unsigned char*)lds;
    F.MI = (volatile LAS int*)(F.lds + MISC_OFF);
    F.tid = threadIdx.x; F.lane = F.tid & 63; F.wave = __builtin_amdgcn_readfirstlane(F.tid >> 6);
    F.G = gridDim.x; { const int bx = blockIdx.x; F.vcu = (F.G % 8 == 0) ? (bx % 8) * (F.G / 8) + bx / 8 : bx; }
    unsigned char* ws = args.ws; F.ws = ws; F.out = args.out;
    F.ctl = (gu32*)(ws + WS_CTL);
    for (int u = F.tid; u < MI_WORDS; u += NWAVES * 64) F.MI[u] = 0;
    __syncthreads();
    XcdBarrier bar; bar.bar = (unsigned*)(F.ctl + CW_BAR); bar.x = 0; bar.st = nullptr;
    if (!PER_PHASE) bar = xcd_barrier_post((unsigned*)(F.ctl + CW_BAR), (volatile LAS unsigned*)(F.MI + MI_BARST));
    const int lo = args.ph_lo, hi = args.ph_hi;
#ifndef PH_MASK
#define PH_MASK 0xFFFFFFFFu
#endif
#define IN(k) (((PH_MASK >> (k)) & 1u) && lo <= (k) && (k) < hi)
#define FRESH() do { unsigned char* w_ = args.ws; asm volatile("" : "+s"(w_)); F.ws = w_; ws = w_; F.ctl = (gu32*)(w_ + WS_CTL); int t_ = threadIdx.x; asm volatile("" : "+v"(t_)); F.tid = t_; F.lane = t_ & 63; F.wave = __builtin_amdgcn_readfirstlane(t_ >> 6); } while (0)
#define SEAM(k) do { if (IN(k) && IN((k) + 1)) { if (PER_PHASE) { if (F.tid == 0) __hip_atomic_store(F.ctl + CW_TMO, 0xBADBA0u, RLX_AGENT); } else xcd_barrier(bar); } } while (0)
    if (IN(0)) { FRESH(); p0_phase(F, args); } SEAM(0);
    if (IN(1)) { FRESH(); p1_phase(F, args); } SEAM(1);
    if (IN(2)) { FRESH(); DenseOrder S; S.init(ws + WS_H, ws + WS_WIN, T, W_IN, D, F.G, (int)blockIdx.x); EpiProj E{(bf16*)(ws + WS_XR), (bf16*)args.out};
        pg8::gemm_phase<EpiProj, DenseOrder, true, false>(F.lds, F.tid, D, S, E); } SEAM(2);
    if (IN(3)) { FRESH(); lru_phase(F, args); } SEAM(3);
    if (IN(4)) { FRESH(); attn_phase(F, (char*)lds); } SEAM(4);
    if (IN(5)) { FRESH(); p5_phase(F, args); } SEAM(5);
    if (IN(6)) { FRESH(); MergeOrder S; S.d.init(ws + WS_GR, ws + WS_WR, T, D, D, F.G, (int)blockIdx.x); S.A1 = (const char*)(ws + WS_H); S.B1 = (const char*)(ws + WS_WA);
        EpiGate E{(const bf16*)args.out, (const bf16*)args.out + (size_t)T * D, (bf16*)(ws + WS_V), (bf16*)(ws + WS_XR)};
        pg8::gemm_phase<EpiGate, MergeOrder, true, false>(F.lds, F.tid, D, S, E); } SEAM(6);
    if (IN(7)) { FRESH(); DenseOrder S; S.init(ws + WS_XR, ws + WS_WO, T, D, D, F.G, (int)blockIdx.x); EpiF32 E{(float*)(ws + WS_Y)};
        pg8::gemm_phase<EpiF32, DenseOrder, true, false>(F.lds, F.tid, D, S, E); } SEAM(7);
    if (IN(8)) { FRESH(); p8_phase(F, args); } SEAM(8);
#pragma unroll 1
    for (int c = 0; c < NCH; ++c) {
        const int pa = 9 + 2 * c, pb = 10 + 2 * c;
        if (IN(pa)) { FRESH(); if (c > 0) moe_combine(F, args, c - 1, false); moe_up(F, c); } SEAM(pa);
        if (IN(pb)) { FRESH(); moe_down(F, c); } SEAM(pb);
    }
    if (IN(9 + 2 * NCH)) { FRESH();
        bool poison = __hip_atomic_load(F.ctl + CW_TMO, RLX_AGENT) != 0u || __hip_atomic_load(F.ctl + CW_BAR + XB_TMO, RLX_AGENT) != 0u;
        moe_combine(F, args, NCH - 1, poison);
    }
#undef IN
#undef SEAM
}

extern "C" void kernel_launch(void* const* d_in, const int* in_sizes, int n_in, void* d_out, int out_size, void* d_ws, size_t ws_size, hipStream_t stream) {
    static int grid = 0;
    if (grid == 0) {
        if (n_in != 32 || out_size != T * D || ws_size < WS_END) { fprintf(stderr, "kernel_launch: unexpected shapes (n_in %d, out %d, ws %zu); nothing launched\n", n_in, out_size, ws_size); grid = -1; return; }
        int dev = 0, cus = 0, per_cu = 0;
        if (hipGetDevice(&dev) != hipSuccess || hipDeviceGetAttribute(&cus, hipDeviceAttributeMultiprocessorCount, dev) != hipSuccess) { grid = -1; return; }
        if (hipFuncSetAttribute((const void*)hybrid_fwd, hipFuncAttributeMaxDynamicSharedMemorySize, LDS_BYTES) != hipSuccess) { fprintf(stderr, "kernel_launch: hipFuncSetAttribute failed\n"); grid = -1; return; }
        if (hipOccupancyMaxActiveBlocksPerMultiprocessor(&per_cu, (const void*)hybrid_fwd, NWAVES * 64, LDS_BYTES) != hipSuccess || per_cu < 1) { fprintf(stderr, "kernel_launch: occupancy query says %d blocks per CU\n", per_cu); per_cu = 1; }
        (void)hipGetLastError();
        grid = cus;
    }
    if (grid < 0) return;
    (void)hipMemsetAsync((char*)d_ws + WS_CTL, 0, CTL_ZERO_BYTES, stream);
    Args a{};
    for (int i = 0; i < 32; ++i) a.in[i] = (const float*)d_in[i];
    a.out = (float*)d_out; a.ws = (unsigned char*)d_ws;
    if (N_LAUNCHES == 1) { a.ph_lo = 0; a.ph_hi = N_PHASES; hipLaunchKernelGGL(hybrid_fwd, dim3(grid), dim3(NWAVES * 64), LDS_BYTES, stream, a); }
    else for (int p = 0; p < N_PHASES; ++p) { a.ph_lo = p; a.ph_hi = p + 1; hipLaunchKernelGGL(hybrid_fwd, dim3(grid), dim3(NWAVES * 64), LDS_BYTES, stream, a); }
}
```

```cpp
#include <hip/hip_runtime.h>
#include <hip/hip_bf16.h>
#include <cstdio>
#include <cstdint>
#include <cmath>

#ifndef MK_N_LAUNCHES
#define MK_N_LAUNCHES 1
#endif

constexpr int BATCH = 16, SEQ = 2048, D = 1024, T = BATCH * SEQ;
constexpr int W_IN = 7 * 1024;
constexpr int NEXP = 64, TOPK = 8, DEXP = 256;
constexpr int NCH = 4, TC = T / NCH;
constexpr float EPS = 1e-6f;
constexpr float LOG2E = 1.4426950408889634f;
constexpr float LAM_INIT = 0.2f;

namespace pg8 {
#define PG8_LAS __attribute__((address_space(3)))
typedef unsigned short bf16_t;
typedef short bf16x8 __attribute__((ext_vector_type(8)));
typedef float f32x4 __attribute__((ext_vector_type(4)));
typedef unsigned u32x4 __attribute__((ext_vector_type(4)));
constexpr int BM = 256, BK = 64, HALF = 128, HTB = HALF * BK * 2, STAGE_BYTES = 8 * HTB, NXCD = 8, WGM = 8;

__host__ __device__ __forceinline__ int lds_byte(int r, int c) { const int st = (r >> 4) * 2 + (c >> 5), rr = r & 15, cc = c & 31, ob = rr * 64 + cc * 2; return st * 1024 + (ob ^ (((ob >> 9) & 1) << 5)); }
__host__ __device__ __forceinline__ void stage_rc(int b, int& R, int& C) { const int st = b / 1024, sb = b % 1024, swz = sb ^ (((sb >> 9) & 1) << 5); R = (st >> 1) * 16 + swz / 64; C = (st & 1) * 32 + (swz % 64) / 2; }
__host__ __device__ __forceinline__ int perm32(int rho) { const int n = rho >> 4, i = rho & 15; return 8 * (i >> 2) + 4 * n + (i & 3); }

struct Unit { int pm, pn, z, e; };

__device__ __forceinline__ unsigned cvt_pk_bf16(float lo, float hi) { unsigned r; asm volatile("v_cvt_pk_bf16_f32 %0, %1, %2" : "=v"(r) : "v"(lo), "v"(hi)); return r; }
__device__ __forceinline__ float sigm(float x) { return __builtin_amdgcn_rcpf(1.0f + __builtin_amdgcn_exp2f(-LOG2E * x)); }
__device__ __forceinline__ float gelu_t(float x) { const float u = 0.7978845608028654f * (x + 0.044715f * x * x * x); return x * sigm(2.0f * u); }
__device__ __forceinline__ float bflo(unsigned w) { return __uint_as_float(w << 16); }
__device__ __forceinline__ float bfhi(unsigned w) { return __uint_as_float(w & 0xffff0000u); }

typedef int i32x4 __attribute__((ext_vector_type(4)));
template <class Epi, class Sched, bool ALIGN_EPI, bool GATHER, bool INT8 = false>
__device__ __forceinline__ void gemm_phase(PG8_LAS unsigned char* lds, const int tid, const int K, const Sched& S, const Epi& E) {
    const int wid = __builtin_amdgcn_readfirstlane(tid >> 6), lane = tid & 63, wr = wid >> 2, wc = wid & 3, fr = lane & 15, fq = lane >> 4;
    const int nt = K / BK;
    unsigned voffA[2], voffB[2];
#pragma unroll
    for (int i = 0; i < 2; ++i) { int R, C; stage_rc(tid * 16 + i * 8192, R, C); const int Rb = Epi::PERM ? ((R & ~31) + perm32(R & 31)) : R;
        voffA[i] = (unsigned)(R * K + C) * 2u; voffB[i] = (unsigned)(Rb * K + C) * 2u; }
    const size_t kstep = (size_t)(BK * 2);
    const size_t hstep = (size_t)HALF * K * 2;
    const unsigned ldsw = (unsigned)wid * 1024u;
    const int aoff = lds_byte(wr * 64 + fr, fq * 8), boff = lds_byte(wc * 32 + fr, fq * 8);
#define PG8_SA(b, h) (((b) * 2 + (h)) * HTB)
#define PG8_SB(b, h) ((4 + (b) * 2 + (h)) * HTB)
#define PG8_STAGE(bufoff, gbase, voff) do { _Pragma("unroll") for (int _i = 0; _i < 2; ++_i) \
        __builtin_amdgcn_global_load_lds((const unsigned*)((const char*)(gbase) + (voff)[_i]), (PG8_LAS unsigned*)(lds + (bufoff) + ldsw + _i * 8192), 16, 0, 0); } while (0)
#define PG8_STAGE_A(bufoff, p, h, VG) do { if constexpr (GATHER) { PG8_STAGE(bufoff, p, VG[h]); } else { PG8_STAGE(bufoff, (p) + (h) * hstep, voffA); } } while (0)
#define PG8_LDA(dst, b, h) do { _Pragma("unroll") for (int m = 0; m < 4; ++m) _Pragma("unroll") for (int k = 0; k < 2; ++k) dst[m][k] = *(const PG8_LAS bf16x8*)(lds + PG8_SA(b, h) + aoff + m * 2048 + k * 1024); } while (0)
#define PG8_LDB(dst, b, h) do { _Pragma("unroll") for (int n = 0; n < 2; ++n) _Pragma("unroll") for (int k = 0; k < 2; ++k) dst[n][k] = *(const PG8_LAS bf16x8*)(lds + PG8_SB(b, h) + boff + n * 2048 + k * 1024); } while (0)
#define PG8_MMA(ai, bj, At, Bt) do { __builtin_amdgcn_s_setprio(1); _Pragma("unroll") for (int m = 0; m < 4; ++m) _Pragma("unroll") for (int n = 0; n < 2; ++n) _Pragma("unroll") for (int k = 0; k < 2; ++k) \
        { if constexpr (INT8) acc[ai][bj][m][n] = __builtin_bit_cast(f32x4, __builtin_amdgcn_mfma_i32_16x16x64_i8(__builtin_bit_cast(i32x4, Bt[n][k]), __builtin_bit_cast(i32x4, At[m][k]), __builtin_bit_cast(i32x4, acc[ai][bj][m][n]), 0, 0, 0)); \
          else acc[ai][bj][m][n] = __builtin_amdgcn_mfma_f32_16x16x32_bf16(Bt[n][k], At[m][k], acc[ai][bj][m][n], 0, 0, 0); } __builtin_amdgcn_s_setprio(0); } while (0)
#define PG8_WAIT_V(n) asm volatile("s_waitcnt vmcnt(" #n ")" ::: "memory")
#define PG8_WAIT_L(n) asm volatile("s_waitcnt lgkmcnt(" #n ")" ::: "memory")
#define PG8_BAR __builtin_amdgcn_s_barrier()
#define PG8_SCHED __builtin_amdgcn_sched_barrier(0)
#define PG8_LOADVG(VG, ui_) do { if constexpr (GATHER) { _Pragma("unroll") for (int h_ = 0; h_ < 2; ++h_) _Pragma("unroll") for (int i_ = 0; i_ < 2; ++i_) \
        { int R_, C_; stage_rc(tid * 16 + i_ * 8192, R_, C_); VG[h_][i_] = ((unsigned)S.tok((ui_), h_ * HALF + R_) * (unsigned)K + (unsigned)C_) * 2u; } } } while (0)
    Unit cur, nxt; int ui = 0;
    if (!S.next(0, cur)) return;
    f32x4 acc[2][2][4][2];
#pragma unroll
    for (int a = 0; a < 2; ++a)
#pragma unroll
        for (int b = 0; b < 2; ++b)
#pragma unroll
            for (int m = 0; m < 4; ++m)
#pragma unroll
                for (int n = 0; n < 2; ++n) acc[a][b][m][n] = (f32x4){0.f, 0.f, 0.f, 0.f};
    bf16x8 At[4][2], B0[2][2], B1[2][2];
    unsigned vgc[2][2];
#pragma unroll
    for (int h_ = 0; h_ < 2; ++h_)
#pragma unroll
        for (int i_ = 0; i_ < 2; ++i_) vgc[h_][i_] = 0u;
    PG8_LOADVG(vgc, 0);
    const char *cA, *cB; S.bases(cur, cA, cB);
    PG8_STAGE(PG8_SB(0, 0), cB, voffB); PG8_STAGE(PG8_SB(0, 1), cB + hstep, voffB); PG8_STAGE_A(PG8_SA(0, 0), cA, 0, vgc); PG8_STAGE_A(PG8_SA(0, 1), cA, 1, vgc);
    if (wr == 1) PG8_BAR;
    PG8_WAIT_V(2); PG8_BAR;
    PG8_STAGE(PG8_SB(1, 0), cB + kstep, voffB); PG8_STAGE_A(PG8_SA(1, 0), cA + kstep, 0, vgc); PG8_STAGE(PG8_SB(1, 1), cB + hstep + kstep, voffB);
    PG8_WAIT_V(6); PG8_BAR;
    for (;;) {
        const bool has_next = S.next(ui + 1, nxt);
        const char *nA = cA, *nB = cB;
        if (has_next) S.bases(nxt, nA, nB);
        for (int t = 0; t < nt; t += 2) {
            const bool last = (t == nt - 2);
            const char* a1 = cA + (size_t)(t + 1) * kstep;
            const char* a2 = last ? nA : cA + (size_t)(t + 2) * kstep; const char* b2 = last ? nB : cB + (size_t)(t + 2) * kstep;
            const char* a3 = a2 + kstep; const char* b3 = b2 + kstep;
            unsigned vgs[2][2];
#pragma unroll
            for (int h_ = 0; h_ < 2; ++h_)
#pragma unroll
                for (int i_ = 0; i_ < 2; ++i_) vgs[h_][i_] = vgc[h_][i_];
            if (last && has_next) PG8_LOADVG(vgs, ui + 1);
            PG8_LDB(B0, 0, 0); PG8_LDB(B1, 0, 1); PG8_SCHED; PG8_LDA(At, 0, 0); PG8_STAGE_A(PG8_SA(1, 1), a1, 1, vgc);
            PG8_WAIT_V(8); PG8_WAIT_L(0); PG8_BAR; PG8_MMA(0, 0, At, B0); PG8_MMA(0, 1, At, B1); PG8_BAR; PG8_SCHED;
            PG8_LDA(At, 0, 1); PG8_STAGE(PG8_SB(0, 0), b2, voffB); PG8_STAGE(PG8_SB(0, 1), b2 + hstep, voffB); PG8_STAGE_A(PG8_SA(0, 0), a2, 0, vgs);
            PG8_WAIT_V(8); PG8_WAIT_L(0); PG8_BAR; PG8_MMA(1, 0, At, B0); PG8_MMA(1, 1, At, B1); PG8_BAR; PG8_SCHED;
            PG8_LDB(B0, 1, 0); PG8_LDB(B1, 1, 1); PG8_SCHED; PG8_LDA(At, 1, 0); PG8_STAGE_A(PG8_SA(0, 1), a2, 1, vgs);
            PG8_WAIT_V(8); PG8_WAIT_L(0); PG8_BAR; PG8_MMA(0, 0, At, B0); PG8_MMA(0, 1, At, B1); PG8_BAR; PG8_SCHED;
            PG8_LDA(At, 1, 1); PG8_STAGE(PG8_SB(1, 0), b3, voffB); PG8_STAGE(PG8_SB(1, 1), b3 + hstep, voffB); PG8_STAGE_A(PG8_SA(1, 0), a3, 0, vgs);
            PG8_WAIT_V(8); PG8_WAIT_L(0); PG8_BAR; PG8_MMA(1, 0, At, B0); PG8_MMA(1, 1, At, B1); PG8_BAR; PG8_SCHED;
        }
        if constexpr (ALIGN_EPI) { if (wr == 0) PG8_BAR; }
        E(acc, cur, wr, wc, fr, fq);
#ifdef PROBE_EPI2
        if (Epi::TWICE) { asm volatile("" ::: "memory"); E(acc, cur, wr, wc, fr, fq); }
#endif
        if (!has_next) break;
#pragma unroll
        for (int a = 0; a < 2; ++a)
#pragma unroll
            for (int b = 0; b < 2; ++b)
#pragma unroll
                for (int m = 0; m < 4; ++m)
#pragma unroll
                    for (int n = 0; n < 2; ++n) acc[a][b][m][n] = (f32x4){0.f, 0.f, 0.f, 0.f};
        cur = nxt; cA = nA; cB = nB; ++ui;
        PG8_LOADVG(vgc, ui);
        if constexpr (ALIGN_EPI) { if (wr == 1) PG8_BAR; }
    }
    PG8_WAIT_V(0);
    if constexpr (!ALIGN_EPI) { if (wr == 0) PG8_BAR; }
    PG8_BAR;
#undef PG8_SA
#undef PG8_SB
#undef PG8_STAGE
#undef PG8_STAGE_A
#undef PG8_LDA
#undef PG8_LDB
#undef PG8_MMA
#undef PG8_WAIT_V
#undef PG8_WAIT_L
#undef PG8_BAR
#undef PG8_SCHED
#undef PG8_LOADVG
}
}

namespace attn_body {
using bf16=__hip_bfloat16;
using bf16x8=__attribute__((ext_vector_type(8)))short;
using s16x4=__attribute__((ext_vector_type(4)))short;
using f32x16=__attribute__((ext_vector_type(16)))float;
using u32x4=__attribute__((ext_vector_type(4)))unsigned;
constexpr int NHEAD=16,SEQ=2048,D=64,DM=NHEAD*D;
constexpr int NW=8,QBLK=32,QB=QBLK*NW,KVBLK=64,NQB=SEQ/QB;
__device__ __forceinline__ int crow(int r,int hi){return (r&3)+8*(r>>2)+4*hi;}
#define SBAR() __builtin_amdgcn_sched_barrier(0)
__device__ __forceinline__ void cmask(f32x16&p0,f32x16&p1,int jb,int qrel,int hi){
  const float NEG=-INFINITY; const int dq=qrel-(64*jb+4*hi);
  #pragma unroll
  for(int r=0;r<16;++r){const int kc=(r&3)+8*(r>>2); if(kc>dq)p0[r]=NEG; if(kc+32>dq)p1[r]=NEG;}
}
__device__ __forceinline__ void cinit(f32x16&p0,f32x16&p1,float sl2,float nv){
  #pragma unroll
  for(int r=0;r<16;++r){const float c=(float)((r&3)+8*(r>>2)); p0[r]=__builtin_fmaf(sl2,c,nv); p1[r]=__builtin_fmaf(sl2,c+32.0f,nv);}
}
#define CI_C(r) ((float)(((r)&3)+8*((r)>>2)))

constexpr int NSLOT=3, SLOTB=8192;
constexpr int LDS_K=0, LDS_V=NSLOT*SLOTB, LDS_WS=2*NSLOT*SLOTB, LDS_OST=LDS_WS+NW*64*4, LDS_BYTES=LDS_OST+NW*4096;
constexpr float C2=0.125f*1.4426950408889634f;
__device__ __forceinline__ void glds16(const void*gsrc,unsigned lds_dst){unsigned keep;
  asm volatile("s_mov_b32 %0, m0\n\ts_mov_b32 m0, %2\n\ts_nop 0\n\tglobal_load_lds_dwordx4 %1, off\n\ts_mov_b32 m0, %0":"=&s"(keep):"v"(gsrc),"s"(lds_dst):"memory");}
__device__ __forceinline__ float max3f(float a,float b,float c){float r;asm("v_max3_f32 %0, %1, %2, %3":"=v"(r):"v"(a),"v"(b),"v"(c));return r;}
__device__ __forceinline__ float max2f(float a,float b){float r;asm("v_max_f32_e32 %0, %1, %2":"=v"(r):"v"(a),"v"(b));return r;}
__device__ __forceinline__ float fadd_s(float a,float b){float r;asm("v_add_f32_e32 %0, %1, %2":"=v"(r):"v"(a),"v"(b));return r;}
__device__ __forceinline__ float fsub_s(float a,float b){float r;asm("v_sub_f32_e32 %0, %1, %2":"=v"(r):"v"(a),"v"(b));return r;}
typedef float f32x2_t __attribute__((ext_vector_type(2))); typedef __bf16 bf16x2_t __attribute__((ext_vector_type(2)));
__device__ __forceinline__ unsigned cvtpk_s(float lo,float hi){f32x2_t v={lo,hi};bf16x2_t b=__builtin_convertvector(v,bf16x2_t);return __builtin_bit_cast(unsigned,b);}
#define WAIT_BAR(N) asm volatile("s_waitcnt vmcnt(" #N ") lgkmcnt(0)\n\ts_barrier":::"memory")

__device__ __forceinline__ void qkt(f32x16&p0,f32x16&p1,const char*Kslot,const bf16x8*qr,int r32,int hi){
  const char*kb=Kslot+hi*1024+r32*16;
  #pragma unroll
  for(int d0=0;d0<4;++d0){
    const bf16x8 b0=*reinterpret_cast<const bf16x8*>(kb+d0*2048);
    const bf16x8 b1=*reinterpret_cast<const bf16x8*>(kb+d0*2048+512);
    p0=__builtin_amdgcn_mfma_f32_32x32x16_bf16(b0,qr[d0],p0,0,0,0);p1=__builtin_amdgcn_mfma_f32_32x32x16_bf16(b1,qr[d0],p1,0,0,0);}
}
typedef __attribute__((address_space(3))) const char* lds_cptr;
typedef short v4i16_t __attribute__((ext_vector_type(4)));
__device__ __forceinline__ void kload8(bf16x8*kf,lds_cptr kp){
  kf[0]=*(const __attribute__((address_space(3))) bf16x8*)(kp);      kf[1]=*(const __attribute__((address_space(3))) bf16x8*)(kp+512);
  kf[2]=*(const __attribute__((address_space(3))) bf16x8*)(kp+2048); kf[3]=*(const __attribute__((address_space(3))) bf16x8*)(kp+2560);
  kf[4]=*(const __attribute__((address_space(3))) bf16x8*)(kp+4096); kf[5]=*(const __attribute__((address_space(3))) bf16x8*)(kp+4608);
  kf[6]=*(const __attribute__((address_space(3))) bf16x8*)(kp+6144); kf[7]=*(const __attribute__((address_space(3))) bf16x8*)(kp+6656);
}
__device__ __forceinline__ void kload2(bf16x8*kf,lds_cptr kp,int j){ kf[2*j]=*(const __attribute__((address_space(3))) bf16x8*)(kp+j*2048); kf[2*j+1]=*(const __attribute__((address_space(3))) bf16x8*)(kp+j*2048+512); }
__device__ __forceinline__ s16x4 vtr(lds_cptr p){ return __builtin_bit_cast(s16x4,__builtin_amdgcn_ds_read_tr16_b64_v4i16((__attribute__((address_space(3))) v4i16_t*)p)); }
__device__ __forceinline__ float rowmax(const f32x16&p0,const f32x16&p1){
  float a=max3f(p0[0],p0[1],p1[0]),b=max3f(p0[2],p0[3],p1[1]);a=max3f(a,p1[2],p1[3]);
  #pragma unroll
  for(int r=4;r<16;r+=4){a=max3f(a,p0[r],p0[r+1]);b=max3f(b,p0[r+2],p0[r+3]);a=max3f(a,p1[r],p1[r+1]);b=max3f(b,p1[r+2],p1[r+3]);}
  const float m=max2f(a,b);
  auto rr=__builtin_amdgcn_permlane32_swap(__float_as_uint(m),__float_as_uint(m),false,false);
  return max2f(__uint_as_float(rr[0]),__uint_as_float(rr[1]));
}
__device__ __forceinline__ void pv(f32x16*o,int vb,bf16x8 pa0,bf16x8 pa1,bf16x8 pa2,bf16x8 pa3){
  #pragma unroll
  for(int d0=0;d0<2;++d0){s16x4 lo[4],hi[4];
    #pragma unroll
    for(int ks=0;ks<4;++ks){
      asm volatile("ds_read_b64_tr_b16 %0,%1 offset:%c2":"=&v"(lo[ks]):"v"(vb),"i"(d0*4096+ks*1024):"memory");
      asm volatile("ds_read_b64_tr_b16 %0,%1 offset:%c2":"=&v"(hi[ks]):"v"(vb),"i"(d0*4096+ks*1024+512):"memory");}
    asm volatile("s_waitcnt lgkmcnt(0)":::"memory");SBAR();
    #define PK(k) (bf16x8){lo[k][0],lo[k][1],lo[k][2],lo[k][3],hi[k][0],hi[k][1],hi[k][2],hi[k][3]}
    o[d0]=__builtin_amdgcn_mfma_f32_32x32x16_bf16(pa0,PK(0),o[d0],0,0,0);
    o[d0]=__builtin_amdgcn_mfma_f32_32x32x16_bf16(pa1,PK(1),o[d0],0,0,0);
    o[d0]=__builtin_amdgcn_mfma_f32_32x32x16_bf16(pa2,PK(2),o[d0],0,0,0);
    o[d0]=__builtin_amdgcn_mfma_f32_32x32x16_bf16(pa3,PK(3),o[d0],0,0,0);
    #undef PK
  }
}
#define ATTN_STORE16(p,v) (*(u32x4*)(p)=(v))
constexpr int LDS_K2=0, LDS_V2=4*8192, LDS_WS2=LDS_V2+3*16384, LDS_OST2=LDS_WS2+NW*64*4, LDS_BYTES2=LDS_OST2+NW*4096;
__device__ __forceinline__ void pv4(f32x16*o,int vb,bf16x8 pa0,bf16x8 pa1,bf16x8 pa2,bf16x8 pa3){
  #pragma unroll
  for(int d0=0;d0<4;++d0){s16x4 lo[4],hi[4];
    #pragma unroll
    for(int ks=0;ks<4;++ks){
      asm volatile("ds_read_b64_tr_b16 %0,%1 offset:%c2":"=&v"(lo[ks]):"v"(vb),"i"(d0*4096+ks*1024):"memory");
      asm volatile("ds_read_b64_tr_b16 %0,%1 offset:%c2":"=&v"(hi[ks]):"v"(vb),"i"(d0*4096+ks*1024+512):"memory");}
    asm volatile("s_waitcnt lgkmcnt(0)":::"memory");SBAR();
    #define PK(k) (bf16x8){lo[k][0],lo[k][1],lo[k][2],lo[k][3],hi[k][0],hi[k][1],hi[k][2],hi[k][3]}
    o[d0]=__builtin_amdgcn_mfma_f32_32x32x16_bf16(pa0,PK(0),o[d0],0,0,0);
    o[d0]=__builtin_amdgcn_mfma_f32_32x32x16_bf16(pa1,PK(1),o[d0],0,0,0);
    o[d0]=__builtin_amdgcn_mfma_f32_32x32x16_bf16(pa2,PK(2),o[d0],0,0,0);
    o[d0]=__builtin_amdgcn_mfma_f32_32x32x16_bf16(pa3,PK(3),o[d0],0,0,0);
    #undef PK
  }
}
template<int THRL,bool FUSE> __device__ __forceinline__ void attn_unit2(const int tid,int b,int h,int m,int qb,float sl2,float lam,const float*gsub,const bf16*Q,const bf16*__restrict__ K,const bf16*__restrict__ V,bf16*O,char*shm){
  const int lane=tid&63,r32=lane&31,hi=lane>>5; const int wid=__builtin_amdgcn_readfirstlane(tid>>6);
  const long rowbase=(long)b*SEQ; const int q0=qb*QB;
  const bf16*Qw=Q+(rowbase+q0+wid*QBLK)*DM+(2*h+m)*D;
  const bf16*Kh=K+rowbase*DM+(2*h+m)*D,*Vh=V+rowbase*DM+2*h*D;
  const unsigned lds0=(unsigned)(uintptr_t)shm;
  float*wsf=(float*)(shm+LDS_WS2)+wid*64;
  const bf16*ksrc=Kh+(long)lane*DM+wid*8;
  const bf16*vsrc=Vh+(long)(16*(wid&3)+(lane>>2))*DM+(wid>>2)*32+(lane&3)*8;
  const unsigned kdst=lds0+LDS_K2+wid*1024, vdst=lds0+LDS_V2+wid*1024;
  #define DMA_K(t,slot) glds16(ksrc+(long)(t)*KVBLK*DM,(unsigned)__builtin_amdgcn_readfirstlane(kdst+(slot)))
  #define DMA_V(t,slot) do{ glds16(vsrc+(long)(t)*KVBLK*DM,(unsigned)__builtin_amdgcn_readfirstlane(vdst+2*(slot))); glds16(vsrc+(long)(t)*KVBLK*DM+64,(unsigned)__builtin_amdgcn_readfirstlane(vdst+2*(slot)+8192)); }while(0)
  const int vb0=(int)(lds0+LDS_V2)+((lane>>4)&1)*32+(lane&3)*8+(4*hi+((lane&15)>>2))*64;
  const char*Kbase=shm+LDS_K2;
  const lds_cptr shm3=(lds_cptr)shm; const lds_cptr kp0=shm3+LDS_K2+hi*1024+r32*16; const lds_cptr vp0=shm3+LDS_V2+((lane>>4)&1)*32+(lane&3)*8+(4*hi+((lane&15)>>2))*64;
  const int NT=(q0+QB)/KVBLK;
  const unsigned qdst=lds0+LDS_OST2+wid*4096;
  #pragma unroll
  for(int d0=0;d0<4;++d0)glds16(&Qw[(long)r32*DM+d0*16+hi*8],(unsigned)__builtin_amdgcn_readfirstlane(qdst+d0*1024));
  DMA_K(0,0);DMA_V(0,0);DMA_K(1,SLOTB);
  const lds_cptr qp0=(lds_cptr)shm+LDS_OST2+wid*4096+lane*16;
  #define QF(d0) (*(const __attribute__((address_space(3))) bf16x8*)(qp0+(d0)*1024))
  const float tb0=sl2*(float)(4*hi);
  float mhat=0.f,l_reg=0.f;f32x16 o[4];o[0]=f32x16{};o[1]=f32x16{};o[2]=f32x16{};o[3]=f32x16{};
  const int qrel=wid*QBLK+r32;
  #define CMASK(P0,P1,t) do{int jb_=(t)-(NT-4); if(jb_>=0)cmask(P0,P1,jb_,qrel,hi);}while(0)
  #define NVAL(tt) (__builtin_fmaf(sl2,(float)(64*(tt)),tb0)-mhat)
  bool resc=false;
  #define START(P0,P1) do{ const float rm=rowmax(P0,P1); resc=false; \
    { const float dl=rm; mhat=fadd_s(mhat,dl); \
      _Pragma("unroll") for(int r=0;r<16;++r){P0[r]=fsub_s(P0[r],dl);P1[r]=fsub_s(P1[r],dl);} } \
    _Pragma("unroll") for(int r=0;r<16;++r)P0[r]=__builtin_amdgcn_exp2f(P0[r]); }while(0)
  #define RESC() do{ if(resc){ asm volatile("s_waitcnt lgkmcnt(0)":::"memory"); \
      _Pragma("unroll") for(int d_=0;d_<4;++d_) _Pragma("unroll") for(int r=0;r<16;++r)o[d_][r]*=wsf[crow(r,hi)]; } }while(0)
  f32x16 pA0,pA1,pB0,pB1;
  int sl_prev=0,sl_cur=0,sl_next=SLOTB,ks_cur=0;
  #define ROT() do{sl_prev=sl_cur;sl_cur=sl_next;sl_next=(sl_next==(NSLOT-1)*SLOTB)?0:sl_next+SLOTB;ks_cur=(ks_cur+SLOTB)&(4*SLOTB-1);}while(0)
  DMA_K(2,2*SLOTB);
  WAIT_BAR(4);
  cinit(pA0,pA1,sl2,tb0);
  { bf16x8 qr[4];
    #pragma unroll
    for(int d0=0;d0<4;++d0)qr[d0]=QF(d0);
    qkt(pA0,pA1,Kbase,qr,r32,hi); }asm volatile("s_nop 15\n\ts_nop 7":"+v"(pA0),"+v"(pA1));CMASK(pA0,pA1,0);
  START(pA0,pA1);
  cinit(pB0,pB1,sl2,NVAL(1));
  _Pragma("unroll") for(int r=0;r<16;++r)pA1[r]=__builtin_amdgcn_exp2f(pA1[r]);
  WAIT_BAR(0);
  DMA_K(3,3*SLOTB);DMA_V(1,SLOTB);
  ROT();
  WAIT_BAR(3);
  s16x4 vlo[8],vhi[8]; u32x4 pw0,pw1,pw2,pw3;
  bf16x8 nka=*(const __attribute__((address_space(3))) bf16x8*)(kp0+ks_cur),nkb=*(const __attribute__((address_space(3))) bf16x8*)(kp0+ks_cur+512),nqa=QF(0),nqb=QF(1);
  #define PKW(P,B) cvtpk_s(P[B],P[B+1])
  #define PAF(k) __builtin_bit_cast(bf16x8,pw##k)
  #define VFR(i) (bf16x8){vlo[(i)&7][0],vlo[(i)&7][1],vlo[(i)&7][2],vlo[(i)&7][3],vhi[(i)&7][0],vhi[(i)&7][1],vhi[(i)&7][2],vhi[(i)&7][3]}
  #define PIN(x) asm volatile("":"+v"(x))
  #define MX3(a,b,c) __builtin_fmaxf(__builtin_fmaxf((a),(b)),(c))
  #define GAPA(MF,A0,A1,A2,A3,W0,W1,PW) do{ MF; sacc+=A0; sacc+=A1; sacc+=A2; sacc+=A3; PIN(sacc); W0; W1; PIN(PW); SBAR(); }while(0)
  #define EX(v) __builtin_amdgcn_exp2f(v)
  #define VRD(f) do{ vlo[(f)&7]=vtr(vp_+(((f)&3)*4096+((f)>>2)*1024)); vhi[(f)&7]=vtr(vp_+(((f)&3)*4096+((f)>>2)*1024+512)); }while(0)
  #define GAPB(f,X,B,Y,OFS) do{ o[(f)&3]=__builtin_amdgcn_mfma_f32_32x32x16_bf16(__builtin_bit_cast(bf16x8,(f)<4?pw0:(f)<8?pw1:(f)<12?pw2:pw3),VFR(f),o[(f)&3],0,0,0); \
    X[B]=EX(X[B]); X[B+1]=EX(X[B+1]); PIN(X); \
    Y[B]=__builtin_fmaf(sl2,CI_C(B)+OFS,nvn); Y[B+1]=__builtin_fmaf(sl2,CI_C(B+1)+OFS,nvn); \
    if((f)+4<16){VRD((f)+4);} SBAR(); }while(0)
  #define KF(j) (*(const __attribute__((address_space(3))) bf16x8*)(kp_+((j)>>1)*2048+((j)&1)*512))
  #define STEP(C0,C1,P0,P1,t,GK,GV,GL) do{ SBAR(); \
    const lds_cptr vp_=vp0+2*sl_prev; const lds_cptr kp_=kp0+ks_cur; \
    bf16x8 ka=nka,kb=nkb,qa=nqa,qb_=nqb; SBAR(); \
    float sacc=(P0[0]+P0[1]); \
    GAPA(C0=__builtin_amdgcn_mfma_f32_32x32x16_bf16(ka,qa,C0,0,0,0), P0[2],P0[3],P0[4],P0[5],     pw0[0]=PKW(P0,0), pw0[1]=PKW(P0,2), pw0); \
    ka=KF(2); SBAR(); \
    GAPA(C1=__builtin_amdgcn_mfma_f32_32x32x16_bf16(kb,qa,C1,0,0,0), P0[6],P0[7],P0[8],P0[9],     pw0[2]=PKW(P0,4), pw0[3]=PKW(P0,6), pw0); \
    kb=KF(3); qa=QF(2); SBAR(); \
    GAPA(C0=__builtin_amdgcn_mfma_f32_32x32x16_bf16(ka,qb_,C0,0,0,0),   P0[10],P0[11],P0[12],P0[13], pw1[0]=PKW(P0,8), pw1[1]=PKW(P0,10), pw1); \
    ka=KF(4); SBAR(); \
    GAPA(C1=__builtin_amdgcn_mfma_f32_32x32x16_bf16(kb,qb_,C1,0,0,0),   P0[14],P0[15],P1[0],P1[1],   pw1[2]=PKW(P0,12),pw1[3]=PKW(P0,14), pw1); \
    kb=KF(5); qb_=QF(3); VRD(0); SBAR(); \
    GAPA(C0=__builtin_amdgcn_mfma_f32_32x32x16_bf16(ka,qa,C0,0,0,0),   P1[2],P1[3],P1[4],P1[5],     pw2[0]=PKW(P1,0), pw2[1]=PKW(P1,2), pw2); \
    ka=KF(6); VRD(1); SBAR(); \
    GAPA(C1=__builtin_amdgcn_mfma_f32_32x32x16_bf16(kb,qa,C1,0,0,0),   P1[6],P1[7],P1[8],P1[9],     pw2[2]=PKW(P1,4), pw2[3]=PKW(P1,6), pw2); \
    kb=KF(7); VRD(2); SBAR(); \
    GAPA(C0=__builtin_amdgcn_mfma_f32_32x32x16_bf16(ka,qb_,C0,0,0,0),   P1[10],P1[11],P1[12],P1[13], pw3[0]=PKW(P1,8), pw3[1]=PKW(P1,10), pw3); \
    VRD(3); SBAR(); \
    GAPA(C1=__builtin_amdgcn_mfma_f32_32x32x16_bf16(kb,qb_,C1,0,0,0),   P1[14],P1[15],0.f,0.f,       pw3[2]=PKW(P1,12),pw3[3]=PKW(P1,14), pw3); \
    l_reg+=sacc; \
    if(GK){DMA_K((t)+3,(ks_cur+3*SLOTB)&(4*SLOTB-1));} if(GV){DMA_V((t)+1,sl_next);} \
    CMASK(C0,C1,t); \
    float nvn; \
    { float a=MX3(C0[0],C0[1],C1[0]),b=MX3(C0[2],C0[3],C1[1]); a=MX3(a,C1[2],C1[3]); \
      _Pragma("unroll") for(int r=4;r<16;r+=4){a=MX3(a,C0[r],C0[r+1]);b=MX3(b,C0[r+2],C0[r+3]);a=MX3(a,C1[r],C1[r+1]);b=MX3(b,C1[r+2],C1[r+3]);} \
      float rm=__builtin_fmaxf(a,b); { auto rr=__builtin_amdgcn_permlane32_swap(__float_as_uint(rm),__float_as_uint(rm),false,false); rm=__builtin_fmaxf(__uint_as_float(rr[0]),__uint_as_float(rr[1])); } \
      resc=false; \
      if(__builtin_expect(__any(rm>(float)THRL),0)){ const float dl=__builtin_fmaxf(rm,0.f); mhat+=dl; \
        _Pragma("unroll") for(int r=0;r<16;++r){C0[r]-=dl;C1[r]-=dl;} \
        const float f=__builtin_amdgcn_exp2f(-dl); l_reg*=f; if(hi==0)wsf[r32]=f; resc=true; } \
      nvn=NVAL((t)+1); } \
    SBAR(); \
    GAPB(0,C0,0,P0,0.0f); GAPB(1,C0,2,P0,0.0f); GAPB(2,C0,4,P0,0.0f); GAPB(3,C0,6,P0,0.0f); \
    GAPB(4,C0,8,P0,0.0f); GAPB(5,C0,10,P0,0.0f); GAPB(6,C0,12,P0,0.0f); GAPB(7,C0,14,P0,0.0f); \
    GAPB(8,C1,0,P1,32.0f); GAPB(9,C1,2,P1,32.0f); GAPB(10,C1,4,P1,32.0f); GAPB(11,C1,6,P1,32.0f); \
    GAPB(12,C1,8,P1,32.0f); GAPB(13,C1,10,P1,32.0f); GAPB(14,C1,12,P1,32.0f); \
    { const lds_cptr kn_=kp0+((ks_cur+SLOTB)&(4*SLOTB-1)); nka=*(const __attribute__((address_space(3))) bf16x8*)(kn_); nkb=*(const __attribute__((address_space(3))) bf16x8*)(kn_+512); nqa=QF(0); nqb=QF(1); SBAR(); } \
    GAPB(15,C1,14,P1,32.0f); \
    }while(0)
  int t=1;
  #undef CMASK
  #define CMASK(P0,P1,t) do{}while(0)
  for(;t+5<NT;t+=2){
    STEP(pB0,pB1,pA0,pA1,t,true,true,true);     WAIT_BAR(3); RESC(); ROT();
    STEP(pA0,pA1,pB0,pB1,t+1,true,true,true);   WAIT_BAR(3); RESC(); ROT();
  }
  #undef CMASK
  #define CMASK(P0,P1,t) do{int jb_=(t)-(NT-4); if(jb_>=0)cmask(P0,P1,jb_,qrel,hi);}while(0)
  #define ENDW(tt) do{ if((tt)+3<NT){WAIT_BAR(3);} else if((tt)+2<NT){WAIT_BAR(2);} else {WAIT_BAR(0);} }while(0)
  for(;t+1<NT;t+=2){
    STEP(pB0,pB1,pA0,pA1,t,(t+3<NT),(t+1<NT),(t+1<NT));       ENDW(t);   RESC(); ROT();
    STEP(pA0,pA1,pB0,pB1,t+1,(t+4<NT),(t+2<NT),(t+2<NT));     ENDW(t+1); RESC(); ROT();
  }
  STEP(pB0,pB1,pA0,pA1,NT-1,false,false,false); RESC();
  { float sacc=pB0[0]+pB0[1]; _Pragma("unroll") for(int r=2;r<16;++r)sacc+=pB0[r]; _Pragma("unroll") for(int r=0;r<16;++r)sacc+=pB1[r]; l_reg+=sacc;
    pw0=(u32x4){PKW(pB0,0),PKW(pB0,2),PKW(pB0,4),PKW(pB0,6)};pw1=(u32x4){PKW(pB0,8),PKW(pB0,10),PKW(pB0,12),PKW(pB0,14)};pw2=(u32x4){PKW(pB1,0),PKW(pB1,2),PKW(pB1,4),PKW(pB1,6)};pw3=(u32x4){PKW(pB1,8),PKW(pB1,10),PKW(pB1,12),PKW(pB1,14)};
    SBAR(); pv4(o,vb0+2*sl_cur,PAF(0),PAF(1),PAF(2),PAF(3)); }
  #undef PKW
  #undef PAF
  #undef VFR
  #undef PIN
  #undef MX3
  #undef GAPA
  #undef GAPB
  #undef EX
  #undef VRD
  #undef KF
  #undef STEP
  #undef ENDW
  {auto rr=__builtin_amdgcn_permlane32_swap(__float_as_uint(l_reg),__float_as_uint(l_reg),false,false);l_reg=__uint_as_float(rr[0])+__uint_as_float(rr[1]);}
  if(hi==0)wsf[32+r32]=l_reg;asm volatile("s_waitcnt lgkmcnt(0)":::"memory");
  float rli[16];
  #pragma unroll
  for(int r=0;r<16;++r)rli[r]=__builtin_amdgcn_rcpf(wsf[32+crow(r,hi)]);
  bf16*Ow=O+(rowbase+q0+wid*QBLK)*DM+2*h*D;
  bf16*stg=(bf16*)(shm+LDS_OST2)+wid*2048;
  if constexpr(!FUSE){
    #pragma unroll
    for(int ps=0;ps<2;++ps){
      #pragma unroll
      for(int r=0;r<16;++r){const int orow=crow(r,hi);
        #pragma unroll
        for(int d0=0;d0<2;++d0)stg[orow*64+d0*32+r32]=__float2bfloat16(o[2*ps+d0][r]*rli[r]);}
      asm volatile("s_waitcnt lgkmcnt(0)":::"memory");
      #pragma unroll
      for(int i=0;i<4;++i){const int row=i*8+(lane>>3),ch=lane&7; const u32x4 v=*(const u32x4*)(stg+row*64+ch*8); ATTN_STORE16(Ow+(long)row*DM+ps*64+ch*8,v);}
      asm volatile("s_waitcnt lgkmcnt(0)":::"memory"); }
    asm volatile("s_waitcnt vmcnt(0)":::"memory");
  } else {
    float dv[2][4][8]; float ss[4]={0.f,0.f,0.f,0.f};
    u32x4 v0p[2][4];
    #pragma unroll
    for(int ps=0;ps<2;++ps)
      #pragma unroll
      for(int i=0;i<4;++i){const int row=i*8+(lane>>3),ch=lane&7; v0p[ps][i]=*(const u32x4*)(Ow+(long)row*DM+ps*64+ch*8);}
    #pragma unroll
    for(int ps=0;ps<2;++ps){
      #pragma unroll
      for(int r=0;r<16;++r){const int orow=crow(r,hi);
        #pragma unroll
        for(int d0=0;d0<2;++d0)stg[orow*64+d0*32+r32]=__float2bfloat16(o[2*ps+d0][r]*rli[r]);}
      asm volatile("s_waitcnt lgkmcnt(0)":::"memory");
      #pragma unroll
      for(int i=0;i<4;++i){const int row=i*8+(lane>>3),ch=lane&7; const u32x4 v1=*(const u32x4*)(stg+row*64+ch*8); const u32x4 v0=v0p[ps][i];
        #pragma unroll
        for(int e=0;e<4;++e){ const float a0=__uint_as_float(v0[e]<<16),a1=__uint_as_float(v0[e]&0xffff0000u),b0=__uint_as_float(v1[e]<<16),b1=__uint_as_float(v1[e]&0xffff0000u);
          const float x0=a0-lam*b0,x1=a1-lam*b1; dv[ps][i][2*e]=x0; dv[ps][i][2*e+1]=x1; ss[i]+=x0*x0+x1*x1; } }
      asm volatile("s_waitcnt lgkmcnt(0)":::"memory"); }
    #pragma unroll
    for(int i=0;i<4;++i){ float s_=ss[i];
      { int b_=__float_as_int(s_); s_+=__int_as_float(__builtin_amdgcn_update_dpp(b_,b_,0xB1,0xF,0xF,false)); b_=__float_as_int(s_); s_+=__int_as_float(__builtin_amdgcn_update_dpp(b_,b_,0x4E,0xF,0xF,false)); b_=__float_as_int(s_); s_+=__int_as_float(__builtin_amdgcn_update_dpp(b_,b_,0x141,0xF,0xF,false)); }
      ss[i]=1.0f/sqrtf(s_*(1.0f/128.0f)+1e-6f); }
    #pragma unroll
    for(int ps=0;ps<2;++ps){ float gg[8];
      #pragma unroll
      for(int e=0;e<8;++e)gg[e]=gsub[ps*64+(lane&7)*8+e]*0.8f;
      #pragma unroll
      for(int i=0;i<4;++i){const int row=i*8+(lane>>3),ch=lane&7; u32x4 w;
        #pragma unroll
        for(int e=0;e<4;++e)w[e]=cvtpk_s(dv[ps][i][2*e]*ss[i]*gg[2*e],dv[ps][i][2*e+1]*ss[i]*gg[2*e+1]);
        ATTN_STORE16(Ow+(long)row*DM+ps*64+ch*8,w);} }
  }
  asm volatile("s_waitcnt lgkmcnt(0)\n\ts_barrier":::"memory");
  #undef DMA_K
  #undef DMA_V
  #undef QF
  #undef CMASK
  #undef NVAL
  #undef START
  #undef RESC
  #undef ROT
}
constexpr int ATTN_LDS_BYTES=LDS_BYTES2;
#undef SBAR
#undef WAIT_BAR
}

constexpr int NWAVES = 8;
constexpr int N_LAUNCHES = MK_N_LAUNCHES;
constexpr int N_PHASES = 9 + 2 * NCH + 1;
constexpr bool PER_PHASE = (MK_N_LAUNCHES != 1);

constexpr size_t MiB = 1u << 20;
constexpr size_t ACT = (size_t)T * D * 2;
constexpr size_t WS_CTL = 0, CTL_ZERO_BYTES = 65536;
constexpr size_t WS_MOD = 1 * MiB;
constexpr size_t WS_SH = WS_MOD + 512 * 1024;
constexpr size_t WS_WIN = 2 * MiB;
constexpr size_t WS_WR = 16 * MiB, WS_WA = 18 * MiB, WS_WO = 20 * MiB;
constexpr size_t WS_LW = 22 * MiB;
constexpr size_t WS_WRH = 23 * MiB, WS_WRL = 23 * MiB + 131072;
constexpr size_t WS_H = 24 * MiB;
constexpr size_t WS_XR = WS_H + ACT;
constexpr size_t WS_GR = WS_XR + ACT;
constexpr size_t WS_Q = WS_GR + ACT;
constexpr size_t WS_K = WS_Q + ACT;
constexpr size_t WS_V = WS_K + ACT;
constexpr size_t WS_O1 = WS_V + ACT;
constexpr size_t WS_END = WS_O1 + ACT;
static_assert(WS_END <= 512 * MiB, "ws map");
constexpr size_t WS_W13 = WS_GR;
constexpr size_t WS_W2 = WS_O1;
constexpr size_t WS_W13S = WS_O1 + 32 * MiB;
constexpr size_t WS_W2S = WS_O1 + 33 * MiB;
constexpr size_t WS_LIST = WS_O1 + 34 * MiB;
constexpr size_t WS_WTS = WS_O1 + 42 * MiB;
constexpr size_t WS_RDEST = WS_O1 + 43 * MiB;
constexpr size_t WS_RWT = WS_O1 + 44 * MiB;
constexpr size_t WS_SA = WS_O1 + 45 * MiB;
constexpr int MAXRT = TC * TOPK / 256 + NEXP + TC / 256;
constexpr int MAXROWS = MAXRT * 256;
constexpr size_t WS_HB = WS_XR;
constexpr size_t WS_SLOT = WS_Q;
constexpr size_t WS_SLOTSC = WS_SLOT + 72 * MiB;
constexpr size_t WS_Y = WS_Q;
static_assert(WS_SLOT + (size_t)(TC * 9) * D * 2 <= WS_O1 && (size_t)MAXROWS * 512 <= ACT, "moe map");
constexpr int CW_TMO = 0;
constexpr int CW_BAR = 4096;
constexpr int CW_CNT = 8192;
constexpr int CW_AMAX = 8192 + 512;

constexpr int RING_BYTES = 139264;
constexpr int MISC_OFF = RING_BYTES;
constexpr int LDS_BYTES = 155648;
constexpr int MI_BARST = 0;
constexpr int MI_CNT = 64;
constexpr int MI_TBASE = 128;
constexpr int MI_TILE_E = 256;
constexpr int MI_TOK = 1024;
constexpr int MI_WORDS = 4096;

#define GAS __attribute__((address_space(1)))
#define LAS __attribute__((address_space(3)))
typedef unsigned short bf16;
typedef unsigned v4u __attribute__((ext_vector_type(4)));
typedef unsigned v2u __attribute__((ext_vector_type(2)));
typedef float f32x4 __attribute__((ext_vector_type(4)));
typedef float f32x16 __attribute__((ext_vector_type(16)));
typedef short bf16x8 __attribute__((ext_vector_type(8)));
typedef GAS unsigned gu32;
#define RLX_AGENT __ATOMIC_RELAXED, __HIP_MEMORY_SCOPE_AGENT
#define LDS_WAIT() asm volatile("s_waitcnt lgkmcnt(0)" ::: "memory")
#define VM_WAIT() asm volatile("s_waitcnt vmcnt(0)" ::: "memory")
__device__ __forceinline__ unsigned f2bf(float f) { unsigned u = __builtin_bit_cast(unsigned, f); return (u + 0x7fffu + ((u >> 16) & 1u)) >> 16; }
__device__ __forceinline__ unsigned pk2(float lo, float hi) { return f2bf(lo) | (f2bf(hi) << 16); }
__device__ __forceinline__ float bf2f(unsigned h) { return __uint_as_float(h << 16); }
using pg8::bflo; using pg8::bfhi; using pg8::sigm;

#define XB_TMO      128
#define XB_XCNT(j)  (256  + 64 * (j))
#define XB_XSUB(j)  (1280 + 64 * (j))
#define XB_XGEN(j)  (2304 + 64 * (j))
#define XB_TOP      3328
#define XB_TOPGEN   3392
#define XCD_BAR_WORDS 3456
#define XB_SPIN_CAP (1u << 18)
__device__ __forceinline__ unsigned xb_ld(unsigned* p)              { return __hip_atomic_load(p, __ATOMIC_RELAXED, __HIP_MEMORY_SCOPE_AGENT); }
__device__ __forceinline__ unsigned xb_add(unsigned* p, unsigned v) { return __hip_atomic_fetch_add(p, v, __ATOMIC_RELAXED, __HIP_MEMORY_SCOPE_AGENT); }
__device__ __forceinline__ unsigned xb_xcc_id() { return (unsigned)__builtin_amdgcn_s_getreg((3 << 11) | 20) & 0xFu; }
#define XB_SPIN(cond, bar) do { unsigned _sp = 0; while (cond) { __builtin_amdgcn_s_sleep(1); \
    if ((++_sp & 255u) == 0u) { if (xb_ld(&(bar)[XB_TMO])) break; if (_sp > XB_SPIN_CAP) { atomicAdd(&(bar)[XB_TMO], 1u); break; } } } } while (0)
struct XcdBarrier { unsigned* bar; unsigned x; volatile LAS unsigned* st; };
__device__ __forceinline__ XcdBarrier xcd_barrier_post(unsigned* bar, volatile LAS unsigned* st) {
    XcdBarrier b; b.bar = bar; b.x = xb_xcc_id(); b.st = st;
    if (threadIdx.x == 0) (void)xb_add(&bar[XB_XCNT(b.x)], 1u);
    return b;
}
__device__ __forceinline__ void xcd_barrier_complete(unsigned* bar, unsigned x, unsigned& nloc, unsigned& nx) {
    const unsigned G = gridDim.x * gridDim.y * gridDim.z;
    unsigned sum, cnt, mine, sp = 0u;
    for (;;) {
        sum = 0u; cnt = 0u; mine = 0u;
#pragma unroll 1
        for (unsigned j = 0; j < 16; ++j) { const unsigned c = xb_ld(&bar[XB_XCNT(j)]); sum += c; cnt += (c > 0u) ? 1u : 0u; mine = (j == x) ? c : mine; }
        if (sum == G) break;
        __builtin_amdgcn_s_sleep(1);
        if ((++sp & 255u) == 0u) { if (xb_ld(&bar[XB_TMO])) break; if (sp > XB_SPIN_CAP) { atomicAdd(&bar[XB_TMO], 1u); break; } }
    }
    nloc = mine > 0u ? mine : 1u; nx = cnt > 0u ? cnt : 1u;
}
__device__ __forceinline__ void xcd_barrier(const XcdBarrier& b) {
    asm volatile("s_waitcnt vmcnt(0)" ::: "memory");
    __syncthreads();
    if (threadIdx.x == 0) {
        unsigned* bar = b.bar; asm volatile("" : "+s"(bar));
        __builtin_amdgcn_s_waitcnt(0);
        unsigned nloc = b.st[0], nx = b.st[1];
        if (nloc == 0u) { xcd_barrier_complete(bar, b.x, nloc, nx); b.st[0] = nloc; b.st[1] = nx; }
        const unsigned old = xb_add(&bar[XB_XSUB(b.x)], 1u);
        const unsigned gen = old / nloc;
        if (old + 1u == (gen + 1u) * nloc) {
            __builtin_amdgcn_fence(__ATOMIC_RELEASE, "agent");
            asm volatile("s_waitcnt vmcnt(0)" ::: "memory");
            const unsigned og = xb_add(&bar[XB_TOP], 1u);
            const unsigned tg = og / nx;
            if (og + 1u == (tg + 1u) * nx) xb_add(&bar[XB_TOPGEN], 1u);
            else XB_SPIN(xb_ld(&bar[XB_TOPGEN]) == tg, bar);
            __builtin_amdgcn_fence(__ATOMIC_ACQUIRE, "agent");
            xb_add(&bar[XB_XGEN(b.x)], 1u);
            asm volatile("s_waitcnt vmcnt(0)" ::: "memory");
        } else {
            XB_SPIN(xb_ld(&bar[XB_XGEN(b.x)]) == gen, bar);
            __builtin_amdgcn_fence(__ATOMIC_ACQUIRE, "agent");
            asm volatile("s_waitcnt vmcnt(0)" ::: "memory");
        }
    }
    __syncthreads();
}

struct Frame {
    LAS unsigned char* lds;
    volatile LAS int* MI;
    gu32* ctl;
    int tid, lane, wave, vcu, G;
    float* out;
    unsigned char* ws;
};
struct Args { const float* in[32]; float* out; unsigned char* ws; int ph_lo, ph_hi; };
__device__ __forceinline__ float dppf(float x, int ctrl_sel) {
    const int b = __float_as_int(x); int r;
    if (ctrl_sel == 0) r = __builtin_amdgcn_update_dpp(b, b, 0xB1, 0xF, 0xF, false);
    else if (ctrl_sel == 1) r = __builtin_amdgcn_update_dpp(b, b, 0x4E, 0xF, 0xF, false);
    else if (ctrl_sel == 2) r = __builtin_amdgcn_update_dpp(b, b, 0x141, 0xF, 0xF, false);
    else r = __builtin_amdgcn_update_dpp(b, b, 0x140, 0xF, 0xF, false);
    return __int_as_float(r);
}
__device__ __forceinline__ float max8_dpp(float x) { x = fmaxf(x, dppf(x, 0)); x = fmaxf(x, dppf(x, 1)); x = fmaxf(x, dppf(x, 2)); return x; }
__device__ __forceinline__ float rl_f(float x, int l) { return __int_as_float(__builtin_amdgcn_readlane(__float_as_int(x), l)); }
__device__ __forceinline__ float wave_max_dpp(float x) { x = max8_dpp(x); x = fmaxf(x, dppf(x, 3)); return fmaxf(fmaxf(rl_f(x, 0), rl_f(x, 16)), fmaxf(rl_f(x, 32), rl_f(x, 48))); }
__device__ __forceinline__ float wave_sum_dpp(float x) { x += dppf(x, 0); x += dppf(x, 1); x += dppf(x, 2); x += dppf(x, 3); return (rl_f(x, 0) + rl_f(x, 16)) + (rl_f(x, 32) + rl_f(x, 48)); }
__device__ __forceinline__ float wave_sum(float v) { return wave_sum_dpp(v); }

typedef short v4i16_t __attribute__((ext_vector_type(4)));
__device__ __forceinline__ v2u tr8(const LAS unsigned char* p) { return __builtin_bit_cast(v2u, __builtin_amdgcn_ds_read_tr16_b64_v4i16((LAS v4i16_t*)p)); }
__device__ __forceinline__ void transpose_item(const float* W, int K, int N, bf16* WT, int kb, int n0, int drow0, LAS float* scr_, int lane) {
    LAS unsigned char* scr = (LAS unsigned char*)scr_;
    const int k0 = 64 * kb, lr = lane >> 4, lc = lane & 15;
#pragma unroll
    for (int hf = 0; hf < 2; ++hf) {
        f32x4 v[8];
#pragma unroll
        for (int r = 0; r < 8; ++r) v[r] = *(const f32x4*)(W + (size_t)(k0 + 32 * hf + 4 * r + lr) * N + n0 + 4 * lc);
#pragma unroll
        for (int r = 0; r < 8; ++r) { v2u o; o.x = pk2(v[r].x, v[r].y); o.y = pk2(v[r].z, v[r].w); *(LAS v2u*)(scr + (32 * hf + 4 * r + lr) * 144 + lc * 8) = o; }
    }
    LDS_WAIT(); asm volatile("" ::: "memory");
    const int g = lane >> 4, q = (lane & 15) >> 2, p = lane & 3;
#pragma unroll
    for (int nb = 0; nb < 4; ++nb)
#pragma unroll
        for (int kk = 0; kk < 2; ++kk) { const int kblk = 4 * kk + g;
            const v2u a = tr8(scr + (8 * kblk + q) * 144 + (16 * nb + 4 * p) * 2), b = tr8(scr + (8 * kblk + 4 + q) * 144 + (16 * nb + 4 * p) * 2);
            v4u o; o.x = a.x; o.y = a.y; o.z = b.x; o.w = b.y;
            *(GAS v4u*)(WT + (size_t)(drow0 + 16 * nb + lc) * K + k0 + 8 * kblk) = o; }
    LDS_WAIT(); asm volatile("" ::: "memory");
}

__device__ __forceinline__ void p0_phase(Frame& F, const Args& A) {
    unsigned char* ws = F.ws;
    LAS float* sc = (LAS float*)F.lds;
    if (F.vcu < 6 * D / 64) {
#pragma unroll 1
        for (int i0 = F.tid; i0 < BATCH * D; i0 += 8 * NWAVES * 64) { float v[8];
#pragma unroll
            for (int u = 0; u < 8; ++u) v[u] = A.in[1][i0 + u * NWAVES * 64];
#pragma unroll
            for (int u = 0; u < 8; ++u) { const int i = i0 + u * NWAVES * 64, b = i >> 10, k = i & 1023; sc[k * 16 + b] = v[u] * sigm(v[u]); } } }
    __syncthreads();
    const int nada = (F.G > 2 * (6 * D / 64)) ? (6 * D / 64) : 0;
    const int NGW = (F.G - nada) * NWAVES, gw = (F.vcu >= nada) ? (F.vcu - nada) * NWAVES + F.wave : 0x40000000;
    LAS float* part = (LAS float*)(F.lds + 65536);
    for (int task = F.vcu; task < 6 * D / 64; task += F.G) {
        const int col = task * 64 + F.lane;
        float acc[16];
#pragma unroll
        for (int b = 0; b < 16; ++b) acc[b] = 0.f;
        const float* wp = A.in[2] + (size_t)(128 * F.wave) * (6 * D) + col;
        const LAS f32x4* sp = (const LAS f32x4*)(sc + (128 * F.wave) * 16);
#pragma unroll 1
        for (int k0 = 0; k0 < 128; k0 += 32) { float wv[32];
#pragma unroll
            for (int i = 0; i < 32; ++i) wv[i] = wp[(size_t)(k0 + i) * (6 * D)];
#pragma unroll
            for (int i = 0; i < 32; ++i) {
#pragma unroll
                for (int q = 0; q < 4; ++q) { const f32x4 sv = sp[(k0 + i) * 4 + q]; acc[4 * q + 0] += wv[i] * sv.x; acc[4 * q + 1] += wv[i] * sv.y; acc[4 * q + 2] += wv[i] * sv.z; acc[4 * q + 3] += wv[i] * sv.w; } } }
#pragma unroll
        for (int b = 0; b < 16; ++b) part[(F.wave * 16 + b) * 64 + F.lane] = acc[b];
        __syncthreads();
        for (int i = F.tid; i < 16 * 64; i += NWAVES * 64) { const int b = i >> 6, c = i & 63; float v = A.in[3][task * 64 + c];
#pragma unroll
            for (int w8 = 0; w8 < 8; ++w8) v += part[(w8 * 16 + b) * 64 + c];
            ((float*)(ws + WS_MOD))[b * (6 * D) + task * 64 + c] = v; }
        __syncthreads();
    }
    __syncthreads();
    LAS float* scr = (LAS float*)(F.lds + F.wave * 16384);
    constexpr int I_SQ = 16 * 16, I_LW = 16 * 4;
    constexpr int NITEMS = 3 * I_SQ + I_LW;
    for (int it = gw; it < NITEMS; it += NGW) {
        int r = it;
        if (r < I_SQ) { transpose_item(A.in[18], D, D, (bf16*)(ws + WS_WR), r / 16, 64 * (r % 16), 64 * (r % 16), scr, F.lane); continue; } r -= I_SQ;
        if (r < I_SQ) { transpose_item(A.in[19], D, D, (bf16*)(ws + WS_WA), r / 16, 64 * (r % 16), 64 * (r % 16), scr, F.lane); continue; } r -= I_SQ;
        if (r < I_SQ) { transpose_item(A.in[20], D, D, (bf16*)(ws + WS_WO), r / 16, 64 * (r % 16), 64 * (r % 16), scr, F.lane); continue; } r -= I_SQ;
        { const int mat = r >> 2, q = r & 3, gate = mat >> 3, n = mat & 7;
          const float* W = (gate ? A.in[10] : A.in[8]) + (size_t)n * 128 * 128;
          transpose_item(W, 128, 128, (bf16*)(ws + WS_LW) + (size_t)(n * 2 + gate) * 128 * 128, q >> 1, 64 * (q & 1), 64 * (q & 1), scr, F.lane); }
    }
    for (long i = (long)gw * 64 + F.lane; i < D * NEXP; i += NGW * 64) { const int k = i >> 6, e = i & 63; const float wv = A.in[23][i]; const unsigned hb = f2bf(wv); const unsigned lb = f2bf(wv - bf2f(hb));
        ((bf16*)(ws + WS_WRH))[e * D + k] = (bf16)hb; ((bf16*)(ws + WS_WRL))[e * D + k] = (bf16)lb; }
    for (int it = gw; it < 130 * 64 + (D * W_IN) / 4096; it += NGW) { const int mtx = it < 130 * 64 ? it >> 6 : 130, part = it < 130 * 64 ? (it & 63) : it - 130 * 64, e = mtx >> 1, w3 = mtx & 1;
        const float* W = (mtx == 130 ? A.in[5] : e < NEXP ? (w3 ? A.in[26] : A.in[25]) + (size_t)e * D * DEXP : (w3 ? A.in[29] : A.in[28])) + (size_t)part * 4096;
        float mx = 0.f;
#pragma unroll
        for (int i = 0; i < 16; ++i) { const f32x4 v = *((const f32x4*)W + F.lane + 64 * i); mx = fmaxf(mx, fmaxf(fmaxf(fabsf(v.x), fabsf(v.y)), fmaxf(fabsf(v.z), fabsf(v.w)))); }
        mx = wave_max_dpp(mx);
        if (F.lane == 0) atomicMax((unsigned*)(F.ctl + CW_AMAX + mtx), __float_as_uint(mx)); }
}

__device__ __forceinline__ void transpose_item_q(const float* W, int K, int N, signed char* WT, int kb, int n0, int drow0, LAS float* scr_, int lane, float inv) {
    LAS unsigned char* scr = (LAS unsigned char*)scr_;
    const int k0 = 64 * kb, lr = lane >> 4, lc = lane & 15;
#pragma unroll
    for (int hf = 0; hf < 2; ++hf) {
        f32x4 v[8];
#pragma unroll
        for (int r = 0; r < 8; ++r) v[r] = *(const f32x4*)(W + (size_t)(k0 + 32 * hf + 4 * r + lr) * N + n0 + 4 * lc);
#pragma unroll
        for (int r = 0; r < 8; ++r) { v2u o; o.x = pk2(v[r].x, v[r].y); o.y = pk2(v[r].z, v[r].w); *(LAS v2u*)(scr + (32 * hf + 4 * r + lr) * 144 + lc * 8) = o; }
    }
    LDS_WAIT(); asm volatile("" ::: "memory");
    const int g = lane >> 4, q = (lane & 15) >> 2, p = lane & 3;
#pragma unroll
    for (int nb = 0; nb < 4; ++nb)
#pragma unroll
        for (int kk = 0; kk < 2; ++kk) { const int kblk = 4 * kk + g;
            const v2u a = tr8(scr + (8 * kblk + q) * 144 + (16 * nb + 4 * p) * 2), b = tr8(scr + (8 * kblk + 4 + q) * 144 + (16 * nb + 4 * p) * 2);
            const unsigned wv[4] = {a.x, a.y, b.x, b.y}; unsigned ob[2] = {0u, 0u};
#pragma unroll
            for (int j = 0; j < 4; ++j) { const int q0 = (int)rintf(bflo(wv[j]) * inv), q1 = (int)rintf(bfhi(wv[j]) * inv);
                ob[j >> 1] |= ((unsigned)(q0 & 0xff) << (16 * (j & 1))) | ((unsigned)(q1 & 0xff) << (16 * (j & 1) + 8)); }
            v2u o; o.x = ob[0]; o.y = ob[1];
            *(GAS v2u*)(WT + (size_t)(drow0 + 16 * nb + lc) * K + k0 + 8 * kblk) = o; }
    LDS_WAIT(); asm volatile("" ::: "memory");
}

__device__ __forceinline__ void p1_phase(Frame& F, const Args& A) {
    const int gw = F.vcu * NWAVES + F.wave, NGW = F.G * NWAVES;
    const float* mod = (const float*)(F.ws + WS_MOD);
    signed char* H = (signed char*)(F.ws + WS_H); float* SH = (float*)(F.ws + WS_SH);
    for (int grp = gw; grp < T / 16; grp += NGW) {
        const int b = (grp * 16) / SEQ;
        f32x4 g[4], sc[4], sh[4];
#pragma unroll
        for (int j = 0; j < 4; ++j) { const int c = 4 * F.lane + 256 * j; g[j] = *(const f32x4*)(A.in[4] + c); sh[j] = *(const f32x4*)(mod + b * 6 * D + c); sc[j] = *(const f32x4*)(mod + b * 6 * D + D + c);
            g[j] = g[j] * (sc[j] + 1.0f); }
        f32x4 vn[4];
        { const GAS f32x4* xr = (const GAS f32x4*)(A.in[0] + (size_t)grp * 16 * D) + F.lane;
#pragma unroll
          for (int j = 0; j < 4; ++j) vn[j] = xr[64 * j]; }
#pragma unroll 2
        for (int rr = 0; rr < 16; ++rr) {
            const size_t m = (size_t)grp * 16 + rr;
            f32x4 v[4]; float s = 0.f;
#pragma unroll
            for (int j = 0; j < 4; ++j) v[j] = vn[j];
            if (rr + 1 < 16) { const GAS f32x4* xr = (const GAS f32x4*)(A.in[0] + (m + 1) * D) + F.lane;
#pragma unroll
                for (int j = 0; j < 4; ++j) vn[j] = xr[64 * j]; }
#pragma unroll
            for (int j = 0; j < 4; ++j) s += (v[j].x * v[j].x + v[j].y * v[j].y) + (v[j].z * v[j].z + v[j].w * v[j].w);
            const float rstd = 1.f / sqrtf(wave_sum(s) * (1.f / D) + EPS);
            float amx = 0.f;
#pragma unroll
            for (int j = 0; j < 4; ++j) { v[j] = v[j] * rstd * g[j] + sh[j]; amx = fmaxf(amx, fmaxf(fmaxf(fabsf(v[j].x), fabsf(v[j].y)), fmaxf(fabsf(v[j].z), fabsf(v[j].w)))); }
            amx = fmaxf(wave_max_dpp(amx), 1e-20f); const float inv = 127.0f / amx; if (F.lane == 0) SH[m] = amx * (1.0f / 127.0f);
#pragma unroll
            for (int j = 0; j < 4; ++j) { const int q0 = (int)rintf(v[j].x * inv), q1 = (int)rintf(v[j].y * inv), q2 = (int)rintf(v[j].z * inv), q3 = (int)rintf(v[j].w * inv);
                *((GAS unsigned*)(H + m * D) + F.lane + 64 * j) = (unsigned)(q0 & 0xff) | ((unsigned)(q1 & 0xff) << 8) | ((unsigned)(q2 & 0xff) << 16) | ((unsigned)(q3 & 0xff) << 24); }
        }
    }
    { LAS float* scr = (LAS float*)(F.lds + F.wave * 16384);
      const float inv = 127.0f / fmaxf(__uint_as_float(__hip_atomic_load(F.ctl + CW_AMAX + 130, RLX_AGENT)), 1e-30f);
      constexpr int I_IN = 16 * (W_IN / 64);
      for (int it = NGW - 1 - gw; it < I_IN; it += NGW)
          transpose_item_q(A.in[5], D, W_IN, (signed char*)(F.ws + WS_WIN), it / (W_IN / 64), 64 * (it % (W_IN / 64)), 64 * (it % (W_IN / 64)), scr, F.lane, inv); }
}

struct DenseOrder {
    const char* A; const char* Bt; int nM, nN, nwg, G, c; size_t tstep;
    __device__ __forceinline__ void init(const void* A_, const void* Bt_, int M, int N, int K, int G_, int c_) { A = (const char*)A_; Bt = (const char*)Bt_; nM = M / 256; nN = N / 256; nwg = nM * nN; G = G_; c = c_; tstep = (size_t)256 * K * 2; }
    __device__ __forceinline__ bool next(int i, pg8::Unit& u) const {
        const long L = (long)i * G + c; if (L >= nwg) return false;
        int wgid = (int)L; { const int q = nwg / 8, r = nwg % 8, xcd = wgid % 8, off = wgid / 8; wgid = (xcd < r ? xcd * (q + 1) : r * (q + 1) + (xcd - r) * q) + off; }
        const int nig = 8 * nN, gid = wgid / nig, fm = gid * 8, gsz = (nM - fm) < 8 ? (nM - fm) : 8;
        u.pm = fm + ((wgid % nig) % gsz); u.pn = (wgid % nig) / gsz; u.z = i; u.e = 0; return true;
    }
    __device__ __forceinline__ void bases(const pg8::Unit& u, const char*& a, const char*& b) const { a = A + (size_t)u.pm * tstep; b = Bt + (size_t)u.pn * tstep; }
    __device__ __forceinline__ int tok(int, int) const { return 0; }
};
struct MergeOrder {
    DenseOrder d; const char *A1, *B1;
    __device__ __forceinline__ bool next(int i, pg8::Unit& u) const { if (!d.next(i >> 1, u)) return false; u.z = i & 1; return true; }
    __device__ __forceinline__ void bases(const pg8::Unit& u, const char*& a, const char*& b) const { a = (u.z ? A1 : d.A) + (size_t)u.pm * d.tstep; b = (u.z ? B1 : d.Bt) + (size_t)u.pn * d.tstep; }
    __device__ __forceinline__ int tok(int, int) const { return 0; }
};
typedef pg8::f32x4 acc_t[2][2][4][2];
struct EpiProj {
    static constexpr bool PERM = true, TWICE = false;
    bf16* ws5; bf16* dout2; volatile LAS int* MI; float sB;
    __device__ __forceinline__ void operator()(const acc_t& acc, const pg8::Unit& u, int wr, int wc, int fr, int fq) const {
        const int t = u.pn >> 2, colt = (u.pn & 3) * 256;
        bf16* base = ws5 + (size_t)(t < 5 ? t : 0) * T * D;
        const int row0 = u.pm * 256 + wr * 64 + fr, col0 = colt + wc * 32 + 8 * fq;
#pragma unroll
        for (int ai = 0; ai < 2; ++ai)
#pragma unroll
            for (int m = 0; m < 4; ++m) { bf16* rowp = base + (size_t)(row0 + ai * 128 + m * 16) * D + col0;
                const float sc = __int_as_float(MI[512 + u.z * 256 + wr * 64 + fr + ai * 128 + m * 16]) * sB;
#pragma unroll
                for (int bj = 0; bj < 2; ++bj) { const pg8::i32x4 I0 = __builtin_bit_cast(pg8::i32x4, acc[ai][bj][m][0]), I1 = __builtin_bit_cast(pg8::i32x4, acc[ai][bj][m][1]);
                    pg8::f32x4 v0, v1;
#pragma unroll
                    for (int i = 0; i < 4; ++i) { float a = (float)I0[i] * sc, b = (float)I1[i] * sc; asm volatile("" : "+v"(a), "+v"(b)); v0[i] = a; v1[i] = b; }
                    if (t >= 5) {
                        unsigned tb[8];
#pragma unroll
                        for (int i = 0; i < 4; ++i) { tb[i] = __float_as_uint(__builtin_fmaf(sigm(v0[i]), 255.0f, 8388608.0f)); tb[4 + i] = __float_as_uint(__builtin_fmaf(sigm(v1[i]), 255.0f, 8388608.0f)); }
                        v2u w; w.x = __builtin_amdgcn_perm(__builtin_amdgcn_perm(tb[3], tb[2], 0x0c0c0400u), __builtin_amdgcn_perm(tb[1], tb[0], 0x0c0c0400u), 0x05040100u);
                        w.y = __builtin_amdgcn_perm(__builtin_amdgcn_perm(tb[7], tb[6], 0x0c0c0400u), __builtin_amdgcn_perm(tb[5], tb[4], 0x0c0c0400u), 0x05040100u);
                        *(v2u*)((unsigned char*)dout2 + (size_t)(t - 5) * T * D + (size_t)(row0 + ai * 128 + m * 16) * D + col0 + bj * 128) = w; continue; }
                    if (t == 1) { for (int i = 0; i < 4; ++i) { v0[i] = pg8::gelu_t(v0[i]); v1[i] = pg8::gelu_t(v1[i]); } }
                    else if (t == 2) { v0 = v0 * attn_body::C2; v1 = v1 * attn_body::C2; }
                    v4u w; w.x = pg8::cvt_pk_bf16(v0[0], v0[1]); w.y = pg8::cvt_pk_bf16(v0[2], v0[3]); w.z = pg8::cvt_pk_bf16(v1[0], v1[1]); w.w = pg8::cvt_pk_bf16(v1[2], v1[3]);
                    *(v4u*)(rowp + bj * 128) = w; } }
    }
};
struct EpiGate {
    static constexpr bool PERM = true, TWICE = false;
    const unsigned char* GA; const unsigned char* GB; bf16* YA; bf16* MG;
    __device__ __forceinline__ void operator()(const acc_t& acc, const pg8::Unit& u, int wr, int wc, int fr, int fq) const {
        const int row0 = u.pm * 256 + wr * 64 + fr, col0 = u.pn * 256 + wc * 32 + 8 * fq;
        const unsigned char* G = u.z ? GB : GA; bf16* O = u.z ? MG : YA;
#pragma unroll
        for (int ai = 0; ai < 2; ++ai)
#pragma unroll
            for (int mp = 0; mp < 2; ++mp) {
                v2u g[2][2]; v4u y[2][2];
#pragma unroll
                for (int mm = 0; mm < 2; ++mm)
#pragma unroll
                    for (int bj = 0; bj < 2; ++bj) { const size_t off = (size_t)(row0 + ai * 128 + (2 * mp + mm) * 16) * D + col0 + bj * 128; g[mm][bj] = *(const v2u*)(G + off);
                        y[mm][bj] = u.z ? *(const v4u*)(YA + off) : (v4u){0u, 0u, 0u, 0u}; }
#pragma unroll
                for (int mm = 0; mm < 2; ++mm)
#pragma unroll
                    for (int bj = 0; bj < 2; ++bj) { const int m = 2 * mp + mm; const size_t off = (size_t)(row0 + ai * 128 + m * 16) * D + col0 + bj * 128; const v2u gg = g[mm][bj]; const v4u yy = y[mm][bj]; constexpr float Q = 1.0f / 255.0f;
                        pg8::f32x4 v0 = acc[ai][bj][m][0], v1 = acc[ai][bj][m][1];
                        v0[0] = v0[0] * ((float)(gg.x & 0xffu) * Q) + bflo(yy.x); v0[1] = v0[1] * ((float)((gg.x >> 8) & 0xffu) * Q) + bfhi(yy.x); v0[2] = v0[2] * ((float)((gg.x >> 16) & 0xffu) * Q) + bflo(yy.y); v0[3] = v0[3] * ((float)(gg.x >> 24) * Q) + bfhi(yy.y);
                        v1[0] = v1[0] * ((float)(gg.y & 0xffu) * Q) + bflo(yy.z); v1[1] = v1[1] * ((float)((gg.y >> 8) & 0xffu) * Q) + bfhi(yy.z); v1[2] = v1[2] * ((float)((gg.y >> 16) & 0xffu) * Q) + bflo(yy.w); v1[3] = v1[3] * ((float)(gg.y >> 24) * Q) + bfhi(yy.w);
                        v4u w; w.x = pg8::cvt_pk_bf16(v0[0], v0[1]); w.y = pg8::cvt_pk_bf16(v0[2], v0[3]); w.z = pg8::cvt_pk_bf16(v1[0], v1[1]); w.w = pg8::cvt_pk_bf16(v1[2], v1[3]);
                        *(v4u*)(O + off) = w; }
                asm volatile("" ::: "memory"); }
    }
};
struct EpiF32 {
    static constexpr bool PERM = true, TWICE = false;
    bf16* Y;
    __device__ __forceinline__ void operator()(const acc_t& acc, const pg8::Unit& u, int wr, int wc, int fr, int fq) const {
        const int row0 = u.pm * 256 + wr * 64 + fr, col0 = u.pn * 256 + wc * 32 + 8 * fq;
#pragma unroll
        for (int ai = 0; ai < 2; ++ai)
#pragma unroll
            for (int m = 0; m < 4; ++m) { bf16* rowp = Y + (size_t)(row0 + ai * 128 + m * 16) * D + col0;
#pragma unroll
                for (int bj = 0; bj < 2; ++bj) { const pg8::f32x4 v0 = acc[ai][bj][m][0], v1 = acc[ai][bj][m][1];
                    v4u w; w.x = pg8::cvt_pk_bf16(v0[0], v0[1]); w.y = pg8::cvt_pk_bf16(v0[2], v0[3]); w.z = pg8::cvt_pk_bf16(v1[0], v1[1]); w.w = pg8::cvt_pk_bf16(v1[2], v1[3]);
                    *(v4u*)(rowp + bj * 128) = w; } }
    }
};

__device__ __forceinline__ void lru_phase(Frame& F, const Args& A) {
    unsigned char* ws = F.ws;
    const bf16* XR = (const bf16*)(ws + WS_XR); bf16* GR = (bf16*)(ws + WS_GR);
    LAS unsigned char* AT = F.lds;
    LAS unsigned char* BT = F.lds + 34816;
    LAS float* AA = (LAS float*)(F.lds + 69632);
    LAS float* UU = (LAS float*)(F.lds + 102400);
    LAS float* SM = (LAS float*)(F.lds + 135168);
    LAS float* CW = (LAS float*)(F.lds + MISC_OFF + 4096);
    const int tid = F.tid, lane = F.lane, w = F.wave, hi = lane >> 5, l31 = lane & 31;
    for (int item = F.vcu; item < BATCH * 16; item += F.G) {
        const int b = item >> 4, n = (item >> 1) & 7, half = item & 1;
        __syncthreads();
        { const bf16* LW = (const bf16*)(ws + WS_LW) + (size_t)n * 2 * 128 * 128;
#pragma unroll
          for (int p = 0; p < 4; ++p) { const int q = tid + 512 * p, row = q >> 4, pc = q & 15; const int gate = row >> 6, d = 64 * half + (row & 63);
              const v4u v = *(const v4u*)(LW + ((size_t)gate * 128 + d) * 128 + pc * 8); *(LAS v4u*)(BT + row * 272 + pc * 16) = v; }
          for (int i = tid; i < 640; i += NWAVES * 64) { const int k = i >> 7, c = i & 127; CW[i] = (k < 4) ? A.in[6][k * D + 128 * n + c] : A.in[7][128 * n + c]; } }
        const int c8 = (tid & 15) * 8, run = tid >> 4, cg0 = 128 * n + c8;
        const int tg = w & 3, cg = w >> 2, lc = 32 * cg + l31, chg = 128 * n + 64 * half + lc;
        const float ba_c = A.in[9][chg], bx_c = A.in[11][chg];
        const float lam = A.in[12][chg]; const float sp8 = 8.0f * log1pf(expf(-lam)) * LOG2E;
        const int sc_c = tid & 63, seg = tid >> 6;
        float hcarry = 0.f;
        v4u xq[7];
        { const bf16* xp = XR + ((size_t)b * SEQ + 4 * run - 3) * D + cg0;
#pragma unroll
          for (int i = 0; i < 7; ++i) xq[i] = (4 * run - 3 + i >= 0) ? *(const v4u*)(xp + (size_t)i * D) : (v4u){0u, 0u, 0u, 0u}; }
        __syncthreads();
#pragma unroll 1
        for (int ck = 0; ck < SEQ / 128; ++ck) {
            const int t0 = 128 * ck;
            bf16* gp = GR + ((size_t)b * SEQ + t0 + 16 * seg) * D + 128 * n + 64 * half + sc_c;
            { unsigned ow[4][4];
#pragma unroll
              for (int hf = 0; hf < 2; ++hf) { float wv[5][4];
#pragma unroll
                  for (int k = 0; k < 5; ++k) { const f32x4 w0 = *(const LAS f32x4*)(CW + k * 128 + c8 + 4 * hf); wv[k][0] = w0.x; wv[k][1] = w0.y; wv[k][2] = w0.z; wv[k][3] = w0.w; }
#pragma unroll
                  for (int tt = 0; tt < 4; ++tt) { float x0 = wv[4][0], x1 = wv[4][1], x2 = wv[4][2], x3 = wv[4][3];
#pragma unroll
                      for (int k = 0; k < 4; ++k) { const unsigned va = hf ? xq[tt + k].z : xq[tt + k].x, vb = hf ? xq[tt + k].w : xq[tt + k].y;
                          x0 += wv[k][0] * bflo(va); x1 += wv[k][1] * bfhi(va); x2 += wv[k][2] * bflo(vb); x3 += wv[k][3] * bfhi(vb); }
                      ow[tt][2 * hf] = pk2(x0, x1); ow[tt][2 * hf + 1] = pk2(x2, x3); } }
#pragma unroll
              for (int tt = 0; tt < 4; ++tt) { v4u o; o.x = ow[tt][0]; o.y = ow[tt][1]; o.z = ow[tt][2]; o.w = ow[tt][3]; *(LAS v4u*)(AT + (4 * run + tt) * 272 + c8 * 2) = o; } }
            if (ck + 1 < SEQ / 128) { const bf16* xp = XR + ((size_t)b * SEQ + t0 + 128 + 4 * run - 3) * D + cg0;
#pragma unroll
                for (int i = 0; i < 7; ++i) xq[i] = *(const v4u*)(xp + (size_t)i * D); }
            __syncthreads();
            { f32x16 accR = f32x16{}, accI = f32x16{};
#pragma unroll
              for (int ks = 0; ks < 8; ++ks) {
                  const bf16x8 a = *(const LAS bf16x8*)(AT + (32 * tg + l31) * 272 + (16 * ks + 8 * hi) * 2);
                  const bf16x8 bR = *(const LAS bf16x8*)(BT + (32 * cg + l31) * 272 + (16 * ks + 8 * hi) * 2);
                  const bf16x8 bI = *(const LAS bf16x8*)(BT + (64 + 32 * cg + l31) * 272 + (16 * ks + 8 * hi) * 2);
                  accR = __builtin_amdgcn_mfma_f32_32x32x16_bf16(a, bR, accR, 0, 0, 0);
                  accI = __builtin_amdgcn_mfma_f32_32x32x16_bf16(a, bI, accI, 0, 0, 0); }
#pragma unroll
              for (int r = 0; r < 16; ++r) {
                  const int tok = 32 * tg + (r & 3) + 8 * (r >> 2) + 4 * hi;
                  const float rg = sigm(accR[r] + ba_c), ig = sigm(accI[r] + bx_c);
                  const float la2 = -sp8 * rg;
                  const float a = __builtin_amdgcn_exp2f(la2);
                  float mult = __builtin_amdgcn_sqrtf(fmaxf(1.0f - a * a, 0.f));
                  if (t0 + tok == 0) mult = 1.0f;
                  const float xcv = bf2f(*(const LAS unsigned short*)(AT + tok * 272 + (64 * half + lc) * 2));
                  AA[tok * 64 + lc] = a; UU[tok * 64 + lc] = mult * ig * xcv; } }
            __syncthreads();
            unsigned short gq[16];
#pragma unroll
            for (int j = 0; j < 16; ++j) gq[j] = gp[(size_t)j * D];
            float hl[16], pl[16];
            { float h = 0.f, P = 1.f;
#pragma unroll
              for (int j = 0; j < 16; ++j) { const float a = AA[(16 * seg + j) * 64 + sc_c], u = UU[(16 * seg + j) * 64 + sc_c]; h = a * h + u; P = P * a; hl[j] = h; pl[j] = P; }
              SM[(seg * 64 + sc_c) * 2] = P; SM[(seg * 64 + sc_c) * 2 + 1] = h; }
            __syncthreads();
            { float cin = hcarry, tot = hcarry;
#pragma unroll
              for (int s = 0; s < 8; ++s) { const float Ps = SM[(s * 64 + sc_c) * 2], hs = SM[(s * 64 + sc_c) * 2 + 1]; tot = Ps * tot + hs; if (s < seg) cin = tot; }
              hcarry = tot;
#pragma unroll
              for (int j = 0; j < 16; ++j) { const float hv = hl[j] + pl[j] * cin; gp[(size_t)j * D] = (bf16)f2bf(hv * bf2f(gq[j])); } }
        }
    }
    __syncthreads();
}

__device__ __forceinline__ void p5_phase(Frame& F, const Args& A) {
    const int gw = F.vcu * NWAVES + F.wave, NGW = F.G * NWAVES;
    float d1 = A.in[13][F.lane] * A.in[14][F.lane], d2 = A.in[15][F.lane] * A.in[16][F.lane];
    const float lam = expf(wave_sum(d1)) - expf(wave_sum(d2)) + LAM_INIT;
    bf16* O0 = (bf16*)(F.ws + WS_H); const bf16* O1 = (const bf16*)(F.ws + WS_O1);
    float g[16];
#pragma unroll
    for (int i = 0; i < 16; ++i) g[i] = A.in[17][(16 * F.lane + i) & 127] * (1.0f - LAM_INIT);
    for (int m = gw; m < T; m += NGW) {
        const v4u a0 = *(const v4u*)(O0 + (size_t)m * D + 16 * F.lane), a1 = *(const v4u*)(O0 + (size_t)m * D + 16 * F.lane + 8);
        const v4u b0 = *(const v4u*)(O1 + (size_t)m * D + 16 * F.lane), b1 = *(const v4u*)(O1 + (size_t)m * D + 16 * F.lane + 8);
        float o[16];
        o[0] = bflo(a0.x) - lam * bflo(b0.x); o[1] = bfhi(a0.x) - lam * bfhi(b0.x); o[2] = bflo(a0.y) - lam * bflo(b0.y); o[3] = bfhi(a0.y) - lam * bfhi(b0.y);
        o[4] = bflo(a0.z) - lam * bflo(b0.z); o[5] = bfhi(a0.z) - lam * bfhi(b0.z); o[6] = bflo(a0.w) - lam * bflo(b0.w); o[7] = bfhi(a0.w) - lam * bfhi(b0.w);
        o[8] = bflo(a1.x) - lam * bflo(b1.x); o[9] = bfhi(a1.x) - lam * bfhi(b1.x); o[10] = bflo(a1.y) - lam * bflo(b1.y); o[11] = bfhi(a1.y) - lam * bfhi(b1.y);
        o[12] = bflo(a1.z) - lam * bflo(b1.z); o[13] = bfhi(a1.z) - lam * bfhi(b1.z); o[14] = bflo(a1.w) - lam * bflo(b1.w); o[15] = bfhi(a1.w) - lam * bfhi(b1.w);
        float s = 0.f;
#pragma unroll
        for (int i = 0; i < 16; ++i) s += o[i] * o[i];
        s += __shfl_xor(s, 1); s += __shfl_xor(s, 2); s += __shfl_xor(s, 4);
        const float rstd = 1.f / sqrtf(s * (1.f / 128.f) + EPS);
        v4u w0, w1;
        w0.x = pk2(o[0] * rstd * g[0], o[1] * rstd * g[1]); w0.y = pk2(o[2] * rstd * g[2], o[3] * rstd * g[3]); w0.z = pk2(o[4] * rstd * g[4], o[5] * rstd * g[5]); w0.w = pk2(o[6] * rstd * g[6], o[7] * rstd * g[7]);
        w1.x = pk2(o[8] * rstd * g[8], o[9] * rstd * g[9]); w1.y = pk2(o[10] * rstd * g[10], o[11] * rstd * g[11]); w1.z = pk2(o[12] * rstd * g[12], o[13] * rstd * g[13]); w1.w = pk2(o[14] * rstd * g[14], o[15] * rstd * g[15]);
        *(v4u*)(O0 + (size_t)m * D + 16 * F.lane) = w0; *(v4u*)(O0 + (size_t)m * D + 16 * F.lane + 8) = w1;
    }
}

#ifndef PROBE_SEG
#define PROBE_SEG 0
#endif
#define SEG_T0() do { if (PROBE_SEG != 0 && F.tid == 0) { volatile LAS unsigned long long* pp_ = (volatile LAS unsigned long long*)(F.MI + 16); pp_[0] = __builtin_amdgcn_s_memrealtime(); } } while (0)
#define SEG_T1(id) do { if (PROBE_SEG != 0 && F.tid == 0) { volatile LAS unsigned long long* pp_ = (volatile LAS unsigned long long*)(F.MI + 16); const unsigned long long t_ = __builtin_amdgcn_s_memrealtime(); if (PROBE_SEG == (id)) pp_[1] += t_ - pp_[0]; pp_[0] = t_; } } while (0)
__device__ __forceinline__ void p8_phase(Frame& F, const Args& A) {
    unsigned char* ws = F.ws;
    const float* mod = (const float*)(ws + WS_MOD); const bf16* Y = (const bf16*)(ws + WS_Y);
    signed char* H2 = (signed char*)(ws + WS_H); float* SA = (float*)(ws + WS_SA);
    LAS unsigned char* TH = F.lds; LAS unsigned char* TL = F.lds + 66048;
    LAS float* red = (LAS float*)F.lds;
    LAS int* cntl = (LAS int*)(F.lds + 135168);
    const int tid = F.tid, lane = F.lane, w = F.wave, hi = lane >> 5, l31 = lane & 31;
    int* lists = (int*)(ws + WS_LIST); float* wts = (float*)(ws + WS_WTS);
    v2u yn[2][4]; f32x4 xn[2][4];
    if (F.vcu < T / 32) {
#pragma unroll
        for (int q = 0; q < 2; ++q) { const size_t m = (size_t)F.vcu * 32 + w * 4 + q;
#pragma unroll
            for (int j = 0; j < 4; ++j) { yn[q][j] = *((const GAS v2u*)(Y + m * D) + lane + 64 * j); xn[q][j] = *((const GAS f32x4*)(A.in[0] + m * D) + lane + 64 * j); } } }
#pragma unroll 1
    for (int tl = F.vcu; tl < T / 32; tl += F.G) {
        const int tok0 = tl * 32, b = tok0 / SEQ, chunk = tok0 / TC;
        if (tid < 64) cntl[tid] = 0;
        SEG_T0();
        f32x4 c_gp[4], c_g2[4], c_sh[4];
#pragma unroll
        for (int j = 0; j < 4; ++j) { const int c = 4 * lane + 256 * j; c_gp[j] = *(const f32x4*)(A.in[21] + c) * *(const f32x4*)(mod + b * 6 * D + 2 * D + c);
            c_g2[j] = *(const f32x4*)(A.in[22] + c) * (*(const f32x4*)(mod + b * 6 * D + 4 * D + c) + 1.0f); c_sh[j] = *(const f32x4*)(mod + b * 6 * D + 3 * D + c); }
#pragma unroll 1
        for (int rp = 0; rp < 2; ++rp) {
            f32x4 y[2][4], x[2][4]; float s[2] = {0.f, 0.f};
#pragma unroll
            for (int q = 0; q < 2; ++q)
#pragma unroll
                for (int j = 0; j < 4; ++j) { const v2u yv = yn[q][j]; y[q][j] = (f32x4){bflo(yv.x), bfhi(yv.x), bflo(yv.y), bfhi(yv.y)}; x[q][j] = xn[q][j]; }
            { const int ntl = rp ? tl + F.G : tl, nrp = rp ^ 1;
              if (ntl < T / 32) {
#pragma unroll
                  for (int q = 0; q < 2; ++q) { const size_t m = (size_t)ntl * 32 + w * 4 + nrp * 2 + q;
#pragma unroll
                      for (int j = 0; j < 4; ++j) { yn[q][j] = *((const GAS v2u*)(Y + m * D) + lane + 64 * j); xn[q][j] = *((const GAS f32x4*)(A.in[0] + m * D) + lane + 64 * j); } } } }
#pragma unroll
            for (int q = 0; q < 2; ++q)
#pragma unroll
                for (int j = 0; j < 4; ++j) s[q] += (y[q][j].x * y[q][j].x + y[q][j].y * y[q][j].y) + (y[q][j].z * y[q][j].z + y[q][j].w * y[q][j].w);
            float s2[2] = {0.f, 0.f};
#pragma unroll
            for (int q = 0; q < 2; ++q) { const size_t m = (size_t)tok0 + w * 4 + rp * 2 + q; const float rstd = 1.f / sqrtf(wave_sum_dpp(s[q]) * (1.f / D) + EPS);
#pragma unroll
                for (int j = 0; j < 4; ++j) { x[q][j] = x[q][j] + c_gp[j] * (y[q][j] * rstd); { v2u xb; xb.x = pk2(x[q][j].x, x[q][j].y); xb.y = pk2(x[q][j].z, x[q][j].w); *((v2u*)(F.out + m * D) + lane + 64 * j) = xb; }
                    s2[q] += (x[q][j].x * x[q][j].x + x[q][j].y * x[q][j].y) + (x[q][j].z * x[q][j].z + x[q][j].w * x[q][j].w); } }
#pragma unroll
            for (int q = 0; q < 2; ++q) { const size_t m = (size_t)tok0 + w * 4 + rp * 2 + q; const float rstd2 = 1.f / sqrtf(wave_sum_dpp(s2[q]) * (1.f / D) + EPS);
                f32x4 hh[4]; float amx = 0.f;
#pragma unroll
                for (int j = 0; j < 4; ++j) { const int c = 4 * lane + 256 * j; const f32x4 h = (x[q][j] * rstd2) * c_g2[j] + c_sh[j]; hh[j] = h;
                    amx = fmaxf(amx, fmaxf(fmaxf(fabsf(h.x), fabsf(h.y)), fmaxf(fabsf(h.z), fabsf(h.w))));
                    v2u o; o.x = pk2(h.x, h.y); o.y = pk2(h.z, h.w);
                    *(LAS v2u*)(TH + (w * 4 + rp * 2 + q) * 2064 + c * 2) = o; }
                amx = fmaxf(wave_max_dpp(amx), 1e-20f); const float inv = 127.0f / amx; if (lane == 0) SA[m] = amx * (1.0f / 127.0f);
#pragma unroll
                for (int j = 0; j < 4; ++j) { const int q0 = (int)rintf(hh[j].x * inv), q1 = (int)rintf(hh[j].y * inv), q2 = (int)rintf(hh[j].z * inv), q3 = (int)rintf(hh[j].w * inv);
                    *((GAS unsigned*)(H2 + m * D) + lane + 64 * j) = (unsigned)(q0 & 0xff) | ((unsigned)(q1 & 0xff) << 8) | ((unsigned)(q2 & 0xff) << 16) | ((unsigned)(q3 & 0xff) << 24); } }
        }
        bf16x8 bH0[8], bH1[8];
        { const bf16* whp = (const bf16*)(ws + WS_WRH) + (size_t)l31 * D + 128 * w + 8 * hi;
#pragma unroll
          for (int ks = 0; ks < 8; ++ks) { bH0[ks] = *(const GAS bf16x8*)(whp + ks * 16); bH1[ks] = *(const GAS bf16x8*)(whp + 32 * D + ks * 16); } }
        __syncthreads(); SEG_T1(1);
        f32x16 acc0 = f32x16{}, acc1 = f32x16{};
        { const LAS unsigned char* ahp = TH + l31 * 2064 + (128 * w + 8 * hi) * 2;
#pragma unroll
          for (int ks = 0; ks < 8; ++ks) {
              const bf16x8 aH = *(const LAS bf16x8*)(ahp + ks * 32);
              acc0 = __builtin_amdgcn_mfma_f32_32x32x16_bf16(aH, bH0[ks], acc0, 0, 0, 0); acc1 = __builtin_amdgcn_mfma_f32_32x32x16_bf16(aH, bH1[ks], acc1, 0, 0, 0); } }
        __syncthreads(); SEG_T1(2);
#pragma unroll
        for (int r = 0; r < 16; ++r) { const int tk = (r & 3) + 8 * (r >> 2) + 4 * hi; red[(w * 32 + tk) * 64 + l31] = acc0[r]; red[(w * 32 + tk) * 64 + 32 + l31] = acc1[r]; }
        __syncthreads();
        int sel_e[4], sel_lp[4], sel_slot[4]; float sel_wt[4];
        const float eb = A.in[24][lane];
#pragma unroll
        for (int q = 0; q < 4; ++q) {
            const int tk = 4 * w + q; float lg = 0.f;
#pragma unroll
            for (int ww = 0; ww < 8; ++ww) lg += red[(ww * 32 + tk) * 64 + lane];
            const float score = 1.0f / (1.0f + expf(-lg)); const float ch = score + eb;
            const float m1 = max8_dpp(ch);
            const unsigned long long eq = __ballot(ch == m1); const int gsh = lane & ~7; const unsigned ge = (unsigned)((eq >> gsh) & 0xffull);
            const int first = gsh + __builtin_ctz(ge);
            const float m2 = max8_dpp((lane == first) ? -INFINITY : ch);
            const float gs = m1 + m2; const int g = lane >> 3;
            int grank = 0;
#pragma unroll
            for (int gg = 0; gg < 8; ++gg) { const float og = rl_f(gs, gg * 8); grank += (og > gs || (og == gs && gg < g)) ? 1 : 0; }
            float cur = (grank < 4) ? ch : -INFINITY;
            int rank = TOPK;
#pragma unroll
            for (int kk = 0; kk < TOPK; ++kk) { const float mx = wave_max_dpp(cur); const unsigned long long mk = __ballot(cur == mx); const int fl = (int)__builtin_ctzll(mk);
                if (lane == fl) { rank = kk; cur = -INFINITY; } }
            const bool sel = rank < TOPK;
            const float wsum = wave_sum_dpp(sel ? score : 0.f);
            sel_e[q] = sel ? lane : -1; sel_slot[q] = (tok0 + tk) * 8 + rank; sel_wt[q] = score / (wsum + 1e-20f) * 2.5f;
            sel_lp[q] = sel ? atomicAdd((int*)&cntl[lane], 1) : 0;
        }
        __syncthreads(); SEG_T1(3);
        if (tid < 64) { const int c = cntl[tid]; cntl[64 + tid] = c ? (int)__hip_atomic_fetch_add((unsigned*)(F.ctl + CW_CNT + chunk * 64 + tid), (unsigned)c, RLX_AGENT) : 0; }
        __syncthreads();
#pragma unroll
        for (int q = 0; q < 4; ++q) if (sel_e[q] >= 0) { const int pos = cntl[64 + lane] + sel_lp[q]; lists[((size_t)chunk * 64 + lane) * TC + pos] = sel_slot[q]; wts[sel_slot[q]] = sel_wt[q]; }
        __syncthreads(); SEG_T1(4);
    }
    SEG_T0();
    __syncthreads(); SEG_T1(5);
}

__device__ __forceinline__ void expert_copies(Frame& F, const Args& A, int gw, int NGW) {
    unsigned char* ws = F.ws; const int lane = F.lane;
    __syncthreads();
    LAS float* scr = (LAS float*)(F.lds + F.wave * 16384);
    constexpr int I13 = 16 * 4, I2 = 4 * 16, PER_E = 2 * I13 + I2;
    for (int it = gw; it < (NEXP + 1) * PER_E; it += NGW) {
        const int e = it / PER_E; int r = it % PER_E;
        const bool sh = (e == NEXP);
        if (r < 2 * I13) { const int w3 = r / I13; r %= I13; const int kb = r >> 2, n0 = 64 * (r & 3);
            const float* W = sh ? (w3 ? A.in[29] : A.in[28]) : ((w3 ? A.in[26] : A.in[25]) + (size_t)e * D * DEXP);
            signed char* WT = sh ? (signed char*)(ws + WS_W13S) : (signed char*)(ws + WS_W13) + (size_t)e * 512 * D;
            const float amx = fmaxf(__uint_as_float(__hip_atomic_load(F.ctl + CW_AMAX + 2 * e + w3, RLX_AGENT)), 1e-30f);
            transpose_item_q(W, D, DEXP, WT, kb, n0, (n0 >> 7) * 256 + (w3 ? 128 : 0) + (n0 & 127), scr, lane, 127.0f / amx); }
        else { r -= 2 * I13; const int kb = r >> 4, n0 = 64 * (r & 15);
            const float* W = sh ? A.in[30] : A.in[27] + (size_t)e * DEXP * D;
            bf16* WT = sh ? (bf16*)(ws + WS_W2S) : (bf16*)(ws + WS_W2) + (size_t)e * D * DEXP;
            transpose_item(W, DEXP, D, WT, kb, n0, n0, scr, lane); }
    }
    __syncthreads();
}
__device__ __forceinline__ int moe_tables(Frame& F, int chunk) {
    __syncthreads();
    if (F.wave == 0) {
        const int cnt = (int)__hip_atomic_load(F.ctl + CW_CNT + chunk * 64 + F.lane, RLX_AGENT);
        const int nt = (cnt + 255) >> 8; int incl = nt;
#pragma unroll
        for (int o = 1; o < 64; o <<= 1) { const int v = __shfl_up(incl, o); if (F.lane >= o) incl += v; }
        const int base = incl - nt;
        F.MI[MI_CNT + F.lane] = cnt; F.MI[MI_TBASE + F.lane] = base; if (F.lane == 63) F.MI[MI_TBASE + NEXP] = incl;
        for (int j = 0; j < nt; ++j) F.MI[MI_TILE_E + base + j] = F.lane; }
    __syncthreads();
    return F.MI[MI_TBASE + NEXP];
}
struct UpOrder {
    const char* ws; volatile LAS int* MI; int nrt_r, nrt, G, c;
    __device__ __forceinline__ bool next(int i, pg8::Unit& u) const { const int L = i * G + c; if (L >= 2 * nrt) return false; u.pm = L >> 1; u.pn = L & 1; u.z = i;
        u.e = (u.pm < nrt_r) ? __builtin_amdgcn_readfirstlane(MI[MI_TILE_E + u.pm]) : NEXP; return true; }
    __device__ __forceinline__ void bases(const pg8::Unit& u, const char*& a, const char*& b) const { a = ws + WS_H; b = (u.e < NEXP ? ws + WS_W13 + (size_t)u.e * 512 * D : ws + WS_W13S) + (size_t)u.pn * 256 * D; }
    __device__ __forceinline__ int tok(int ui, int row) const { return MI[MI_TOK + ui * 256 + row]; }
};
struct EpiSwiglu {
    static constexpr bool PERM = true, TWICE = false;
    bf16* HB; volatile LAS int* MI; gu32* amax;
    __device__ __forceinline__ void operator()(const acc_t& acc, const pg8::Unit& u, int wr, int wc, int fr, int fq) const {
        const int row0 = u.pm * 256 + wr * 64 + fr, col0 = u.pn * 128 + wc * 32 + 8 * fq;
        const float sB1 = __int_as_float(MI[MI_TOK + 2048 + 2 * u.z]), sB3 = __int_as_float(MI[MI_TOK + 2048 + 2 * u.z + 1]);
#pragma unroll
        for (int ai = 0; ai < 2; ++ai)
#pragma unroll
            for (int m = 0; m < 4; ++m) { bf16* rowp = HB + (size_t)(row0 + ai * 128 + m * 16) * DEXP + col0;
                const float sA = __int_as_float(MI[MI_TOK + 1024 + u.z * 256 + wr * 64 + fr + ai * 128 + m * 16]); const float s1 = sA * sB1, s3 = sA * sB3;
                float v[8];
                { const pg8::i32x4 A0 = __builtin_bit_cast(pg8::i32x4, acc[ai][0][m][0]), A1 = __builtin_bit_cast(pg8::i32x4, acc[ai][0][m][1]), G0 = __builtin_bit_cast(pg8::i32x4, acc[ai][1][m][0]), G1 = __builtin_bit_cast(pg8::i32x4, acc[ai][1][m][1]);
#pragma unroll
                  for (int i = 0; i < 4; ++i) { float a = (float)A0[i] * s1, g = (float)G0[i] * s3; asm volatile("" : "+v"(a), "+v"(g)); v[i] = a * sigm(a) * g;
                      float a2 = (float)A1[i] * s1, g2 = (float)G1[i] * s3; asm volatile("" : "+v"(a2), "+v"(g2)); v[4 + i] = a2 * sigm(a2) * g2; } }
                v4u w; w.x = pg8::cvt_pk_bf16(v[0], v[1]); w.y = pg8::cvt_pk_bf16(v[2], v[3]); w.z = pg8::cvt_pk_bf16(v[4], v[5]); w.w = pg8::cvt_pk_bf16(v[6], v[7]);
                *(v4u*)rowp = w; asm volatile("" ::: "memory"); }
    }
};
struct DownOrder {
    const char* ws; volatile LAS int* MI; int nrt_r, nrt, G, c;
    __device__ __forceinline__ bool next(int i, pg8::Unit& u) const { const int L = i * G + c; if (L >= 4 * nrt) return false; u.pm = L >> 2; u.pn = L & 3; u.z = i;
        u.e = (u.pm < nrt_r) ? __builtin_amdgcn_readfirstlane(MI[MI_TILE_E + u.pm]) : NEXP; return true; }
    __device__ __forceinline__ void bases(const pg8::Unit& u, const char*& a, const char*& b) const { a = ws + WS_HB + (size_t)u.pm * 256 * DEXP * 2; b = (u.e < NEXP ? ws + WS_W2 + (size_t)u.e * D * DEXP * 2 : ws + WS_W2S) + (size_t)u.pn * 256 * DEXP * 2; }
    __device__ __forceinline__ int tok(int, int) const { return 0; }
};
struct EpiScatter {
    static constexpr bool PERM = true, TWICE = true;
    unsigned char* SL; float* SC; volatile LAS int* MI;
    __device__ __forceinline__ void operator()(const acc_t& acc, const pg8::Unit& u, int wr, int wc, int fr, int fq) const {
        const int col0 = u.pn * 256 + wc * 32 + 8 * fq;
#pragma unroll
        for (int ai = 0; ai < 2; ++ai)
#pragma unroll
            for (int m = 0; m < 4; ++m) { const int rl = wr * 64 + fr + ai * 128 + m * 16; const int dest = MI[MI_TOK + u.z * 512 + rl]; const float wt = __int_as_float(MI[MI_TOK + u.z * 512 + 256 + rl]);
                float amx[2];
#pragma unroll
                for (int bj = 0; bj < 2; ++bj) { const pg8::f32x4 v0 = acc[ai][bj][m][0], v1 = acc[ai][bj][m][1];
                    float a = fmaxf(fmaxf(fmaxf(fabsf(v0[0]), fabsf(v0[1])), fmaxf(fabsf(v0[2]), fabsf(v0[3]))), fmaxf(fmaxf(fabsf(v1[0]), fabsf(v1[1])), fmaxf(fabsf(v1[2]), fabsf(v1[3]))));
                    { auto r = __builtin_amdgcn_permlane16_swap(__float_as_uint(a), __float_as_uint(a), false, false); a = fmaxf(__uint_as_float(r[0]), __uint_as_float(r[1])); }
                    { auto r = __builtin_amdgcn_permlane32_swap(__float_as_uint(a), __float_as_uint(a), false, false); a = fmaxf(__uint_as_float(r[0]), __uint_as_float(r[1])); }
                    amx[bj] = fmaxf(a, 1e-30f); }
                if (dest >= 0) { unsigned char* rowp = SL + (size_t)dest * D + col0;
#pragma unroll
                    for (int bj = 0; bj < 2; ++bj) { const pg8::f32x4 v0 = acc[ai][bj][m][0], v1 = acc[ai][bj][m][1];
                        const float mult = 127.0f * __builtin_amdgcn_rcpf(amx[bj]);
                        unsigned t[8];
#pragma unroll
                        for (int i = 0; i < 4; ++i) { t[i] = __float_as_uint(__builtin_fmaf(v0[i], mult, 12583040.0f)); t[4 + i] = __float_as_uint(__builtin_fmaf(v1[i], mult, 12583040.0f)); }
                        v2u w; w.x = __builtin_amdgcn_perm(__builtin_amdgcn_perm(t[3], t[2], 0x0c0c0400u), __builtin_amdgcn_perm(t[1], t[0], 0x0c0c0400u), 0x05040100u);
                        w.y = __builtin_amdgcn_perm(__builtin_amdgcn_perm(t[7], t[6], 0x0c0c0400u), __builtin_amdgcn_perm(t[5], t[4], 0x0c0c0400u), 0x05040100u);
                        *(v2u*)(rowp + bj * 128) = w; }
                    if (fq < 2) SC[(size_t)dest * 32 + u.pn * 8 + fq * 4 + wc] = (fq ? amx[1] : amx[0]) * wt * (1.0f / 127.0f); } }
    }
};
__device__ __forceinline__ void p2_phase(Frame& F, const Args& A) {
    unsigned char* ws = F.ws;
    DenseOrder S; S.init(ws + WS_H, ws + WS_WIN, T, W_IN, D / 2, F.G, (int)blockIdx.x);
    const float* SH = (const float*)(ws + WS_SH);
    { float v[7]; int pmv[7];
#pragma unroll
      for (int k = 0; k < 7; ++k) { pg8::Unit u; pmv[k] = S.next((F.tid >> 8) + 2 * k, u) ? u.pm : -1; v[k] = pmv[k] >= 0 ? SH[pmv[k] * 256 + (F.tid & 255)] : 0.f; }
#pragma unroll
      for (int k = 0; k < 7; ++k) if (pmv[k] >= 0) F.MI[512 + ((F.tid >> 8) + 2 * k) * 256 + (F.tid & 255)] = __float_as_int(v[k]); }
    __syncthreads();
    EpiProj E{(bf16*)(ws + WS_XR), (bf16*)F.out, F.MI, fmaxf(__uint_as_float(__hip_atomic_load(F.ctl + CW_AMAX + 130, RLX_AGENT)), 1e-30f) * (1.0f / 127.0f)};
    int Kk = D / 2; asm volatile("" : "+s"(Kk));
    pg8::gemm_phase<EpiProj, DenseOrder, true, false, true>(F.lds, F.tid, Kk, S, E);
}
__device__ __forceinline__ void moe_up(Frame& F, int chunk) {
    unsigned char* ws = F.ws;
    const int nrt_r = moe_tables(F, chunk), nrt = nrt_r + TC / 256;
    const int* lists = (const int*)(ws + WS_LIST); const float* wts = (const float*)(ws + WS_WTS);
    int* rdest = (int*)(ws + WS_RDEST); float* rwt = (float*)(ws + WS_RWT);
    { const int r = F.tid & 255; int tokn[2], dest[2], slot[2]; float wt[2], sa[2]; bool act[2]; int rt_[2];
#pragma unroll
      for (int k = 0; k < 2; ++k) { const int i = (F.tid >> 8) + 2 * k, L = i * F.G + F.vcu, rt = L >> 1; act[k] = L < 2 * nrt; rt_[k] = rt; slot[k] = -1; tokn[k] = chunk * TC; dest[k] = -1; wt[k] = 0.f;
          if (act[k]) { if (rt < nrt_r) { const int e = F.MI[MI_TILE_E + rt]; const int idx = (rt - F.MI[MI_TBASE + e]) * 256 + r; if (idx < F.MI[MI_CNT + e]) slot[k] = lists[((size_t)chunk * 64 + e) * TC + idx]; }
              else { tokn[k] = chunk * TC + (rt - nrt_r) * 256 + r; dest[k] = TC * 8 + (rt - nrt_r) * 256 + r; wt[k] = 1.0f; } } }
#pragma unroll
      for (int k = 0; k < 2; ++k) if (slot[k] >= 0) { tokn[k] = slot[k] >> 3; dest[k] = slot[k] - chunk * TC * 8; wt[k] = wts[slot[k]]; }
#pragma unroll
      for (int k = 0; k < 2; ++k) sa[k] = ((const float*)(ws + WS_SA))[tokn[k]];
#pragma unroll
      for (int k = 0; k < 2; ++k) if (act[k]) { const int i = (F.tid >> 8) + 2 * k, L = i * F.G + F.vcu;
          F.MI[MI_TOK + i * 256 + r] = tokn[k]; F.MI[MI_TOK + 1024 + i * 256 + r] = __float_as_int(sa[k]);
          if ((L & 1) == 0) { rdest[rt_[k] * 256 + r] = dest[k]; rwt[rt_[k] * 256 + r] = wt[k]; } }
      if (F.tid < 8) { const int i = F.tid >> 1, rr = F.tid & 1, L = i * F.G + F.vcu;
          if (L < 2 * nrt) { const int rt = L >> 1; const int e_ = (rt < nrt_r) ? F.MI[MI_TILE_E + rt] : NEXP;
              F.MI[MI_TOK + 2048 + 2 * i + rr] = __float_as_int(fmaxf(__uint_as_float(__hip_atomic_load(F.ctl + CW_AMAX + 2 * e_ + rr, RLX_AGENT)), 1e-30f) * (1.0f / 127.0f)); } } }
    __syncthreads();
    UpOrder S{(const char*)ws, F.MI, nrt_r, nrt, F.G, F.vcu};
    EpiSwiglu E{(bf16*)(ws + WS_HB), F.MI, F.ctl + CW_AMAX};
    int Kk = D / 2; asm volatile("" : "+s"(Kk));
    pg8::gemm_phase<EpiSwiglu, UpOrder, true, true, true>(F.lds, F.tid, Kk, S, E);
}
__device__ __forceinline__ void moe_down(Frame& F, int chunk) {
    unsigned char* ws = F.ws;
    __syncthreads();
    const int nrt_r = F.MI[MI_TBASE + NEXP], nrt = nrt_r + TC / 256;
    { const int* rdest = (const int*)(ws + WS_RDEST); const int* rwt = (const int*)(ws + WS_RWT);
      const int* src = (F.tid < 256 ? rdest : rwt) + (F.tid & 255); int v[6];
#pragma unroll
      for (int i = 0; i < 6; ++i) { const int L = i * F.G + F.vcu; v[i] = (L < 4 * nrt) ? src[(L >> 2) * 256] : 0; }
#pragma unroll
      for (int i = 0; i < 6; ++i) { const int L = i * F.G + F.vcu; if (L < 4 * nrt) F.MI[MI_TOK + i * 512 + F.tid] = v[i]; } }
    __syncthreads();
    DownOrder S{(const char*)ws, F.MI, nrt_r, nrt, F.G, F.vcu};
    EpiScatter E{ws + WS_SLOT, (float*)(ws + WS_SLOTSC), F.MI};
    int Kk = DEXP; asm volatile("" : "+s"(Kk));
    pg8::gemm_phase<EpiScatter, DownOrder, false, false>(F.lds, F.tid, Kk, S, E);
}
__device__ __forceinline__ void moe_combine(Frame& F, const Args& A, int chunk, bool poison) {
    unsigned char* ws = F.ws;
    const float* mod = (const float*)(ws + WS_MOD); const unsigned char* SL = ws + WS_SLOT; const float* SC = (const float*)(ws + WS_SLOTSC);
    const int gw = F.vcu * NWAVES + F.wave, NGW = F.G * NWAVES;
    f32x4 gpv[4];
#pragma unroll
    for (int j = 0; j < 4; ++j) gpv[j] = *(const f32x4*)(A.in[31] + 4 * F.lane + 256 * j);
    unsigned dA[9][4], dB[9][4]; float sA[9][4], sB[9][4]; v2u xA[4], xB[4];
#define CB_LOAD(tl_, d_, s_, x_) do { const int t_ = (tl_); \
        _Pragma("unroll") for (int j = 0; j < 4; ++j) x_[j] = *((const GAS v2u*)(F.out + ((size_t)chunk * TC + t_) * D) + F.lane + 64 * j); \
        asm volatile("" ::: "memory"); \
        _Pragma("unroll") for (int k = 0; k < 9; ++k) { const size_t row = (size_t)(k < 8 ? t_ * 8 + k : TC * 8 + t_); \
            _Pragma("unroll") for (int j = 0; j < 4; ++j) { d_[k][j] = *((const GAS unsigned*)(SL + row * D) + F.lane + 64 * j); s_[k][j] = *((const GAS float*)SC + row * 32 + 8 * j + (F.lane >> 3)); } } } while (0)
#define CB_REDUCE(tl_, d_, s_, x_) do { const int t_ = (tl_); const size_t m = (size_t)chunk * TC + t_; const int b = (int)(m / SEQ); \
        f32x4 gt[4]; _Pragma("unroll") for (int j = 0; j < 4; ++j) gt[j] = *(const f32x4*)(mod + b * 6 * D + 5 * D + 4 * F.lane + 256 * j); \
        f32x4 y[4]; float bias[4]; \
        _Pragma("unroll") for (int j = 0; j < 4; ++j) { y[j] = (f32x4){0.f, 0.f, 0.f, 0.f}; bias[j] = 0.f; } \
        _Pragma("unroll") for (int k = 0; k < 9; ++k) _Pragma("unroll") for (int j = 0; j < 4; ++j) { const unsigned dd = d_[k][j]; const float sv = s_[k][j]; \
            y[j].x = __builtin_fmaf((float)(dd & 0xffu), sv, y[j].x); y[j].y = __builtin_fmaf((float)((dd >> 8) & 0xffu), sv, y[j].y); \
            y[j].z = __builtin_fmaf((float)((dd >> 16) & 0xffu), sv, y[j].z); y[j].w = __builtin_fmaf((float)(dd >> 24), sv, y[j].w); bias[j] += sv; } \
        _Pragma("unroll") for (int j = 0; j < 4; ++j) { const float bb = 128.0f * bias[j]; y[j].x -= bb; y[j].y -= bb; y[j].z -= bb; y[j].w -= bb; } \
        float s = 0.f; \
        _Pragma("unroll") for (int j = 0; j < 4; ++j) s += (y[j].x * y[j].x + y[j].y * y[j].y) + (y[j].z * y[j].z + y[j].w * y[j].w); \
        const float rstd = 1.f / sqrtf(wave_sum(s) * (1.f / D) + EPS); \
        asm volatile("" ::: "memory"); \
        _Pragma("unroll") for (int j = 0; j < 4; ++j) { f32x4* op = (f32x4*)(F.out + m * D) + F.lane + 64 * j; const v2u xb = x_[j]; \
            f32x4 o = (f32x4){bflo(xb.x), bfhi(xb.x), bflo(xb.y), bfhi(xb.y)} + gt[j] * (y[j] * rstd * gpv[j]); \
            if (poison) { const float q_ = __builtin_nanf(""); o = (f32x4){q_, q_, q_, q_}; } \
            *op = o; } } while (0)
    int tl = gw;
    if (tl < TC) CB_LOAD(tl, dA, sA, xA);
#pragma unroll 1
    while (tl < TC) {
        if (tl + NGW < TC) CB_LOAD(tl + NGW, dB, sB, xB);
        CB_REDUCE(tl, dA, sA, xA);
        tl += NGW; if (tl >= TC) break;
        if (tl + NGW < TC) CB_LOAD(tl + NGW, dA, sA, xA);
        CB_REDUCE(tl, dB, sB, xB);
        tl += NGW;
    }
#undef CB_LOAD
#undef CB_REDUCE
}

__device__ __forceinline__ void attn_phase(Frame& F, const Args& A, char* lds_generic) {
    const attn_body::bf16* Q = (const attn_body::bf16*)(F.ws + WS_Q); const attn_body::bf16* K = (const attn_body::bf16*)(F.ws + WS_K); const attn_body::bf16* V = (const attn_body::bf16*)(F.ws + WS_V);
    attn_body::bf16* O = (attn_body::bf16*)(F.ws + WS_H);
    const float d1 = A.in[13][F.lane] * A.in[14][F.lane], d2 = A.in[15][F.lane] * A.in[16][F.lane];
    const float lam = expf(wave_sum(d1)) - expf(wave_sum(d2)) + LAM_INIT;
    const int npr = (BATCH * 16 - F.vcu + F.G - 1) / F.G;
#pragma unroll 1
    for (int it = 0; it < npr * 8; ++it) {
        const int pr = F.vcu + (it >> 3) * F.G, qi = (it >> 1) & 3, m = it & 1;
        const int pair = pr >> 1, st = pr & 1, b = pair >> 3, h = pair & 7;
        const int qb = st ? (qi == 0 ? 6 : qi == 1 ? 5 : qi == 2 ? 2 : 1) : (qi == 0 ? 7 : qi == 1 ? 4 : qi == 2 ? 3 : 0);
        const float sl2 = exp2f(-(float)(h + 1)) * LOG2E;
        if (m == 0) attn_body::attn_unit2<8, false>(F.tid, b, h, 0, qb, sl2, lam, A.in[17], Q, K, V, O, lds_generic);
        else        attn_body::attn_unit2<8, true >(F.tid, b, h, 1, qb, sl2, lam, A.in[17], Q, K, V, O, lds_generic);
    }
}

__global__ void __launch_bounds__(NWAVES * 64, 2) hybrid_fwd(Args args) {
    extern __shared__ __attribute__((aligned(16))) unsigned char lds[];
    Frame F;
    F.lds = (LAS unsigned char*)lds;
    F.MI = (volatile LAS int*)(F.lds + MISC_OFF);
    F.tid = threadIdx.x; F.lane = F.tid & 63; F.wave = __builtin_amdgcn_readfirstlane(F.tid >> 6);
    F.G = gridDim.x; { const int bx = blockIdx.x; F.vcu = (F.G % 8 == 0) ? (bx % 8) * (F.G / 8) + bx / 8 : bx; }
    unsigned char* ws = args.ws; F.ws = ws; F.out = args.out;
    F.ctl = (gu32*)(ws + WS_CTL);
    for (int u = F.tid; u < MI_WORDS; u += NWAVES * 64) F.MI[u] = 0;
    __syncthreads();
    XcdBarrier bar; bar.bar = (unsigned*)(F.ctl + CW_BAR); bar.x = 0; bar.st = nullptr;
    if (!PER_PHASE) bar = xcd_barrier_post((unsigned*)(F.ctl + CW_BAR), (volatile LAS unsigned*)(F.MI + MI_BARST));
    const int lo = args.ph_lo, hi = args.ph_hi;
#ifndef PH_MASK
#define PH_MASK 0xFFFFFFFFu
#endif
#ifndef PROBE_MASK
#define PROBE_MASK 0u
#endif
#define PSTAMP(k) do { if (PROBE_MASK != 0u && F.tid == 0) { const unsigned long long t_ = __builtin_amdgcn_s_memrealtime(); volatile LAS unsigned long long* pp_ = (volatile LAS unsigned long long*)(F.MI + 16); \
        if ((PROBE_MASK >> (k)) & 1u) pp_[1] += t_ - pp_[0]; pp_[0] = t_; } } while (0)
#define FRESH() do { unsigned char* w_ = args.ws; asm volatile("" : "+s"(w_)); F.ws = w_; ws = w_; F.ctl = (gu32*)(w_ + WS_CTL); int t_ = threadIdx.x; asm volatile("" : "+v"(t_)); F.tid = t_; F.lane = t_ & 63; F.wave = __builtin_amdgcn_readfirstlane(t_ >> 6); } while (0)
    if ((PROBE_MASK != 0u || PROBE_SEG != 0) && F.tid == 0) { volatile LAS unsigned long long* pp_ = (volatile LAS unsigned long long*)(F.MI + 16); pp_[0] = __builtin_amdgcn_s_memrealtime(); pp_[1] = 0ull; }
#define IN(k) (((PH_MASK >> (k)) & 1u) && lo <= (k) && (k) < hi)
#define SEAM(k) do { if (IN(k) && IN((k) + 1)) { if (PER_PHASE) { if (F.tid == 0) __hip_atomic_store(F.ctl + CW_TMO, 0xBADBA0u, RLX_AGENT); } else xcd_barrier(bar); } PSTAMP(k); } while (0)
    if (IN(0)) { FRESH(); p0_phase(F, args); } SEAM(0);
    if (IN(1)) { FRESH(); p1_phase(F, args); } SEAM(1);
    if (IN(2)) { FRESH(); p2_phase(F, args); } SEAM(2);
    if (IN(3)) { FRESH(); lru_phase(F, args); } if (PER_PHASE) { SEAM(3); } else { PSTAMP(3); }
    if (IN(4)) { FRESH(); attn_phase(F, args, (char*)lds); } SEAM(4);
    if (PER_PHASE) { SEAM(5); }
    if (IN(6)) { FRESH(); MergeOrder S; S.d.init(ws + WS_GR, ws + WS_WR, T, D, D, F.G, (int)blockIdx.x); S.A1 = (const char*)(ws + WS_H); S.B1 = (const char*)(ws + WS_WA);
        EpiGate E{(const unsigned char*)args.out, (const unsigned char*)args.out + (size_t)T * D, (bf16*)(ws + WS_V), (bf16*)(ws + WS_XR)};
        pg8::gemm_phase<EpiGate, MergeOrder, true, false>(F.lds, F.tid, D, S, E); } SEAM(6);
    if (IN(7)) { FRESH();
        const int bx = (int)blockIdx.x; const bool split = (F.G % 16 == 0);
        if (!split || ((bx >> 3) & 1) == 0) { DenseOrder S; S.init(ws + WS_XR, ws + WS_WO, T, D, D, split ? F.G / 2 : F.G, split ? (bx & 7) + 8 * (bx >> 4) : bx); EpiF32 E{(bf16*)(ws + WS_Y)};
            pg8::gemm_phase<EpiF32, DenseOrder, true, false>(F.lds, F.tid, D, S, E); }
        if (!split) { FRESH(); expert_copies(F, args, (int)blockIdx.x * NWAVES + F.wave, F.G * NWAVES); }
        else if (((bx >> 3) & 1) == 1) expert_copies(F, args, ((bx & 7) + 8 * (bx >> 4)) * NWAVES + F.wave, (F.G / 2) * NWAVES);
    } SEAM(7);
    if (IN(8)) { FRESH(); p8_phase(F, args); } SEAM(8);
#pragma unroll 1
    for (int c = 0; c < NCH; ++c) {
        const int pa = 9 + 2 * c, pb = 10 + 2 * c;
        if (IN(pa)) { FRESH(); if (c > 0) moe_combine(F, args, c - 1, false); moe_up(F, c); } SEAM(pa);
        if (IN(pb)) { FRESH(); moe_down(F, c); } SEAM(pb);
    }
    if (IN(9 + 2 * NCH)) { FRESH();
        bool poison = __hip_atomic_load(F.ctl + CW_TMO, RLX_AGENT) != 0u || __hip_atomic_load(F.ctl + CW_BAR + XB_TMO, RLX_AGENT) != 0u;
        moe_combine(F, args, NCH - 1, poison);
    }
    PSTAMP(17);
#undef IN
#undef SEAM
    if (PROBE_MASK != 0u || PROBE_SEG != 0) { __syncthreads(); if (F.tid == 0) { volatile LAS unsigned long long* pp_ = (volatile LAS unsigned long long*)(F.MI + 16);
        unsigned long long acc_ = pp_[1]; const unsigned long long t2_ = __builtin_amdgcn_s_memrealtime();
        while (__builtin_amdgcn_s_memrealtime() - t2_ < acc_) __builtin_amdgcn_s_sleep(8); } __syncthreads(); }
}

extern "C" void kernel_launch(void* const* d_in, const int* in_sizes, int n_in, void* d_out, int out_size, void* d_ws, size_t ws_size, hipStream_t stream) {
    static int grid = 0;
    if (grid == 0) {
        if (n_in != 32 || out_size != T * D || ws_size < WS_END) { fprintf(stderr, "kernel_launch: unexpected shapes (n_in %d, out %d, ws %zu); nothing launched\n", n_in, out_size, ws_size); grid = -1; return; }
        int dev = 0, cus = 0, per_cu = 0;
        if (hipGetDevice(&dev) != hipSuccess || hipDeviceGetAttribute(&cus, hipDeviceAttributeMultiprocessorCount, dev) != hipSuccess) { grid = -1; return; }
        if (hipFuncSetAttribute((const void*)hybrid_fwd, hipFuncAttributeMaxDynamicSharedMemorySize, LDS_BYTES) != hipSuccess) { fprintf(stderr, "kernel_launch: hipFuncSetAttribute failed\n"); grid = -1; return; }
        if (hipOccupancyMaxActiveBlocksPerMultiprocessor(&per_cu, (const void*)hybrid_fwd, NWAVES * 64, LDS_BYTES) != hipSuccess || per_cu < 1) { fprintf(stderr, "kernel_launch: occupancy query says %d blocks per CU\n", per_cu); per_cu = 1; }
        (void)hipGetLastError();
        grid = cus;
    }
    if (grid < 0) return;
    (void)hipMemsetAsync((char*)d_ws + WS_CTL, 0, CTL_ZERO_BYTES, stream);
    Args a{};
    for (int i = 0; i < 32; ++i) a.in[i] = (const float*)d_in[i];
    a.out = (float*)d_out; a.ws = (unsigned char*)d_ws;
    if (N_LAUNCHES == 1) { a.ph_lo = 0; a.ph_hi = N_PHASES; hipLaunchKernelGGL(hybrid_fwd, dim3(grid), dim3(NWAVES * 64), LDS_BYTES, stream, a); }
    else for (int p = 0; p < N_PHASES; ++p) { a.ph_lo = p; a.ph_hi = p + 1; hipLaunchKernelGGL(hybrid_fwd, dim3(grid), dim3(NWAVES * 64), LDS_BYTES, stream, a); }
}
```

```cpp
#include <hip/hip_runtime.h>
#include <hip/hip_bf16.h>
#include <cstdio>
#include <cstdint>
#include <cmath>

#ifndef MK_N_LAUNCHES
#define MK_N_LAUNCHES 1
#endif

constexpr int BATCH = 16, SEQ = 2048, D = 1024, T = BATCH * SEQ;
constexpr int W_IN = 7 * 1024;
constexpr int NEXP = 64, TOPK = 8, DEXP = 256;
constexpr int NCH = 4, TC = T / NCH;
constexpr float EPS = 1e-6f;
constexpr float LOG2E = 1.4426950408889634f;
constexpr float LAM_INIT = 0.2f;

namespace pg8 {
#define PG8_LAS __attribute__((address_space(3)))
typedef unsigned short bf16_t;
typedef short bf16x8 __attribute__((ext_vector_type(8)));
typedef float f32x4 __attribute__((ext_vector_type(4)));
typedef unsigned u32x4 __attribute__((ext_vector_type(4)));
constexpr int BM = 256, BK = 64, HALF = 128, HTB = HALF * BK * 2, STAGE_BYTES = 8 * HTB, NXCD = 8, WGM = 8;

__host__ __device__ __forceinline__ int lds_byte(int r, int c) { const int st = (r >> 4) * 2 + (c >> 5), rr = r & 15, cc = c & 31, ob = rr * 64 + cc * 2; return st * 1024 + (ob ^ (((ob >> 9) & 1) << 5)); }
__host__ __device__ __forceinline__ void stage_rc(int b, int& R, int& C) { const int st = b / 1024, sb = b % 1024, swz = sb ^ (((sb >> 9) & 1) << 5); R = (st >> 1) * 16 + swz / 64; C = (st & 1) * 32 + (swz % 64) / 2; }
__host__ __device__ __forceinline__ int perm32(int rho) { const int n = rho >> 4, i = rho & 15; return 8 * (i >> 2) + 4 * n + (i & 3); }

struct Unit { int pm, pn, z, e; };

__device__ __forceinline__ unsigned cvt_pk_bf16(float lo, float hi) { unsigned r; asm volatile("v_cvt_pk_bf16_f32 %0, %1, %2" : "=v"(r) : "v"(lo), "v"(hi)); return r; }
__device__ __forceinline__ float sigm(float x) { return __builtin_amdgcn_rcpf(1.0f + __builtin_amdgcn_exp2f(-LOG2E * x)); }
__device__ __forceinline__ float gelu_t(float x) { const float u = 0.7978845608028654f * (x + 0.044715f * x * x * x); return x * sigm(2.0f * u); }
__device__ __forceinline__ float bflo(unsigned w) { return __uint_as_float(w << 16); }
__device__ __forceinline__ float bfhi(unsigned w) { return __uint_as_float(w & 0xffff0000u); }

typedef int i32x4 __attribute__((ext_vector_type(4)));
template <class Epi, class Sched, bool ALIGN_EPI, bool GATHER, bool INT8 = false>
__device__ __forceinline__ void gemm_phase(PG8_LAS unsigned char* lds, const int tid, const int K, const Sched& S, const Epi& E) {
    const int wid = __builtin_amdgcn_readfirstlane(tid >> 6), lane = tid & 63, wr = wid >> 2, wc = wid & 3, fr = lane & 15, fq = lane >> 4;
    const int nt = K / BK;
    unsigned voffA[2], voffB[2];
#pragma unroll
    for (int i = 0; i < 2; ++i) { int R, C; stage_rc(tid * 16 + i * 8192, R, C); const int Rb = Epi::PERM ? ((R & ~31) + perm32(R & 31)) : R;
        voffA[i] = (unsigned)(R * K + C) * 2u; voffB[i] = (unsigned)(Rb * K + C) * 2u; }
    const size_t kstep = (size_t)(BK * 2);
    const size_t hstep = (size_t)HALF * K * 2;
    const unsigned ldsw = (unsigned)wid * 1024u;
    const int aoff = lds_byte(wr * 64 + fr, fq * 8), boff = lds_byte(wc * 32 + fr, fq * 8);
#define PG8_SA(b, h) (((b) * 2 + (h)) * HTB)
#define PG8_SB(b, h) ((4 + (b) * 2 + (h)) * HTB)
#define PG8_STAGE(bufoff, gbase, voff) do { _Pragma("unroll") for (int _i = 0; _i < 2; ++_i) \
        __builtin_amdgcn_global_load_lds((const unsigned*)((const char*)(gbase) + (voff)[_i]), (PG8_LAS unsigned*)(lds + (bufoff) + ldsw + _i * 8192), 16, 0, 0); } while (0)
#define PG8_STAGE_A(bufoff, p, h, VG) do { if constexpr (GATHER) { PG8_STAGE(bufoff, p, VG[h]); } else { PG8_STAGE(bufoff, (p) + (h) * hstep, voffA); } } while (0)
#define PG8_LDA(dst, b, h) do { _Pragma("unroll") for (int m = 0; m < 4; ++m) _Pragma("unroll") for (int k = 0; k < 2; ++k) dst[m][k] = *(const PG8_LAS bf16x8*)(lds + PG8_SA(b, h) + aoff + m * 2048 + k * 1024); } while (0)
#define PG8_LDB(dst, b, h) do { _Pragma("unroll") for (int n = 0; n < 2; ++n) _Pragma("unroll") for (int k = 0; k < 2; ++k) dst[n][k] = *(const PG8_LAS bf16x8*)(lds + PG8_SB(b, h) + boff + n * 2048 + k * 1024); } while (0)
#define PG8_MMA(ai, bj, At, Bt) do { __builtin_amdgcn_s_setprio(1); _Pragma("unroll") for (int m = 0; m < 4; ++m) _Pragma("unroll") for (int n = 0; n < 2; ++n) _Pragma("unroll") for (int k = 0; k < 2; ++k) \
        { if constexpr (INT8) acc[ai][bj][m][n] = __builtin_bit_cast(f32x4, __builtin_amdgcn_mfma_i32_16x16x64_i8(__builtin_bit_cast(i32x4, Bt[n][k]), __builtin_bit_cast(i32x4, At[m][k]), __builtin_bit_cast(i32x4, acc[ai][bj][m][n]), 0, 0, 0)); \
          else acc[ai][bj][m][n] = __builtin_amdgcn_mfma_f32_16x16x32_bf16(Bt[n][k], At[m][k], acc[ai][bj][m][n], 0, 0, 0); } __builtin_amdgcn_s_setprio(0); } while (0)
#define PG8_WAIT_V(n) asm volatile("s_waitcnt vmcnt(" #n ")" ::: "memory")
#define PG8_WAIT_L(n) asm volatile("s_waitcnt lgkmcnt(" #n ")" ::: "memory")
#define PG8_BAR __builtin_amdgcn_s_barrier()
#define PG8_SCHED __builtin_amdgcn_sched_barrier(0)
#define PG8_LOADVG(VG, ui_) do { if constexpr (GATHER) { _Pragma("unroll") for (int h_ = 0; h_ < 2; ++h_) _Pragma("unroll") for (int i_ = 0; i_ < 2; ++i_) \
        { int R_, C_; stage_rc(tid * 16 + i_ * 8192, R_, C_); VG[h_][i_] = ((unsigned)S.tok((ui_), h_ * HALF + R_) * (unsigned)K + (unsigned)C_) * 2u; } } } while (0)
    Unit cur, nxt; int ui = 0;
    if (!S.next(0, cur)) return;
    f32x4 acc[2][2][4][2];
#pragma unroll
    for (int a = 0; a < 2; ++a)
#pragma unroll
        for (int b = 0; b < 2; ++b)
#pragma unroll
            for (int m = 0; m < 4; ++m)
#pragma unroll
                for (int n = 0; n < 2; ++n) acc[a][b][m][n] = (f32x4){0.f, 0.f, 0.f, 0.f};
    bf16x8 At[4][2], B0[2][2], B1[2][2];
    unsigned vgc[2][2];
#pragma unroll
    for (int h_ = 0; h_ < 2; ++h_)
#pragma unroll
        for (int i_ = 0; i_ < 2; ++i_) vgc[h_][i_] = 0u;
    PG8_LOADVG(vgc, 0);
    const char *cA, *cB; S.bases(cur, cA, cB);
    PG8_STAGE(PG8_SB(0, 0), cB, voffB); PG8_STAGE(PG8_SB(0, 1), cB + hstep, voffB); PG8_STAGE_A(PG8_SA(0, 0), cA, 0, vgc); PG8_STAGE_A(PG8_SA(0, 1), cA, 1, vgc);
    if (wr == 1) PG8_BAR;
    PG8_WAIT_V(2); PG8_BAR;
    PG8_STAGE(PG8_SB(1, 0), cB + kstep, voffB); PG8_STAGE_A(PG8_SA(1, 0), cA + kstep, 0, vgc); PG8_STAGE(PG8_SB(1, 1), cB + hstep + kstep, voffB);
    PG8_WAIT_V(6); PG8_BAR;
    for (;;) {
        const bool has_next = S.next(ui + 1, nxt);
        const char *nA = cA, *nB = cB;
        if (has_next) S.bases(nxt, nA, nB);
        for (int t = 0; t < nt; t += 2) {
            const bool last = (t == nt - 2);
            const char* a1 = cA + (size_t)(t + 1) * kstep;
            const char* a2 = last ? nA : cA + (size_t)(t + 2) * kstep; const char* b2 = last ? nB : cB + (size_t)(t + 2) * kstep;
            const char* a3 = a2 + kstep; const char* b3 = b2 + kstep;
            unsigned vgs[2][2];
#pragma unroll
            for (int h_ = 0; h_ < 2; ++h_)
#pragma unroll
                for (int i_ = 0; i_ < 2; ++i_) vgs[h_][i_] = vgc[h_][i_];
            if (last && has_next) PG8_LOADVG(vgs, ui + 1);
            PG8_LDB(B0, 0, 0); PG8_LDB(B1, 0, 1); PG8_SCHED; PG8_LDA(At, 0, 0); PG8_STAGE_A(PG8_SA(1, 1), a1, 1, vgc);
            PG8_WAIT_V(8); PG8_WAIT_L(0); PG8_BAR; PG8_MMA(0, 0, At, B0); PG8_MMA(0, 1, At, B1); PG8_BAR; PG8_SCHED;
            PG8_LDA(At, 0, 1); PG8_STAGE(PG8_SB(0, 0), b2, voffB); PG8_STAGE(PG8_SB(0, 1), b2 + hstep, voffB); PG8_STAGE_A(PG8_SA(0, 0), a2, 0, vgs);
            PG8_WAIT_V(8); PG8_WAIT_L(0); PG8_BAR; PG8_MMA(1, 0, At, B0); PG8_MMA(1, 1, At, B1); PG8_BAR; PG8_SCHED;
            PG8_LDB(B0, 1, 0); PG8_LDB(B1, 1, 1); PG8_SCHED; PG8_LDA(At, 1, 0); PG8_STAGE_A(PG8_SA(0, 1), a2, 1, vgs);
            PG8_WAIT_V(8); PG8_WAIT_L(0); PG8_BAR; PG8_MMA(0, 0, At, B0); PG8_MMA(0, 1, At, B1); PG8_BAR; PG8_SCHED;
            PG8_LDA(At, 1, 1); PG8_STAGE(PG8_SB(1, 0), b3, voffB); PG8_STAGE(PG8_SB(1, 1), b3 + hstep, voffB); PG8_STAGE_A(PG8_SA(1, 0), a3, 0, vgs);
            PG8_WAIT_V(8); PG8_WAIT_L(0); PG8_BAR; PG8_MMA(1, 0, At, B0); PG8_MMA(1, 1, At, B1); PG8_BAR; PG8_SCHED;
        }
        if constexpr (ALIGN_EPI) { if (wr == 0) PG8_BAR; }
        E(acc, cur, wr, wc, fr, fq);
#ifdef PROBE_EPI2
        if (Epi::TWICE) { asm volatile("" ::: "memory"); E(acc, cur, wr, wc, fr, fq); }
#endif
        if (!has_next) break;
#pragma unroll
        for (int a = 0; a < 2; ++a)
#pragma unroll
            for (int b = 0; b < 2; ++b)
#pragma unroll
                for (int m = 0; m < 4; ++m)
#pragma unroll
                    for (int n = 0; n < 2; ++n) acc[a][b][m][n] = (f32x4){0.f, 0.f, 0.f, 0.f};
        cur = nxt; cA = nA; cB = nB; ++ui;
        PG8_LOADVG(vgc, ui);
        if constexpr (ALIGN_EPI) { if (wr == 1) PG8_BAR; }
    }
    PG8_WAIT_V(0);
    if constexpr (!ALIGN_EPI) { if (wr == 0) PG8_BAR; }
    PG8_BAR;
#undef PG8_SA
#undef PG8_SB
#undef PG8_STAGE
#undef PG8_STAGE_A
#undef PG8_LDA
#undef PG8_LDB
#undef PG8_MMA
#undef PG8_WAIT_V
#undef PG8_WAIT_L
#undef PG8_BAR
#undef PG8_SCHED
#undef PG8_LOADVG
}
}

namespace attn_body {
using bf16=__hip_bfloat16;
using bf16x8=__attribute__((ext_vector_type(8)))short;
using s16x4=__attribute__((ext_vector_type(4)))short;
using f32x16=__attribute__((ext_vector_type(16)))float;
using u32x4=__attribute__((ext_vector_type(4)))unsigned;
constexpr int NHEAD=16,SEQ=2048,D=64,DM=NHEAD*D;
constexpr int NW=8,QBLK=32,QB=QBLK*NW,KVBLK=64,NQB=SEQ/QB;
__device__ __forceinline__ int crow(int r,int hi){return (r&3)+8*(r>>2)+4*hi;}
#define SBAR() __builtin_amdgcn_sched_barrier(0)
__device__ __forceinline__ void cmask(f32x16&p0,f32x16&p1,int jb,int qrel,int hi){
  const float NEG=-INFINITY; const int dq=qrel-(64*jb+4*hi);
  #pragma unroll
  for(int r=0;r<16;++r){const int kc=(r&3)+8*(r>>2); if(kc>dq)p0[r]=NEG; if(kc+32>dq)p1[r]=NEG;}
}
__device__ __forceinline__ void cinit(f32x16&p0,f32x16&p1,float sl2,float nv){
  #pragma unroll
  for(int r=0;r<16;++r){const float c=(float)((r&3)+8*(r>>2)); p0[r]=__builtin_fmaf(sl2,c,nv); p1[r]=__builtin_fmaf(sl2,c+32.0f,nv);}
}
#define CI_C(r) ((float)(((r)&3)+8*((r)>>2)))

constexpr int NSLOT=3, SLOTB=8192;
constexpr int LDS_K=0, LDS_V=NSLOT*SLOTB, LDS_WS=2*NSLOT*SLOTB, LDS_OST=LDS_WS+NW*64*4, LDS_BYTES=LDS_OST+NW*4096;
constexpr float C2=0.125f*1.4426950408889634f;
__device__ __forceinline__ void glds16(const void*gsrc,unsigned lds_dst){unsigned keep;
  asm volatile("s_mov_b32 %0, m0\n\ts_mov_b32 m0, %2\n\ts_nop 0\n\tglobal_load_lds_dwordx4 %1, off\n\ts_mov_b32 m0, %0":"=&s"(keep):"v"(gsrc),"s"(lds_dst):"memory");}
__device__ __forceinline__ float max3f(float a,float b,float c){float r;asm("v_max3_f32 %0, %1, %2, %3":"=v"(r):"v"(a),"v"(b),"v"(c));return r;}
__device__ __forceinline__ float max2f(float a,float b){float r;asm("v_max_f32_e32 %0, %1, %2":"=v"(r):"v"(a),"v"(b));return r;}
__device__ __forceinline__ float fadd_s(float a,float b){float r;asm("v_add_f32_e32 %0, %1, %2":"=v"(r):"v"(a),"v"(b));return r;}
__device__ __forceinline__ float fsub_s(float a,float b){float r;asm("v_sub_f32_e32 %0, %1, %2":"=v"(r):"v"(a),"v"(b));return r;}
typedef float f32x2_t __attribute__((ext_vector_type(2))); typedef __bf16 bf16x2_t __attribute__((ext_vector_type(2)));
__device__ __forceinline__ unsigned cvtpk_s(float lo,float hi){f32x2_t v={lo,hi};bf16x2_t b=__builtin_convertvector(v,bf16x2_t);return __builtin_bit_cast(unsigned,b);}
#define WAIT_BAR(N) asm volatile("s_waitcnt vmcnt(" #N ") lgkmcnt(0)\n\ts_barrier":::"memory")

__device__ __forceinline__ void qkt(f32x16&p0,f32x16&p1,const char*Kslot,const bf16x8*qr,int r32,int hi){
  const char*kb=Kslot+hi*1024+r32*16;
  #pragma unroll
  for(int d0=0;d0<4;++d0){
    const bf16x8 b0=*reinterpret_cast<const bf16x8*>(kb+d0*2048);
    const bf16x8 b1=*reinterpret_cast<const bf16x8*>(kb+d0*2048+512);
    p0=__builtin_amdgcn_mfma_f32_32x32x16_bf16(b0,qr[d0],p0,0,0,0);p1=__builtin_amdgcn_mfma_f32_32x32x16_bf16(b1,qr[d0],p1,0,0,0);}
}
typedef __attribute__((address_space(3))) const char* lds_cptr;
typedef short v4i16_t __attribute__((ext_vector_type(4)));
__device__ __forceinline__ void kload8(bf16x8*kf,lds_cptr kp){
  kf[0]=*(const __attribute__((address_space(3))) bf16x8*)(kp);      kf[1]=*(const __attribute__((address_space(3))) bf16x8*)(kp+512);
  kf[2]=*(const __attribute__((address_space(3))) bf16x8*)(kp+2048); kf[3]=*(const __attribute__((address_space(3))) bf16x8*)(kp+2560);
  kf[4]=*(const __attribute__((address_space(3))) bf16x8*)(kp+4096); kf[5]=*(const __attribute__((address_space(3))) bf16x8*)(kp+4608);
  kf[6]=*(const __attribute__((address_space(3))) bf16x8*)(kp+6144); kf[7]=*(const __attribute__((address_space(3))) bf16x8*)(kp+6656);
}
__device__ __forceinline__ void kload2(bf16x8*kf,lds_cptr kp,int j){ kf[2*j]=*(const __attribute__((address_space(3))) bf16x8*)(kp+j*2048); kf[2*j+1]=*(const __attribute__((address_space(3))) bf16x8*)(kp+j*2048+512); }
__device__ __forceinline__ s16x4 vtr(lds_cptr p){ return __builtin_bit_cast(s16x4,__builtin_amdgcn_ds_read_tr16_b64_v4i16((__attribute__((address_space(3))) v4i16_t*)p)); }
__device__ __forceinline__ float rowmax(const f32x16&p0,const f32x16&p1){
  float a=max3f(p0[0],p0[1],p1[0]),b=max3f(p0[2],p0[3],p1[1]);a=max3f(a,p1[2],p1[3]);
  #pragma unroll
  for(int r=4;r<16;r+=4){a=max3f(a,p0[r],p0[r+1]);b=max3f(b,p0[r+2],p0[r+3]);a=max3f(a,p1[r],p1[r+1]);b=max3f(b,p1[r+2],p1[r+3]);}
  const float m=max2f(a,b);
  auto rr=__builtin_amdgcn_permlane32_swap(__float_as_uint(m),__float_as_uint(m),false,false);
  return max2f(__uint_as_float(rr[0]),__uint_as_float(rr[1]));
}
__device__ __forceinline__ void pv(f32x16*o,int vb,bf16x8 pa0,bf16x8 pa1,bf16x8 pa2,bf16x8 pa3){
  #pragma unroll
  for(int d0=0;d0<2;++d0){s16x4 lo[4],hi[4];
    #pragma unroll
    for(int ks=0;ks<4;++ks){
      asm volatile("ds_read_b64_tr_b16 %0,%1 offset:%c2":"=&v"(lo[ks]):"v"(vb),"i"(d0*4096+ks*1024):"memory");
      asm volatile("ds_read_b64_tr_b16 %0,%1 offset:%c2":"=&v"(hi[ks]):"v"(vb),"i"(d0*4096+ks*1024+512):"memory");}
    asm volatile("s_waitcnt lgkmcnt(0)":::"memory");SBAR();
    #define PK(k) (bf16x8){lo[k][0],lo[k][1],lo[k][2],lo[k][3],hi[k][0],hi[k][1],hi[k][2],hi[k][3]}
    o[d0]=__builtin_amdgcn_mfma_f32_32x32x16_bf16(pa0,PK(0),o[d0],0,0,0);
    o[d0]=__builtin_amdgcn_mfma_f32_32x32x16_bf16(pa1,PK(1),o[d0],0,0,0);
    o[d0]=__builtin_amdgcn_mfma_f32_32x32x16_bf16(pa2,PK(2),o[d0],0,0,0);
    o[d0]=__builtin_amdgcn_mfma_f32_32x32x16_bf16(pa3,PK(3),o[d0],0,0,0);
    #undef PK
  }
}
#define ATTN_STORE16(p,v) (*(u32x4*)(p)=(v))
constexpr int LDS_K2=0, LDS_V2=4*8192, LDS_WS2=LDS_V2+3*16384, LDS_OST2=LDS_WS2+NW*64*4, LDS_BYTES2=LDS_OST2+NW*4096;
__device__ __forceinline__ void pv4(f32x16*o,int vb,bf16x8 pa0,bf16x8 pa1,bf16x8 pa2,bf16x8 pa3){
  #pragma unroll
  for(int d0=0;d0<4;++d0){s16x4 lo[4],hi[4];
    #pragma unroll
    for(int ks=0;ks<4;++ks){
      asm volatile("ds_read_b64_tr_b16 %0,%1 offset:%c2":"=&v"(lo[ks]):"v"(vb),"i"(d0*4096+ks*1024):"memory");
      asm volatile("ds_read_b64_tr_b16 %0,%1 offset:%c2":"=&v"(hi[ks]):"v"(vb),"i"(d0*4096+ks*1024+512):"memory");}
    asm volatile("s_waitcnt lgkmcnt(0)":::"memory");SBAR();
    #define PK(k) (bf16x8){lo[k][0],lo[k][1],lo[k][2],lo[k][3],hi[k][0],hi[k][1],hi[k][2],hi[k][3]}
    o[d0]=__builtin_amdgcn_mfma_f32_32x32x16_bf16(pa0,PK(0),o[d0],0,0,0);
    o[d0]=__builtin_amdgcn_mfma_f32_32x32x16_bf16(pa1,PK(1),o[d0],0,0,0);
    o[d0]=__builtin_amdgcn_mfma_f32_32x32x16_bf16(pa2,PK(2),o[d0],0,0,0);
    o[d0]=__builtin_amdgcn_mfma_f32_32x32x16_bf16(pa3,PK(3),o[d0],0,0,0);
    #undef PK
  }
}
template<int THRL,bool FUSE> __device__ __forceinline__ void attn_unit2(const int tid,int b,int h,int m,int qb,float sl2,float lam,const float*gsub,const bf16*Q,const bf16*__restrict__ K,const bf16*__restrict__ V,bf16*O,char*shm){
  const int lane=tid&63,r32=lane&31,hi=lane>>5; const int wid=__builtin_amdgcn_readfirstlane(tid>>6);
  const long rowbase=(long)b*SEQ; const int q0=qb*QB;
  const bf16*Qw=Q+(rowbase+q0+wid*QBLK)*DM+(2*h+m)*D;
  const bf16*Kh=K+rowbase*DM+(2*h+m)*D,*Vh=V+rowbase*DM+2*h*D;
  const unsigned lds0=(unsigned)(uintptr_t)shm;
  float*wsf=(float*)(shm+LDS_WS2)+wid*64;
  const bf16*ksrc=Kh+(long)lane*DM+wid*8;
  const bf16*vsrc=Vh+(long)(16*(wid&3)+(lane>>2))*DM+(wid>>2)*32+(lane&3)*8;
  const unsigned kdst=lds0+LDS_K2+wid*1024, vdst=lds0+LDS_V2+wid*1024;
  #define DMA_K(t,slot) glds16(ksrc+(long)(t)*KVBLK*DM,(unsigned)__builtin_amdgcn_readfirstlane(kdst+(slot)))
  #define DMA_V(t,slot) do{ glds16(vsrc+(long)(t)*KVBLK*DM,(unsigned)__builtin_amdgcn_readfirstlane(vdst+2*(slot))); glds16(vsrc+(long)(t)*KVBLK*DM+64,(unsigned)__builtin_amdgcn_readfirstlane(vdst+2*(slot)+8192)); }while(0)
  const int vb0=(int)(lds0+LDS_V2)+((lane>>4)&1)*32+(lane&3)*8+(4*hi+((lane&15)>>2))*64;
  const char*Kbase=shm+LDS_K2;
  const lds_cptr shm3=(lds_cptr)shm; const lds_cptr kp0=shm3+LDS_K2+hi*1024+r32*16; const lds_cptr vp0=shm3+LDS_V2+((lane>>4)&1)*32+(lane&3)*8+(4*hi+((lane&15)>>2))*64;
  const int NT=(q0+QB)/KVBLK;
  const unsigned qdst=lds0+LDS_OST2+wid*4096;
  #pragma unroll
  for(int d0=0;d0<4;++d0)glds16(&Qw[(long)r32*DM+d0*16+hi*8],(unsigned)__builtin_amdgcn_readfirstlane(qdst+d0*1024));
  DMA_K(0,0);DMA_V(0,0);DMA_K(1,SLOTB);
  const lds_cptr qp0=(lds_cptr)shm+LDS_OST2+wid*4096+lane*16;
  #define QF(d0) (*(const __attribute__((address_space(3))) bf16x8*)(qp0+(d0)*1024))
  const float tb0=sl2*(float)(4*hi);
  float mhat=0.f,l_reg=0.f;f32x16 o[4];o[0]=f32x16{};o[1]=f32x16{};o[2]=f32x16{};o[3]=f32x16{};
  const int qrel=wid*QBLK+r32;
  #define CMASK(P0,P1,t) do{int jb_=(t)-(NT-4); if(jb_>=0)cmask(P0,P1,jb_,qrel,hi);}while(0)
  #define NVAL(tt) (__builtin_fmaf(sl2,(float)(64*(tt)),tb0)-mhat)
  bool resc=false;
  #define START(P0,P1) do{ const float rm=rowmax(P0,P1); resc=false; \
    { const float dl=rm; mhat=fadd_s(mhat,dl); \
      _Pragma("unroll") for(int r=0;r<16;++r){P0[r]=fsub_s(P0[r],dl);P1[r]=fsub_s(P1[r],dl);} } \
    _Pragma("unroll") for(int r=0;r<16;++r)P0[r]=__builtin_amdgcn_exp2f(P0[r]); }while(0)
  #define RESC() do{ if(resc){ asm volatile("s_waitcnt lgkmcnt(0)":::"memory"); \
      _Pragma("unroll") for(int d_=0;d_<4;++d_) _Pragma("unroll") for(int r=0;r<16;++r)o[d_][r]*=wsf[crow(r,hi)]; } }while(0)
  f32x16 pA0,pA1,pB0,pB1;
  int sl_prev=0,sl_cur=0,sl_next=SLOTB,ks_cur=0;
  #define ROT() do{sl_prev=sl_cur;sl_cur=sl_next;sl_next=(sl_next==(NSLOT-1)*SLOTB)?0:sl_next+SLOTB;ks_cur=(ks_cur+SLOTB)&(4*SLOTB-1);}while(0)
  DMA_K(2,2*SLOTB);
  WAIT_BAR(4);
  cinit(pA0,pA1,sl2,tb0);
  { bf16x8 qr[4];
    #pragma unroll
    for(int d0=0;d0<4;++d0)qr[d0]=QF(d0);
    qkt(pA0,pA1,Kbase,qr,r32,hi); }asm volatile("s_nop 15\n\ts_nop 7":"+v"(pA0),"+v"(pA1));CMASK(pA0,pA1,0);
  START(pA0,pA1);
  cinit(pB0,pB1,sl2,NVAL(1));
  _Pragma("unroll") for(int r=0;r<16;++r)pA1[r]=__builtin_amdgcn_exp2f(pA1[r]);
  WAIT_BAR(0);
  DMA_K(3,3*SLOTB);DMA_V(1,SLOTB);
  ROT();
  WAIT_BAR(3);
  s16x4 vlo[8],vhi[8]; u32x4 pw0,pw1,pw2,pw3;
  bf16x8 nka=*(const __attribute__((address_space(3))) bf16x8*)(kp0+ks_cur),nkb=*(const __attribute__((address_space(3))) bf16x8*)(kp0+ks_cur+512),nqa=QF(0),nqb=QF(1);
  #define PKW(P,B) cvtpk_s(P[B],P[B+1])
  #define PAF(k) __builtin_bit_cast(bf16x8,pw##k)
  #define VFR(i) (bf16x8){vlo[(i)&7][0],vlo[(i)&7][1],vlo[(i)&7][2],vlo[(i)&7][3],vhi[(i)&7][0],vhi[(i)&7][1],vhi[(i)&7][2],vhi[(i)&7][3]}
  #define PIN(x) asm volatile("":"+v"(x))
  #define MX3(a,b,c) __builtin_fmaxf(__builtin_fmaxf((a),(b)),(c))
  #define GAPA(MF,A0,A1,A2,A3,W0,W1,PW) do{ MF; sacc+=A0; sacc+=A1; sacc+=A2; sacc+=A3; PIN(sacc); W0; W1; PIN(PW); SBAR(); }while(0)
  #define EX(v) __builtin_amdgcn_exp2f(v)
  #define VRD(f) do{ vlo[(f)&7]=vtr(vp_+(((f)&3)*4096+((f)>>2)*1024)); vhi[(f)&7]=vtr(vp_+(((f)&3)*4096+((f)>>2)*1024+512)); }while(0)
  #define GAPB(f,X,B,Y,OFS) do{ o[(f)&3]=__builtin_amdgcn_mfma_f32_32x32x16_bf16(__builtin_bit_cast(bf16x8,(f)<4?pw0:(f)<8?pw1:(f)<12?pw2:pw3),VFR(f),o[(f)&3],0,0,0); \
    X[B]=EX(X[B]); X[B+1]=EX(X[B+1]); PIN(X); \
    Y[B]=__builtin_fmaf(sl2,CI_C(B)+OFS,nvn); Y[B+1]=__builtin_fmaf(sl2,CI_C(B+1)+OFS,nvn); \
    if((f)+4<16){VRD((f)+4);} SBAR(); }while(0)
  #define KF(j) (*(const __attribute__((address_space(3))) bf16x8*)(kp_+((j)>>1)*2048+((j)&1)*512))
  #define STEP(C0,C1,P0,P1,t,GK,GV,GL) do{ SBAR(); \
    const lds_cptr vp_=vp0+2*sl_prev; const lds_cptr kp_=kp0+ks_cur; \
    bf16x8 ka=nka,kb=nkb,qa=nqa,qb_=nqb; SBAR(); \
    float sacc=(P0[0]+P0[1]); \
    GAPA(C0=__builtin_amdgcn_mfma_f32_32x32x16_bf16(ka,qa,C0,0,0,0), P0[2],P0[3],P0[4],P0[5],     pw0[0]=PKW(P0,0), pw0[1]=PKW(P0,2), pw0); \
    ka=KF(2); SBAR(); \
    GAPA(C1=__builtin_amdgcn_mfma_f32_32x32x16_bf16(kb,qa,C1,0,0,0), P0[6],P0[7],P0[8],P0[9],     pw0[2]=PKW(P0,4), pw0[3]=PKW(P0,6), pw0); \
    kb=KF(3); qa=QF(2); SBAR(); \
    GAPA(C0=__builtin_amdgcn_mfma_f32_32x32x16_bf16(ka,qb_,C0,0,0,0),   P0[10],P0[11],P0[12],P0[13], pw1[0]=PKW(P0,8), pw1[1]=PKW(P0,10), pw1); \
    ka=KF(4); SBAR(); \
    GAPA(C1=__builtin_amdgcn_mfma_f32_32x32x16_bf16(kb,qb_,C1,0,0,0),   P0[14],P0[15],P1[0],P1[1],   pw1[2]=PKW(P0,12),pw1[3]=PKW(P0,14), pw1); \
    kb=KF(5); qb_=QF(3); VRD(0); SBAR(); \
    GAPA(C0=__builtin_amdgcn_mfma_f32_32x32x16_bf16(ka,qa,C0,0,0,0),   P1[2],P1[3],P1[4],P1[5],     pw2[0]=PKW(P1,0), pw2[1]=PKW(P1,2), pw2); \
    ka=KF(6); VRD(1); SBAR(); \
    GAPA(C1=__builtin_amdgcn_mfma_f32_32x32x16_bf16(kb,qa,C1,0,0,0),   P1[6],P1[7],P1[8],P1[9],     pw2[2]=PKW(P1,4), pw2[3]=PKW(P1,6), pw2); \
    kb=KF(7); VRD(2); SBAR(); \
    GAPA(C0=__builtin_amdgcn_mfma_f32_32x32x16_bf16(ka,qb_,C0,0,0,0),   P1[10],P1[11],P1[12],P1[13], pw3[0]=PKW(P1,8), pw3[1]=PKW(P1,10), pw3); \
    VRD(3); SBAR(); \
    GAPA(C1=__builtin_amdgcn_mfma_f32_32x32x16_bf16(kb,qb_,C1,0,0,0),   P1[14],P1[15],0.f,0.f,       pw3[2]=PKW(P1,12),pw3[3]=PKW(P1,14), pw3); \
    l_reg+=sacc; \
    if(GK){DMA_K((t)+3,(ks_cur+3*SLOTB)&(4*SLOTB-1));} if(GV){DMA_V((t)+1,sl_next);} \
    CMASK(C0,C1,t); \
    float nvn; \
    { float a=MX3(C0[0],C0[1],C1[0]),b=MX3(C0[2],C0[3],C1[1]); a=MX3(a,C1[2],C1[3]); \
      _Pragma("unroll") for(int r=4;r<16;r+=4){a=MX3(a,C0[r],C0[r+1]);b=MX3(b,C0[r+2],C0[r+3]);a=MX3(a,C1[r],C1[r+1]);b=MX3(b,C1[r+2],C1[r+3]);} \
      float rm=__builtin_fmaxf(a,b); { auto rr=__builtin_amdgcn_permlane32_swap(__float_as_uint(rm),__float_as_uint(rm),false,false); rm=__builtin_fmaxf(__uint_as_float(rr[0]),__uint_as_float(rr[1])); } \
      resc=false; \
      if(__builtin_expect(__any(rm>(float)THRL),0)){ const float dl=__builtin_fmaxf(rm,0.f); mhat+=dl; \
        _Pragma("unroll") for(int r=0;r<16;++r){C0[r]-=dl;C1[r]-=dl;} \
        const float f=__builtin_amdgcn_exp2f(-dl); l_reg*=f; if(hi==0)wsf[r32]=f; resc=true; } \
      nvn=NVAL((t)+1); } \
    SBAR(); \
    GAPB(0,C0,0,P0,0.0f); GAPB(1,C0,2,P0,0.0f); GAPB(2,C0,4,P0,0.0f); GAPB(3,C0,6,P0,0.0f); \
    GAPB(4,C0,8,P0,0.0f); GAPB(5,C0,10,P0,0.0f); GAPB(6,C0,12,P0,0.0f); GAPB(7,C0,14,P0,0.0f); \
    GAPB(8,C1,0,P1,32.0f); GAPB(9,C1,2,P1,32.0f); GAPB(10,C1,4,P1,32.0f); GAPB(11,C1,6,P1,32.0f); \
    GAPB(12,C1,8,P1,32.0f); GAPB(13,C1,10,P1,32.0f); GAPB(14,C1,12,P1,32.0f); \
    { const lds_cptr kn_=kp0+((ks_cur+SLOTB)&(4*SLOTB-1)); nka=*(const __attribute__((address_space(3))) bf16x8*)(kn_); nkb=*(const __attribute__((address_space(3))) bf16x8*)(kn_+512); nqa=QF(0); nqb=QF(1); SBAR(); } \
    GAPB(15,C1,14,P1,32.0f); \
    }while(0)
  int t=1;
  #undef CMASK
  #define CMASK(P0,P1,t) do{}while(0)
  for(;t+5<NT;t+=2){
    STEP(pB0,pB1,pA0,pA1,t,true,true,true);     WAIT_BAR(3); RESC(); ROT();
    STEP(pA0,pA1,pB0,pB1,t+1,true,true,true);   WAIT_BAR(3); RESC(); ROT();
  }
  #undef CMASK
  #define CMASK(P0,P1,t) do{int jb_=(t)-(NT-4); if(jb_>=0)cmask(P0,P1,jb_,qrel,hi);}while(0)
  #define ENDW(tt) do{ if((tt)+3<NT){WAIT_BAR(3);} else if((tt)+2<NT){WAIT_BAR(2);} else {WAIT_BAR(0);} }while(0)
  for(;t+1<NT;t+=2){
    STEP(pB0,pB1,pA0,pA1,t,(t+3<NT),(t+1<NT),(t+1<NT));       ENDW(t);   RESC(); ROT();
    STEP(pA0,pA1,pB0,pB1,t+1,(t+4<NT),(t+2<NT),(t+2<NT));     ENDW(t+1); RESC(); ROT();
  }
  STEP(pB0,pB1,pA0,pA1,NT-1,false,false,false); RESC();
  { float sacc=pB0[0]+pB0[1]; _Pragma("unroll") for(int r=2;r<16;++r)sacc+=pB0[r]; _Pragma("unroll") for(int r=0;r<16;++r)sacc+=pB1[r]; l_reg+=sacc;
    pw0=(u32x4){PKW(pB0,0),PKW(pB0,2),PKW(pB0,4),PKW(pB0,6)};pw1=(u32x4){PKW(pB0,8),PKW(pB0,10),PKW(pB0,12),PKW(pB0,14)};pw2=(u32x4){PKW(pB1,0),PKW(pB1,2),PKW(pB1,4),PKW(pB1,6)};pw3=(u32x4){PKW(pB1,8),PKW(pB1,10),PKW(pB1,12),PKW(pB1,14)};
    SBAR(); pv4(o,vb0+2*sl_cur,PAF(0),PAF(1),PAF(2),PAF(3)); }
  #undef PKW
  #undef PAF
  #undef VFR
  #undef PIN
  #undef MX3
  #undef GAPA
  #undef GAPB
  #undef EX
  #undef VRD
  #undef KF
  #undef STEP
  #undef ENDW
  {auto rr=__builtin_amdgcn_permlane32_swap(__float_as_uint(l_reg),__float_as_uint(l_reg),false,false);l_reg=__uint_as_float(rr[0])+__uint_as_float(rr[1]);}
  if(hi==0)wsf[32+r32]=l_reg;asm volatile("s_waitcnt lgkmcnt(0)":::"memory");
  float rli[16];
  #pragma unroll
  for(int r=0;r<16;++r)rli[r]=__builtin_amdgcn_rcpf(wsf[32+crow(r,hi)]);
  bf16*Ow=O+(rowbase+q0+wid*QBLK)*DM+2*h*D;
  bf16*stg=(bf16*)(shm+LDS_OST2)+wid*2048;
  if constexpr(!FUSE){
    #pragma unroll
    for(int ps=0;ps<2;++ps){
      #pragma unroll
      for(int r=0;r<16;++r){const int orow=crow(r,hi);
        #pragma unroll
        for(int d0=0;d0<2;++d0)stg[orow*64+d0*32+r32]=__float2bfloat16(o[2*ps+d0][r]*rli[r]);}
      asm volatile("s_waitcnt lgkmcnt(0)":::"memory");
      #pragma unroll
      for(int i=0;i<4;++i){const int row=i*8+(lane>>3),ch=lane&7; const u32x4 v=*(const u32x4*)(stg+row*64+ch*8); ATTN_STORE16(Ow+(long)row*DM+ps*64+ch*8,v);}
      asm volatile("s_waitcnt lgkmcnt(0)":::"memory"); }
    asm volatile("s_waitcnt vmcnt(0)":::"memory");
  } else {
    float dv[2][4][8]; float ss[4]={0.f,0.f,0.f,0.f};
    u32x4 v0p[2][4];
    #pragma unroll
    for(int ps=0;ps<2;++ps)
      #pragma unroll
      for(int i=0;i<4;++i){const int row=i*8+(lane>>3),ch=lane&7; v0p[ps][i]=*(const u32x4*)(Ow+(long)row*DM+ps*64+ch*8);}
    #pragma unroll
    for(int ps=0;ps<2;++ps){
      #pragma unroll
      for(int r=0;r<16;++r){const int orow=crow(r,hi);
        #pragma unroll
        for(int d0=0;d0<2;++d0)stg[orow*64+d0*32+r32]=__float2bfloat16(o[2*ps+d0][r]*rli[r]);}
      asm volatile("s_waitcnt lgkmcnt(0)":::"memory");
      #pragma unroll
      for(int i=0;i<4;++i){const int row=i*8+(lane>>3),ch=lane&7; const u32x4 v1=*(const u32x4*)(stg+row*64+ch*8); const u32x4 v0=v0p[ps][i];
        #pragma unroll
        for(int e=0;e<4;++e){ const float a0=__uint_as_float(v0[e]<<16),a1=__uint_as_float(v0[e]&0xffff0000u),b0=__uint_as_float(v1[e]<<16),b1=__uint_as_float(v1[e]&0xffff0000u);
          const float x0=a0-lam*b0,x1=a1-lam*b1; dv[ps][i][2*e]=x0; dv[ps][i][2*e+1]=x1; ss[i]+=x0*x0+x1*x1; } }
      asm volatile("s_waitcnt lgkmcnt(0)":::"memory"); }
    #pragma unroll
    for(int i=0;i<4;++i){ float s_=ss[i];
      { int b_=__float_as_int(s_); s_+=__int_as_float(__builtin_amdgcn_update_dpp(b_,b_,0xB1,0xF,0xF,false)); b_=__float_as_int(s_); s_+=__int_as_float(__builtin_amdgcn_update_dpp(b_,b_,0x4E,0xF,0xF,false)); b_=__float_as_int(s_); s_+=__int_as_float(__builtin_amdgcn_update_dpp(b_,b_,0x141,0xF,0xF,false)); }
      ss[i]=1.0f/sqrtf(s_*(1.0f/128.0f)+1e-6f); }
    #pragma unroll
    for(int ps=0;ps<2;++ps){ float gg[8];
      #pragma unroll
      for(int e=0;e<8;++e)gg[e]=gsub[ps*64+(lane&7)*8+e]*0.8f;
      #pragma unroll
      for(int i=0;i<4;++i){const int row=i*8+(lane>>3),ch=lane&7; u32x4 w;
        #pragma unroll
        for(int e=0;e<4;++e)w[e]=cvtpk_s(dv[ps][i][2*e]*ss[i]*gg[2*e],dv[ps][i][2*e+1]*ss[i]*gg[2*e+1]);
        ATTN_STORE16(Ow+(long)row*DM+ps*64+ch*8,w);} }
  }
  asm volatile("s_waitcnt lgkmcnt(0)\n\ts_barrier":::"memory");
  #undef DMA_K
  #undef DMA_V
  #undef QF
  #undef CMASK
  #undef NVAL
  #undef START
  #undef RESC
  #undef ROT
}
constexpr int ATTN_LDS_BYTES=LDS_BYTES2;
#undef SBAR
#undef WAIT_BAR
}

constexpr int NWAVES = 8;
constexpr int N_LAUNCHES = MK_N_LAUNCHES;
constexpr int N_PHASES = 9 + 2 * NCH + 1;
constexpr bool PER_PHASE = (MK_N_LAUNCHES != 1);

constexpr size_t MiB = 1u << 20;
constexpr size_t ACT = (size_t)T * D * 2;
constexpr size_t WS_CTL = 0, CTL_ZERO_BYTES = 65536;
constexpr size_t WS_MOD = 1 * MiB;
constexpr size_t WS_SH = WS_MOD + 512 * 1024;
constexpr size_t WS_WIN = 2 * MiB;
constexpr size_t WS_WR = 16 * MiB, WS_WA = 18 * MiB, WS_WO = 20 * MiB;
constexpr size_t WS_LW = 22 * MiB;
constexpr size_t WS_WRH = 23 * MiB, WS_WRL = 23 * MiB + 131072;
constexpr size_t WS_H = 24 * MiB;
constexpr size_t WS_XR = WS_H + ACT;
constexpr size_t WS_GR = WS_XR + ACT;
constexpr size_t WS_Q = WS_GR + ACT;
constexpr size_t WS_K = WS_Q + ACT;
constexpr size_t WS_V = WS_K + ACT;
constexpr size_t WS_O1 = WS_V + ACT;
constexpr size_t WS_END = WS_O1 + ACT;
static_assert(WS_END <= 512 * MiB, "ws map");
constexpr size_t WS_W13 = WS_GR;
constexpr size_t WS_W2 = WS_O1;
constexpr size_t WS_W13S = WS_O1 + 32 * MiB;
constexpr size_t WS_W2S = WS_O1 + 33 * MiB;
constexpr size_t WS_LIST = WS_O1 + 34 * MiB;
constexpr size_t WS_WTS = WS_O1 + 42 * MiB;
constexpr size_t WS_RDEST = WS_O1 + 43 * MiB;
constexpr size_t WS_RWT = WS_O1 + 44 * MiB;
constexpr size_t WS_SA = WS_O1 + 45 * MiB;
constexpr int MAXRT = TC * TOPK / 256 + NEXP + TC / 256;
constexpr int MAXROWS = MAXRT * 256;
constexpr size_t WS_HB = WS_XR;
constexpr size_t WS_SLOT = WS_Q;
constexpr size_t WS_SLOTSC = WS_SLOT + 72 * MiB;
constexpr size_t WS_Y = WS_Q;
static_assert(WS_SLOT + (size_t)(TC * 9) * D * 2 <= WS_O1 && (size_t)MAXROWS * 512 <= ACT, "moe map");
constexpr int CW_TMO = 0;
constexpr int CW_BAR = 4096;
constexpr int CW_CNT = 8192;
constexpr int CW_AMAX = 8192 + 512;

constexpr int RING_BYTES = 139264;
constexpr int MISC_OFF = RING_BYTES;
constexpr int LDS_BYTES = 155648;
constexpr int MI_BARST = 0;
constexpr int MI_CNT = 64;
constexpr int MI_TBASE = 128;
constexpr int MI_TILE_E = 256;
constexpr int MI_TOK = 1024;
constexpr int MI_WORDS = 4096;

#define GAS __attribute__((address_space(1)))
#define LAS __attribute__((address_space(3)))
typedef unsigned short bf16;
typedef unsigned v4u __attribute__((ext_vector_type(4)));
typedef unsigned v2u __attribute__((ext_vector_type(2)));
typedef float f32x4 __attribute__((ext_vector_type(4)));
typedef float f32x16 __attribute__((ext_vector_type(16)));
typedef short bf16x8 __attribute__((ext_vector_type(8)));
typedef GAS unsigned gu32;
#define RLX_AGENT __ATOMIC_RELAXED, __HIP_MEMORY_SCOPE_AGENT
#define LDS_WAIT() asm volatile("s_waitcnt lgkmcnt(0)" ::: "memory")
#define VM_WAIT() asm volatile("s_waitcnt vmcnt(0)" ::: "memory")
__device__ __forceinline__ unsigned f2bf(float f) { unsigned u = __builtin_bit_cast(unsigned, f); return (u + 0x7fffu + ((u >> 16) & 1u)) >> 16; }
__device__ __forceinline__ unsigned pk2(float lo, float hi) { return f2bf(lo) | (f2bf(hi) << 16); }
__device__ __forceinline__ float bf2f(unsigned h) { return __uint_as_float(h << 16); }
using pg8::bflo; using pg8::bfhi; using pg8::sigm;

#define XB_TMO      128
#define XB_XCNT(j)  (256  + 64 * (j))
#define XB_XSUB(j)  (1280 + 64 * (j))
#define XB_XGEN(j)  (2304 + 64 * (j))
#define XB_TOP      3328
#define XB_TOPGEN   3392
#define XCD_BAR_WORDS 3456
#define XB_SPIN_CAP (1u << 18)
__device__ __forceinline__ unsigned xb_ld(unsigned* p)              { return __hip_atomic_load(p, __ATOMIC_RELAXED, __HIP_MEMORY_SCOPE_AGENT); }
__device__ __forceinline__ unsigned xb_add(unsigned* p, unsigned v) { return __hip_atomic_fetch_add(p, v, __ATOMIC_RELAXED, __HIP_MEMORY_SCOPE_AGENT); }
__device__ __forceinline__ unsigned xb_xcc_id() { return (unsigned)__builtin_amdgcn_s_getreg((3 << 11) | 20) & 0xFu; }
#define XB_SPIN(cond, bar) do { unsigned _sp = 0; while (cond) { __builtin_amdgcn_s_sleep(1); \
    if ((++_sp & 255u) == 0u) { if (xb_ld(&(bar)[XB_TMO])) break; if (_sp > XB_SPIN_CAP) { atomicAdd(&(bar)[XB_TMO], 1u); break; } } } } while (0)
struct XcdBarrier { unsigned* bar; unsigned x; volatile LAS unsigned* st; };
__device__ __forceinline__ XcdBarrier xcd_barrier_post(unsigned* bar, volatile LAS unsigned* st) {
    XcdBarrier b; b.bar = bar; b.x = xb_xcc_id(); b.st = st;
    if (threadIdx.x == 0) (void)xb_add(&bar[XB_XCNT(b.x)], 1u);
    return b;
}
__device__ __forceinline__ void xcd_barrier_complete(unsigned* bar, unsigned x, unsigned& nloc, unsigned& nx) {
    const unsigned G = gridDim.x * gridDim.y * gridDim.z;
    unsigned sum, cnt, mine, sp = 0u;
    for (;;) {
        sum = 0u; cnt = 0u; mine = 0u;
#pragma unroll 1
        for (unsigned j = 0; j < 16; ++j) { const unsigned c = xb_ld(&bar[XB_XCNT(j)]); sum += c; cnt += (c > 0u) ? 1u : 0u; mine = (j == x) ? c : mine; }
        if (sum == G) break;
        __builtin_amdgcn_s_sleep(1);
        if ((++sp & 255u) == 0u) { if (xb_ld(&bar[XB_TMO])) break; if (sp > XB_SPIN_CAP) { atomicAdd(&bar[XB_TMO], 1u); break; } }
    }
    nloc = mine > 0u ? mine : 1u; nx = cnt > 0u ? cnt : 1u;
}
__device__ __forceinline__ void xcd_barrier(const XcdBarrier& b) {
    asm volatile("s_waitcnt vmcnt(0)" ::: "memory");
    __syncthreads();
    if (threadIdx.x == 0) {
        unsigned* bar = b.bar; asm volatile("" : "+s"(bar));
        __builtin_amdgcn_s_waitcnt(0);
        unsigned nloc = b.st[0], nx = b.st[1];
        if (nloc == 0u) { xcd_barrier_complete(bar, b.x, nloc, nx); b.st[0] = nloc; b.st[1] = nx; }
        const unsigned old = xb_add(&bar[XB_XSUB(b.x)], 1u);
        const unsigned gen = old / nloc;
        if (old + 1u == (gen + 1u) * nloc) {
            __builtin_amdgcn_fence(__ATOMIC_RELEASE, "agent");
            asm volatile("s_waitcnt vmcnt(0)" ::: "memory");
            const unsigned og = xb_add(&bar[XB_TOP], 1u);
            const unsigned tg = og / nx;
            if (og + 1u == (tg + 1u) * nx) xb_add(&bar[XB_TOPGEN], 1u);
            else XB_SPIN(xb_ld(&bar[XB_TOPGEN]) == tg, bar);
            __builtin_amdgcn_fence(__ATOMIC_ACQUIRE, "agent");
            xb_add(&bar[XB_XGEN(b.x)], 1u);
            asm volatile("s_waitcnt vmcnt(0)" ::: "memory");
        } else {
            XB_SPIN(xb_ld(&bar[XB_XGEN(b.x)]) == gen, bar);
            __builtin_amdgcn_fence(__ATOMIC_ACQUIRE, "agent");
            asm volatile("s_waitcnt vmcnt(0)" ::: "memory");
        }
    }
    __syncthreads();
}

struct Frame {
    LAS unsigned char* lds;
    volatile LAS int* MI;
    gu32* ctl;
    int tid, lane, wave, vcu, G;
    float* out;
    unsigned char* ws;
};
struct Args { const float* in[32]; float* out; unsigned char* ws; int ph_lo, ph_hi; };
__device__ __forceinline__ float dppf(float x, int ctrl_sel) {
    const int b = __float_as_int(x); int r;
    if (ctrl_sel == 0) r = __builtin_amdgcn_update_dpp(b, b, 0xB1, 0xF, 0xF, false);
    else if (ctrl_sel == 1) r = __builtin_amdgcn_update_dpp(b, b, 0x4E, 0xF, 0xF, false);
    else if (ctrl_sel == 2) r = __builtin_amdgcn_update_dpp(b, b, 0x141, 0xF, 0xF, false);
    else r = __builtin_amdgcn_update_dpp(b, b, 0x140, 0xF, 0xF, false);
    return __int_as_float(r);
}
__device__ __forceinline__ float max8_dpp(float x) { x = fmaxf(x, dppf(x, 0)); x = fmaxf(x, dppf(x, 1)); x = fmaxf(x, dppf(x, 2)); return x; }
__device__ __forceinline__ float rl_f(float x, int l) { return __int_as_float(__builtin_amdgcn_readlane(__float_as_int(x), l)); }
__device__ __forceinline__ float wave_max_dpp(float x) { x = max8_dpp(x); x = fmaxf(x, dppf(x, 3)); return fmaxf(fmaxf(rl_f(x, 0), rl_f(x, 16)), fmaxf(rl_f(x, 32), rl_f(x, 48))); }
__device__ __forceinline__ float wave_sum_dpp(float x) { x += dppf(x, 0); x += dppf(x, 1); x += dppf(x, 2); x += dppf(x, 3); return (rl_f(x, 0) + rl_f(x, 16)) + (rl_f(x, 32) + rl_f(x, 48)); }
__device__ __forceinline__ float wave_sum(float v) { return wave_sum_dpp(v); }

typedef short v4i16_t __attribute__((ext_vector_type(4)));
__device__ __forceinline__ v2u tr8(const LAS unsigned char* p) { return __builtin_bit_cast(v2u, __builtin_amdgcn_ds_read_tr16_b64_v4i16((LAS v4i16_t*)p)); }
__device__ __forceinline__ void transpose_item(const float* W, int K, int N, bf16* WT, int kb, int n0, int drow0, LAS float* scr_, int lane) {
    LAS unsigned char* scr = (LAS unsigned char*)scr_;
    const int k0 = 64 * kb, lr = lane >> 4, lc = lane & 15;
#pragma unroll
    for (int hf = 0; hf < 2; ++hf) {
        f32x4 v[8];
#pragma unroll
        for (int r = 0; r < 8; ++r) v[r] = *(const f32x4*)(W + (size_t)(k0 + 32 * hf + 4 * r + lr) * N + n0 + 4 * lc);
#pragma unroll
        for (int r = 0; r < 8; ++r) { v2u o; o.x = pk2(v[r].x, v[r].y); o.y = pk2(v[r].z, v[r].w); *(LAS v2u*)(scr + (32 * hf + 4 * r + lr) * 144 + lc * 8) = o; }
    }
    LDS_WAIT(); asm volatile("" ::: "memory");
    const int g = lane >> 4, q = (lane & 15) >> 2, p = lane & 3;
#pragma unroll
    for (int nb = 0; nb < 4; ++nb)
#pragma unroll
        for (int kk = 0; kk < 2; ++kk) { const int kblk = 4 * kk + g;
            const v2u a = tr8(scr + (8 * kblk + q) * 144 + (16 * nb + 4 * p) * 2), b = tr8(scr + (8 * kblk + 4 + q) * 144 + (16 * nb + 4 * p) * 2);
            v4u o; o.x = a.x; o.y = a.y; o.z = b.x; o.w = b.y;
            *(GAS v4u*)(WT + (size_t)(drow0 + 16 * nb + lc) * K + k0 + 8 * kblk) = o; }
    LDS_WAIT(); asm volatile("" ::: "memory");
}

__device__ __forceinline__ void p0_phase(Frame& F, const Args& A) {
    unsigned char* ws = F.ws;
    LAS float* sc = (LAS float*)F.lds;
    if (F.vcu < 6 * D / 64) {
#pragma unroll 1
        for (int i0 = F.tid; i0 < BATCH * D; i0 += 8 * NWAVES * 64) { float v[8];
#pragma unroll
            for (int u = 0; u < 8; ++u) v[u] = A.in[1][i0 + u * NWAVES * 64];
#pragma unroll
            for (int u = 0; u < 8; ++u) { const int i = i0 + u * NWAVES * 64, b = i >> 10, k = i & 1023; sc[k * 16 + b] = v[u] * sigm(v[u]); } } }
    __syncthreads();
    const int nada = (F.G > 2 * (6 * D / 64)) ? (6 * D / 64) : 0;
    const int NGW = (F.G - nada) * NWAVES, gw = (F.vcu >= nada) ? (F.vcu - nada) * NWAVES + F.wave : 0x40000000;
    LAS float* part = (LAS float*)(F.lds + 65536);
    for (int task = F.vcu; task < 6 * D / 64; task += F.G) {
        const int col = task * 64 + F.lane;
        float acc[16];
#pragma unroll
        for (int b = 0; b < 16; ++b) acc[b] = 0.f;
        const float* wp = A.in[2] + (size_t)(128 * F.wave) * (6 * D) + col;
        const LAS f32x4* sp = (const LAS f32x4*)(sc + (128 * F.wave) * 16);
#pragma unroll 1
        for (int k0 = 0; k0 < 128; k0 += 32) { float wv[32];
#pragma unroll
            for (int i = 0; i < 32; ++i) wv[i] = wp[(size_t)(k0 + i) * (6 * D)];
#pragma unroll
            for (int i = 0; i < 32; ++i) {
#pragma unroll
                for (int q = 0; q < 4; ++q) { const f32x4 sv = sp[(k0 + i) * 4 + q]; acc[4 * q + 0] += wv[i] * sv.x; acc[4 * q + 1] += wv[i] * sv.y; acc[4 * q + 2] += wv[i] * sv.z; acc[4 * q + 3] += wv[i] * sv.w; } } }
#pragma unroll
        for (int b = 0; b < 16; ++b) part[(F.wave * 16 + b) * 64 + F.lane] = acc[b];
        __syncthreads();
        for (int i = F.tid; i < 16 * 64; i += NWAVES * 64) { const int b = i >> 6, c = i & 63; float v = A.in[3][task * 64 + c];
#pragma unroll
            for (int w8 = 0; w8 < 8; ++w8) v += part[(w8 * 16 + b) * 64 + c];
            ((float*)(ws + WS_MOD))[b * (6 * D) + task * 64 + c] = v; }
        __syncthreads();
    }
    __syncthreads();
    LAS float* scr = (LAS float*)(F.lds + F.wave * 16384);
    constexpr int I_SQ = 16 * 16, I_LW = 16 * 4;
    constexpr int NITEMS = 3 * I_SQ + I_LW;
    for (int it = gw; it < NITEMS; it += NGW) {
        int r = it;
        if (r < I_SQ) { transpose_item(A.in[18], D, D, (bf16*)(ws + WS_WR), r / 16, 64 * (r % 16), 64 * (r % 16), scr, F.lane); continue; } r -= I_SQ;
        if (r < I_SQ) { transpose_item(A.in[19], D, D, (bf16*)(ws + WS_WA), r / 16, 64 * (r % 16), 64 * (r % 16), scr, F.lane); continue; } r -= I_SQ;
        if (r < I_SQ) { transpose_item(A.in[20], D, D, (bf16*)(ws + WS_WO), r / 16, 64 * (r % 16), 64 * (r % 16), scr, F.lane); continue; } r -= I_SQ;
        { const int mat = r >> 2, q = r & 3, gate = mat >> 3, n = mat & 7;
          const float* W = (gate ? A.in[10] : A.in[8]) + (size_t)n * 128 * 128;
          transpose_item(W, 128, 128, (bf16*)(ws + WS_LW) + (size_t)(n * 2 + gate) * 128 * 128, q >> 1, 64 * (q & 1), 64 * (q & 1), scr, F.lane); }
    }
    for (long i = (long)gw * 64 + F.lane; i < D * NEXP; i += NGW * 64) { const int k = i >> 6, e = i & 63; const float wv = A.in[23][i]; const unsigned hb = f2bf(wv); const unsigned lb = f2bf(wv - bf2f(hb));
        ((bf16*)(ws + WS_WRH))[e * D + k] = (bf16)hb; ((bf16*)(ws + WS_WRL))[e * D + k] = (bf16)lb; }
    for (int it = gw; it < 130 * 64 + (D * W_IN) / 4096; it += NGW) { const int mtx = it < 130 * 64 ? it >> 6 : 130, part = it < 130 * 64 ? (it & 63) : it - 130 * 64, e = mtx >> 1, w3 = mtx & 1;
        const float* W = (mtx == 130 ? A.in[5] : e < NEXP ? (w3 ? A.in[26] : A.in[25]) + (size_t)e * D * DEXP : (w3 ? A.in[29] : A.in[28])) + (size_t)part * 4096;
        float mx = 0.f;
#pragma unroll
        for (int i = 0; i < 16; ++i) { const f32x4 v = *((const f32x4*)W + F.lane + 64 * i); mx = fmaxf(mx, fmaxf(fmaxf(fabsf(v.x), fabsf(v.y)), fmaxf(fabsf(v.z), fabsf(v.w)))); }
        mx = wave_max_dpp(mx);
        if (F.lane == 0) atomicMax((unsigned*)(F.ctl + CW_AMAX + mtx), __float_as_uint(mx)); }
}

__device__ __forceinline__ void transpose_item_q(const float* W, int K, int N, signed char* WT, int kb, int n0, int drow0, LAS float* scr_, int lane, float inv) {
    LAS unsigned char* scr = (LAS unsigned char*)scr_;
    const int k0 = 64 * kb, lr = lane >> 4, lc = lane & 15;
#pragma unroll
    for (int hf = 0; hf < 2; ++hf) {
        f32x4 v[8];
#pragma unroll
        for (int r = 0; r < 8; ++r) v[r] = *(const f32x4*)(W + (size_t)(k0 + 32 * hf + 4 * r + lr) * N + n0 + 4 * lc);
#pragma unroll
        for (int r = 0; r < 8; ++r) { v2u o; o.x = pk2(v[r].x, v[r].y); o.y = pk2(v[r].z, v[r].w); *(LAS v2u*)(scr + (32 * hf + 4 * r + lr) * 144 + lc * 8) = o; }
    }
    LDS_WAIT(); asm volatile("" ::: "memory");
    const int g = lane >> 4, q = (lane & 15) >> 2, p = lane & 3;
#pragma unroll
    for (int nb = 0; nb < 4; ++nb)
#pragma unroll
        for (int kk = 0; kk < 2; ++kk) { const int kblk = 4 * kk + g;
            const v2u a = tr8(scr + (8 * kblk + q) * 144 + (16 * nb + 4 * p) * 2), b = tr8(scr + (8 * kblk + 4 + q) * 144 + (16 * nb + 4 * p) * 2);
            const unsigned wv[4] = {a.x, a.y, b.x, b.y}; unsigned ob[2] = {0u, 0u};
#pragma unroll
            for (int j = 0; j < 4; ++j) { const int q0 = (int)rintf(bflo(wv[j]) * inv), q1 = (int)rintf(bfhi(wv[j]) * inv);
                ob[j >> 1] |= ((unsigned)(q0 & 0xff) << (16 * (j & 1))) | ((unsigned)(q1 & 0xff) << (16 * (j & 1) + 8)); }
            v2u o; o.x = ob[0]; o.y = ob[1];
            *(GAS v2u*)(WT + (size_t)(drow0 + 16 * nb + lc) * K + k0 + 8 * kblk) = o; }
    LDS_WAIT(); asm volatile("" ::: "memory");
}

__device__ __forceinline__ void p1_phase(Frame& F, const Args& A) {
    const int gw = F.vcu * NWAVES + F.wave, NGW = F.G * NWAVES;
    const float* mod = (const float*)(F.ws + WS_MOD);
    signed char* H = (signed char*)(F.ws + WS_H); float* SH = (float*)(F.ws + WS_SH);
    for (int grp = gw; grp < T / 16; grp += NGW) {
        const int b = (grp * 16) / SEQ;
        f32x4 g[4], sc[4], sh[4];
#pragma unroll
        for (int j = 0; j < 4; ++j) { const int c = 4 * F.lane + 256 * j; g[j] = *(const f32x4*)(A.in[4] + c); sh[j] = *(const f32x4*)(mod + b * 6 * D + c); sc[j] = *(const f32x4*)(mod + b * 6 * D + D + c);
            g[j] = g[j] * (sc[j] + 1.0f); }
        f32x4 vn[4];
        { const GAS f32x4* xr = (const GAS f32x4*)(A.in[0] + (size_t)grp * 16 * D) + F.lane;
#pragma unroll
          for (int j = 0; j < 4; ++j) vn[j] = xr[64 * j]; }
#pragma unroll 2
        for (int rr = 0; rr < 16; ++rr) {
            const size_t m = (size_t)grp * 16 + rr;
            f32x4 v[4]; float s = 0.f;
#pragma unroll
            for (int j = 0; j < 4; ++j) v[j] = vn[j];
            if (rr + 1 < 16) { const GAS f32x4* xr = (const GAS f32x4*)(A.in[0] + (m + 1) * D) + F.lane;
#pragma unroll
                for (int j = 0; j < 4; ++j) vn[j] = xr[64 * j]; }
#pragma unroll
            for (int j = 0; j < 4; ++j) s += (v[j].x * v[j].x + v[j].y * v[j].y) + (v[j].z * v[j].z + v[j].w * v[j].w);
            const float rstd = 1.f / sqrtf(wave_sum(s) * (1.f / D) + EPS);
            float amx = 0.f;
#pragma unroll
            for (int j = 0; j < 4; ++j) { v[j] = v[j] * rstd * g[j] + sh[j]; amx = fmaxf(amx, fmaxf(fmaxf(fabsf(v[j].x), fabsf(v[j].y)), fmaxf(fabsf(v[j].z), fabsf(v[j].w)))); }
            amx = fmaxf(wave_max_dpp(amx), 1e-20f); const float inv = 127.0f / amx; if (F.lane == 0) SH[m] = amx * (1.0f / 127.0f);
#pragma unroll
            for (int j = 0; j < 4; ++j) { const int q0 = (int)rintf(v[j].x * inv), q1 = (int)rintf(v[j].y * inv), q2 = (int)rintf(v[j].z * inv), q3 = (int)rintf(v[j].w * inv);
                *((GAS unsigned*)(H + m * D) + F.lane + 64 * j) = (unsigned)(q0 & 0xff) | ((unsigned)(q1 & 0xff) << 8) | ((unsigned)(q2 & 0xff) << 16) | ((unsigned)(q3 & 0xff) << 24); }
        }
    }
    { LAS float* scr = (LAS float*)(F.lds + F.wave * 16384);
      const float inv = 127.0f / fmaxf(__uint_as_float(__hip_atomic_load(F.ctl + CW_AMAX + 130, RLX_AGENT)), 1e-30f);
      constexpr int I_IN = 16 * (W_IN / 64);
      for (int it = NGW - 1 - gw; it < I_IN; it += NGW)
          transpose_item_q(A.in[5], D, W_IN, (signed char*)(F.ws + WS_WIN), it / (W_IN / 64), 64 * (it % (W_IN / 64)), 64 * (it % (W_IN / 64)), scr, F.lane, inv); }
}

struct DenseOrder {
    const char* A; const char* Bt; int nM, nN, nwg, G, c; size_t tstep;
    __device__ __forceinline__ void init(const void* A_, const void* Bt_, int M, int N, int K, int G_, int c_) { A = (const char*)A_; Bt = (const char*)Bt_; nM = M / 256; nN = N / 256; nwg = nM * nN; G = G_; c = c_; tstep = (size_t)256 * K * 2; }
    __device__ __forceinline__ bool next(int i, pg8::Unit& u) const {
        const long L = (long)i * G + c; if (L >= nwg) return false;
        int wgid = (int)L; { const int q = nwg / 8, r = nwg % 8, xcd = wgid % 8, off = wgid / 8; wgid = (xcd < r ? xcd * (q + 1) : r * (q + 1) + (xcd - r) * q) + off; }
        const int nig = 8 * nN, gid = wgid / nig, fm = gid * 8, gsz = (nM - fm) < 8 ? (nM - fm) : 8;
        u.pm = fm + ((wgid % nig) % gsz); u.pn = (wgid % nig) / gsz; u.z = i; u.e = 0; return true;
    }
    __device__ __forceinline__ void bases(const pg8::Unit& u, const char*& a, const char*& b) const { a = A + (size_t)u.pm * tstep; b = Bt + (size_t)u.pn * tstep; }
    __device__ __forceinline__ int tok(int, int) const { return 0; }
};
struct MergeOrder {
    DenseOrder d; const char *A1, *B1;
    __device__ __forceinline__ bool next(int i, pg8::Unit& u) const { if (!d.next(i >> 1, u)) return false; u.z = i & 1; return true; }
    __device__ __forceinline__ void bases(const pg8::Unit& u, const char*& a, const char*& b) const { a = (u.z ? A1 : d.A) + (size_t)u.pm * d.tstep; b = (u.z ? B1 : d.Bt) + (size_t)u.pn * d.tstep; }
    __device__ __forceinline__ int tok(int, int) const { return 0; }
};
typedef pg8::f32x4 acc_t[2][2][4][2];
struct EpiProj {
    static constexpr bool PERM = true, TWICE = false;
    bf16* ws5; bf16* dout2; volatile LAS int* MI; float sB;
    __device__ __forceinline__ void operator()(const acc_t& acc, const pg8::Unit& u, int wr, int wc, int fr, int fq) const {
        const int t = u.pn >> 2, colt = (u.pn & 3) * 256;
        bf16* base = ws5 + (size_t)(t < 5 ? t : 0) * T * D;
        const int row0 = u.pm * 256 + wr * 64 + fr, col0 = colt + wc * 32 + 8 * fq;
#pragma unroll
        for (int ai = 0; ai < 2; ++ai)
#pragma unroll
            for (int m = 0; m < 4; ++m) { bf16* rowp = base + (size_t)(row0 + ai * 128 + m * 16) * D + col0;
                const float sc = __int_as_float(MI[512 + u.z * 256 + wr * 64 + fr + ai * 128 + m * 16]) * sB;
#pragma unroll
                for (int bj = 0; bj < 2; ++bj) { const pg8::i32x4 I0 = __builtin_bit_cast(pg8::i32x4, acc[ai][bj][m][0]), I1 = __builtin_bit_cast(pg8::i32x4, acc[ai][bj][m][1]);
                    pg8::f32x4 v0, v1;
#pragma unroll
                    for (int i = 0; i < 4; ++i) { float a = (float)I0[i] * sc, b = (float)I1[i] * sc; asm volatile("" : "+v"(a), "+v"(b)); v0[i] = a; v1[i] = b; }
                    if (t >= 5) {
                        unsigned tb[8];
#pragma unroll
                        for (int i = 0; i < 4; ++i) { tb[i] = __float_as_uint(__builtin_fmaf(sigm(v0[i]), 255.0f, 8388608.0f)); tb[4 + i] = __float_as_uint(__builtin_fmaf(sigm(v1[i]), 255.0f, 8388608.0f)); }
                        v2u w; w.x = __builtin_amdgcn_perm(__builtin_amdgcn_perm(tb[3], tb[2], 0x0c0c0400u), __builtin_amdgcn_perm(tb[1], tb[0], 0x0c0c0400u), 0x05040100u);
                        w.y = __builtin_amdgcn_perm(__builtin_amdgcn_perm(tb[7], tb[6], 0x0c0c0400u), __builtin_amdgcn_perm(tb[5], tb[4], 0x0c0c0400u), 0x05040100u);
                        *(v2u*)((unsigned char*)dout2 + (size_t)(t - 5) * T * D + (size_t)(row0 + ai * 128 + m * 16) * D + col0 + bj * 128) = w; continue; }
                    if (t == 1) { for (int i = 0; i < 4; ++i) { v0[i] = pg8::gelu_t(v0[i]); v1[i] = pg8::gelu_t(v1[i]); } }
                    else if (t == 2) { v0 = v0 * attn_body::C2; v1 = v1 * attn_body::C2; }
                    v4u w; w.x = pg8::cvt_pk_bf16(v0[0], v0[1]); w.y = pg8::cvt_pk_bf16(v0[2], v0[3]); w.z = pg8::cvt_pk_bf16(v1[0], v1[1]); w.w = pg8::cvt_pk_bf16(v1[2], v1[3]);
                    *(v4u*)(rowp + bj * 128) = w; } }
    }
};
struct EpiGate {
    static constexpr bool PERM = true, TWICE = false;
    const unsigned char* GA; const unsigned char* GB; bf16* YA; bf16* MG;
    __device__ __forceinline__ void operator()(const acc_t& acc, const pg8::Unit& u, int wr, int wc, int fr, int fq) const {
        const int row0 = u.pm * 256 + wr * 64 + fr, col0 = u.pn * 256 + wc * 32 + 8 * fq;
        const unsigned char* G = u.z ? GB : GA; bf16* O = u.z ? MG : YA;
#pragma unroll
        for (int ai = 0; ai < 2; ++ai)
#pragma unroll
            for (int mp = 0; mp < 2; ++mp) {
                v2u g[2][2]; v4u y[2][2];
#pragma unroll
                for (int mm = 0; mm < 2; ++mm)
#pragma unroll
                    for (int bj = 0; bj < 2; ++bj) { const size_t off = (size_t)(row0 + ai * 128 + (2 * mp + mm) * 16) * D + col0 + bj * 128; g[mm][bj] = *(const v2u*)(G + off);
                        y[mm][bj] = u.z ? *(const v4u*)(YA + off) : (v4u){0u, 0u, 0u, 0u}; }
#pragma unroll
                for (int mm = 0; mm < 2; ++mm)
#pragma unroll
                    for (int bj = 0; bj < 2; ++bj) { const int m = 2 * mp + mm; const size_t off = (size_t)(row0 + ai * 128 + m * 16) * D + col0 + bj * 128; const v2u gg = g[mm][bj]; const v4u yy = y[mm][bj]; constexpr float Q = 1.0f / 255.0f;
                        pg8::f32x4 v0 = acc[ai][bj][m][0], v1 = acc[ai][bj][m][1];
                        v0[0] = v0[0] * ((float)(gg.x & 0xffu) * Q) + bflo(yy.x); v0[1] = v0[1] * ((float)((gg.x >> 8) & 0xffu) * Q) + bfhi(yy.x); v0[2] = v0[2] * ((float)((gg.x >> 16) & 0xffu) * Q) + bflo(yy.y); v0[3] = v0[3] * ((float)(gg.x >> 24) * Q) + bfhi(yy.y);
                        v1[0] = v1[0] * ((float)(gg.y & 0xffu) * Q) + bflo(yy.z); v1[1] = v1[1] * ((float)((gg.y >> 8) & 0xffu) * Q) + bfhi(yy.z); v1[2] = v1[2] * ((float)((gg.y >> 16) & 0xffu) * Q) + bflo(yy.w); v1[3] = v1[3] * ((float)(gg.y >> 24) * Q) + bfhi(yy.w);
                        v4u w; w.x = pg8::cvt_pk_bf16(v0[0], v0[1]); w.y = pg8::cvt_pk_bf16(v0[2], v0[3]); w.z = pg8::cvt_pk_bf16(v1[0], v1[1]); w.w = pg8::cvt_pk_bf16(v1[2], v1[3]);
                        *(v4u*)(O + off) = w; }
                asm volatile("" ::: "memory"); }
    }
};
struct EpiF32 {
    static constexpr bool PERM = true, TWICE = false;
    bf16* Y;
    __device__ __forceinline__ void operator()(const acc_t& acc, const pg8::Unit& u, int wr, int wc, int fr, int fq) const {
        const int row0 = u.pm * 256 + wr * 64 + fr, col0 = u.pn * 256 + wc * 32 + 8 * fq;
#pragma unroll
        for (int ai = 0; ai < 2; ++ai)
#pragma unroll
            for (int m = 0; m < 4; ++m) { bf16* rowp = Y + (size_t)(row0 + ai * 128 + m * 16) * D + col0;
#pragma unroll
                for (int bj = 0; bj < 2; ++bj) { const pg8::f32x4 v0 = acc[ai][bj][m][0], v1 = acc[ai][bj][m][1];
                    v4u w; w.x = pg8::cvt_pk_bf16(v0[0], v0[1]); w.y = pg8::cvt_pk_bf16(v0[2], v0[3]); w.z = pg8::cvt_pk_bf16(v1[0], v1[1]); w.w = pg8::cvt_pk_bf16(v1[2], v1[3]);
                    *(v4u*)(rowp + bj * 128) = w; } }
    }
};

__device__ __forceinline__ void lru_phase(Frame& F, const Args& A) {
    unsigned char* ws = F.ws;
    const bf16* XR = (const bf16*)(ws + WS_XR); bf16* GR = (bf16*)(ws + WS_GR);
    LAS unsigned char* AT = F.lds;
    LAS unsigned char* BT = F.lds + 34816;
    LAS float* AA = (LAS float*)(F.lds + 69632);
    LAS float* UU = (LAS float*)(F.lds + 102400);
    LAS float* SM = (LAS float*)(F.lds + 135168);
    LAS float* CW = (LAS float*)(F.lds + MISC_OFF + 4096);
    const int tid = F.tid, lane = F.lane, w = F.wave, hi = lane >> 5, l31 = lane & 31;
    for (int item = F.vcu; item < BATCH * 16; item += F.G) {
        const int b = item >> 4, n = (item >> 1) & 7, half = item & 1;
        __syncthreads();
        { const bf16* LW = (const bf16*)(ws + WS_LW) + (size_t)n * 2 * 128 * 128;
#pragma unroll
          for (int p = 0; p < 4; ++p) { const int q = tid + 512 * p, row = q >> 4, pc = q & 15; const int gate = row >> 6, d = 64 * half + (row & 63);
              const v4u v = *(const v4u*)(LW + ((size_t)gate * 128 + d) * 128 + pc * 8); *(LAS v4u*)(BT + row * 272 + pc * 16) = v; }
          for (int i = tid; i < 640; i += NWAVES * 64) { const int k = i >> 7, c = i & 127; CW[i] = (k < 4) ? A.in[6][k * D + 128 * n + c] : A.in[7][128 * n + c]; } }
        const int c8 = (tid & 15) * 8, run = tid >> 4, cg0 = 128 * n + c8;
        const int tg = w & 3, cg = w >> 2, lc = 32 * cg + l31, chg = 128 * n + 64 * half + lc;
        const float ba_c = A.in[9][chg], bx_c = A.in[11][chg];
        const float lam = A.in[12][chg]; const float sp8 = 8.0f * log1pf(expf(-lam)) * LOG2E;
        const int sc_c = tid & 63, seg = tid >> 6;
        float hcarry = 0.f;
        v4u xq[7];
        { const bf16* xp = XR + ((size_t)b * SEQ + 4 * run - 3) * D + cg0;
#pragma unroll
          for (int i = 0; i < 7; ++i) xq[i] = (4 * run - 3 + i >= 0) ? *(const v4u*)(xp + (size_t)i * D) : (v4u){0u, 0u, 0u, 0u}; }
        __syncthreads();
#pragma unroll 1
        for (int ck = 0; ck < SEQ / 128; ++ck) {
            const int t0 = 128 * ck;
            bf16* gp = GR + ((size_t)b * SEQ + t0 + 16 * seg) * D + 128 * n + 64 * half + sc_c;
            { unsigned ow[4][4];
#pragma unroll
              for (int hf = 0; hf < 2; ++hf) { float wv[5][4];
#pragma unroll
                  for (int k = 0; k < 5; ++k) { const f32x4 w0 = *(const LAS f32x4*)(CW + k * 128 + c8 + 4 * hf); wv[k][0] = w0.x; wv[k][1] = w0.y; wv[k][2] = w0.z; wv[k][3] = w0.w; }
#pragma unroll
                  for (int tt = 0; tt < 4; ++tt) { float x0 = wv[4][0], x1 = wv[4][1], x2 = wv[4][2], x3 = wv[4][3];
#pragma unroll
                      for (int k = 0; k < 4; ++k) { const unsigned va = hf ? xq[tt + k].z : xq[tt + k].x, vb = hf ? xq[tt + k].w : xq[tt + k].y;
                          x0 += wv[k][0] * bflo(va); x1 += wv[k][1] * bfhi(va); x2 += wv[k][2] * bflo(vb); x3 += wv[k][3] * bfhi(vb); }
                      ow[tt][2 * hf] = pk2(x0, x1); ow[tt][2 * hf + 1] = pk2(x2, x3); } }
#pragma unroll
              for (int tt = 0; tt < 4; ++tt) { v4u o; o.x = ow[tt][0]; o.y = ow[tt][1]; o.z = ow[tt][2]; o.w = ow[tt][3]; *(LAS v4u*)(AT + (4 * run + tt) * 272 + c8 * 2) = o; } }
            if (ck + 1 < SEQ / 128) { const bf16* xp = XR + ((size_t)b * SEQ + t0 + 128 + 4 * run - 3) * D + cg0;
#pragma unroll
                for (int i = 0; i < 7; ++i) xq[i] = *(const v4u*)(xp + (size_t)i * D); }
            __syncthreads();
            { f32x16 accR = f32x16{}, accI = f32x16{};
#pragma unroll
              for (int ks = 0; ks < 8; ++ks) {
                  const bf16x8 a = *(const LAS bf16x8*)(AT + (32 * tg + l31) * 272 + (16 * ks + 8 * hi) * 2);
                  const bf16x8 bR = *(const LAS bf16x8*)(BT + (32 * cg + l31) * 272 + (16 * ks + 8 * hi) * 2);
                  const bf16x8 bI = *(const LAS bf16x8*)(BT + (64 + 32 * cg + l31) * 272 + (16 * ks + 8 * hi) * 2);
                  accR = __builtin_amdgcn_mfma_f32_32x32x16_bf16(a, bR, accR, 0, 0, 0);
                  accI = __builtin_amdgcn_mfma_f32_32x32x16_bf16(a, bI, accI, 0, 0, 0); }
#pragma unroll
              for (int r = 0; r < 16; ++r) {
                  const int tok = 32 * tg + (r & 3) + 8 * (r >> 2) + 4 * hi;
                  const float rg = sigm(accR[r] + ba_c), ig = sigm(accI[r] + bx_c);
                  const float la2 = -sp8 * rg;
                  const float a = __builtin_amdgcn_exp2f(la2);
                  float mult = __builtin_amdgcn_sqrtf(fmaxf(1.0f - a * a, 0.f));
                  if (t0 + tok == 0) mult = 1.0f;
                  const float xcv = bf2f(*(const LAS unsigned short*)(AT + tok * 272 + (64 * half + lc) * 2));
                  AA[tok * 64 + lc] = a; UU[tok * 64 + lc] = mult * ig * xcv; } }
            __syncthreads();
            unsigned short gq[16];
#pragma unroll
            for (int j = 0; j < 16; ++j) gq[j] = gp[(size_t)j * D];
            float hl[16], pl[16];
            { float h = 0.f, P = 1.f;
#pragma unroll
              for (int j = 0; j < 16; ++j) { const float a = AA[(16 * seg + j) * 64 + sc_c], u = UU[(16 * seg + j) * 64 + sc_c]; h = a * h + u; P = P * a; hl[j] = h; pl[j] = P; }
              SM[(seg * 64 + sc_c) * 2] = P; SM[(seg * 64 + sc_c) * 2 + 1] = h; }
            __syncthreads();
            { float cin = hcarry, tot = hcarry;
#pragma unroll
              for (int s = 0; s < 8; ++s) { const float Ps = SM[(s * 64 + sc_c) * 2], hs = SM[(s * 64 + sc_c) * 2 + 1]; tot = Ps * tot + hs; if (s < seg) cin = tot; }
              hcarry = tot;
#pragma unroll
              for (int j = 0; j < 16; ++j) { const float hv = hl[j] + pl[j] * cin; gp[(size_t)j * D] = (bf16)f2bf(hv * bf2f(gq[j])); } }
        }
    }
    __syncthreads();
}

__device__ __forceinline__ void p5_phase(Frame& F, const Args& A) {
    const int gw = F.vcu * NWAVES + F.wave, NGW = F.G * NWAVES;
    float d1 = A.in[13][F.lane] * A.in[14][F.lane], d2 = A.in[15][F.lane] * A.in[16][F.lane];
    const float lam = expf(wave_sum(d1)) - expf(wave_sum(d2)) + LAM_INIT;
    bf16* O0 = (bf16*)(F.ws + WS_H); const bf16* O1 = (const bf16*)(F.ws + WS_O1);
    float g[16];
#pragma unroll
    for (int i = 0; i < 16; ++i) g[i] = A.in[17][(16 * F.lane + i) & 127] * (1.0f - LAM_INIT);
    for (int m = gw; m < T; m += NGW) {
        const v4u a0 = *(const v4u*)(O0 + (size_t)m * D + 16 * F.lane), a1 = *(const v4u*)(O0 + (size_t)m * D + 16 * F.lane + 8);
        const v4u b0 = *(const v4u*)(O1 + (size_t)m * D + 16 * F.lane), b1 = *(const v4u*)(O1 + (size_t)m * D + 16 * F.lane + 8);
        float o[16];
        o[0] = bflo(a0.x) - lam * bflo(b0.x); o[1] = bfhi(a0.x) - lam * bfhi(b0.x); o[2] = bflo(a0.y) - lam * bflo(b0.y); o[3] = bfhi(a0.y) - lam * bfhi(b0.y);
        o[4] = bflo(a0.z) - lam * bflo(b0.z); o[5] = bfhi(a0.z) - lam * bfhi(b0.z); o[6] = bflo(a0.w) - lam * bflo(b0.w); o[7] = bfhi(a0.w) - lam * bfhi(b0.w);
        o[8] = bflo(a1.x) - lam * bflo(b1.x); o[9] = bfhi(a1.x) - lam * bfhi(b1.x); o[10] = bflo(a1.y) - lam * bflo(b1.y); o[11] = bfhi(a1.y) - lam * bfhi(b1.y);
        o[12] = bflo(a1.z) - lam * bflo(b1.z); o[13] = bfhi(a1.z) - lam * bfhi(b1.z); o[14] = bflo(a1.w) - lam * bflo(b1.w); o[15] = bfhi(a1.w) - lam * bfhi(b1.w);
        float s = 0.f;
#pragma unroll
        for (int i = 0; i < 16; ++i) s += o[i] * o[i];
        s += __shfl_xor(s, 1); s += __shfl_xor(s, 2); s += __shfl_xor(s, 4);
        const float rstd = 1.f / sqrtf(s * (1.f / 128.f) + EPS);
        v4u w0, w1;
        w0.x = pk2(o[0] * rstd * g[0], o[1] * rstd * g[1]); w0.y = pk2(o[2] * rstd * g[2], o[3] * rstd * g[3]); w0.z = pk2(o[4] * rstd * g[4], o[5] * rstd * g[5]); w0.w = pk2(o[6] * rstd * g[6], o[7] * rstd * g[7]);
        w1.x = pk2(o[8] * rstd * g[8], o[9] * rstd * g[9]); w1.y = pk2(o[10] * rstd * g[10], o[11] * rstd * g[11]); w1.z = pk2(o[12] * rstd * g[12], o[13] * rstd * g[13]); w1.w = pk2(o[14] * rstd * g[14], o[15] * rstd * g[15]);
        *(v4u*)(O0 + (size_t)m * D + 16 * F.lane) = w0; *(v4u*)(O0 + (size_t)m * D + 16 * F.lane + 8) = w1;
    }
}

#ifndef PROBE_SEG
#define PROBE_SEG 0
#endif
#define SEG_T0() do { if (PROBE_SEG != 0 && F.tid == 0) { volatile LAS unsigned long long* pp_ = (volatile LAS unsigned long long*)(F.MI + 16); pp_[0] = __builtin_amdgcn_s_memrealtime(); } } while (0)
#define SEG_T1(id) do { if (PROBE_SEG != 0 && F.tid == 0) { volatile LAS unsigned long long* pp_ = (volatile LAS unsigned long long*)(F.MI + 16); const unsigned long long t_ = __builtin_amdgcn_s_memrealtime(); if (PROBE_SEG == (id)) pp_[1] += t_ - pp_[0]; pp_[0] = t_; } } while (0)
__device__ __forceinline__ void p8_phase(Frame& F, const Args& A) {
    unsigned char* ws = F.ws;
    const float* mod = (const float*)(ws + WS_MOD); const bf16* Y = (const bf16*)(ws + WS_Y);
    signed char* H2 = (signed char*)(ws + WS_H); float* SA = (float*)(ws + WS_SA);
    LAS unsigned char* TH = F.lds; LAS unsigned char* TL = F.lds + 66048;
    LAS float* red = (LAS float*)F.lds;
    LAS int* cntl = (LAS int*)(F.lds + 135168);
    const int tid = F.tid, lane = F.lane, w = F.wave, hi = lane >> 5, l31 = lane & 31;
    int* lists = (int*)(ws + WS_LIST); float* wts = (float*)(ws + WS_WTS);
    v2u yn[2][4]; f32x4 xn[2][4];
    if (F.vcu < T / 32) {
#pragma unroll
        for (int q = 0; q < 2; ++q) { const size_t m = (size_t)F.vcu * 32 + w * 4 + q;
#pragma unroll
            for (int j = 0; j < 4; ++j) { yn[q][j] = *((const GAS v2u*)(Y + m * D) + lane + 64 * j); xn[q][j] = *((const GAS f32x4*)(A.in[0] + m * D) + lane + 64 * j); } } }
#pragma unroll 1
    for (int tl = F.vcu; tl < T / 32; tl += F.G) {
        const int tok0 = tl * 32, b = tok0 / SEQ, chunk = tok0 / TC;
        if (tid < 64) cntl[tid] = 0;
        SEG_T0();
        f32x4 c_gp[4], c_g2[4], c_sh[4];
#pragma unroll
        for (int j = 0; j < 4; ++j) { const int c = 4 * lane + 256 * j; c_gp[j] = *(const f32x4*)(A.in[21] + c) * *(const f32x4*)(mod + b * 6 * D + 2 * D + c);
            c_g2[j] = *(const f32x4*)(A.in[22] + c) * (*(const f32x4*)(mod + b * 6 * D + 4 * D + c) + 1.0f); c_sh[j] = *(const f32x4*)(mod + b * 6 * D + 3 * D + c); }
#pragma unroll 1
        for (int rp = 0; rp < 2; ++rp) {
            f32x4 y[2][4], x[2][4]; float s[2] = {0.f, 0.f};
#pragma unroll
            for (int q = 0; q < 2; ++q)
#pragma unroll
                for (int j = 0; j < 4; ++j) { const v2u yv = yn[q][j]; y[q][j] = (f32x4){bflo(yv.x), bfhi(yv.x), bflo(yv.y), bfhi(yv.y)}; x[q][j] = xn[q][j]; }
            { const int ntl = rp ? tl + F.G : tl, nrp = rp ^ 1;
              if (ntl < T / 32) {
#pragma unroll
                  for (int q = 0; q < 2; ++q) { const size_t m = (size_t)ntl * 32 + w * 4 + nrp * 2 + q;
#pragma unroll
                      for (int j = 0; j < 4; ++j) { yn[q][j] = *((const GAS v2u*)(Y + m * D) + lane + 64 * j); xn[q][j] = *((const GAS f32x4*)(A.in[0] + m * D) + lane + 64 * j); } } } }
#pragma unroll
            for (int q = 0; q < 2; ++q)
#pragma unroll
                for (int j = 0; j < 4; ++j) s[q] += (y[q][j].x * y[q][j].x + y[q][j].y * y[q][j].y) + (y[q][j].z * y[q][j].z + y[q][j].w * y[q][j].w);
            float s2[2] = {0.f, 0.f};
#pragma unroll
            for (int q = 0; q < 2; ++q) { const size_t m = (size_t)tok0 + w * 4 + rp * 2 + q; const float rstd = 1.f / sqrtf(wave_sum_dpp(s[q]) * (1.f / D) + EPS);
#pragma unroll
                for (int j = 0; j < 4; ++j) { x[q][j] = x[q][j] + c_gp[j] * (y[q][j] * rstd); { v2u xb; xb.x = pk2(x[q][j].x, x[q][j].y); xb.y = pk2(x[q][j].z, x[q][j].w); *((v2u*)(F.out + m * D) + lane + 64 * j) = xb; }
                    s2[q] += (x[q][j].x * x[q][j].x + x[q][j].y * x[q][j].y) + (x[q][j].z * x[q][j].z + x[q][j].w * x[q][j].w); } }
#pragma unroll
            for (int q = 0; q < 2; ++q) { const size_t m = (size_t)tok0 + w * 4 + rp * 2 + q; const float rstd2 = 1.f / sqrtf(wave_sum_dpp(s2[q]) * (1.f / D) + EPS);
                f32x4 hh[4]; float amx = 0.f;
#pragma unroll
                for (int j = 0; j < 4; ++j) { const int c = 4 * lane + 256 * j; const f32x4 h = (x[q][j] * rstd2) * c_g2[j] + c_sh[j]; hh[j] = h;
                    amx = fmaxf(amx, fmaxf(fmaxf(fabsf(h.x), fabsf(h.y)), fmaxf(fabsf(h.z), fabsf(h.w))));
                    v2u o; o.x = pk2(h.x, h.y); o.y = pk2(h.z, h.w);
                    *(LAS v2u*)(TH + (w * 4 + rp * 2 + q) * 2064 + c * 2) = o; }
                amx = fmaxf(wave_max_dpp(amx), 1e-20f); const float inv = 127.0f / amx; if (lane == 0) SA[m] = amx * (1.0f / 127.0f);
#pragma unroll
                for (int j = 0; j < 4; ++j) { const int q0 = (int)rintf(hh[j].x * inv), q1 = (int)rintf(hh[j].y * inv), q2 = (int)rintf(hh[j].z * inv), q3 = (int)rintf(hh[j].w * inv);
                    *((GAS unsigned*)(H2 + m * D) + lane + 64 * j) = (unsigned)(q0 & 0xff) | ((unsigned)(q1 & 0xff) << 8) | ((unsigned)(q2 & 0xff) << 16) | ((unsigned)(q3 & 0xff) << 24); } }
        }
        bf16x8 bH0[8], bH1[8];
        { const bf16* whp = (const bf16*)(ws + WS_WRH) + (size_t)l31 * D + 128 * w + 8 * hi;
#pragma unroll
          for (int ks = 0; ks < 8; ++ks) { bH0[ks] = *(const GAS bf16x8*)(whp + ks * 16); bH1[ks] = *(const GAS bf16x8*)(whp + 32 * D + ks * 16); } }
        __syncthreads(); SEG_T1(1);
        f32x16 acc0 = f32x16{}, acc1 = f32x16{};
        { const LAS unsigned char* ahp = TH + l31 * 2064 + (128 * w + 8 * hi) * 2;
#pragma unroll
          for (int ks = 0; ks < 8; ++ks) {
              const bf16x8 aH = *(const LAS bf16x8*)(ahp + ks * 32);
              acc0 = __builtin_amdgcn_mfma_f32_32x32x16_bf16(aH, bH0[ks], acc0, 0, 0, 0); acc1 = __builtin_amdgcn_mfma_f32_32x32x16_bf16(aH, bH1[ks], acc1, 0, 0, 0); } }
        __syncthreads(); SEG_T1(2);
#pragma unroll
        for (int r = 0; r < 16; ++r) { const int tk = (r & 3) + 8 * (r >> 2) + 4 * hi; red[(w * 32 + tk) * 64 + l31] = acc0[r]; red[(w * 32 + tk) * 64 + 32 + l31] = acc1[r]; }
        __syncthreads();
        int sel_e[4], sel_lp[4], sel_slot[4]; float sel_wt[4];
        const float eb = A.in[24][lane];
#pragma unroll
        for (int q = 0; q < 4; ++q) {
            const int tk = 4 * w + q; float lg = 0.f;
#pragma unroll
            for (int ww = 0; ww < 8; ++ww) lg += red[(ww * 32 + tk) * 64 + lane];
            const float score = 1.0f / (1.0f + expf(-lg)); const float ch = score + eb;
            const float m1 = max8_dpp(ch);
            const unsigned long long eq = __ballot(ch == m1); const int gsh = lane & ~7; const unsigned ge = (unsigned)((eq >> gsh) & 0xffull);
            const int first = gsh + __builtin_ctz(ge);
            const float m2 = max8_dpp((lane == first) ? -INFINITY : ch);
            const float gs = m1 + m2; const int g = lane >> 3;
            int grank = 0;
#pragma unroll
            for (int gg = 0; gg < 8; ++gg) { const float og = rl_f(gs, gg * 8); grank += (og > gs || (og == gs && gg < g)) ? 1 : 0; }
            float cur = (grank < 4) ? ch : -INFINITY;
            int rank = TOPK;
#pragma unroll
            for (int kk = 0; kk < TOPK; ++kk) { const float mx = wave_max_dpp(cur); const unsigned long long mk = __ballot(cur == mx); const int fl = (int)__builtin_ctzll(mk);
                if (lane == fl) { rank = kk; cur = -INFINITY; } }
            const bool sel = rank < TOPK;
            const float wsum = wave_sum_dpp(sel ? score : 0.f);
            sel_e[q] = sel ? lane : -1; sel_slot[q] = (tok0 + tk) * 8 + rank; sel_wt[q] = score / (wsum + 1e-20f) * 2.5f;
            sel_lp[q] = sel ? atomicAdd((int*)&cntl[lane], 1) : 0;
        }
        __syncthreads(); SEG_T1(3);
        if (tid < 64) { const int c = cntl[tid]; cntl[64 + tid] = c ? (int)__hip_atomic_fetch_add((unsigned*)(F.ctl + CW_CNT + chunk * 64 + tid), (unsigned)c, RLX_AGENT) : 0; }
        __syncthreads();
#pragma unroll
        for (int q = 0; q < 4; ++q) if (sel_e[q] >= 0) { const int pos = cntl[64 + lane] + sel_lp[q]; lists[((size_t)chunk * 64 + lane) * TC + pos] = sel_slot[q]; wts[sel_slot[q]] = sel_wt[q]; }
        __syncthreads(); SEG_T1(4);
    }
    SEG_T0();
    __syncthreads();
    LAS float* scr = (LAS float*)(F.lds + w * 16384);
    const int gw = F.vcu * NWAVES + w, NGW = F.G * NWAVES;
    constexpr int I13 = 16 * 4, I2 = 4 * 16, PER_E = 2 * I13 + I2;
    for (int it = gw; it < (NEXP + 1) * PER_E; it += NGW) {
        const int e = it / PER_E; int r = it % PER_E;
        const bool sh = (e == NEXP);
        if (r < 2 * I13) { const int w3 = r / I13; r %= I13; const int kb = r >> 2, n0 = 64 * (r & 3);
            const float* W = sh ? (w3 ? A.in[29] : A.in[28]) : ((w3 ? A.in[26] : A.in[25]) + (size_t)e * D * DEXP);
            signed char* WT = sh ? (signed char*)(ws + WS_W13S) : (signed char*)(ws + WS_W13) + (size_t)e * 512 * D;
            const float amx = fmaxf(__uint_as_float(__hip_atomic_load(F.ctl + CW_AMAX + 2 * e + w3, RLX_AGENT)), 1e-30f);
            transpose_item_q(W, D, DEXP, WT, kb, n0, (n0 >> 7) * 256 + (w3 ? 128 : 0) + (n0 & 127), scr, lane, 127.0f / amx); }
        else { r -= 2 * I13; const int kb = r >> 4, n0 = 64 * (r & 15);
            const float* W = sh ? A.in[30] : A.in[27] + (size_t)e * DEXP * D;
            bf16* WT = sh ? (bf16*)(ws + WS_W2S) : (bf16*)(ws + WS_W2) + (size_t)e * D * DEXP;
            transpose_item(W, DEXP, D, WT, kb, n0, n0, scr, lane); }
    }
    __syncthreads(); SEG_T1(5);
}

__device__ __forceinline__ int moe_tables(Frame& F, int chunk) {
    __syncthreads();
    if (F.wave == 0) {
        const int cnt = (int)__hip_atomic_load(F.ctl + CW_CNT + chunk * 64 + F.lane, RLX_AGENT);
        const int nt = (cnt + 255) >> 8; int incl = nt;
#pragma unroll
        for (int o = 1; o < 64; o <<= 1) { const int v = __shfl_up(incl, o); if (F.lane >= o) incl += v; }
        const int base = incl - nt;
        F.MI[MI_CNT + F.lane] = cnt; F.MI[MI_TBASE + F.lane] = base; if (F.lane == 63) F.MI[MI_TBASE + NEXP] = incl;
        for (int j = 0; j < nt; ++j) F.MI[MI_TILE_E + base + j] = F.lane; }
    __syncthreads();
    return F.MI[MI_TBASE + NEXP];
}
struct UpOrder {
    const char* ws; volatile LAS int* MI; int nrt_r, nrt, G, c;
    __device__ __forceinline__ bool next(int i, pg8::Unit& u) const { const int L = i * G + c; if (L >= 2 * nrt) return false; u.pm = L >> 1; u.pn = L & 1; u.z = i;
        u.e = (u.pm < nrt_r) ? __builtin_amdgcn_readfirstlane(MI[MI_TILE_E + u.pm]) : NEXP; return true; }
    __device__ __forceinline__ void bases(const pg8::Unit& u, const char*& a, const char*& b) const { a = ws + WS_H; b = (u.e < NEXP ? ws + WS_W13 + (size_t)u.e * 512 * D : ws + WS_W13S) + (size_t)u.pn * 256 * D; }
    __device__ __forceinline__ int tok(int ui, int row) const { return MI[MI_TOK + ui * 256 + row]; }
};
struct EpiSwiglu {
    static constexpr bool PERM = true, TWICE = false;
    bf16* HB; volatile LAS int* MI; gu32* amax;
    __device__ __forceinline__ void operator()(const acc_t& acc, const pg8::Unit& u, int wr, int wc, int fr, int fq) const {
        const int row0 = u.pm * 256 + wr * 64 + fr, col0 = u.pn * 128 + wc * 32 + 8 * fq;
        const float sB1 = __int_as_float(MI[MI_TOK + 2048 + 2 * u.z]), sB3 = __int_as_float(MI[MI_TOK + 2048 + 2 * u.z + 1]);
#pragma unroll
        for (int ai = 0; ai < 2; ++ai)
#pragma unroll
            for (int m = 0; m < 4; ++m) { bf16* rowp = HB + (size_t)(row0 + ai * 128 + m * 16) * DEXP + col0;
                const float sA = __int_as_float(MI[MI_TOK + 1024 + u.z * 256 + wr * 64 + fr + ai * 128 + m * 16]); const float s1 = sA * sB1, s3 = sA * sB3;
                float v[8];
                { const pg8::i32x4 A0 = __builtin_bit_cast(pg8::i32x4, acc[ai][0][m][0]), A1 = __builtin_bit_cast(pg8::i32x4, acc[ai][0][m][1]), G0 = __builtin_bit_cast(pg8::i32x4, acc[ai][1][m][0]), G1 = __builtin_bit_cast(pg8::i32x4, acc[ai][1][m][1]);
#pragma unroll
                  for (int i = 0; i < 4; ++i) { float a = (float)A0[i] * s1, g = (float)G0[i] * s3; asm volatile("" : "+v"(a), "+v"(g)); v[i] = a * sigm(a) * g;
                      float a2 = (float)A1[i] * s1, g2 = (float)G1[i] * s3; asm volatile("" : "+v"(a2), "+v"(g2)); v[4 + i] = a2 * sigm(a2) * g2; } }
                v4u w; w.x = pg8::cvt_pk_bf16(v[0], v[1]); w.y = pg8::cvt_pk_bf16(v[2], v[3]); w.z = pg8::cvt_pk_bf16(v[4], v[5]); w.w = pg8::cvt_pk_bf16(v[6], v[7]);
                *(v4u*)rowp = w; asm volatile("" ::: "memory"); }
    }
};
struct DownOrder {
    const char* ws; volatile LAS int* MI; int nrt_r, nrt, G, c;
    __device__ __forceinline__ bool next(int i, pg8::Unit& u) const { const int L = i * G + c; if (L >= 4 * nrt) return false; u.pm = L >> 2; u.pn = L & 3; u.z = i;
        u.e = (u.pm < nrt_r) ? __builtin_amdgcn_readfirstlane(MI[MI_TILE_E + u.pm]) : NEXP; return true; }
    __device__ __forceinline__ void bases(const pg8::Unit& u, const char*& a, const char*& b) const { a = ws + WS_HB + (size_t)u.pm * 256 * DEXP * 2; b = (u.e < NEXP ? ws + WS_W2 + (size_t)u.e * D * DEXP * 2 : ws + WS_W2S) + (size_t)u.pn * 256 * DEXP * 2; }
    __device__ __forceinline__ int tok(int, int) const { return 0; }
};
struct EpiScatter {
    static constexpr bool PERM = true, TWICE = true;
    unsigned char* SL; volatile LAS int* MI;
    __device__ __forceinline__ void operator()(const acc_t& acc, const pg8::Unit& u, int wr, int wc, int fr, int fq) const {
        const int col0 = u.pn * 256 + wc * 32 + 8 * fq;
#pragma unroll
        for (int ai = 0; ai < 2; ++ai)
#pragma unroll
            for (int m = 0; m < 4; ++m) { const int rl = wr * 64 + fr + ai * 128 + m * 16; const int dest = MI[MI_TOK + u.z * 512 + rl]; const float wt = 16.0f * __int_as_float(MI[MI_TOK + u.z * 512 + 256 + rl]);
                if (dest >= 0) { unsigned char* rowp = SL + (size_t)dest * D + col0;
#pragma unroll
                    for (int bj = 0; bj < 2; ++bj) { const pg8::f32x4 v0 = acc[ai][bj][m][0], v1 = acc[ai][bj][m][1];
                        float q[8];
#pragma unroll
                        for (int i = 0; i < 4; ++i) { q[i] = __builtin_amdgcn_fmed3f(v0[i] * wt, -448.0f, 448.0f); q[4 + i] = __builtin_amdgcn_fmed3f(v1[i] * wt, -448.0f, 448.0f); }
                        v2u w; w.x = (unsigned)__builtin_amdgcn_cvt_pk_fp8_f32(q[0], q[1], 0, false); w.x = (unsigned)__builtin_amdgcn_cvt_pk_fp8_f32(q[2], q[3], (int)w.x, true);
                        w.y = (unsigned)__builtin_amdgcn_cvt_pk_fp8_f32(q[4], q[5], 0, false); w.y = (unsigned)__builtin_amdgcn_cvt_pk_fp8_f32(q[6], q[7], (int)w.y, true);
                        *(v2u*)(rowp + bj * 128) = w; asm volatile("" ::: "memory"); } } }
    }
};
__device__ __forceinline__ void p2_phase(Frame& F, const Args& A) {
    unsigned char* ws = F.ws;
    DenseOrder S; S.init(ws + WS_H, ws + WS_WIN, T, W_IN, D / 2, F.G, (int)blockIdx.x);
    const float* SH = (const float*)(ws + WS_SH);
    { float v[7]; int pmv[7];
#pragma unroll
      for (int k = 0; k < 7; ++k) { pg8::Unit u; pmv[k] = S.next((F.tid >> 8) + 2 * k, u) ? u.pm : -1; v[k] = pmv[k] >= 0 ? SH[pmv[k] * 256 + (F.tid & 255)] : 0.f; }
#pragma unroll
      for (int k = 0; k < 7; ++k) if (pmv[k] >= 0) F.MI[512 + ((F.tid >> 8) + 2 * k) * 256 + (F.tid & 255)] = __float_as_int(v[k]); }
    __syncthreads();
    EpiProj E{(bf16*)(ws + WS_XR), (bf16*)F.out, F.MI, fmaxf(__uint_as_float(__hip_atomic_load(F.ctl + CW_AMAX + 130, RLX_AGENT)), 1e-30f) * (1.0f / 127.0f)};
    int Kk = D / 2; asm volatile("" : "+s"(Kk));
    pg8::gemm_phase<EpiProj, DenseOrder, true, false, true>(F.lds, F.tid, Kk, S, E);
}
__device__ __forceinline__ void moe_up(Frame& F, int chunk) {
    unsigned char* ws = F.ws;
    const int nrt_r = moe_tables(F, chunk), nrt = nrt_r + TC / 256;
    const int* lists = (const int*)(ws + WS_LIST); const float* wts = (const float*)(ws + WS_WTS);
    int* rdest = (int*)(ws + WS_RDEST); float* rwt = (float*)(ws + WS_RWT);
    { const int r = F.tid & 255; int tokn[2], dest[2], slot[2]; float wt[2], sa[2]; bool act[2]; int rt_[2];
#pragma unroll
      for (int k = 0; k < 2; ++k) { const int i = (F.tid >> 8) + 2 * k, L = i * F.G + F.vcu, rt = L >> 1; act[k] = L < 2 * nrt; rt_[k] = rt; slot[k] = -1; tokn[k] = chunk * TC; dest[k] = -1; wt[k] = 0.f;
          if (act[k]) { if (rt < nrt_r) { const int e = F.MI[MI_TILE_E + rt]; const int idx = (rt - F.MI[MI_TBASE + e]) * 256 + r; if (idx < F.MI[MI_CNT + e]) slot[k] = lists[((size_t)chunk * 64 + e) * TC + idx]; }
              else { tokn[k] = chunk * TC + (rt - nrt_r) * 256 + r; dest[k] = TC * 8 + (rt - nrt_r) * 256 + r; wt[k] = 1.0f; } } }
#pragma unroll
      for (int k = 0; k < 2; ++k) if (slot[k] >= 0) { tokn[k] = slot[k] >> 3; dest[k] = slot[k] - chunk * TC * 8; wt[k] = wts[slot[k]]; }
#pragma unroll
      for (int k = 0; k < 2; ++k) sa[k] = ((const float*)(ws + WS_SA))[tokn[k]];
#pragma unroll
      for (int k = 0; k < 2; ++k) if (act[k]) { const int i = (F.tid >> 8) + 2 * k, L = i * F.G + F.vcu;
          F.MI[MI_TOK + i * 256 + r] = tokn[k]; F.MI[MI_TOK + 1024 + i * 256 + r] = __float_as_int(sa[k]);
          if ((L & 1) == 0) { rdest[rt_[k] * 256 + r] = dest[k]; rwt[rt_[k] * 256 + r] = wt[k]; } }
      if (F.tid < 8) { const int i = F.tid >> 1, rr = F.tid & 1, L = i * F.G + F.vcu;
          if (L < 2 * nrt) { const int rt = L >> 1; const int e_ = (rt < nrt_r) ? F.MI[MI_TILE_E + rt] : NEXP;
              F.MI[MI_TOK + 2048 + 2 * i + rr] = __float_as_int(fmaxf(__uint_as_float(__hip_atomic_load(F.ctl + CW_AMAX + 2 * e_ + rr, RLX_AGENT)), 1e-30f) * (1.0f / 127.0f)); } } }
    __syncthreads();
    UpOrder S{(const char*)ws, F.MI, nrt_r, nrt, F.G, F.vcu};
    EpiSwiglu E{(bf16*)(ws + WS_HB), F.MI, F.ctl + CW_AMAX};
    int Kk = D / 2; asm volatile("" : "+s"(Kk));
    pg8::gemm_phase<EpiSwiglu, UpOrder, true, true, true>(F.lds, F.tid, Kk, S, E);
}
__device__ __forceinline__ void moe_down(Frame& F, int chunk) {
    unsigned char* ws = F.ws;
    __syncthreads();
    const int nrt_r = F.MI[MI_TBASE + NEXP], nrt = nrt_r + TC / 256;
    { const int* rdest = (const int*)(ws + WS_RDEST); const int* rwt = (const int*)(ws + WS_RWT);
      const int* src = (F.tid < 256 ? rdest : rwt) + (F.tid & 255); int v[6];
#pragma unroll
      for (int i = 0; i < 6; ++i) { const int L = i * F.G + F.vcu; v[i] = (L < 4 * nrt) ? src[(L >> 2) * 256] : 0; }
#pragma unroll
      for (int i = 0; i < 6; ++i) { const int L = i * F.G + F.vcu; if (L < 4 * nrt) F.MI[MI_TOK + i * 512 + F.tid] = v[i]; } }
    __syncthreads();
    DownOrder S{(const char*)ws, F.MI, nrt_r, nrt, F.G, F.vcu};
    EpiScatter E{ws + WS_SLOT, F.MI};
    int Kk = DEXP; asm volatile("" : "+s"(Kk));
    pg8::gemm_phase<EpiScatter, DownOrder, false, false>(F.lds, F.tid, Kk, S, E);
}
__device__ __forceinline__ void moe_combine(Frame& F, const Args& A, int chunk, bool poison) {
    unsigned char* ws = F.ws;
    const float* mod = (const float*)(ws + WS_MOD); const unsigned char* SL = ws + WS_SLOT;
    const int gw = F.vcu * NWAVES + F.wave, NGW = F.G * NWAVES;
    f32x4 gpv[4];
#pragma unroll
    for (int j = 0; j < 4; ++j) gpv[j] = *(const f32x4*)(A.in[31] + 4 * F.lane + 256 * j);
    unsigned dA[9][4], dB[9][4]; v2u xA[4], xB[4];
#define CB_LOAD(tl_, d_, x_) do { const int t_ = __builtin_amdgcn_readfirstlane(tl_);        \
        _Pragma("unroll") for (int j = 0; j < 4; ++j) x_[j] = *((const GAS v2u*)(F.out + ((size_t)chunk * TC + t_) * D) + F.lane + 64 * j); \
        asm volatile("" ::: "memory"); \
        const GAS unsigned* b0_ = (const GAS unsigned*)(SL + (size_t)t_ * 8 * D) + F.lane; const GAS unsigned* b1_ = b0_ + 4 * (D / 4); \
        const GAS unsigned* b2_ = (const GAS unsigned*)(SL + ((size_t)TC * 8 + t_) * D) + F.lane;         \
        _Pragma("unroll") for (int k = 0; k < 9; ++k) \
            _Pragma("unroll") for (int j = 0; j < 4; ++j) d_[k][j] = (k < 4 ? b0_ : k < 8 ? b1_ : b2_)[(k < 8 ? (k & 3) : 0) * (D / 4) + 64 * j]; } while (0)
#define CB_REDUCE(tl_, d_, x_) do { const int t_ = __builtin_amdgcn_readfirstlane(tl_); const size_t m = (size_t)chunk * TC + t_; const int b = (int)(m / SEQ); \
        f32x4 gt[4]; _Pragma("unroll") for (int j = 0; j < 4; ++j) gt[j] = *(const f32x4*)(mod + b * 6 * D + 5 * D + 4 * F.lane + 256 * j); \
        f32x4 y[4]; \
        _Pragma("unroll") for (int j = 0; j < 4; ++j) y[j] = (f32x4){0.f, 0.f, 0.f, 0.f}; \
        _Pragma("unroll") for (int k = 0; k < 9; ++k) { _Pragma("unroll") for (int j = 0; j < 4; ++j) { const int dd = (int)d_[k][j]; \
            const auto lo_ = __builtin_amdgcn_cvt_pk_f32_fp8(dd, false); const auto hi_ = __builtin_amdgcn_cvt_pk_f32_fp8(dd, true); \
            y[j].x += lo_[0]; y[j].y += lo_[1]; y[j].z += hi_[0]; y[j].w += hi_[1]; } \
            __builtin_amdgcn_sched_barrier(0); } \
        _Pragma("unroll") for (int j = 0; j < 4; ++j) y[j] = y[j] * 0.0625f; \
        float s = 0.f; \
        _Pragma("unroll") for (int j = 0; j < 4; ++j) s += (y[j].x * y[j].x + y[j].y * y[j].y) + (y[j].z * y[j].z + y[j].w * y[j].w); \
        const float rstd = 1.f / sqrtf(wave_sum(s) * (1.f / D) + EPS); \
        asm volatile("" ::: "memory"); \
        _Pragma("unroll") for (int j = 0; j < 4; ++j) { f32x4* op = (f32x4*)(F.out + m * D) + F.lane + 64 * j; const v2u xb = x_[j]; \
            f32x4 o = (f32x4){bflo(xb.x), bfhi(xb.x), bflo(xb.y), bfhi(xb.y)} + gt[j] * (y[j] * rstd * gpv[j]); \
            if (poison) { const float q_ = __builtin_nanf(""); o = (f32x4){q_, q_, q_, q_}; } \
            *op = o; } } while (0)
    for (int tl = gw; tl < TC; tl += NGW) { CB_LOAD(tl, dA, xA); CB_REDUCE(tl, dA, xA); }
#undef CB_LOAD
#undef CB_REDUCE
}

__device__ __forceinline__ void attn_phase(Frame& F, const Args& A, char* lds_generic) {
    const attn_body::bf16* Q = (const attn_body::bf16*)(F.ws + WS_Q); const attn_body::bf16* K = (const attn_body::bf16*)(F.ws + WS_K); const attn_body::bf16* V = (const attn_body::bf16*)(F.ws + WS_V);
    attn_body::bf16* O = (attn_body::bf16*)(F.ws + WS_H);
    const float d1 = A.in[13][F.lane] * A.in[14][F.lane], d2 = A.in[15][F.lane] * A.in[16][F.lane];
    const float lam = expf(wave_sum(d1)) - expf(wave_sum(d2)) + LAM_INIT;
    const int npr = (BATCH * 16 - F.vcu + F.G - 1) / F.G;
#pragma unroll 1
    for (int it = 0; it < npr * 8; ++it) {
        const int pr = F.vcu + (it >> 3) * F.G, qi = (it >> 1) & 3, m = it & 1;
        const int pair = pr >> 1, st = pr & 1, b = pair >> 3, h = pair & 7;
        const int qb = st ? (qi == 0 ? 6 : qi == 1 ? 5 : qi == 2 ? 2 : 1) : (qi == 0 ? 7 : qi == 1 ? 4 : qi == 2 ? 3 : 0);
        const float sl2 = exp2f(-(float)(h + 1)) * LOG2E;
        if (m == 0) attn_body::attn_unit2<8, false>(F.tid, b, h, 0, qb, sl2, lam, A.in[17], Q, K, V, O, lds_generic);
        else        attn_body::attn_unit2<8, true >(F.tid, b, h, 1, qb, sl2, lam, A.in[17], Q, K, V, O, lds_generic);
    }
}

__global__ void __launch_bounds__(NWAVES * 64, 2) hybrid_fwd(Args args) {
    extern __shared__ __attribute__((aligned(16))) unsigned char lds[];
    Frame F;
    F.lds = (LAS unsigned char*)lds;
    F.MI = (volatile LAS int*)(F.lds + MISC_OFF);
    F.tid = threadIdx.x; F.lane = F.tid & 63; F.wave = __builtin_amdgcn_readfirstlane(F.tid >> 6);
    F.G = gridDim.x; { const int bx = blockIdx.x; F.vcu = (F.G % 8 == 0) ? (bx % 8) * (F.G / 8) + bx / 8 : bx; }
    unsigned char* ws = args.ws; F.ws = ws; F.out = args.out;
    F.ctl = (gu32*)(ws + WS_CTL);
    for (int u = F.tid; u < MI_WORDS; u += NWAVES * 64) F.MI[u] = 0;
    __syncthreads();
    XcdBarrier bar; bar.bar = (unsigned*)(F.ctl + CW_BAR); bar.x = 0; bar.st = nullptr;
    if (!PER_PHASE) bar = xcd_barrier_post((unsigned*)(F.ctl + CW_BAR), (volatile LAS unsigned*)(F.MI + MI_BARST));
    const int lo = args.ph_lo, hi = args.ph_hi;
#ifndef PH_MASK
#define PH_MASK 0xFFFFFFFFu
#endif
#ifndef PROBE_MASK
#define PROBE_MASK 0u
#endif
#define PSTAMP(k) do { if (PROBE_MASK != 0u && F.tid == 0) { const unsigned long long t_ = __builtin_amdgcn_s_memrealtime(); volatile LAS unsigned long long* pp_ = (volatile LAS unsigned long long*)(F.MI + 16); \
        if ((PROBE_MASK >> (k)) & 1u) pp_[1] += t_ - pp_[0]; pp_[0] = t_; } } while (0)
#define FRESH() do { unsigned char* w_ = args.ws; asm volatile("" : "+s"(w_)); F.ws = w_; ws = w_; F.ctl = (gu32*)(w_ + WS_CTL); int t_ = threadIdx.x; asm volatile("" : "+v"(t_)); F.tid = t_; F.lane = t_ & 63; F.wave = __builtin_amdgcn_readfirstlane(t_ >> 6); } while (0)
    if ((PROBE_MASK != 0u || PROBE_SEG != 0) && F.tid == 0) { volatile LAS unsigned long long* pp_ = (volatile LAS unsigned long long*)(F.MI + 16); pp_[0] = __builtin_amdgcn_s_memrealtime(); pp_[1] = 0ull; }
#define IN(k) (((PH_MASK >> (k)) & 1u) && lo <= (k) && (k) < hi)
#define SEAM(k) do { if (IN(k) && IN((k) + 1)) { if (PER_PHASE) { if (F.tid == 0) __hip_atomic_store(F.ctl + CW_TMO, 0xBADBA0u, RLX_AGENT); } else xcd_barrier(bar); } PSTAMP(k); } while (0)
    if (IN(0)) { FRESH(); p0_phase(F, args); } SEAM(0);
    if (IN(1)) { FRESH(); p1_phase(F, args); } SEAM(1);
    if (IN(2)) { FRESH(); p2_phase(F, args); } SEAM(2);
    if (IN(3)) { FRESH(); lru_phase(F, args); } if (PER_PHASE) { SEAM(3); } else { PSTAMP(3); }
    if (IN(4)) { FRESH(); attn_phase(F, args, (char*)lds); } SEAM(4);
    if (PER_PHASE) { SEAM(5); }
    if (IN(6)) { FRESH(); MergeOrder S; S.d.init(ws + WS_GR, ws + WS_WR, T, D, D, F.G, (int)blockIdx.x); S.A1 = (const char*)(ws + WS_H); S.B1 = (const char*)(ws + WS_WA);
        EpiGate E{(const unsigned char*)args.out, (const unsigned char*)args.out + (size_t)T * D, (bf16*)(ws + WS_V), (bf16*)(ws + WS_XR)};
        pg8::gemm_phase<EpiGate, MergeOrder, true, false>(F.lds, F.tid, D, S, E); } SEAM(6);
    if (IN(7)) { FRESH(); DenseOrder S; S.init(ws + WS_XR, ws + WS_WO, T, D, D, F.G, (int)blockIdx.x); EpiF32 E{(bf16*)(ws + WS_Y)};
        pg8::gemm_phase<EpiF32, DenseOrder, true, false>(F.lds, F.tid, D, S, E); } SEAM(7);
    if (IN(8)) { FRESH(); p8_phase(F, args); } SEAM(8);
#pragma unroll 1
    for (int c = 0; c < NCH; ++c) {
        const int pa = 9 + 2 * c, pb = 10 + 2 * c;
        if (IN(pa)) { FRESH(); if (c > 0) { int cm = c - 1; asm volatile("" : "+s"(cm)); moe_combine(F, args, cm, false); FRESH(); } int cu = c; asm volatile("" : "+s"(cu)); moe_up(F, cu); } SEAM(pa);
        if (IN(pb)) { FRESH(); int cd = c; asm volatile("" : "+s"(cd)); moe_down(F, cd); } SEAM(pb);
    }
    if (IN(9 + 2 * NCH)) { FRESH();
        bool poison = __hip_atomic_load(F.ctl + CW_TMO, RLX_AGENT) != 0u || __hip_atomic_load(F.ctl + CW_BAR + XB_TMO, RLX_AGENT) != 0u;
        moe_combine(F, args, NCH - 1, poison);
    }
    PSTAMP(17);
#undef IN
#undef SEAM
    if (PROBE_MASK != 0u || PROBE_SEG != 0) { __syncthreads(); if (F.tid == 0) { volatile LAS unsigned long long* pp_ = (volatile LAS unsigned long long*)(F.MI + 16);
        unsigned long long acc_ = pp_[1]; const unsigned long long t2_ = __builtin_amdgcn_s_memrealtime();
        while (__builtin_amdgcn_s_memrealtime() - t2_ < acc_) __builtin_amdgcn_s_sleep(8); } __syncthreads(); }
}

extern "C" void kernel_launch(void* const* d_in, const int* in_sizes, int n_in, void* d_out, int out_size, void* d_ws, size_t ws_size, hipStream_t stream) {
    static int grid = 0;
    if (grid == 0) {
        if (n_in != 32 || out_size != T * D || ws_size < WS_END) { fprintf(stderr, "kernel_launch: unexpected shapes (n_in %d, out %d, ws %zu); nothing launched\n", n_in, out_size, ws_size); grid = -1; return; }
        int dev = 0, cus = 0, per_cu = 0;
        if (hipGetDevice(&dev) != hipSuccess || hipDeviceGetAttribute(&cus, hipDeviceAttributeMultiprocessorCount, dev) != hipSuccess) { grid = -1; return; }
        if (hipFuncSetAttribute((const void*)hybrid_fwd, hipFuncAttributeMaxDynamicSharedMemorySize, LDS_BYTES) != hipSuccess) { fprintf(stderr, "kernel_launch: hipFuncSetAttribute failed\n"); grid = -1; return; }
        if (hipOccupancyMaxActiveBlocksPerMultiprocessor(&per_cu, (const void*)hybrid_fwd, NWAVES * 64, LDS_BYTES) != hipSuccess || per_cu < 1) { fprintf(stderr, "kernel_launch: occupancy query says %d blocks per CU\n", per_cu); per_cu = 1; }
        (void)hipGetLastError();
        grid = cus;
    }
    if (grid < 0) return;
    (void)hipMemsetAsync((char*)d_ws + WS_CTL, 0, CTL_ZERO_BYTES, stream);
    Args a{};
    for (int i = 0; i < 32; ++i) a.in[i] = (const float*)d_in[i];
    a.out = (float*)d_out; a.ws = (unsigned char*)d_ws;
    if (N_LAUNCHES == 1) { a.ph_lo = 0; a.ph_hi = N_PHASES; hipLaunchKernelGGL(hybrid_fwd, dim3(grid), dim3(NWAVES * 64), LDS_BYTES, stream, a); }
    else for (int p = 0; p < N_PHASES; ++p) { a.ph_lo = p; a.ph_hi = p + 1; hipLaunchKernelGGL(hybrid_fwd, dim3(grid), dim3(NWAVES * 64), LDS_BYTES, stream, a); }
}
```

```cpp
#include <hip/hip_runtime.h>
#include <hip/hip_bf16.h>
#include <cstdio>
#include <cstdint>
#include <cmath>

#ifndef MK_N_LAUNCHES
#define MK_N_LAUNCHES 1
#endif

constexpr int BATCH = 16, SEQ = 2048, D = 1024, T = BATCH * SEQ;
constexpr int W_IN = 7 * 1024;
constexpr int NEXP = 64, TOPK = 8, DEXP = 256;
constexpr int NCH = 2, TC = T / NCH;
constexpr float EPS = 1e-6f;
constexpr float LOG2E = 1.4426950408889634f;
constexpr float LAM_INIT = 0.2f;

namespace pg8 {
#define PG8_LAS __attribute__((address_space(3)))
typedef unsigned short bf16_t;
typedef short bf16x8 __attribute__((ext_vector_type(8)));
typedef float f32x4 __attribute__((ext_vector_type(4)));
typedef unsigned u32x4 __attribute__((ext_vector_type(4)));
constexpr int BM = 256, BK = 64, HALF = 128, HTB = HALF * BK * 2, STAGE_BYTES = 8 * HTB, NXCD = 8, WGM = 8;

__host__ __device__ __forceinline__ int lds_byte(int r, int c) { const int st = (r >> 4) * 2 + (c >> 5), rr = r & 15, cc = c & 31, ob = rr * 64 + cc * 2; return st * 1024 + (ob ^ (((ob >> 9) & 1) << 5)); }
__host__ __device__ __forceinline__ void stage_rc(int b, int& R, int& C) { const int st = b / 1024, sb = b % 1024, swz = sb ^ (((sb >> 9) & 1) << 5); R = (st >> 1) * 16 + swz / 64; C = (st & 1) * 32 + (swz % 64) / 2; }
__host__ __device__ __forceinline__ int perm32(int rho) { const int n = rho >> 4, i = rho & 15; return 8 * (i >> 2) + 4 * n + (i & 3); }

struct Unit { int pm, pn, z, e; };

__device__ __forceinline__ unsigned cvt_pk_bf16(float lo, float hi) { unsigned r; asm volatile("v_cvt_pk_bf16_f32 %0, %1, %2" : "=v"(r) : "v"(lo), "v"(hi)); return r; }
__device__ __forceinline__ float sigm(float x) { return __builtin_amdgcn_rcpf(1.0f + __builtin_amdgcn_exp2f(-LOG2E * x)); }
__device__ __forceinline__ float gelu_t(float x) { const float u = 0.7978845608028654f * (x + 0.044715f * x * x * x); return x * sigm(2.0f * u); }
__device__ __forceinline__ float bflo(unsigned w) { return __uint_as_float(w << 16); }
__device__ __forceinline__ float bfhi(unsigned w) { return __uint_as_float(w & 0xffff0000u); }

typedef int i32x4 __attribute__((ext_vector_type(4)));
template <class Epi, class Sched, bool ALIGN_EPI, bool GATHER, bool INT8 = false>
__device__ __forceinline__ void gemm_phase(PG8_LAS unsigned char* lds, const int tid, const int K, const Sched& S, const Epi& E) {
    const int wid = __builtin_amdgcn_readfirstlane(tid >> 6), lane = tid & 63, wr = wid >> 2, wc = wid & 3, fr = lane & 15, fq = lane >> 4;
    const int nt = K / BK;
    unsigned voffA[2], voffB[2];
#pragma unroll
    for (int i = 0; i < 2; ++i) { int R, C; stage_rc(tid * 16 + i * 8192, R, C); const int Rb = Epi::PERM ? ((R & ~31) + perm32(R & 31)) : R;
        voffA[i] = (unsigned)(R * K + C) * 2u; voffB[i] = (unsigned)(Rb * K + C) * 2u; }
    const size_t kstep = (size_t)(BK * 2);
    const size_t hstep = (size_t)HALF * K * 2;
    const unsigned ldsw = (unsigned)wid * 1024u;
    const int aoff = lds_byte(wr * 64 + fr, fq * 8), boff = lds_byte(wc * 32 + fr, fq * 8);
#define PG8_SA(b, h) (((b) * 2 + (h)) * HTB)
#define PG8_SB(b, h) ((4 + (b) * 2 + (h)) * HTB)
#define PG8_STAGE(bufoff, gbase, voff) do { _Pragma("unroll") for (int _i = 0; _i < 2; ++_i) \
        __builtin_amdgcn_global_load_lds((const unsigned*)((const char*)(gbase) + (voff)[_i]), (PG8_LAS unsigned*)(lds + (bufoff) + ldsw + _i * 8192), 16, 0, 0); } while (0)
#define PG8_STAGE_A(bufoff, p, h, VG) do { if constexpr (GATHER) { PG8_STAGE(bufoff, p, VG[h]); } else { PG8_STAGE(bufoff, (p) + (h) * hstep, voffA); } } while (0)
#define PG8_LDA(dst, b, h) do { _Pragma("unroll") for (int m = 0; m < 4; ++m) _Pragma("unroll") for (int k = 0; k < 2; ++k) dst[m][k] = *(const PG8_LAS bf16x8*)(lds + PG8_SA(b, h) + aoff + m * 2048 + k * 1024); } while (0)
#define PG8_LDB(dst, b, h) do { _Pragma("unroll") for (int n = 0; n < 2; ++n) _Pragma("unroll") for (int k = 0; k < 2; ++k) dst[n][k] = *(const PG8_LAS bf16x8*)(lds + PG8_SB(b, h) + boff + n * 2048 + k * 1024); } while (0)
#define PG8_MMA(ai, bj, At, Bt) do { __builtin_amdgcn_s_setprio(1); _Pragma("unroll") for (int m = 0; m < 4; ++m) _Pragma("unroll") for (int n = 0; n < 2; ++n) _Pragma("unroll") for (int k = 0; k < 2; ++k) \
        { if constexpr (INT8) acc[ai][bj][m][n] = __builtin_bit_cast(f32x4, __builtin_amdgcn_mfma_i32_16x16x64_i8(__builtin_bit_cast(i32x4, Bt[n][k]), __builtin_bit_cast(i32x4, At[m][k]), __builtin_bit_cast(i32x4, acc[ai][bj][m][n]), 0, 0, 0)); \
          else acc[ai][bj][m][n] = __builtin_amdgcn_mfma_f32_16x16x32_bf16(Bt[n][k], At[m][k], acc[ai][bj][m][n], 0, 0, 0); } __builtin_amdgcn_s_setprio(0); } while (0)
#define PG8_WAIT_V(n) asm volatile("s_waitcnt vmcnt(" #n ")" ::: "memory")
#define PG8_WAIT_L(n) asm volatile("s_waitcnt lgkmcnt(" #n ")" ::: "memory")
#define PG8_BAR __builtin_amdgcn_s_barrier()
#define PG8_SCHED __builtin_amdgcn_sched_barrier(0)
#define PG8_LOADVG(VG, ui_) do { if constexpr (GATHER) { _Pragma("unroll") for (int h_ = 0; h_ < 2; ++h_) _Pragma("unroll") for (int i_ = 0; i_ < 2; ++i_) \
        { int R_, C_; stage_rc(tid * 16 + i_ * 8192, R_, C_); VG[h_][i_] = ((unsigned)S.tok((ui_), h_ * HALF + R_) * (unsigned)K + (unsigned)C_) * 2u; } } } while (0)
    Unit cur, nxt; int ui = 0;
    if (!S.next(0, cur)) return;
    f32x4 acc[2][2][4][2];
#pragma unroll
    for (int a = 0; a < 2; ++a)
#pragma unroll
        for (int b = 0; b < 2; ++b)
#pragma unroll
            for (int m = 0; m < 4; ++m)
#pragma unroll
                for (int n = 0; n < 2; ++n) acc[a][b][m][n] = (f32x4){0.f, 0.f, 0.f, 0.f};
    bf16x8 At[4][2], B0[2][2], B1[2][2];
    unsigned vgc[2][2];
#pragma unroll
    for (int h_ = 0; h_ < 2; ++h_)
#pragma unroll
        for (int i_ = 0; i_ < 2; ++i_) vgc[h_][i_] = 0u;
    PG8_LOADVG(vgc, 0);
    const char *cA, *cB; S.bases(cur, cA, cB);
    PG8_STAGE(PG8_SB(0, 0), cB, voffB); PG8_STAGE(PG8_SB(0, 1), cB + hstep, voffB); PG8_STAGE_A(PG8_SA(0, 0), cA, 0, vgc); PG8_STAGE_A(PG8_SA(0, 1), cA, 1, vgc);
    if (wr == 1) PG8_BAR;
    PG8_WAIT_V(2); PG8_BAR;
    PG8_STAGE(PG8_SB(1, 0), cB + kstep, voffB); PG8_STAGE_A(PG8_SA(1, 0), cA + kstep, 0, vgc); PG8_STAGE(PG8_SB(1, 1), cB + hstep + kstep, voffB);
    PG8_WAIT_V(6); PG8_BAR;
    for (;;) {
        const bool has_next = S.next(ui + 1, nxt);
        const char *nA = cA, *nB = cB;
        if (has_next) S.bases(nxt, nA, nB);
        for (int t = 0; t < nt; t += 2) {
            const bool last = (t == nt - 2);
            const char* a1 = cA + (size_t)(t + 1) * kstep;
            const char* a2 = last ? nA : cA + (size_t)(t + 2) * kstep; const char* b2 = last ? nB : cB + (size_t)(t + 2) * kstep;
            const char* a3 = a2 + kstep; const char* b3 = b2 + kstep;
            unsigned vgs[2][2];
#pragma unroll
            for (int h_ = 0; h_ < 2; ++h_)
#pragma unroll
                for (int i_ = 0; i_ < 2; ++i_) vgs[h_][i_] = vgc[h_][i_];
            if (last && has_next) PG8_LOADVG(vgs, ui + 1);
            PG8_LDB(B0, 0, 0); PG8_LDB(B1, 0, 1); PG8_SCHED; PG8_LDA(At, 0, 0); PG8_STAGE_A(PG8_SA(1, 1), a1, 1, vgc);
            PG8_WAIT_V(8); PG8_WAIT_L(0); PG8_BAR; PG8_MMA(0, 0, At, B0); PG8_MMA(0, 1, At, B1); PG8_BAR; PG8_SCHED;
            PG8_LDA(At, 0, 1); PG8_STAGE(PG8_SB(0, 0), b2, voffB); PG8_STAGE(PG8_SB(0, 1), b2 + hstep, voffB); PG8_STAGE_A(PG8_SA(0, 0), a2, 0, vgs);
            PG8_WAIT_V(8); PG8_WAIT_L(0); PG8_BAR; PG8_MMA(1, 0, At, B0); PG8_MMA(1, 1, At, B1); PG8_BAR; PG8_SCHED;
            PG8_LDB(B0, 1, 0); PG8_LDB(B1, 1, 1); PG8_SCHED; PG8_LDA(At, 1, 0); PG8_STAGE_A(PG8_SA(0, 1), a2, 1, vgs);
            PG8_WAIT_V(8); PG8_WAIT_L(0); PG8_BAR; PG8_MMA(0, 0, At, B0); PG8_MMA(0, 1, At, B1); PG8_BAR; PG8_SCHED;
            PG8_LDA(At, 1, 1); PG8_STAGE(PG8_SB(1, 0), b3, voffB); PG8_STAGE(PG8_SB(1, 1), b3 + hstep, voffB); PG8_STAGE_A(PG8_SA(1, 0), a3, 0, vgs);
            PG8_WAIT_V(8); PG8_WAIT_L(0); PG8_BAR; PG8_MMA(1, 0, At, B0); PG8_MMA(1, 1, At, B1); PG8_BAR; PG8_SCHED;
        }
        if constexpr (ALIGN_EPI) { if (wr == 0) PG8_BAR; }
        E(acc, cur, wr, wc, fr, fq);
#ifdef PROBE_EPI2
        if (Epi::TWICE) { asm volatile("" ::: "memory"); E(acc, cur, wr, wc, fr, fq); }
#endif
        if (!has_next) break;
#pragma unroll
        for (int a = 0; a < 2; ++a)
#pragma unroll
            for (int b = 0; b < 2; ++b)
#pragma unroll
                for (int m = 0; m < 4; ++m)
#pragma unroll
                    for (int n = 0; n < 2; ++n) acc[a][b][m][n] = (f32x4){0.f, 0.f, 0.f, 0.f};
        cur = nxt; cA = nA; cB = nB; ++ui;
        PG8_LOADVG(vgc, ui);
        if constexpr (ALIGN_EPI) { if (wr == 1) PG8_BAR; }
    }
    PG8_WAIT_V(0);
    if constexpr (!ALIGN_EPI) { if (wr == 0) PG8_BAR; }
    PG8_BAR;
#undef PG8_SA
#undef PG8_SB
#undef PG8_STAGE
#undef PG8_STAGE_A
#undef PG8_LDA
#undef PG8_LDB
#undef PG8_MMA
#undef PG8_WAIT_V
#undef PG8_WAIT_L
#undef PG8_BAR
#undef PG8_SCHED
#undef PG8_LOADVG
}
}

namespace attn_body {
using bf16=__hip_bfloat16;
using bf16x8=__attribute__((ext_vector_type(8)))short;
using s16x4=__attribute__((ext_vector_type(4)))short;
using f32x16=__attribute__((ext_vector_type(16)))float;
using u32x4=__attribute__((ext_vector_type(4)))unsigned;
constexpr int NHEAD=16,SEQ=2048,D=64,DM=NHEAD*D;
constexpr int NW=8,QBLK=32,QB=QBLK*NW,KVBLK=64,NQB=SEQ/QB;
__device__ __forceinline__ int crow(int r,int hi){return (r&3)+8*(r>>2)+4*hi;}
#define SBAR() __builtin_amdgcn_sched_barrier(0)
__device__ __forceinline__ void cmask(f32x16&p0,f32x16&p1,int jb,int qrel,int hi){
  const float NEG=-INFINITY; const int dq=qrel-(64*jb+4*hi);
  #pragma unroll
  for(int r=0;r<16;++r){const int kc=(r&3)+8*(r>>2); if(kc>dq)p0[r]=NEG; if(kc+32>dq)p1[r]=NEG;}
}
__device__ __forceinline__ void cinit(f32x16&p0,f32x16&p1,float sl2,float nv){
  #pragma unroll
  for(int r=0;r<16;++r){const float c=(float)((r&3)+8*(r>>2)); p0[r]=__builtin_fmaf(sl2,c,nv); p1[r]=__builtin_fmaf(sl2,c+32.0f,nv);}
}
#define CI_C(r) ((float)(((r)&3)+8*((r)>>2)))

constexpr int NSLOT=3, SLOTB=8192;
constexpr int LDS_K=0, LDS_V=NSLOT*SLOTB, LDS_WS=2*NSLOT*SLOTB, LDS_OST=LDS_WS+NW*64*4, LDS_BYTES=LDS_OST+NW*4096;
constexpr float C2=0.125f*1.4426950408889634f;
__device__ __forceinline__ void glds16(const void*gsrc,unsigned lds_dst){unsigned keep;
  asm volatile("s_mov_b32 %0, m0\n\ts_mov_b32 m0, %2\n\ts_nop 0\n\tglobal_load_lds_dwordx4 %1, off\n\ts_mov_b32 m0, %0":"=&s"(keep):"v"(gsrc),"s"(lds_dst):"memory");}
__device__ __forceinline__ float max3f(float a,float b,float c){float r;asm("v_max3_f32 %0, %1, %2, %3":"=v"(r):"v"(a),"v"(b),"v"(c));return r;}
__device__ __forceinline__ float max2f(float a,float b){float r;asm("v_max_f32_e32 %0, %1, %2":"=v"(r):"v"(a),"v"(b));return r;}
__device__ __forceinline__ float fadd_s(float a,float b){float r;asm("v_add_f32_e32 %0, %1, %2":"=v"(r):"v"(a),"v"(b));return r;}
__device__ __forceinline__ float fsub_s(float a,float b){float r;asm("v_sub_f32_e32 %0, %1, %2":"=v"(r):"v"(a),"v"(b));return r;}
typedef float f32x2_t __attribute__((ext_vector_type(2))); typedef __bf16 bf16x2_t __attribute__((ext_vector_type(2)));
__device__ __forceinline__ unsigned cvtpk_s(float lo,float hi){f32x2_t v={lo,hi};bf16x2_t b=__builtin_convertvector(v,bf16x2_t);return __builtin_bit_cast(unsigned,b);}
#define WAIT_BAR(N) asm volatile("s_waitcnt vmcnt(" #N ") lgkmcnt(0)\n\ts_barrier":::"memory")

__device__ __forceinline__ void qkt(f32x16&p0,f32x16&p1,const char*Kslot,const bf16x8*qr,int r32,int hi){
  const char*kb=Kslot+hi*1024+r32*16;
  #pragma unroll
  for(int d0=0;d0<4;++d0){
    const bf16x8 b0=*reinterpret_cast<const bf16x8*>(kb+d0*2048);
    const bf16x8 b1=*reinterpret_cast<const bf16x8*>(kb+d0*2048+512);
    p0=__builtin_amdgcn_mfma_f32_32x32x16_bf16(b0,qr[d0],p0,0,0,0);p1=__builtin_amdgcn_mfma_f32_32x32x16_bf16(b1,qr[d0],p1,0,0,0);}
}
typedef __attribute__((address_space(3))) const char* lds_cptr;
typedef short v4i16_t __attribute__((ext_vector_type(4)));
__device__ __forceinline__ void kload8(bf16x8*kf,lds_cptr kp){
  kf[0]=*(const __attribute__((address_space(3))) bf16x8*)(kp);      kf[1]=*(const __attribute__((address_space(3))) bf16x8*)(kp+512);
  kf[2]=*(const __attribute__((address_space(3))) bf16x8*)(kp+2048); kf[3]=*(const __attribute__((address_space(3))) bf16x8*)(kp+2560);
  kf[4]=*(const __attribute__((address_space(3))) bf16x8*)(kp+4096); kf[5]=*(const __attribute__((address_space(3))) bf16x8*)(kp+4608);
  kf[6]=*(const __attribute__((address_space(3))) bf16x8*)(kp+6144); kf[7]=*(const __attribute__((address_space(3))) bf16x8*)(kp+6656);
}
__device__ __forceinline__ void kload2(bf16x8*kf,lds_cptr kp,int j){ kf[2*j]=*(const __attribute__((address_space(3))) bf16x8*)(kp+j*2048); kf[2*j+1]=*(const __attribute__((address_space(3))) bf16x8*)(kp+j*2048+512); }
__device__ __forceinline__ s16x4 vtr(lds_cptr p){ return __builtin_bit_cast(s16x4,__builtin_amdgcn_ds_read_tr16_b64_v4i16((__attribute__((address_space(3))) v4i16_t*)p)); }
__device__ __forceinline__ float rowmax(const f32x16&p0,const f32x16&p1){
  float a=max3f(p0[0],p0[1],p1[0]),b=max3f(p0[2],p0[3],p1[1]);a=max3f(a,p1[2],p1[3]);
  #pragma unroll
  for(int r=4;r<16;r+=4){a=max3f(a,p0[r],p0[r+1]);b=max3f(b,p0[r+2],p0[r+3]);a=max3f(a,p1[r],p1[r+1]);b=max3f(b,p1[r+2],p1[r+3]);}
  const float m=max2f(a,b);
  auto rr=__builtin_amdgcn_permlane32_swap(__float_as_uint(m),__float_as_uint(m),false,false);
  return max2f(__uint_as_float(rr[0]),__uint_as_float(rr[1]));
}
__device__ __forceinline__ void pv(f32x16*o,int vb,bf16x8 pa0,bf16x8 pa1,bf16x8 pa2,bf16x8 pa3){
  #pragma unroll
  for(int d0=0;d0<2;++d0){s16x4 lo[4],hi[4];
    #pragma unroll
    for(int ks=0;ks<4;++ks){
      asm volatile("ds_read_b64_tr_b16 %0,%1 offset:%c2":"=&v"(lo[ks]):"v"(vb),"i"(d0*4096+ks*1024):"memory");
      asm volatile("ds_read_b64_tr_b16 %0,%1 offset:%c2":"=&v"(hi[ks]):"v"(vb),"i"(d0*4096+ks*1024+512):"memory");}
    asm volatile("s_waitcnt lgkmcnt(0)":::"memory");SBAR();
    #define PK(k) (bf16x8){lo[k][0],lo[k][1],lo[k][2],lo[k][3],hi[k][0],hi[k][1],hi[k][2],hi[k][3]}
    o[d0]=__builtin_amdgcn_mfma_f32_32x32x16_bf16(pa0,PK(0),o[d0],0,0,0);
    o[d0]=__builtin_amdgcn_mfma_f32_32x32x16_bf16(pa1,PK(1),o[d0],0,0,0);
    o[d0]=__builtin_amdgcn_mfma_f32_32x32x16_bf16(pa2,PK(2),o[d0],0,0,0);
    o[d0]=__builtin_amdgcn_mfma_f32_32x32x16_bf16(pa3,PK(3),o[d0],0,0,0);
    #undef PK
  }
}
#define ATTN_STORE16(p,v) (*(u32x4*)(p)=(v))
constexpr int LDS_K2=0, LDS_V2=4*8192, LDS_WS2=LDS_V2+3*16384, LDS_OST2=LDS_WS2+NW*64*4, LDS_BYTES2=LDS_OST2+NW*4096;
__device__ __forceinline__ void pv4(f32x16*o,int vb,bf16x8 pa0,bf16x8 pa1,bf16x8 pa2,bf16x8 pa3){
  #pragma unroll
  for(int d0=0;d0<4;++d0){s16x4 lo[4],hi[4];
    #pragma unroll
    for(int ks=0;ks<4;++ks){
      asm volatile("ds_read_b64_tr_b16 %0,%1 offset:%c2":"=&v"(lo[ks]):"v"(vb),"i"(d0*4096+ks*1024):"memory");
      asm volatile("ds_read_b64_tr_b16 %0,%1 offset:%c2":"=&v"(hi[ks]):"v"(vb),"i"(d0*4096+ks*1024+512):"memory");}
    asm volatile("s_waitcnt lgkmcnt(0)":::"memory");SBAR();
    #define PK(k) (bf16x8){lo[k][0],lo[k][1],lo[k][2],lo[k][3],hi[k][0],hi[k][1],hi[k][2],hi[k][3]}
    o[d0]=__builtin_amdgcn_mfma_f32_32x32x16_bf16(pa0,PK(0),o[d0],0,0,0);
    o[d0]=__builtin_amdgcn_mfma_f32_32x32x16_bf16(pa1,PK(1),o[d0],0,0,0);
    o[d0]=__builtin_amdgcn_mfma_f32_32x32x16_bf16(pa2,PK(2),o[d0],0,0,0);
    o[d0]=__builtin_amdgcn_mfma_f32_32x32x16_bf16(pa3,PK(3),o[d0],0,0,0);
    #undef PK
  }
}
template<int THRL,bool FUSE> __device__ __forceinline__ void attn_unit2(const int tid,int b,int h,int m,int qb,float sl2,float lam,const float*gsub,const bf16*Q,const bf16*__restrict__ K,const bf16*__restrict__ V,bf16*O,char*shm){
  const int lane=tid&63,r32=lane&31,hi=lane>>5; const int wid=__builtin_amdgcn_readfirstlane(tid>>6);
  const long rowbase=(long)b*SEQ; const int q0=qb*QB;
  const bf16*Qw=Q+(rowbase+q0+wid*QBLK)*DM+(2*h+m)*D;
  const bf16*Kh=K+rowbase*DM+(2*h+m)*D,*Vh=V+rowbase*DM+2*h*D;
  const unsigned lds0=(unsigned)(uintptr_t)shm;
  float*wsf=(float*)(shm+LDS_WS2)+wid*64;
  const bf16*ksrc=Kh+(long)lane*DM+wid*8;
  const bf16*vsrc=Vh+(long)(16*(wid&3)+(lane>>2))*DM+(wid>>2)*32+(lane&3)*8;
  const unsigned kdst=lds0+LDS_K2+wid*1024, vdst=lds0+LDS_V2+wid*1024;
  #define DMA_K(t,slot) glds16(ksrc+(long)(t)*KVBLK*DM,(unsigned)__builtin_amdgcn_readfirstlane(kdst+(slot)))
  #define DMA_V(t,slot) do{ glds16(vsrc+(long)(t)*KVBLK*DM,(unsigned)__builtin_amdgcn_readfirstlane(vdst+2*(slot))); glds16(vsrc+(long)(t)*KVBLK*DM+64,(unsigned)__builtin_amdgcn_readfirstlane(vdst+2*(slot)+8192)); }while(0)
  const int vb0=(int)(lds0+LDS_V2)+((lane>>4)&1)*32+(lane&3)*8+(4*hi+((lane&15)>>2))*64;
  const char*Kbase=shm+LDS_K2;
  const lds_cptr shm3=(lds_cptr)shm; const lds_cptr kp0=shm3+LDS_K2+hi*1024+r32*16; const lds_cptr vp0=shm3+LDS_V2+((lane>>4)&1)*32+(lane&3)*8+(4*hi+((lane&15)>>2))*64;
  const int NT=(q0+QB)/KVBLK;
  const unsigned qdst=lds0+LDS_OST2+wid*4096;
  #pragma unroll
  for(int d0=0;d0<4;++d0)glds16(&Qw[(long)r32*DM+d0*16+hi*8],(unsigned)__builtin_amdgcn_readfirstlane(qdst+d0*1024));
  DMA_K(0,0);DMA_V(0,0);DMA_K(1,SLOTB);
  const lds_cptr qp0=(lds_cptr)shm+LDS_OST2+wid*4096+lane*16;
  #define QF(d0) (*(const __attribute__((address_space(3))) bf16x8*)(qp0+(d0)*1024))
  const float tb0=sl2*(float)(4*hi);
  float mhat=0.f,l_reg=0.f;f32x16 o[4];o[0]=f32x16{};o[1]=f32x16{};o[2]=f32x16{};o[3]=f32x16{};
  const int qrel=wid*QBLK+r32;
  #define CMASK(P0,P1,t) do{int jb_=(t)-(NT-4); if(jb_>=0)cmask(P0,P1,jb_,qrel,hi);}while(0)
  #define NVAL(tt) (__builtin_fmaf(sl2,(float)(64*(tt)),tb0)-mhat)
  bool resc=false;
  #define START(P0,P1) do{ const float rm=rowmax(P0,P1); resc=false; \
    { const float dl=rm; mhat=fadd_s(mhat,dl); \
      _Pragma("unroll") for(int r=0;r<16;++r){P0[r]=fsub_s(P0[r],dl);P1[r]=fsub_s(P1[r],dl);} } \
    _Pragma("unroll") for(int r=0;r<16;++r)P0[r]=__builtin_amdgcn_exp2f(P0[r]); }while(0)
  #define RESC() do{ if(resc){ asm volatile("s_waitcnt lgkmcnt(0)":::"memory"); \
      _Pragma("unroll") for(int d_=0;d_<4;++d_) _Pragma("unroll") for(int r=0;r<16;++r)o[d_][r]*=wsf[crow(r,hi)]; } }while(0)
  f32x16 pA0,pA1,pB0,pB1;
  int sl_prev=0,sl_cur=0,sl_next=SLOTB,ks_cur=0;
  #define ROT() do{sl_prev=sl_cur;sl_cur=sl_next;sl_next=(sl_next==(NSLOT-1)*SLOTB)?0:sl_next+SLOTB;ks_cur=(ks_cur+SLOTB)&(4*SLOTB-1);}while(0)
  DMA_K(2,2*SLOTB);
  WAIT_BAR(4);
  cinit(pA0,pA1,sl2,tb0);
  { bf16x8 qr[4];
    #pragma unroll
    for(int d0=0;d0<4;++d0)qr[d0]=QF(d0);
    qkt(pA0,pA1,Kbase,qr,r32,hi); }asm volatile("s_nop 15\n\ts_nop 7":"+v"(pA0),"+v"(pA1));CMASK(pA0,pA1,0);
  START(pA0,pA1);
  cinit(pB0,pB1,sl2,NVAL(1));
  _Pragma("unroll") for(int r=0;r<16;++r)pA1[r]=__builtin_amdgcn_exp2f(pA1[r]);
  WAIT_BAR(0);
  DMA_K(3,3*SLOTB);DMA_V(1,SLOTB);
  ROT();
  WAIT_BAR(3);
  s16x4 vlo[8],vhi[8]; u32x4 pw0,pw1,pw2,pw3;
  bf16x8 nka=*(const __attribute__((address_space(3))) bf16x8*)(kp0+ks_cur),nkb=*(const __attribute__((address_space(3))) bf16x8*)(kp0+ks_cur+512),nqa=QF(0),nqb=QF(1);
  #define PKW(P,B) cvtpk_s(P[B],P[B+1])
  #define PAF(k) __builtin_bit_cast(bf16x8,pw##k)
  #define VFR(i) (bf16x8){vlo[(i)&7][0],vlo[(i)&7][1],vlo[(i)&7][2],vlo[(i)&7][3],vhi[(i)&7][0],vhi[(i)&7][1],vhi[(i)&7][2],vhi[(i)&7][3]}
  #define PIN(x) asm volatile("":"+v"(x))
  #define MX3(a,b,c) __builtin_fmaxf(__builtin_fmaxf((a),(b)),(c))
  #define GAPA(MF,A0,A1,A2,A3,W0,W1,PW) do{ MF; sacc+=A0; sacc+=A1; sacc+=A2; sacc+=A3; PIN(sacc); W0; W1; PIN(PW); SBAR(); }while(0)
  #define EX(v) __builtin_amdgcn_exp2f(v)
  #define VRD(f) do{ vlo[(f)&7]=vtr(vp_+(((f)&3)*4096+((f)>>2)*1024)); vhi[(f)&7]=vtr(vp_+(((f)&3)*4096+((f)>>2)*1024+512)); }while(0)
  #define GAPB(f,X,B,Y,OFS) do{ o[(f)&3]=__builtin_amdgcn_mfma_f32_32x32x16_bf16(__builtin_bit_cast(bf16x8,(f)<4?pw0:(f)<8?pw1:(f)<12?pw2:pw3),VFR(f),o[(f)&3],0,0,0); \
    X[B]=EX(X[B]); X[B+1]=EX(X[B+1]); PIN(X); \
    Y[B]=__builtin_fmaf(sl2,CI_C(B)+OFS,nvn); Y[B+1]=__builtin_fmaf(sl2,CI_C(B+1)+OFS,nvn); \
    if((f)+4<16){VRD((f)+4);} SBAR(); }while(0)
  #define KF(j) (*(const __attribute__((address_space(3))) bf16x8*)(kp_+((j)>>1)*2048+((j)&1)*512))
  #define STEP(C0,C1,P0,P1,t,GK,GV,GL) do{ SBAR(); \
    const lds_cptr vp_=vp0+2*sl_prev; const lds_cptr kp_=kp0+ks_cur; \
    bf16x8 ka=nka,kb=nkb,qa=nqa,qb_=nqb; SBAR(); \
    float sacc=(P0[0]+P0[1]); \
    GAPA(C0=__builtin_amdgcn_mfma_f32_32x32x16_bf16(ka,qa,C0,0,0,0), P0[2],P0[3],P0[4],P0[5],     pw0[0]=PKW(P0,0), pw0[1]=PKW(P0,2), pw0); \
    ka=KF(2); SBAR(); \
    GAPA(C1=__builtin_amdgcn_mfma_f32_32x32x16_bf16(kb,qa,C1,0,0,0), P0[6],P0[7],P0[8],P0[9],     pw0[2]=PKW(P0,4), pw0[3]=PKW(P0,6), pw0); \
    kb=KF(3); qa=QF(2); SBAR(); \
    GAPA(C0=__builtin_amdgcn_mfma_f32_32x32x16_bf16(ka,qb_,C0,0,0,0),   P0[10],P0[11],P0[12],P0[13], pw1[0]=PKW(P0,8), pw1[1]=PKW(P0,10), pw1); \
    ka=KF(4); SBAR(); \
    GAPA(C1=__builtin_amdgcn_mfma_f32_32x32x16_bf16(kb,qb_,C1,0,0,0),   P0[14],P0[15],P1[0],P1[1],   pw1[2]=PKW(P0,12),pw1[3]=PKW(P0,14), pw1); \
    kb=KF(5); qb_=QF(3); VRD(0); SBAR(); \
    GAPA(C0=__builtin_amdgcn_mfma_f32_32x32x16_bf16(ka,qa,C0,0,0,0),   P1[2],P1[3],P1[4],P1[5],     pw2[0]=PKW(P1,0), pw2[1]=PKW(P1,2), pw2); \
    ka=KF(6); VRD(1); SBAR(); \
    GAPA(C1=__builtin_amdgcn_mfma_f32_32x32x16_bf16(kb,qa,C1,0,0,0),   P1[6],P1[7],P1[8],P1[9],     pw2[2]=PKW(P1,4), pw2[3]=PKW(P1,6), pw2); \
    kb=KF(7); VRD(2); SBAR(); \
    GAPA(C0=__builtin_amdgcn_mfma_f32_32x32x16_bf16(ka,qb_,C0,0,0,0),   P1[10],P1[11],P1[12],P1[13], pw3[0]=PKW(P1,8), pw3[1]=PKW(P1,10), pw3); \
    VRD(3); SBAR(); \
    GAPA(C1=__builtin_amdgcn_mfma_f32_32x32x16_bf16(kb,qb_,C1,0,0,0),   P1[14],P1[15],0.f,0.f,       pw3[2]=PKW(P1,12),pw3[3]=PKW(P1,14), pw3); \
    l_reg+=sacc; \
    if(GK){DMA_K((t)+3,(ks_cur+3*SLOTB)&(4*SLOTB-1));} if(GV){DMA_V((t)+1,sl_next);} \
    CMASK(C0,C1,t); \
    float nvn; \
    { float a=MX3(C0[0],C0[1],C1[0]),b=MX3(C0[2],C0[3],C1[1]); a=MX3(a,C1[2],C1[3]); \
      _Pragma("unroll") for(int r=4;r<16;r+=4){a=MX3(a,C0[r],C0[r+1]);b=MX3(b,C0[r+2],C0[r+3]);a=MX3(a,C1[r],C1[r+1]);b=MX3(b,C1[r+2],C1[r+3]);} \
      float rm=__builtin_fmaxf(a,b); { auto rr=__builtin_amdgcn_permlane32_swap(__float_as_uint(rm),__float_as_uint(rm),false,false); rm=__builtin_fmaxf(__uint_as_float(rr[0]),__uint_as_float(rr[1])); } \
      resc=false; \
      if(__builtin_expect(__any(rm>(float)THRL),0)){ const float dl=__builtin_fmaxf(rm,0.f); mhat+=dl; \
        _Pragma("unroll") for(int r=0;r<16;++r){C0[r]-=dl;C1[r]-=dl;} \
        const float f=__builtin_amdgcn_exp2f(-dl); l_reg*=f; if(hi==0)wsf[r32]=f; resc=true; } \
      nvn=NVAL((t)+1); } \
    SBAR(); \
    GAPB(0,C0,0,P0,0.0f); GAPB(1,C0,2,P0,0.0f); GAPB(2,C0,4,P0,0.0f); GAPB(3,C0,6,P0,0.0f); \
    GAPB(4,C0,8,P0,0.0f); GAPB(5,C0,10,P0,0.0f); GAPB(6,C0,12,P0,0.0f); GAPB(7,C0,14,P0,0.0f); \
    GAPB(8,C1,0,P1,32.0f); GAPB(9,C1,2,P1,32.0f); GAPB(10,C1,4,P1,32.0f); GAPB(11,C1,6,P1,32.0f); \
    GAPB(12,C1,8,P1,32.0f); GAPB(13,C1,10,P1,32.0f); GAPB(14,C1,12,P1,32.0f); \
    { const lds_cptr kn_=kp0+((ks_cur+SLOTB)&(4*SLOTB-1)); nka=*(const __attribute__((address_space(3))) bf16x8*)(kn_); nkb=*(const __attribute__((address_space(3))) bf16x8*)(kn_+512); nqa=QF(0); nqb=QF(1); SBAR(); } \
    GAPB(15,C1,14,P1,32.0f); \
    }while(0)
  int t=1;
  #undef CMASK
  #define CMASK(P0,P1,t) do{}while(0)
  for(;t+5<NT;t+=2){
    STEP(pB0,pB1,pA0,pA1,t,true,true,true);     WAIT_BAR(3); RESC(); ROT();
    STEP(pA0,pA1,pB0,pB1,t+1,true,true,true);   WAIT_BAR(3); RESC(); ROT();
  }
  #undef CMASK
  #define CMASK(P0,P1,t) do{int jb_=(t)-(NT-4); if(jb_>=0)cmask(P0,P1,jb_,qrel,hi);}while(0)
  #define ENDW(tt) do{ if((tt)+3<NT){WAIT_BAR(3);} else if((tt)+2<NT){WAIT_BAR(2);} else {WAIT_BAR(0);} }while(0)
  for(;t+1<NT;t+=2){
    STEP(pB0,pB1,pA0,pA1,t,(t+3<NT),(t+1<NT),(t+1<NT));       ENDW(t);   RESC(); ROT();
    STEP(pA0,pA1,pB0,pB1,t+1,(t+4<NT),(t+2<NT),(t+2<NT));     ENDW(t+1); RESC(); ROT();
  }
  STEP(pB0,pB1,pA0,pA1,NT-1,false,false,false); RESC();
  { float sacc=pB0[0]+pB0[1]; _Pragma("unroll") for(int r=2;r<16;++r)sacc+=pB0[r]; _Pragma("unroll") for(int r=0;r<16;++r)sacc+=pB1[r]; l_reg+=sacc;
    pw0=(u32x4){PKW(pB0,0),PKW(pB0,2),PKW(pB0,4),PKW(pB0,6)};pw1=(u32x4){PKW(pB0,8),PKW(pB0,10),PKW(pB0,12),PKW(pB0,14)};pw2=(u32x4){PKW(pB1,0),PKW(pB1,2),PKW(pB1,4),PKW(pB1,6)};pw3=(u32x4){PKW(pB1,8),PKW(pB1,10),PKW(pB1,12),PKW(pB1,14)};
    SBAR(); pv4(o,vb0+2*sl_cur,PAF(0),PAF(1),PAF(2),PAF(3)); }
  #undef PKW
  #undef PAF
  #undef VFR
  #undef PIN
  #undef MX3
  #undef GAPA
  #undef GAPB
  #undef EX
  #undef VRD
  #undef KF
  #undef STEP
  #undef ENDW
  {auto rr=__builtin_amdgcn_permlane32_swap(__float_as_uint(l_reg),__float_as_uint(l_reg),false,false);l_reg=__uint_as_float(rr[0])+__uint_as_float(rr[1]);}
  if(hi==0)wsf[32+r32]=l_reg;asm volatile("s_waitcnt lgkmcnt(0)":::"memory");
  float rli[16];
  #pragma unroll
  for(int r=0;r<16;++r)rli[r]=__builtin_amdgcn_rcpf(wsf[32+crow(r,hi)]);
  bf16*Ow=O+(rowbase+q0+wid*QBLK)*DM+2*h*D;
  bf16*stg=(bf16*)(shm+LDS_OST2)+wid*2048;
  if constexpr(!FUSE){
    #pragma unroll
    for(int ps=0;ps<2;++ps){
      #pragma unroll
      for(int r=0;r<16;++r){const int orow=crow(r,hi);
        #pragma unroll
        for(int d0=0;d0<2;++d0)stg[orow*64+d0*32+r32]=__float2bfloat16(o[2*ps+d0][r]*rli[r]);}
      asm volatile("s_waitcnt lgkmcnt(0)":::"memory");
      #pragma unroll
      for(int i=0;i<4;++i){const int row=i*8+(lane>>3),ch=lane&7; const u32x4 v=*(const u32x4*)(stg+row*64+ch*8); ATTN_STORE16(Ow+(long)row*DM+ps*64+ch*8,v);}
      asm volatile("s_waitcnt lgkmcnt(0)":::"memory"); }
    asm volatile("s_waitcnt vmcnt(0)":::"memory");
  } else {
    float dv[2][4][8]; float ss[4]={0.f,0.f,0.f,0.f};
    u32x4 v0p[2][4];
    #pragma unroll
    for(int ps=0;ps<2;++ps)
      #pragma unroll
      for(int i=0;i<4;++i){const int row=i*8+(lane>>3),ch=lane&7; v0p[ps][i]=*(const u32x4*)(Ow+(long)row*DM+ps*64+ch*8);}
    #pragma unroll
    for(int ps=0;ps<2;++ps){
      #pragma unroll
      for(int r=0;r<16;++r){const int orow=crow(r,hi);
        #pragma unroll
        for(int d0=0;d0<2;++d0)stg[orow*64+d0*32+r32]=__float2bfloat16(o[2*ps+d0][r]*rli[r]);}
      asm volatile("s_waitcnt lgkmcnt(0)":::"memory");
      #pragma unroll
      for(int i=0;i<4;++i){const int row=i*8+(lane>>3),ch=lane&7; const u32x4 v1=*(const u32x4*)(stg+row*64+ch*8); const u32x4 v0=v0p[ps][i];
        #pragma unroll
        for(int e=0;e<4;++e){ const float a0=__uint_as_float(v0[e]<<16),a1=__uint_as_float(v0[e]&0xffff0000u),b0=__uint_as_float(v1[e]<<16),b1=__uint_as_float(v1[e]&0xffff0000u);
          const float x0=a0-lam*b0,x1=a1-lam*b1; dv[ps][i][2*e]=x0; dv[ps][i][2*e+1]=x1; ss[i]+=x0*x0+x1*x1; } }
      asm volatile("s_waitcnt lgkmcnt(0)":::"memory"); }
    #pragma unroll
    for(int i=0;i<4;++i){ float s_=ss[i];
      { int b_=__float_as_int(s_); s_+=__int_as_float(__builtin_amdgcn_update_dpp(b_,b_,0xB1,0xF,0xF,false)); b_=__float_as_int(s_); s_+=__int_as_float(__builtin_amdgcn_update_dpp(b_,b_,0x4E,0xF,0xF,false)); b_=__float_as_int(s_); s_+=__int_as_float(__builtin_amdgcn_update_dpp(b_,b_,0x141,0xF,0xF,false)); }
      ss[i]=1.0f/sqrtf(s_*(1.0f/128.0f)+1e-6f); }
    #pragma unroll
    for(int ps=0;ps<2;++ps){ float gg[8];
      #pragma unroll
      for(int e=0;e<8;++e)gg[e]=gsub[ps*64+(lane&7)*8+e]*0.8f;
      #pragma unroll
      for(int i=0;i<4;++i){const int row=i*8+(lane>>3),ch=lane&7; u32x4 w;
        #pragma unroll
        for(int e=0;e<4;++e)w[e]=cvtpk_s(dv[ps][i][2*e]*ss[i]*gg[2*e],dv[ps][i][2*e+1]*ss[i]*gg[2*e+1]);
        ATTN_STORE16(Ow+(long)row*DM+ps*64+ch*8,w);} }
  }
  asm volatile("s_waitcnt lgkmcnt(0)\n\ts_barrier":::"memory");
  #undef DMA_K
  #undef DMA_V
  #undef QF
  #undef CMASK
  #undef NVAL
  #undef START
  #undef RESC
  #undef ROT
}
constexpr int ATTN_LDS_BYTES=LDS_BYTES2;
#undef SBAR
#undef WAIT_BAR
}

constexpr int NWAVES = 8;
constexpr int N_LAUNCHES = MK_N_LAUNCHES;
constexpr int N_PHASES = 9 + 2 * NCH + 1;
constexpr bool PER_PHASE = (MK_N_LAUNCHES != 1);

constexpr size_t MiB = 1u << 20;
constexpr size_t ACT = (size_t)T * D * 2;
constexpr size_t WS_CTL = 0, CTL_ZERO_BYTES = 65536;
constexpr size_t WS_MOD = 1 * MiB;
constexpr size_t WS_SH = WS_MOD + 512 * 1024;
constexpr size_t WS_WIN = 2 * MiB;
constexpr size_t WS_WR = 16 * MiB, WS_WA = 18 * MiB, WS_WO = 20 * MiB;
constexpr size_t WS_LW = 22 * MiB;
constexpr size_t WS_WRH = 23 * MiB, WS_WRL = 23 * MiB + 131072;
constexpr size_t WS_H = 24 * MiB;
constexpr size_t WS_XR = WS_H + ACT;
constexpr size_t WS_GR = WS_XR + ACT;
constexpr size_t WS_Q = WS_GR + ACT;
constexpr size_t WS_K = WS_Q + ACT;
constexpr size_t WS_V = WS_K + ACT;
constexpr size_t WS_O1 = WS_V + ACT;
constexpr size_t WS_END = WS_O1 + ACT;
static_assert(WS_END <= 512 * MiB, "ws map");
constexpr size_t WS_W13 = WS_GR;
constexpr size_t WS_W2 = WS_O1;
constexpr size_t WS_W13S = WS_O1 + 32 * MiB;
constexpr size_t WS_W2S = WS_O1 + 33 * MiB;
constexpr size_t WS_LIST = WS_O1 + 34 * MiB;
constexpr size_t WS_WTS = WS_O1 + 42 * MiB;
constexpr size_t WS_RDEST = WS_O1 + 43 * MiB;
constexpr size_t WS_RWT = WS_O1 + 44 * MiB;
constexpr size_t WS_SA = WS_O1 + 45 * MiB;
constexpr int MAXRT = TC * TOPK / 256 + NEXP + TC / 256;
constexpr int MAXROWS = MAXRT * 256;
constexpr size_t WS_HB = WS_H + 32 * MiB;
constexpr size_t WS_SLOT = WS_Q;
constexpr size_t WS_SLOTSC = WS_SLOT + 72 * MiB;
constexpr size_t WS_Y = WS_Q;
static_assert(WS_SLOT + (size_t)(TC * 9) * D <= WS_O1 && WS_HB + (size_t)MAXROWS * 512 <= WS_GR && (size_t)MAXROWS * 4 <= MiB, "moe map");
constexpr int CW_TMO = 0;
constexpr int CW_BAR = 4096;
constexpr int CW_CNT = 8192;
constexpr int CW_AMAX = 8192 + 512;

constexpr int RING_BYTES = 139264;
constexpr int MISC_OFF = RING_BYTES;
constexpr int LDS_BYTES = 155648;
constexpr int MI_BARST = 0;
constexpr int MI_CNT = 64;
constexpr int MI_TBASE = 128;
constexpr int MI_TILE_E = 256;
constexpr int MI_SB = 896;
constexpr int MI_TOK = 1024;
constexpr int MI_SA = 2560;
constexpr int MI_WORDS = 4096;

#define GAS __attribute__((address_space(1)))
#define LAS __attribute__((address_space(3)))
typedef unsigned short bf16;
typedef unsigned v4u __attribute__((ext_vector_type(4)));
typedef unsigned v2u __attribute__((ext_vector_type(2)));
typedef float f32x4 __attribute__((ext_vector_type(4)));
typedef float f32x16 __attribute__((ext_vector_type(16)));
typedef short bf16x8 __attribute__((ext_vector_type(8)));
typedef GAS unsigned gu32;
#define RLX_AGENT __ATOMIC_RELAXED, __HIP_MEMORY_SCOPE_AGENT
#define LDS_WAIT() asm volatile("s_waitcnt lgkmcnt(0)" ::: "memory")
#define VM_WAIT() asm volatile("s_waitcnt vmcnt(0)" ::: "memory")
__device__ __forceinline__ unsigned f2bf(float f) { unsigned u = __builtin_bit_cast(unsigned, f); return (u + 0x7fffu + ((u >> 16) & 1u)) >> 16; }
__device__ __forceinline__ unsigned pk2(float lo, float hi) { return f2bf(lo) | (f2bf(hi) << 16); }
__device__ __forceinline__ float bf2f(unsigned h) { return __uint_as_float(h << 16); }
using pg8::bflo; using pg8::bfhi; using pg8::sigm;

#define XB_TMO      128
#define XB_XCNT(j)  (256  + 64 * (j))
#define XB_XSUB(j)  (1280 + 64 * (j))
#define XB_XGEN(j)  (2304 + 64 * (j))
#define XB_TOP      3328
#define XB_TOPGEN   3392
#define XCD_BAR_WORDS 3456
#define XB_SPIN_CAP (1u << 18)
__device__ __forceinline__ unsigned xb_ld(unsigned* p)              { return __hip_atomic_load(p, __ATOMIC_RELAXED, __HIP_MEMORY_SCOPE_AGENT); }
__device__ __forceinline__ unsigned xb_add(unsigned* p, unsigned v) { return __hip_atomic_fetch_add(p, v, __ATOMIC_RELAXED, __HIP_MEMORY_SCOPE_AGENT); }
__device__ __forceinline__ unsigned xb_xcc_id() { return (unsigned)__builtin_amdgcn_s_getreg((3 << 11) | 20) & 0xFu; }
#define XB_SPIN(cond, bar) do { unsigned _sp = 0; while (cond) { __builtin_amdgcn_s_sleep(1); \
    if ((++_sp & 255u) == 0u) { if (xb_ld(&(bar)[XB_TMO])) break; if (_sp > XB_SPIN_CAP) { atomicAdd(&(bar)[XB_TMO], 1u); break; } } } } while (0)
struct XcdBarrier { unsigned* bar; unsigned x; volatile LAS unsigned* st; };
__device__ __forceinline__ XcdBarrier xcd_barrier_post(unsigned* bar, volatile LAS unsigned* st) {
    XcdBarrier b; b.bar = bar; b.x = xb_xcc_id(); b.st = st;
    if (threadIdx.x == 0) (void)xb_add(&bar[XB_XCNT(b.x)], 1u);
    return b;
}
__device__ __forceinline__ void xcd_barrier_complete(unsigned* bar, unsigned x, unsigned& nloc, unsigned& nx) {
    const unsigned G = gridDim.x * gridDim.y * gridDim.z;
    unsigned sum, cnt, mine, sp = 0u;
    for (;;) {
        sum = 0u; cnt = 0u; mine = 0u;
#pragma unroll 1
        for (unsigned j = 0; j < 16; ++j) { const unsigned c = xb_ld(&bar[XB_XCNT(j)]); sum += c; cnt += (c > 0u) ? 1u : 0u; mine = (j == x) ? c : mine; }
        if (sum == G) break;
        __builtin_amdgcn_s_sleep(1);
        if ((++sp & 255u) == 0u) { if (xb_ld(&bar[XB_TMO])) break; if (sp > XB_SPIN_CAP) { atomicAdd(&bar[XB_TMO], 1u); break; } }
    }
    nloc = mine > 0u ? mine : 1u; nx = cnt > 0u ? cnt : 1u;
}
__device__ __forceinline__ void xcd_barrier(const XcdBarrier& b) {
    asm volatile("s_waitcnt vmcnt(0)" ::: "memory");
    __syncthreads();
    if (threadIdx.x == 0) {
        unsigned* bar = b.bar; asm volatile("" : "+s"(bar));
        __builtin_amdgcn_s_waitcnt(0);
        unsigned nloc = b.st[0], nx = b.st[1];
        if (nloc == 0u) { xcd_barrier_complete(bar, b.x, nloc, nx); b.st[0] = nloc; b.st[1] = nx; }
        const unsigned old = xb_add(&bar[XB_XSUB(b.x)], 1u);
        const unsigned gen = old / nloc;
        if (old + 1u == (gen + 1u) * nloc) {
            __builtin_amdgcn_fence(__ATOMIC_RELEASE, "agent");
            asm volatile("s_waitcnt vmcnt(0)" ::: "memory");
            const unsigned og = xb_add(&bar[XB_TOP], 1u);
            const unsigned tg = og / nx;
            if (og + 1u == (tg + 1u) * nx) xb_add(&bar[XB_TOPGEN], 1u);
            else XB_SPIN(xb_ld(&bar[XB_TOPGEN]) == tg, bar);
            __builtin_amdgcn_fence(__ATOMIC_ACQUIRE, "agent");
            xb_add(&bar[XB_XGEN(b.x)], 1u);
            asm volatile("s_waitcnt vmcnt(0)" ::: "memory");
        } else {
            XB_SPIN(xb_ld(&bar[XB_XGEN(b.x)]) == gen, bar);
            __builtin_amdgcn_fence(__ATOMIC_ACQUIRE, "agent");
            asm volatile("s_waitcnt vmcnt(0)" ::: "memory");
        }
    }
    __syncthreads();
}

struct Frame {
    LAS unsigned char* lds;
    volatile LAS int* MI;
    gu32* ctl;
    int tid, lane, wave, vcu, G;
    float* out;
    unsigned char* ws;
};
struct Args { const float* in[32]; float* out; unsigned char* ws; int ph_lo, ph_hi; };
__device__ __forceinline__ float dppf(float x, int ctrl_sel) {
    const int b = __float_as_int(x); int r;
    if (ctrl_sel == 0) r = __builtin_amdgcn_update_dpp(b, b, 0xB1, 0xF, 0xF, false);
    else if (ctrl_sel == 1) r = __builtin_amdgcn_update_dpp(b, b, 0x4E, 0xF, 0xF, false);
    else if (ctrl_sel == 2) r = __builtin_amdgcn_update_dpp(b, b, 0x141, 0xF, 0xF, false);
    else r = __builtin_amdgcn_update_dpp(b, b, 0x140, 0xF, 0xF, false);
    return __int_as_float(r);
}
__device__ __forceinline__ float max8_dpp(float x) { x = fmaxf(x, dppf(x, 0)); x = fmaxf(x, dppf(x, 1)); x = fmaxf(x, dppf(x, 2)); return x; }
__device__ __forceinline__ float rl_f(float x, int l) { return __int_as_float(__builtin_amdgcn_readlane(__float_as_int(x), l)); }
__device__ __forceinline__ float wave_max_dpp(float x) { x = max8_dpp(x); x = fmaxf(x, dppf(x, 3)); return fmaxf(fmaxf(rl_f(x, 0), rl_f(x, 16)), fmaxf(rl_f(x, 32), rl_f(x, 48))); }
__device__ __forceinline__ float wave_sum_dpp(float x) { x += dppf(x, 0); x += dppf(x, 1); x += dppf(x, 2); x += dppf(x, 3); return (rl_f(x, 0) + rl_f(x, 16)) + (rl_f(x, 32) + rl_f(x, 48)); }
__device__ __forceinline__ float wave_sum(float v) { return wave_sum_dpp(v); }

typedef short v4i16_t __attribute__((ext_vector_type(4)));
__device__ __forceinline__ v2u tr8(const LAS unsigned char* p) { return __builtin_bit_cast(v2u, __builtin_amdgcn_ds_read_tr16_b64_v4i16((LAS v4i16_t*)p)); }
__device__ __forceinline__ void transpose_item(const float* W, int K, int N, bf16* WT, int kb, int n0, int drow0, LAS float* scr_, int lane) {
    LAS unsigned char* scr = (LAS unsigned char*)scr_;
    const int k0 = 64 * kb, lr = lane >> 4, lc = lane & 15;
#pragma unroll
    for (int hf = 0; hf < 2; ++hf) {
        f32x4 v[8];
#pragma unroll
        for (int r = 0; r < 8; ++r) v[r] = *(const f32x4*)(W + (size_t)(k0 + 32 * hf + 4 * r + lr) * N + n0 + 4 * lc);
#pragma unroll
        for (int r = 0; r < 8; ++r) { v2u o; o.x = pk2(v[r].x, v[r].y); o.y = pk2(v[r].z, v[r].w); *(LAS v2u*)(scr + (32 * hf + 4 * r + lr) * 144 + lc * 8) = o; }
    }
    LDS_WAIT(); asm volatile("" ::: "memory");
    const int g = lane >> 4, q = (lane & 15) >> 2, p = lane & 3;
#pragma unroll
    for (int nb = 0; nb < 4; ++nb)
#pragma unroll
        for (int kk = 0; kk < 2; ++kk) { const int kblk = 4 * kk + g;
            const v2u a = tr8(scr + (8 * kblk + q) * 144 + (16 * nb + 4 * p) * 2), b = tr8(scr + (8 * kblk + 4 + q) * 144 + (16 * nb + 4 * p) * 2);
            v4u o; o.x = a.x; o.y = a.y; o.z = b.x; o.w = b.y;
            *(GAS v4u*)(WT + (size_t)(drow0 + 16 * nb + lc) * K + k0 + 8 * kblk) = o; }
    LDS_WAIT(); asm volatile("" ::: "memory");
}

__device__ __forceinline__ void p0_phase(Frame& F, const Args& A) {
    unsigned char* ws = F.ws;
    LAS float* sc = (LAS float*)F.lds;
    if (F.vcu < 6 * D / 64) {
#pragma unroll 1
        for (int i0 = F.tid; i0 < BATCH * D; i0 += 8 * NWAVES * 64) { float v[8];
#pragma unroll
            for (int u = 0; u < 8; ++u) v[u] = A.in[1][i0 + u * NWAVES * 64];
#pragma unroll
            for (int u = 0; u < 8; ++u) { const int i = i0 + u * NWAVES * 64, b = i >> 10, k = i & 1023; sc[k * 16 + b] = v[u] * sigm(v[u]); } } }
    __syncthreads();
    const int nada = (F.G > 2 * (6 * D / 64)) ? (6 * D / 64) : 0;
    const int NGW = (F.G - nada) * NWAVES, gw = (F.vcu >= nada) ? (F.vcu - nada) * NWAVES + F.wave : 0x40000000;
    LAS float* part = (LAS float*)(F.lds + 65536);
    for (int task = F.vcu; task < 6 * D / 64; task += F.G) {
        const int col = task * 64 + F.lane;
        float acc[16];
#pragma unroll
        for (int b = 0; b < 16; ++b) acc[b] = 0.f;
        const float* wp = A.in[2] + (size_t)(128 * F.wave) * (6 * D) + col;
        const LAS f32x4* sp = (const LAS f32x4*)(sc + (128 * F.wave) * 16);
#pragma unroll 1
        for (int k0 = 0; k0 < 128; k0 += 32) { float wv[32];
#pragma unroll
            for (int i = 0; i < 32; ++i) wv[i] = wp[(size_t)(k0 + i) * (6 * D)];
#pragma unroll
            for (int i = 0; i < 32; ++i) {
#pragma unroll
                for (int q = 0; q < 4; ++q) { const f32x4 sv = sp[(k0 + i) * 4 + q]; acc[4 * q + 0] += wv[i] * sv.x; acc[4 * q + 1] += wv[i] * sv.y; acc[4 * q + 2] += wv[i] * sv.z; acc[4 * q + 3] += wv[i] * sv.w; } } }
#pragma unroll
        for (int b = 0; b < 16; ++b) part[(F.wave * 16 + b) * 64 + F.lane] = acc[b];
        __syncthreads();
        for (int i = F.tid; i < 16 * 64; i += NWAVES * 64) { const int b = i >> 6, c = i & 63; float v = A.in[3][task * 64 + c];
#pragma unroll
            for (int w8 = 0; w8 < 8; ++w8) v += part[(w8 * 16 + b) * 64 + c];
            ((float*)(ws + WS_MOD))[b * (6 * D) + task * 64 + c] = v; }
        __syncthreads();
    }
    __syncthreads();
    LAS float* scr = (LAS float*)(F.lds + F.wave * 16384);
    constexpr int I_SQ = 16 * 16, I_LW = 16 * 4;
    constexpr int NITEMS = 3 * I_SQ + I_LW;
    for (int it = gw; it < NITEMS; it += NGW) {
        int r = it;
        if (r < I_SQ) { transpose_item(A.in[18], D, D, (bf16*)(ws + WS_WR), r / 16, 64 * (r % 16), 64 * (r % 16), scr, F.lane); continue; } r -= I_SQ;
        if (r < I_SQ) { transpose_item(A.in[19], D, D, (bf16*)(ws + WS_WA), r / 16, 64 * (r % 16), 64 * (r % 16), scr, F.lane); continue; } r -= I_SQ;
        if (r < I_SQ) { transpose_item(A.in[20], D, D, (bf16*)(ws + WS_WO), r / 16, 64 * (r % 16), 64 * (r % 16), scr, F.lane); continue; } r -= I_SQ;
        { const int mat = r >> 2, q = r & 3, gate = mat >> 3, n = mat & 7;
          const float* W = (gate ? A.in[10] : A.in[8]) + (size_t)n * 128 * 128;
          transpose_item(W, 128, 128, (bf16*)(ws + WS_LW) + (size_t)(n * 2 + gate) * 128 * 128, q >> 1, 64 * (q & 1), 64 * (q & 1), scr, F.lane); }
    }
    for (long i = (long)gw * 64 + F.lane; i < D * NEXP; i += NGW * 64) { const int k = i >> 6, e = i & 63; const float wv = A.in[23][i]; const unsigned hb = f2bf(wv); const unsigned lb = f2bf(wv - bf2f(hb));
        ((bf16*)(ws + WS_WRH))[e * D + k] = (bf16)hb; ((bf16*)(ws + WS_WRL))[e * D + k] = (bf16)lb; }
    for (int it = gw; it < 130 * 64 + (D * W_IN) / 4096; it += NGW) { const int mtx = it < 130 * 64 ? it >> 6 : 130, part = it < 130 * 64 ? (it & 63) : it - 130 * 64, e = mtx >> 1, w3 = mtx & 1;
        const float* W = (mtx == 130 ? A.in[5] : e < NEXP ? (w3 ? A.in[26] : A.in[25]) + (size_t)e * D * DEXP : (w3 ? A.in[29] : A.in[28])) + (size_t)part * 4096;
        float mx = 0.f;
#pragma unroll
        for (int i = 0; i < 16; ++i) { const f32x4 v = *((const f32x4*)W + F.lane + 64 * i); mx = fmaxf(mx, fmaxf(fmaxf(fabsf(v.x), fabsf(v.y)), fmaxf(fabsf(v.z), fabsf(v.w)))); }
        mx = wave_max_dpp(mx);
        if (F.lane == 0) atomicMax((unsigned*)(F.ctl + CW_AMAX + mtx), __float_as_uint(mx)); }
}

__device__ __forceinline__ void transpose_item_q(const float* W, int K, int N, signed char* WT, int kb, int n0, int drow0, LAS float* scr_, int lane, float inv) {
    LAS unsigned char* scr = (LAS unsigned char*)scr_;
    const int k0 = 64 * kb, lr = lane >> 4, lc = lane & 15;
#pragma unroll
    for (int hf = 0; hf < 2; ++hf) {
        f32x4 v[8];
#pragma unroll
        for (int r = 0; r < 8; ++r) v[r] = *(const f32x4*)(W + (size_t)(k0 + 32 * hf + 4 * r + lr) * N + n0 + 4 * lc);
#pragma unroll
        for (int r = 0; r < 8; ++r) { v2u o; o.x = pk2(v[r].x, v[r].y); o.y = pk2(v[r].z, v[r].w); *(LAS v2u*)(scr + (32 * hf + 4 * r + lr) * 144 + lc * 8) = o; }
    }
    LDS_WAIT(); asm volatile("" ::: "memory");
    const int g = lane >> 4, q = (lane & 15) >> 2, p = lane & 3;
#pragma unroll
    for (int nb = 0; nb < 4; ++nb)
#pragma unroll
        for (int kk = 0; kk < 2; ++kk) { const int kblk = 4 * kk + g;
            const v2u a = tr8(scr + (8 * kblk + q) * 144 + (16 * nb + 4 * p) * 2), b = tr8(scr + (8 * kblk + 4 + q) * 144 + (16 * nb + 4 * p) * 2);
            const unsigned wv[4] = {a.x, a.y, b.x, b.y}; unsigned ob[2] = {0u, 0u};
#pragma unroll
            for (int j = 0; j < 4; ++j) { const int q0 = (int)rintf(bflo(wv[j]) * inv), q1 = (int)rintf(bfhi(wv[j]) * inv);
                ob[j >> 1] |= ((unsigned)(q0 & 0xff) << (16 * (j & 1))) | ((unsigned)(q1 & 0xff) << (16 * (j & 1) + 8)); }
            v2u o; o.x = ob[0]; o.y = ob[1];
            *(GAS v2u*)(WT + (size_t)(drow0 + 16 * nb + lc) * K + k0 + 8 * kblk) = o; }
    LDS_WAIT(); asm volatile("" ::: "memory");
}

__device__ __forceinline__ void p1_phase(Frame& F, const Args& A) {
    const int gw = F.vcu * NWAVES + F.wave, NGW = F.G * NWAVES;
    const float* mod = (const float*)(F.ws + WS_MOD);
    signed char* H = (signed char*)(F.ws + WS_H); float* SH = (float*)(F.ws + WS_SH);
    for (int grp = gw; grp < T / 16; grp += NGW) {
        const int b = (grp * 16) / SEQ;
        f32x4 g[4], sc[4], sh[4];
#pragma unroll
        for (int j = 0; j < 4; ++j) { const int c = 4 * F.lane + 256 * j; g[j] = *(const f32x4*)(A.in[4] + c); sh[j] = *(const f32x4*)(mod + b * 6 * D + c); sc[j] = *(const f32x4*)(mod + b * 6 * D + D + c);
            g[j] = g[j] * (sc[j] + 1.0f); }
        f32x4 vn[4];
        { const GAS f32x4* xr = (const GAS f32x4*)(A.in[0] + (size_t)grp * 16 * D) + F.lane;
#pragma unroll
          for (int j = 0; j < 4; ++j) vn[j] = xr[64 * j]; }
#pragma unroll 2
        for (int rr = 0; rr < 16; ++rr) {
            const size_t m = (size_t)grp * 16 + rr;
            f32x4 v[4]; float s = 0.f;
#pragma unroll
            for (int j = 0; j < 4; ++j) v[j] = vn[j];
            if (rr + 1 < 16) { const GAS f32x4* xr = (const GAS f32x4*)(A.in[0] + (m + 1) * D) + F.lane;
#pragma unroll
                for (int j = 0; j < 4; ++j) vn[j] = xr[64 * j]; }
#pragma unroll
            for (int j = 0; j < 4; ++j) s += (v[j].x * v[j].x + v[j].y * v[j].y) + (v[j].z * v[j].z + v[j].w * v[j].w);
            const float rstd = 1.f / sqrtf(wave_sum(s) * (1.f / D) + EPS);
            float amx = 0.f;
#pragma unroll
            for (int j = 0; j < 4; ++j) { v[j] = v[j] * rstd * g[j] + sh[j]; amx = fmaxf(amx, fmaxf(fmaxf(fabsf(v[j].x), fabsf(v[j].y)), fmaxf(fabsf(v[j].z), fabsf(v[j].w)))); }
            amx = fmaxf(wave_max_dpp(amx), 1e-20f); const float inv = 127.0f / amx; if (F.lane == 0) SH[m] = amx * (1.0f / 127.0f);
#pragma unroll
            for (int j = 0; j < 4; ++j) { const int q0 = (int)rintf(v[j].x * inv), q1 = (int)rintf(v[j].y * inv), q2 = (int)rintf(v[j].z * inv), q3 = (int)rintf(v[j].w * inv);
                *((GAS unsigned*)(H + m * D) + F.lane + 64 * j) = (unsigned)(q0 & 0xff) | ((unsigned)(q1 & 0xff) << 8) | ((unsigned)(q2 & 0xff) << 16) | ((unsigned)(q3 & 0xff) << 24); }
        }
    }
    { LAS float* scr = (LAS float*)(F.lds + F.wave * 16384);
      const float inv = 127.0f / fmaxf(__uint_as_float(__hip_atomic_load(F.ctl + CW_AMAX + 130, RLX_AGENT)), 1e-30f);
      constexpr int I_IN = 16 * (W_IN / 64);
      for (int it = NGW - 1 - gw; it < I_IN; it += NGW)
          transpose_item_q(A.in[5], D, W_IN, (signed char*)(F.ws + WS_WIN), it / (W_IN / 64), 64 * (it % (W_IN / 64)), 64 * (it % (W_IN / 64)), scr, F.lane, inv); }
}

struct DenseOrder {
    const char* A; const char* Bt; int nM, nN, nwg, G, c; size_t tstep;
    __device__ __forceinline__ void init(const void* A_, const void* Bt_, int M, int N, int K, int G_, int c_) { A = (const char*)A_; Bt = (const char*)Bt_; nM = M / 256; nN = N / 256; nwg = nM * nN; G = G_; c = c_; tstep = (size_t)256 * K * 2; }
    __device__ __forceinline__ bool next(int i, pg8::Unit& u) const {
        const long L = (long)i * G + c; if (L >= nwg) return false;
        int wgid = (int)L; { const int q = nwg / 8, r = nwg % 8, xcd = wgid % 8, off = wgid / 8; wgid = (xcd < r ? xcd * (q + 1) : r * (q + 1) + (xcd - r) * q) + off; }
        const int nig = 8 * nN, gid = wgid / nig, fm = gid * 8, gsz = (nM - fm) < 8 ? (nM - fm) : 8;
        u.pm = fm + ((wgid % nig) % gsz); u.pn = (wgid % nig) / gsz; u.z = i; u.e = 0; return true;
    }
    __device__ __forceinline__ void bases(const pg8::Unit& u, const char*& a, const char*& b) const { a = A + (size_t)u.pm * tstep; b = Bt + (size_t)u.pn * tstep; }
    __device__ __forceinline__ int tok(int, int) const { return 0; }
};
struct MergeOrder {
    DenseOrder d; const char *A1, *B1;
    __device__ __forceinline__ bool next(int i, pg8::Unit& u) const { if (!d.next(i >> 1, u)) return false; u.z = i & 1; return true; }
    __device__ __forceinline__ void bases(const pg8::Unit& u, const char*& a, const char*& b) const { a = (u.z ? A1 : d.A) + (size_t)u.pm * d.tstep; b = (u.z ? B1 : d.Bt) + (size_t)u.pn * d.tstep; }
    __device__ __forceinline__ int tok(int, int) const { return 0; }
};
typedef pg8::f32x4 acc_t[2][2][4][2];
struct EpiProj {
    static constexpr bool PERM = true, TWICE = false;
    bf16* ws5; bf16* dout2; volatile LAS int* MI; float sB;
    __device__ __forceinline__ void operator()(const acc_t& acc, const pg8::Unit& u, int wr, int wc, int fr, int fq) const {
        const int t = u.pn >> 2, colt = (u.pn & 3) * 256;
        bf16* base = ws5 + (size_t)(t < 5 ? t : 0) * T * D;
        const int row0 = u.pm * 256 + wr * 64 + fr, col0 = colt + wc * 32 + 8 * fq;
#pragma unroll
        for (int ai = 0; ai < 2; ++ai)
#pragma unroll
            for (int m = 0; m < 4; ++m) { bf16* rowp = base + (size_t)(row0 + ai * 128 + m * 16) * D + col0;
                const float sc = __int_as_float(MI[512 + u.z * 256 + wr * 64 + fr + ai * 128 + m * 16]) * sB;
#pragma unroll
                for (int bj = 0; bj < 2; ++bj) { const pg8::i32x4 I0 = __builtin_bit_cast(pg8::i32x4, acc[ai][bj][m][0]), I1 = __builtin_bit_cast(pg8::i32x4, acc[ai][bj][m][1]);
                    pg8::f32x4 v0, v1;
#pragma unroll
                    for (int i = 0; i < 4; ++i) { float a = (float)I0[i] * sc, b = (float)I1[i] * sc; asm volatile("" : "+v"(a), "+v"(b)); v0[i] = a; v1[i] = b; }
                    if (t >= 5) {
                        unsigned tb[8];
#pragma unroll
                        for (int i = 0; i < 4; ++i) { tb[i] = __float_as_uint(__builtin_fmaf(sigm(v0[i]), 255.0f, 8388608.0f)); tb[4 + i] = __float_as_uint(__builtin_fmaf(sigm(v1[i]), 255.0f, 8388608.0f)); }
                        v2u w; w.x = __builtin_amdgcn_perm(__builtin_amdgcn_perm(tb[3], tb[2], 0x0c0c0400u), __builtin_amdgcn_perm(tb[1], tb[0], 0x0c0c0400u), 0x05040100u);
                        w.y = __builtin_amdgcn_perm(__builtin_amdgcn_perm(tb[7], tb[6], 0x0c0c0400u), __builtin_amdgcn_perm(tb[5], tb[4], 0x0c0c0400u), 0x05040100u);
                        *(v2u*)((unsigned char*)dout2 + (size_t)(t - 5) * T * D + (size_t)(row0 + ai * 128 + m * 16) * D + col0 + bj * 128) = w; continue; }
                    if (t == 1) { for (int i = 0; i < 4; ++i) { v0[i] = pg8::gelu_t(v0[i]); v1[i] = pg8::gelu_t(v1[i]); } }
                    else if (t == 2) { v0 = v0 * attn_body::C2; v1 = v1 * attn_body::C2; }
                    v4u w; w.x = pg8::cvt_pk_bf16(v0[0], v0[1]); w.y = pg8::cvt_pk_bf16(v0[2], v0[3]); w.z = pg8::cvt_pk_bf16(v1[0], v1[1]); w.w = pg8::cvt_pk_bf16(v1[2], v1[3]);
                    *(v4u*)(rowp + bj * 128) = w; } }
    }
};
struct EpiGate {
    static constexpr bool PERM = true, TWICE = false;
    const unsigned char* GA; const unsigned char* GB; bf16* YA; bf16* MG;
    __device__ __forceinline__ void operator()(const acc_t& acc, const pg8::Unit& u, int wr, int wc, int fr, int fq) const {
        const int row0 = u.pm * 256 + wr * 64 + fr, col0 = u.pn * 256 + wc * 32 + 8 * fq;
        const unsigned char* G = u.z ? GB : GA; bf16* O = u.z ? MG : YA;
#pragma unroll
        for (int ai = 0; ai < 2; ++ai)
#pragma unroll
            for (int mp = 0; mp < 2; ++mp) {
                v2u g[2][2]; v4u y[2][2];
#pragma unroll
                for (int mm = 0; mm < 2; ++mm)
#pragma unroll
                    for (int bj = 0; bj < 2; ++bj) { const size_t off = (size_t)(row0 + ai * 128 + (2 * mp + mm) * 16) * D + col0 + bj * 128; g[mm][bj] = *(const v2u*)(G + off);
                        y[mm][bj] = u.z ? *(const v4u*)(YA + off) : (v4u){0u, 0u, 0u, 0u}; }
#pragma unroll
                for (int mm = 0; mm < 2; ++mm)
#pragma unroll
                    for (int bj = 0; bj < 2; ++bj) { const int m = 2 * mp + mm; const size_t off = (size_t)(row0 + ai * 128 + m * 16) * D + col0 + bj * 128; const v2u gg = g[mm][bj]; const v4u yy = y[mm][bj]; constexpr float Q = 1.0f / 255.0f;
                        pg8::f32x4 v0 = acc[ai][bj][m][0], v1 = acc[ai][bj][m][1];
                        v0[0] = v0[0] * ((float)(gg.x & 0xffu) * Q) + bflo(yy.x); v0[1] = v0[1] * ((float)((gg.x >> 8) & 0xffu) * Q) + bfhi(yy.x); v0[2] = v0[2] * ((float)((gg.x >> 16) & 0xffu) * Q) + bflo(yy.y); v0[3] = v0[3] * ((float)(gg.x >> 24) * Q) + bfhi(yy.y);
                        v1[0] = v1[0] * ((float)(gg.y & 0xffu) * Q) + bflo(yy.z); v1[1] = v1[1] * ((float)((gg.y >> 8) & 0xffu) * Q) + bfhi(yy.z); v1[2] = v1[2] * ((float)((gg.y >> 16) & 0xffu) * Q) + bflo(yy.w); v1[3] = v1[3] * ((float)(gg.y >> 24) * Q) + bfhi(yy.w);
                        v4u w; w.x = pg8::cvt_pk_bf16(v0[0], v0[1]); w.y = pg8::cvt_pk_bf16(v0[2], v0[3]); w.z = pg8::cvt_pk_bf16(v1[0], v1[1]); w.w = pg8::cvt_pk_bf16(v1[2], v1[3]);
                        *(v4u*)(O + off) = w; }
                asm volatile("" ::: "memory"); }
    }
};
struct EpiF32 {
    static constexpr bool PERM = true, TWICE = false;
    bf16* Y;
    __device__ __forceinline__ void operator()(const acc_t& acc, const pg8::Unit& u, int wr, int wc, int fr, int fq) const {
        const int row0 = u.pm * 256 + wr * 64 + fr, col0 = u.pn * 256 + wc * 32 + 8 * fq;
#pragma unroll
        for (int ai = 0; ai < 2; ++ai)
#pragma unroll
            for (int m = 0; m < 4; ++m) { bf16* rowp = Y + (size_t)(row0 + ai * 128 + m * 16) * D + col0;
#pragma unroll
                for (int bj = 0; bj < 2; ++bj) { const pg8::f32x4 v0 = acc[ai][bj][m][0], v1 = acc[ai][bj][m][1];
                    v4u w; w.x = pg8::cvt_pk_bf16(v0[0], v0[1]); w.y = pg8::cvt_pk_bf16(v0[2], v0[3]); w.z = pg8::cvt_pk_bf16(v1[0], v1[1]); w.w = pg8::cvt_pk_bf16(v1[2], v1[3]);
                    *(v4u*)(rowp + bj * 128) = w; } }
    }
};

__device__ __forceinline__ void lru_phase(Frame& F, const Args& A) {
    unsigned char* ws = F.ws;
    const bf16* XR = (const bf16*)(ws + WS_XR); bf16* GR = (bf16*)(ws + WS_GR);
    LAS unsigned char* AT = F.lds;
    LAS unsigned char* BT = F.lds + 34816;
    LAS float* AA = (LAS float*)(F.lds + 69632);
    LAS float* UU = (LAS float*)(F.lds + 102400);
    LAS float* SM = (LAS float*)(F.lds + 135168);
    LAS float* CW = (LAS float*)(F.lds + MISC_OFF + 4096);
    const int tid = F.tid, lane = F.lane, w = F.wave, hi = lane >> 5, l31 = lane & 31;
    for (int item = F.vcu; item < BATCH * 16; item += F.G) {
        const int b = item >> 4, n = (item >> 1) & 7, half = item & 1;
        __syncthreads();
        { const bf16* LW = (const bf16*)(ws + WS_LW) + (size_t)n * 2 * 128 * 128;
#pragma unroll
          for (int p = 0; p < 4; ++p) { const int q = tid + 512 * p, row = q >> 4, pc = q & 15; const int gate = row >> 6, d = 64 * half + (row & 63);
              const v4u v = *(const v4u*)(LW + ((size_t)gate * 128 + d) * 128 + pc * 8); *(LAS v4u*)(BT + row * 272 + pc * 16) = v; }
          for (int i = tid; i < 640; i += NWAVES * 64) { const int k = i >> 7, c = i & 127; CW[i] = (k < 4) ? A.in[6][k * D + 128 * n + c] : A.in[7][128 * n + c]; } }
        const int c8 = (tid & 15) * 8, run = tid >> 4, cg0 = 128 * n + c8;
        const int tg = w & 3, cg = w >> 2, lc = 32 * cg + l31, chg = 128 * n + 64 * half + lc;
        const float ba_c = A.in[9][chg], bx_c = A.in[11][chg];
        const float lam = A.in[12][chg]; const float sp8 = 8.0f * log1pf(expf(-lam)) * LOG2E;
        const int sc_c = tid & 63, seg = tid >> 6;
        float hcarry = 0.f;
        v4u xq[7];
        { const bf16* xp = XR + ((size_t)b * SEQ + 4 * run - 3) * D + cg0;
#pragma unroll
          for (int i = 0; i < 7; ++i) xq[i] = (4 * run - 3 + i >= 0) ? *(const v4u*)(xp + (size_t)i * D) : (v4u){0u, 0u, 0u, 0u}; }
        __syncthreads();
#pragma unroll 1
        for (int ck = 0; ck < SEQ / 128; ++ck) {
            const int t0 = 128 * ck;
            bf16* gp = GR + ((size_t)b * SEQ + t0 + 16 * seg) * D + 128 * n + 64 * half + sc_c;
            { unsigned ow[4][4];
#pragma unroll
              for (int hf = 0; hf < 2; ++hf) { float wv[5][4];
#pragma unroll
                  for (int k = 0; k < 5; ++k) { const f32x4 w0 = *(const LAS f32x4*)(CW + k * 128 + c8 + 4 * hf); wv[k][0] = w0.x; wv[k][1] = w0.y; wv[k][2] = w0.z; wv[k][3] = w0.w; }
#pragma unroll
                  for (int tt = 0; tt < 4; ++tt) { float x0 = wv[4][0], x1 = wv[4][1], x2 = wv[4][2], x3 = wv[4][3];
#pragma unroll
                      for (int k = 0; k < 4; ++k) { const unsigned va = hf ? xq[tt + k].z : xq[tt + k].x, vb = hf ? xq[tt + k].w : xq[tt + k].y;
                          x0 += wv[k][0] * bflo(va); x1 += wv[k][1] * bfhi(va); x2 += wv[k][2] * bflo(vb); x3 += wv[k][3] * bfhi(vb); }
                      ow[tt][2 * hf] = pk2(x0, x1); ow[tt][2 * hf + 1] = pk2(x2, x3); } }
#pragma unroll
              for (int tt = 0; tt < 4; ++tt) { v4u o; o.x = ow[tt][0]; o.y = ow[tt][1]; o.z = ow[tt][2]; o.w = ow[tt][3]; *(LAS v4u*)(AT + (4 * run + tt) * 272 + c8 * 2) = o; } }
            if (ck + 1 < SEQ / 128) { const bf16* xp = XR + ((size_t)b * SEQ + t0 + 128 + 4 * run - 3) * D + cg0;
#pragma unroll
                for (int i = 0; i < 7; ++i) xq[i] = *(const v4u*)(xp + (size_t)i * D); }
            __syncthreads();
            { f32x16 accR = f32x16{}, accI = f32x16{};
#pragma unroll
              for (int ks = 0; ks < 8; ++ks) {
                  const bf16x8 a = *(const LAS bf16x8*)(AT + (32 * tg + l31) * 272 + (16 * ks + 8 * hi) * 2);
                  const bf16x8 bR = *(const LAS bf16x8*)(BT + (32 * cg + l31) * 272 + (16 * ks + 8 * hi) * 2);
                  const bf16x8 bI = *(const LAS bf16x8*)(BT + (64 + 32 * cg + l31) * 272 + (16 * ks + 8 * hi) * 2);
                  accR = __builtin_amdgcn_mfma_f32_32x32x16_bf16(a, bR, accR, 0, 0, 0);
                  accI = __builtin_amdgcn_mfma_f32_32x32x16_bf16(a, bI, accI, 0, 0, 0); }
#pragma unroll
              for (int r = 0; r < 16; ++r) {
                  const int tok = 32 * tg + (r & 3) + 8 * (r >> 2) + 4 * hi;
                  const float rg = sigm(accR[r] + ba_c), ig = sigm(accI[r] + bx_c);
                  const float la2 = -sp8 * rg;
                  const float a = __builtin_amdgcn_exp2f(la2);
                  float mult = __builtin_amdgcn_sqrtf(fmaxf(1.0f - a * a, 0.f));
                  if (t0 + tok == 0) mult = 1.0f;
                  const float xcv = bf2f(*(const LAS unsigned short*)(AT + tok * 272 + (64 * half + lc) * 2));
                  AA[tok * 64 + lc] = a; UU[tok * 64 + lc] = mult * ig * xcv; } }
            __syncthreads();
            unsigned short gq[16];
#pragma unroll
            for (int j = 0; j < 16; ++j) gq[j] = gp[(size_t)j * D];
            float hl[16], pl[16];
            { float h = 0.f, P = 1.f;
#pragma unroll
              for (int j = 0; j < 16; ++j) { const float a = AA[(16 * seg + j) * 64 + sc_c], u = UU[(16 * seg + j) * 64 + sc_c]; h = a * h + u; P = P * a; hl[j] = h; pl[j] = P; }
              SM[(seg * 64 + sc_c) * 2] = P; SM[(seg * 64 + sc_c) * 2 + 1] = h; }
            __syncthreads();
            { float cin = hcarry, tot = hcarry;
#pragma unroll
              for (int s = 0; s < 8; ++s) { const float Ps = SM[(s * 64 + sc_c) * 2], hs = SM[(s * 64 + sc_c) * 2 + 1]; tot = Ps * tot + hs; if (s < seg) cin = tot; }
              hcarry = tot;
#pragma unroll
              for (int j = 0; j < 16; ++j) { const float hv = hl[j] + pl[j] * cin; gp[(size_t)j * D] = (bf16)f2bf(hv * bf2f(gq[j])); } }
        }
    }
    __syncthreads();
}

__device__ __forceinline__ void p5_phase(Frame& F, const Args& A) {
    const int gw = F.vcu * NWAVES + F.wave, NGW = F.G * NWAVES;
    float d1 = A.in[13][F.lane] * A.in[14][F.lane], d2 = A.in[15][F.lane] * A.in[16][F.lane];
    const float lam = expf(wave_sum(d1)) - expf(wave_sum(d2)) + LAM_INIT;
    bf16* O0 = (bf16*)(F.ws + WS_H); const bf16* O1 = (const bf16*)(F.ws + WS_O1);
    float g[16];
#pragma unroll
    for (int i = 0; i < 16; ++i) g[i] = A.in[17][(16 * F.lane + i) & 127] * (1.0f - LAM_INIT);
    for (int m = gw; m < T; m += NGW) {
        const v4u a0 = *(const v4u*)(O0 + (size_t)m * D + 16 * F.lane), a1 = *(const v4u*)(O0 + (size_t)m * D + 16 * F.lane + 8);
        const v4u b0 = *(const v4u*)(O1 + (size_t)m * D + 16 * F.lane), b1 = *(const v4u*)(O1 + (size_t)m * D + 16 * F.lane + 8);
        float o[16];
        o[0] = bflo(a0.x) - lam * bflo(b0.x); o[1] = bfhi(a0.x) - lam * bfhi(b0.x); o[2] = bflo(a0.y) - lam * bflo(b0.y); o[3] = bfhi(a0.y) - lam * bfhi(b0.y);
        o[4] = bflo(a0.z) - lam * bflo(b0.z); o[5] = bfhi(a0.z) - lam * bfhi(b0.z); o[6] = bflo(a0.w) - lam * bflo(b0.w); o[7] = bfhi(a0.w) - lam * bfhi(b0.w);
        o[8] = bflo(a1.x) - lam * bflo(b1.x); o[9] = bfhi(a1.x) - lam * bfhi(b1.x); o[10] = bflo(a1.y) - lam * bflo(b1.y); o[11] = bfhi(a1.y) - lam * bfhi(b1.y);
        o[12] = bflo(a1.z) - lam * bflo(b1.z); o[13] = bfhi(a1.z) - lam * bfhi(b1.z); o[14] = bflo(a1.w) - lam * bflo(b1.w); o[15] = bfhi(a1.w) - lam * bfhi(b1.w);
        float s = 0.f;
#pragma unroll
        for (int i = 0; i < 16; ++i) s += o[i] * o[i];
        s += __shfl_xor(s, 1); s += __shfl_xor(s, 2); s += __shfl_xor(s, 4);
        const float rstd = 1.f / sqrtf(s * (1.f / 128.f) + EPS);
        v4u w0, w1;
        w0.x = pk2(o[0] * rstd * g[0], o[1] * rstd * g[1]); w0.y = pk2(o[2] * rstd * g[2], o[3] * rstd * g[3]); w0.z = pk2(o[4] * rstd * g[4], o[5] * rstd * g[5]); w0.w = pk2(o[6] * rstd * g[6], o[7] * rstd * g[7]);
        w1.x = pk2(o[8] * rstd * g[8], o[9] * rstd * g[9]); w1.y = pk2(o[10] * rstd * g[10], o[11] * rstd * g[11]); w1.z = pk2(o[12] * rstd * g[12], o[13] * rstd * g[13]); w1.w = pk2(o[14] * rstd * g[14], o[15] * rstd * g[15]);
        *(v4u*)(O0 + (size_t)m * D + 16 * F.lane) = w0; *(v4u*)(O0 + (size_t)m * D + 16 * F.lane + 8) = w1;
    }
}

#ifndef PROBE_SEG
#define PROBE_SEG 0
#endif
#define SEG_T0() do { if (PROBE_SEG != 0 && F.tid == 0) { volatile LAS unsigned long long* pp_ = (volatile LAS unsigned long long*)(F.MI + 16); pp_[0] = __builtin_amdgcn_s_memrealtime(); } } while (0)
#define SEG_T1(id) do { if (PROBE_SEG != 0 && F.tid == 0) { volatile LAS unsigned long long* pp_ = (volatile LAS unsigned long long*)(F.MI + 16); const unsigned long long t_ = __builtin_amdgcn_s_memrealtime(); if (PROBE_SEG == (id)) pp_[1] += t_ - pp_[0]; pp_[0] = t_; } } while (0)
__device__ __forceinline__ void p8_phase(Frame& F, const Args& A) {
    unsigned char* ws = F.ws;
    const float* mod = (const float*)(ws + WS_MOD); const bf16* Y = (const bf16*)(ws + WS_Y);
    signed char* H2 = (signed char*)(ws + WS_H); float* SA = (float*)(ws + WS_SA);
    LAS unsigned char* TH = F.lds; LAS unsigned char* TL = F.lds + 66048;
    LAS float* red = (LAS float*)F.lds;
    LAS int* cntl = (LAS int*)(F.lds + 135168);
    const int tid = F.tid, lane = F.lane, w = F.wave, hi = lane >> 5, l31 = lane & 31;
    int* lists = (int*)(ws + WS_LIST); float* wts = (float*)(ws + WS_WTS);
    v2u yn[2][4]; f32x4 xn[2][4];
    if (F.vcu < T / 32) {
#pragma unroll
        for (int q = 0; q < 2; ++q) { const size_t m = (size_t)F.vcu * 32 + w * 4 + q;
#pragma unroll
            for (int j = 0; j < 4; ++j) { yn[q][j] = *((const GAS v2u*)(Y + m * D) + lane + 64 * j); xn[q][j] = *((const GAS f32x4*)(A.in[0] + m * D) + lane + 64 * j); } } }
#pragma unroll 1
    for (int tl = F.vcu; tl < T / 32; tl += F.G) {
        const int tok0 = tl * 32, b = tok0 / SEQ, chunk = tok0 / TC;
        if (tid < 64) cntl[tid] = 0;
        SEG_T0();
        f32x4 c_gp[4], c_g2[4], c_sh[4];
#pragma unroll
        for (int j = 0; j < 4; ++j) { const int c = 4 * lane + 256 * j; c_gp[j] = *(const f32x4*)(A.in[21] + c) * *(const f32x4*)(mod + b * 6 * D + 2 * D + c);
            c_g2[j] = *(const f32x4*)(A.in[22] + c) * (*(const f32x4*)(mod + b * 6 * D + 4 * D + c) + 1.0f); c_sh[j] = *(const f32x4*)(mod + b * 6 * D + 3 * D + c); }
#pragma unroll 1
        for (int rp = 0; rp < 2; ++rp) {
            f32x4 y[2][4], x[2][4]; float s[2] = {0.f, 0.f};
#pragma unroll
            for (int q = 0; q < 2; ++q)
#pragma unroll
                for (int j = 0; j < 4; ++j) { const v2u yv = yn[q][j]; y[q][j] = (f32x4){bflo(yv.x), bfhi(yv.x), bflo(yv.y), bfhi(yv.y)}; x[q][j] = xn[q][j]; }
            { const int ntl = rp ? tl + F.G : tl, nrp = rp ^ 1;
              if (ntl < T / 32) {
#pragma unroll
                  for (int q = 0; q < 2; ++q) { const size_t m = (size_t)ntl * 32 + w * 4 + nrp * 2 + q;
#pragma unroll
                      for (int j = 0; j < 4; ++j) { yn[q][j] = *((const GAS v2u*)(Y + m * D) + lane + 64 * j); xn[q][j] = *((const GAS f32x4*)(A.in[0] + m * D) + lane + 64 * j); } } } }
#pragma unroll
            for (int q = 0; q < 2; ++q)
#pragma unroll
                for (int j = 0; j < 4; ++j) s[q] += (y[q][j].x * y[q][j].x + y[q][j].y * y[q][j].y) + (y[q][j].z * y[q][j].z + y[q][j].w * y[q][j].w);
            float s2[2] = {0.f, 0.f};
#pragma unroll
            for (int q = 0; q < 2; ++q) { const size_t m = (size_t)tok0 + w * 4 + rp * 2 + q; const float rstd = 1.f / sqrtf(wave_sum_dpp(s[q]) * (1.f / D) + EPS);
#pragma unroll
                for (int j = 0; j < 4; ++j) { x[q][j] = x[q][j] + c_gp[j] * (y[q][j] * rstd); { v2u xb; xb.x = pk2(x[q][j].x, x[q][j].y); xb.y = pk2(x[q][j].z, x[q][j].w); *((v2u*)(F.out + m * D) + lane + 64 * j) = xb; }
                    s2[q] += (x[q][j].x * x[q][j].x + x[q][j].y * x[q][j].y) + (x[q][j].z * x[q][j].z + x[q][j].w * x[q][j].w); } }
#pragma unroll
            for (int q = 0; q < 2; ++q) { const size_t m = (size_t)tok0 + w * 4 + rp * 2 + q; const float rstd2 = 1.f / sqrtf(wave_sum_dpp(s2[q]) * (1.f / D) + EPS);
                f32x4 hh[4]; float amx = 0.f;
#pragma unroll
                for (int j = 0; j < 4; ++j) { const int c = 4 * lane + 256 * j; const f32x4 h = (x[q][j] * rstd2) * c_g2[j] + c_sh[j]; hh[j] = h;
                    amx = fmaxf(amx, fmaxf(fmaxf(fabsf(h.x), fabsf(h.y)), fmaxf(fabsf(h.z), fabsf(h.w))));
                    v2u o; o.x = pk2(h.x, h.y); o.y = pk2(h.z, h.w);
                    *(LAS v2u*)(TH + (w * 4 + rp * 2 + q) * 2064 + c * 2) = o; }
                amx = fmaxf(wave_max_dpp(amx), 1e-20f); const float inv = 127.0f / amx; if (lane == 0) SA[m] = amx * (1.0f / 127.0f);
#pragma unroll
                for (int j = 0; j < 4; ++j) { const int q0 = (int)rintf(hh[j].x * inv), q1 = (int)rintf(hh[j].y * inv), q2 = (int)rintf(hh[j].z * inv), q3 = (int)rintf(hh[j].w * inv);
                    *((GAS unsigned*)(H2 + m * D) + lane + 64 * j) = (unsigned)(q0 & 0xff) | ((unsigned)(q1 & 0xff) << 8) | ((unsigned)(q2 & 0xff) << 16) | ((unsigned)(q3 & 0xff) << 24); } }
        }
        bf16x8 bH0[8], bH1[8];
        { const bf16* whp = (const bf16*)(ws + WS_WRH) + (size_t)l31 * D + 128 * w + 8 * hi;
#pragma unroll
          for (int ks = 0; ks < 8; ++ks) { bH0[ks] = *(const GAS bf16x8*)(whp + ks * 16); bH1[ks] = *(const GAS bf16x8*)(whp + 32 * D + ks * 16); } }
        __syncthreads(); SEG_T1(1);
        f32x16 acc0 = f32x16{}, acc1 = f32x16{};
        { const LAS unsigned char* ahp = TH + l31 * 2064 + (128 * w + 8 * hi) * 2;
#pragma unroll
          for (int ks = 0; ks < 8; ++ks) {
              const bf16x8 aH = *(const LAS bf16x8*)(ahp + ks * 32);
              acc0 = __builtin_amdgcn_mfma_f32_32x32x16_bf16(aH, bH0[ks], acc0, 0, 0, 0); acc1 = __builtin_amdgcn_mfma_f32_32x32x16_bf16(aH, bH1[ks], acc1, 0, 0, 0); } }
        __syncthreads(); SEG_T1(2);
#pragma unroll
        for (int r = 0; r < 16; ++r) { const int tk = (r & 3) + 8 * (r >> 2) + 4 * hi; red[(w * 32 + tk) * 64 + l31] = acc0[r]; red[(w * 32 + tk) * 64 + 32 + l31] = acc1[r]; }
        __syncthreads();
        int sel_e[4], sel_lp[4], sel_slot[4]; float sel_wt[4];
        const float eb = A.in[24][lane];
#pragma unroll
        for (int q = 0; q < 4; ++q) {
            const int tk = 4 * w + q; float lg = 0.f;
#pragma unroll
            for (int ww = 0; ww < 8; ++ww) lg += red[(ww * 32 + tk) * 64 + lane];
            const float score = 1.0f / (1.0f + expf(-lg)); const float ch = score + eb;
            const float m1 = max8_dpp(ch);
            const unsigned long long eq = __ballot(ch == m1); const int gsh = lane & ~7; const unsigned ge = (unsigned)((eq >> gsh) & 0xffull);
            const int first = gsh + __builtin_ctz(ge);
            const float m2 = max8_dpp((lane == first) ? -INFINITY : ch);
            const float gs = m1 + m2; const int g = lane >> 3;
            int grank = 0;
#pragma unroll
            for (int gg = 0; gg < 8; ++gg) { const float og = rl_f(gs, gg * 8); grank += (og > gs || (og == gs && gg < g)) ? 1 : 0; }
            float cur = (grank < 4) ? ch : -INFINITY;
            int rank = TOPK;
#pragma unroll
            for (int kk = 0; kk < TOPK; ++kk) { const float mx = wave_max_dpp(cur); const unsigned long long mk = __ballot(cur == mx); const int fl = (int)__builtin_ctzll(mk);
                if (lane == fl) { rank = kk; cur = -INFINITY; } }
            const bool sel = rank < TOPK;
            const float wsum = wave_sum_dpp(sel ? score : 0.f);
            sel_e[q] = sel ? lane : -1; sel_slot[q] = (tok0 + tk) * 8 + rank; sel_wt[q] = score / (wsum + 1e-20f) * 2.5f;
            sel_lp[q] = sel ? atomicAdd((int*)&cntl[lane], 1) : 0;
        }
        __syncthreads(); SEG_T1(3);
        if (tid < 64) { const int c = cntl[tid]; cntl[64 + tid] = c ? (int)__hip_atomic_fetch_add((unsigned*)(F.ctl + CW_CNT + chunk * 64 + tid), (unsigned)c, RLX_AGENT) : 0; }
        __syncthreads();
#pragma unroll
        for (int q = 0; q < 4; ++q) if (sel_e[q] >= 0) { const int pos = cntl[64 + lane] + sel_lp[q]; lists[((size_t)chunk * 64 + lane) * TC + pos] = sel_slot[q]; wts[sel_slot[q]] = sel_wt[q]; }
        __syncthreads(); SEG_T1(4);
    }
    SEG_T0();
    __syncthreads();
    LAS float* scr = (LAS float*)(F.lds + w * 16384);
    const int gw = F.vcu * NWAVES + w, NGW = F.G * NWAVES;
    constexpr int I13 = 16 * 4, I2 = 4 * 16, PER_E = 2 * I13 + I2;
    for (int it = gw; it < (NEXP + 1) * PER_E; it += NGW) {
        const int e = it / PER_E; int r = it % PER_E;
        const bool sh = (e == NEXP);
        if (r < 2 * I13) { const int w3 = r / I13; r %= I13; const int kb = r >> 2, n0 = 64 * (r & 3);
            const float* W = sh ? (w3 ? A.in[29] : A.in[28]) : ((w3 ? A.in[26] : A.in[25]) + (size_t)e * D * DEXP);
            signed char* WT = sh ? (signed char*)(ws + WS_W13S) : (signed char*)(ws + WS_W13) + (size_t)e * 512 * D;
            const float amx = fmaxf(__uint_as_float(__hip_atomic_load(F.ctl + CW_AMAX + 2 * e + w3, RLX_AGENT)), 1e-30f);
            transpose_item_q(W, D, DEXP, WT, kb, n0, (n0 >> 7) * 256 + (w3 ? 128 : 0) + (n0 & 127), scr, lane, 127.0f / amx); }
        else { r -= 2 * I13; const int kb = r >> 4, n0 = 64 * (r & 15);
            const float* W = sh ? A.in[30] : A.in[27] + (size_t)e * DEXP * D;
            bf16* WT = sh ? (bf16*)(ws + WS_W2S) : (bf16*)(ws + WS_W2) + (size_t)e * D * DEXP;
            transpose_item(W, DEXP, D, WT, kb, n0, n0, scr, lane); }
    }
    __syncthreads(); SEG_T1(5);
}

__device__ __forceinline__ int moe_tables(Frame& F, int chunk) {
    __syncthreads();
    if (F.wave == 0) {
        const int cnt = (int)__hip_atomic_load(F.ctl + CW_CNT + chunk * 64 + F.lane, RLX_AGENT);
        const int nt = (cnt + 255) >> 8; int incl = nt;
#pragma unroll
        for (int o = 1; o < 64; o <<= 1) { const int v = __shfl_up(incl, o); if (F.lane >= o) incl += v; }
        const int base = incl - nt;
        F.MI[MI_CNT + F.lane] = cnt; F.MI[MI_TBASE + F.lane] = base; if (F.lane == 63) F.MI[MI_TBASE + NEXP] = incl;
        for (int j = 0; j < nt; ++j) F.MI[MI_TILE_E + base + j] = F.lane; }
    __syncthreads();
    return F.MI[MI_TBASE + NEXP];
}
struct UpOrder {
    const char* ws; volatile LAS int* MI; int nrt_r, nrt, G, c;
    __device__ __forceinline__ bool next(int i, pg8::Unit& u) const { const int L = i * G + c; if (L >= 2 * nrt) return false; u.pm = L >> 1; u.pn = L & 1; u.z = i;
        u.e = (u.pm < nrt_r) ? __builtin_amdgcn_readfirstlane(MI[MI_TILE_E + u.pm]) : NEXP; return true; }
    __device__ __forceinline__ void bases(const pg8::Unit& u, const char*& a, const char*& b) const { a = ws + WS_H; b = (u.e < NEXP ? ws + WS_W13 + (size_t)u.e * 512 * D : ws + WS_W13S) + (size_t)u.pn * 256 * D; }
    __device__ __forceinline__ int tok(int ui, int row) const { return MI[MI_TOK + ui * 256 + row]; }
};
struct EpiSwiglu {
    static constexpr bool PERM = true, TWICE = false;
    bf16* HB; volatile LAS int* MI; gu32* amax;
    __device__ __forceinline__ void operator()(const acc_t& acc, const pg8::Unit& u, int wr, int wc, int fr, int fq) const {
        const int row0 = u.pm * 256 + wr * 64 + fr, col0 = u.pn * 128 + wc * 32 + 8 * fq;
        const float sB1 = __int_as_float(MI[MI_SB + 2 * u.z]), sB3 = __int_as_float(MI[MI_SB + 2 * u.z + 1]);
#pragma unroll
        for (int ai = 0; ai < 2; ++ai)
#pragma unroll
            for (int m = 0; m < 4; ++m) { bf16* rowp = HB + (size_t)(row0 + ai * 128 + m * 16) * DEXP + col0;
                const float sA = __int_as_float(MI[MI_SA + u.z * 256 + wr * 64 + fr + ai * 128 + m * 16]); const float s1 = sA * sB1, s3 = sA * sB3;
                float v[8];
                { const pg8::i32x4 A0 = __builtin_bit_cast(pg8::i32x4, acc[ai][0][m][0]), A1 = __builtin_bit_cast(pg8::i32x4, acc[ai][0][m][1]), G0 = __builtin_bit_cast(pg8::i32x4, acc[ai][1][m][0]), G1 = __builtin_bit_cast(pg8::i32x4, acc[ai][1][m][1]);
#pragma unroll
                  for (int i = 0; i < 4; ++i) { float a = (float)A0[i] * s1, g = (float)G0[i] * s3; asm volatile("" : "+v"(a), "+v"(g)); v[i] = a * sigm(a) * g;
                      float a2 = (float)A1[i] * s1, g2 = (float)G1[i] * s3; asm volatile("" : "+v"(a2), "+v"(g2)); v[4 + i] = a2 * sigm(a2) * g2; } }
                v4u w; w.x = pg8::cvt_pk_bf16(v[0], v[1]); w.y = pg8::cvt_pk_bf16(v[2], v[3]); w.z = pg8::cvt_pk_bf16(v[4], v[5]); w.w = pg8::cvt_pk_bf16(v[6], v[7]);
                *(v4u*)rowp = w; asm volatile("" ::: "memory"); }
    }
};
struct DownOrder {
    const char* ws; volatile LAS int* MI; int nrt_r, nrt, G, c;
    __device__ __forceinline__ bool next(int i, pg8::Unit& u) const { const int L = i * G + c; if (L >= 4 * nrt) return false; u.pm = L >> 2; u.pn = L & 3; u.z = i;
        u.e = (u.pm < nrt_r) ? __builtin_amdgcn_readfirstlane(MI[MI_TILE_E + u.pm]) : NEXP; return true; }
    __device__ __forceinline__ void bases(const pg8::Unit& u, const char*& a, const char*& b) const { a = ws + WS_HB + (size_t)u.pm * 256 * DEXP * 2; b = (u.e < NEXP ? ws + WS_W2 + (size_t)u.e * D * DEXP * 2 : ws + WS_W2S) + (size_t)u.pn * 256 * DEXP * 2; }
    __device__ __forceinline__ int tok(int, int) const { return 0; }
};
struct EpiScatter {
    static constexpr bool PERM = true, TWICE = true;
    unsigned char* SL; volatile LAS int* MI;
    __device__ __forceinline__ void operator()(const acc_t& acc, const pg8::Unit& u, int wr, int wc, int fr, int fq) const {
        const int col0 = u.pn * 256 + wc * 32 + 8 * fq;
#pragma unroll
        for (int ai = 0; ai < 2; ++ai)
#pragma unroll
            for (int m = 0; m < 4; ++m) { const int rl = wr * 64 + fr + ai * 128 + m * 16; const int dest = MI[MI_TOK + u.z * 256 + rl]; const float wt = 16.0f;
                if (dest >= 0) { unsigned char* rowp = SL + (size_t)dest * D + col0;
#pragma unroll
                    for (int bj = 0; bj < 2; ++bj) { const pg8::f32x4 v0 = acc[ai][bj][m][0], v1 = acc[ai][bj][m][1];
                        float q[8];
#pragma unroll
                        for (int i = 0; i < 4; ++i) { q[i] = __builtin_amdgcn_fmed3f(v0[i] * wt, -448.0f, 448.0f); q[4 + i] = __builtin_amdgcn_fmed3f(v1[i] * wt, -448.0f, 448.0f); }
                        v2u w; w.x = (unsigned)__builtin_amdgcn_cvt_pk_fp8_f32(q[0], q[1], 0, false); w.x = (unsigned)__builtin_amdgcn_cvt_pk_fp8_f32(q[2], q[3], (int)w.x, true);
                        w.y = (unsigned)__builtin_amdgcn_cvt_pk_fp8_f32(q[4], q[5], 0, false); w.y = (unsigned)__builtin_amdgcn_cvt_pk_fp8_f32(q[6], q[7], (int)w.y, true);
                        *(v2u*)(rowp + bj * 128) = w; asm volatile("" ::: "memory"); } } }
    }
};
__device__ __forceinline__ void p2_phase(Frame& F, const Args& A) {
    unsigned char* ws = F.ws;
    DenseOrder S; S.init(ws + WS_H, ws + WS_WIN, T, W_IN, D / 2, F.G, (int)blockIdx.x);
    const float* SH = (const float*)(ws + WS_SH);
    { float v[7]; int pmv[7];
#pragma unroll
      for (int k = 0; k < 7; ++k) { pg8::Unit u; pmv[k] = S.next((F.tid >> 8) + 2 * k, u) ? u.pm : -1; v[k] = pmv[k] >= 0 ? SH[pmv[k] * 256 + (F.tid & 255)] : 0.f; }
#pragma unroll
      for (int k = 0; k < 7; ++k) if (pmv[k] >= 0) F.MI[512 + ((F.tid >> 8) + 2 * k) * 256 + (F.tid & 255)] = __float_as_int(v[k]); }
    __syncthreads();
    EpiProj E{(bf16*)(ws + WS_XR), (bf16*)F.out, F.MI, fmaxf(__uint_as_float(__hip_atomic_load(F.ctl + CW_AMAX + 130, RLX_AGENT)), 1e-30f) * (1.0f / 127.0f)};
    int Kk = D / 2; asm volatile("" : "+s"(Kk));
    pg8::gemm_phase<EpiProj, DenseOrder, true, false, true>(F.lds, F.tid, Kk, S, E);
}
__device__ __forceinline__ void moe_up(Frame& F, int chunk) {
    unsigned char* ws = F.ws;
    const int nrt_r = moe_tables(F, chunk), nrt = nrt_r + TC / 256;
    const int* lists = (const int*)(ws + WS_LIST);
    int* rdest = (int*)(ws + WS_RDEST);
    { const int r = F.tid & 255; int tokn[3], dest[3], slot[3]; float sa[3]; bool act[3]; int rt_[3];
#pragma unroll
      for (int k = 0; k < 3; ++k) { const int i = (F.tid >> 8) + 2 * k, L = i * F.G + F.vcu, rt = L >> 1; act[k] = L < 2 * nrt; rt_[k] = rt; slot[k] = -1; tokn[k] = chunk * TC; dest[k] = -1;
          if (act[k]) { if (rt < nrt_r) { const int e = F.MI[MI_TILE_E + rt]; const int idx = (rt - F.MI[MI_TBASE + e]) * 256 + r; if (idx < F.MI[MI_CNT + e]) slot[k] = lists[((size_t)chunk * 64 + e) * TC + idx]; }
              else { tokn[k] = chunk * TC + (rt - nrt_r) * 256 + r; dest[k] = TC * 8 + (rt - nrt_r) * 256 + r; } } }
#pragma unroll
      for (int k = 0; k < 3; ++k) if (slot[k] >= 0) { tokn[k] = slot[k] >> 3; dest[k] = slot[k] - chunk * TC * 8; }
#pragma unroll
      for (int k = 0; k < 3; ++k) sa[k] = ((const float*)(ws + WS_SA))[tokn[k]];
#pragma unroll
      for (int k = 0; k < 3; ++k) if (act[k]) { const int i = (F.tid >> 8) + 2 * k, L = i * F.G + F.vcu;
          F.MI[MI_TOK + i * 256 + r] = tokn[k]; F.MI[MI_SA + i * 256 + r] = __float_as_int(sa[k]);
          if ((L & 1) == 0) rdest[rt_[k] * 256 + r] = dest[k]; }
      if (F.tid < 12) { const int i = F.tid >> 1, rr = F.tid & 1, L = i * F.G + F.vcu;
          if (L < 2 * nrt) { const int rt = L >> 1; const int e_ = (rt < nrt_r) ? F.MI[MI_TILE_E + rt] : NEXP;
              F.MI[MI_SB + 2 * i + rr] = __float_as_int(fmaxf(__uint_as_float(__hip_atomic_load(F.ctl + CW_AMAX + 2 * e_ + rr, RLX_AGENT)), 1e-30f) * (1.0f / 127.0f)); } } }
    __syncthreads();
    UpOrder S{(const char*)ws, F.MI, nrt_r, nrt, F.G, F.vcu};
    EpiSwiglu E{(bf16*)(ws + WS_HB), F.MI, F.ctl + CW_AMAX};
    int Kk = D / 2; asm volatile("" : "+s"(Kk));
    pg8::gemm_phase<EpiSwiglu, UpOrder, true, true, true>(F.lds, F.tid, Kk, S, E);
}
__device__ __forceinline__ void moe_down(Frame& F, int chunk) {
    unsigned char* ws = F.ws;
    __syncthreads();
    const int nrt_r = F.MI[MI_TBASE + NEXP], nrt = nrt_r + TC / 256;
    { const int* rdest = (const int*)(ws + WS_RDEST) + (F.tid & 255); int v[5];
#pragma unroll
      for (int k = 0; k < 5; ++k) { const int L = ((F.tid >> 8) + 2 * k) * F.G + F.vcu; v[k] = (L < 4 * nrt) ? rdest[(L >> 2) * 256] : -1; }
#pragma unroll
      for (int k = 0; k < 5; ++k) { const int i = (F.tid >> 8) + 2 * k, L = i * F.G + F.vcu; if (L < 4 * nrt) F.MI[MI_TOK + i * 256 + (F.tid & 255)] = v[k]; } }
    __syncthreads();
    DownOrder S{(const char*)ws, F.MI, nrt_r, nrt, F.G, F.vcu};
    EpiScatter E{ws + WS_SLOT, F.MI};
    int Kk = DEXP; asm volatile("" : "+s"(Kk));
    pg8::gemm_phase<EpiScatter, DownOrder, false, false>(F.lds, F.tid, Kk, S, E);
}
__device__ __forceinline__ void moe_combine(Frame& F, const Args& A, int chunk, bool poison) {
    unsigned char* ws = F.ws;
    const float* mod = (const float*)(ws + WS_MOD); const unsigned char* SL = ws + WS_SLOT; const float* wts = (const float*)(ws + WS_WTS);
    const int gw = F.vcu * NWAVES + F.wave, NGW = F.G * NWAVES;
    f32x4 gpv[4];
#pragma unroll
    for (int j = 0; j < 4; ++j) gpv[j] = *(const f32x4*)(A.in[31] + 4 * F.lane + 256 * j);
    unsigned dA[9][4], dB[9][4]; v2u xA[4], xB[4];
#define CB_LOAD(tl_, d_, x_) do { const int t_ = __builtin_amdgcn_readfirstlane(tl_);        \
        _Pragma("unroll") for (int j = 0; j < 4; ++j) x_[j] = *((const GAS v2u*)(F.out + ((size_t)chunk * TC + t_) * D) + F.lane + 64 * j); \
        asm volatile("" ::: "memory"); \
        const GAS unsigned* b0_ = (const GAS unsigned*)(SL + (size_t)t_ * 8 * D) + F.lane; const GAS unsigned* b1_ = b0_ + 4 * (D / 4); \
        const GAS unsigned* b2_ = (const GAS unsigned*)(SL + ((size_t)TC * 8 + t_) * D) + F.lane;         \
        _Pragma("unroll") for (int k = 0; k < 9; ++k) \
            _Pragma("unroll") for (int j = 0; j < 4; ++j) d_[k][j] = (k < 4 ? b0_ : k < 8 ? b1_ : b2_)[(k < 8 ? (k & 3) : 0) * (D / 4) + 64 * j]; } while (0)
#define CB_REDUCE(tl_, d_, x_) do { const int t_ = __builtin_amdgcn_readfirstlane(tl_); const size_t m = (size_t)chunk * TC + t_; const int b = (int)(m / SEQ); \
        f32x4 gt[4]; _Pragma("unroll") for (int j = 0; j < 4; ++j) gt[j] = *(const f32x4*)(mod + b * 6 * D + 5 * D + 4 * F.lane + 256 * j); \
        const float wl_ = (F.lane < 8) ? wts[m * 8 + F.lane] : 1.0f;        \
        f32x4 y[4]; \
        _Pragma("unroll") for (int j = 0; j < 4; ++j) y[j] = (f32x4){0.f, 0.f, 0.f, 0.f}; \
        _Pragma("unroll") for (int k = 0; k < 9; ++k) { const float wk_ = (k < 8) ? rl_f(wl_, k) : 1.0f; _Pragma("unroll") for (int j = 0; j < 4; ++j) { const int dd = (int)d_[k][j]; \
            const auto lo_ = __builtin_amdgcn_cvt_pk_f32_fp8(dd, false); const auto hi_ = __builtin_amdgcn_cvt_pk_f32_fp8(dd, true); \
            y[j].x = __builtin_fmaf(lo_[0], wk_, y[j].x); y[j].y = __builtin_fmaf(lo_[1], wk_, y[j].y); y[j].z = __builtin_fmaf(hi_[0], wk_, y[j].z); y[j].w = __builtin_fmaf(hi_[1], wk_, y[j].w); } \
            __builtin_amdgcn_sched_barrier(0); } \
        _Pragma("unroll") for (int j = 0; j < 4; ++j) y[j] = y[j] * 0.0625f; \
        float s = 0.f; \
        _Pragma("unroll") for (int j = 0; j < 4; ++j) s += (y[j].x * y[j].x + y[j].y * y[j].y) + (y[j].z * y[j].z + y[j].w * y[j].w); \
        const float rstd = 1.f / sqrtf(wave_sum(s) * (1.f / D) + EPS); \
        asm volatile("" ::: "memory"); \
        _Pragma("unroll") for (int j = 0; j < 4; ++j) { f32x4* op = (f32x4*)(F.out + m * D) + F.lane + 64 * j; const v2u xb = x_[j]; \
            f32x4 o = (f32x4){bflo(xb.x), bfhi(xb.x), bflo(xb.y), bfhi(xb.y)} + gt[j] * (y[j] * rstd * gpv[j]); \
            if (poison) { const float q_ = __builtin_nanf(""); o = (f32x4){q_, q_, q_, q_}; } \
            *op = o; } } while (0)
    for (int tl = gw; tl < TC; tl += NGW) { CB_LOAD(tl, dA, xA); CB_REDUCE(tl, dA, xA); }
#undef CB_LOAD
#undef CB_REDUCE
}

__device__ __forceinline__ void attn_phase(Frame& F, const Args& A, char* lds_generic) {
    const attn_body::bf16* Q = (const attn_body::bf16*)(F.ws + WS_Q); const attn_body::bf16* K = (const attn_body::bf16*)(F.ws + WS_K); const attn_body::bf16* V = (const attn_body::bf16*)(F.ws + WS_V);
    attn_body::bf16* O = (attn_body::bf16*)(F.ws + WS_H);
    const float d1 = A.in[13][F.lane] * A.in[14][F.lane], d2 = A.in[15][F.lane] * A.in[16][F.lane];
    const float lam = expf(wave_sum(d1)) - expf(wave_sum(d2)) + LAM_INIT;
    const int npr = (BATCH * 16 - F.vcu + F.G - 1) / F.G;
#pragma unroll 1
    for (int it = 0; it < npr * 8; ++it) {
        const int pr = F.vcu + (it >> 3) * F.G, qi = (it >> 1) & 3, m = it & 1;
        const int pair = pr >> 1, st = pr & 1, b = pair >> 3, h = pair & 7;
        const int qb = st ? (qi == 0 ? 6 : qi == 1 ? 5 : qi == 2 ? 2 : 1) : (qi == 0 ? 7 : qi == 1 ? 4 : qi == 2 ? 3 : 0);
        const float sl2 = exp2f(-(float)(h + 1)) * LOG2E;
        if (m == 0) attn_body::attn_unit2<8, false>(F.tid, b, h, 0, qb, sl2, lam, A.in[17], Q, K, V, O, lds_generic);
        else        attn_body::attn_unit2<8, true >(F.tid, b, h, 1, qb, sl2, lam, A.in[17], Q, K, V, O, lds_generic);
    }
}

__global__ void __launch_bounds__(NWAVES * 64, 2) hybrid_fwd(Args args) {
    extern __shared__ __attribute__((aligned(16))) unsigned char lds[];
    Frame F;
    F.lds = (LAS unsigned char*)lds;
    F.MI = (volatile LAS int*)(F.lds + MISC_OFF);
    F.tid = threadIdx.x; F.lane = F.tid & 63; F.wave = __builtin_amdgcn_readfirstlane(F.tid >> 6);
    F.G = gridDim.x; { const int bx = blockIdx.x; F.vcu = (F.G % 8 == 0) ? (bx % 8) * (F.G / 8) + bx / 8 : bx; }
    unsigned char* ws = args.ws; F.ws = ws; F.out = args.out;
    F.ctl = (gu32*)(ws + WS_CTL);
    for (int u = F.tid; u < MI_WORDS; u += NWAVES * 64) F.MI[u] = 0;
    __syncthreads();
    XcdBarrier bar; bar.bar = (unsigned*)(F.ctl + CW_BAR); bar.x = 0; bar.st = nullptr;
    if (!PER_PHASE) bar = xcd_barrier_post((unsigned*)(F.ctl + CW_BAR), (volatile LAS unsigned*)(F.MI + MI_BARST));
    const int lo = args.ph_lo, hi = args.ph_hi;
#ifndef PH_MASK
#define PH_MASK 0xFFFFFFFFu
#endif
#ifndef PROBE_MASK
#define PROBE_MASK 0u
#endif
#define PSTAMP(k) do { if (PROBE_MASK != 0u && F.tid == 0) { const unsigned long long t_ = __builtin_amdgcn_s_memrealtime(); volatile LAS unsigned long long* pp_ = (volatile LAS unsigned long long*)(F.MI + 16); \
        if ((PROBE_MASK >> (k)) & 1u) pp_[1] += t_ - pp_[0]; pp_[0] = t_; } } while (0)
#define FRESH() do { unsigned char* w_ = args.ws; asm volatile("" : "+s"(w_)); F.ws = w_; ws = w_; F.ctl = (gu32*)(w_ + WS_CTL); int t_ = threadIdx.x; asm volatile("" : "+v"(t_)); F.tid = t_; F.lane = t_ & 63; F.wave = __builtin_amdgcn_readfirstlane(t_ >> 6); } while (0)
    if ((PROBE_MASK != 0u || PROBE_SEG != 0) && F.tid == 0) { volatile LAS unsigned long long* pp_ = (volatile LAS unsigned long long*)(F.MI + 16); pp_[0] = __builtin_amdgcn_s_memrealtime(); pp_[1] = 0ull; }
#define IN(k) (((PH_MASK >> (k)) & 1u) && lo <= (k) && (k) < hi)
#define SEAM(k) do { if (IN(k) && IN((k) + 1)) { if (PER_PHASE) { if (F.tid == 0) __hip_atomic_store(F.ctl + CW_TMO, 0xBADBA0u, RLX_AGENT); } else xcd_barrier(bar); } PSTAMP(k); } while (0)
    if (IN(0)) { FRESH(); p0_phase(F, args); } SEAM(0);
    if (IN(1)) { FRESH(); p1_phase(F, args); } SEAM(1);
    if (IN(2)) { FRESH(); p2_phase(F, args); } SEAM(2);
    if (IN(3)) { FRESH(); lru_phase(F, args); } if (PER_PHASE) { SEAM(3); } else { PSTAMP(3); }
    if (IN(4)) { FRESH(); attn_phase(F, args, (char*)lds); } SEAM(4);
    if (PER_PHASE) { SEAM(5); }
    if (IN(6)) { FRESH(); MergeOrder S; S.d.init(ws + WS_GR, ws + WS_WR, T, D, D, F.G, (int)blockIdx.x); S.A1 = (const char*)(ws + WS_H); S.B1 = (const char*)(ws + WS_WA);
        EpiGate E{(const unsigned char*)args.out, (const unsigned char*)args.out + (size_t)T * D, (bf16*)(ws + WS_V), (bf16*)(ws + WS_XR)};
        pg8::gemm_phase<EpiGate, MergeOrder, true, false>(F.lds, F.tid, D, S, E); } SEAM(6);
    if (IN(7)) { FRESH(); DenseOrder S; S.init(ws + WS_XR, ws + WS_WO, T, D, D, F.G, (int)blockIdx.x); EpiF32 E{(bf16*)(ws + WS_Y)};
        pg8::gemm_phase<EpiF32, DenseOrder, true, false>(F.lds, F.tid, D, S, E); } SEAM(7);
    if (IN(8)) { FRESH(); p8_phase(F, args); } SEAM(8);
#pragma unroll 1
    for (int c = 0; c < NCH; ++c) {
        const int pa = 9 + 2 * c, pb = 10 + 2 * c;
        if (IN(pa)) { FRESH(); if (c > 0) { int cm = c - 1; asm volatile("" : "+s"(cm)); moe_combine(F, args, cm, false); FRESH(); } int cu = c; asm volatile("" : "+s"(cu)); moe_up(F, cu); } SEAM(pa);
        if (IN(pb)) { FRESH(); int cd = c; asm volatile("" : "+s"(cd)); moe_down(F, cd); } SEAM(pb);
    }
    if (IN(9 + 2 * NCH)) { FRESH();
        bool poison = __hip_atomic_load(F.ctl + CW_TMO, RLX_AGENT) != 0u || __hip_atomic_load(F.ctl + CW_BAR + XB_TMO, RLX_AGENT) != 0u;
        moe_combine(F, args, NCH - 1, poison);
    }
    PSTAMP(17);
#undef IN
#undef SEAM
    if (PROBE_MASK != 0u || PROBE_SEG != 0) { __syncthreads(); if (F.tid == 0) { volatile LAS unsigned long long* pp_ = (volatile LAS unsigned long long*)(F.MI + 16);
        unsigned long long acc_ = pp_[1]; const unsigned long long t2_ = __builtin_amdgcn_s_memrealtime();
        while (__builtin_amdgcn_s_memrealtime() - t2_ < acc_) __builtin_amdgcn_s_sleep(8); } __syncthreads(); }
}

extern "C" void kernel_launch(void* const* d_in, const int* in_sizes, int n_in, void* d_out, int out_size, void* d_ws, size_t ws_size, hipStream_t stream) {
    static int grid = 0;
    if (grid == 0) {
        if (n_in != 32 || out_size != T * D || ws_size < WS_END) { fprintf(stderr, "kernel_launch: unexpected shapes (n_in %d, out %d, ws %zu); nothing launched\n", n_in, out_size, ws_size); grid = -1; return; }
        int dev = 0, cus = 0, per_cu = 0;
        if (hipGetDevice(&dev) != hipSuccess || hipDeviceGetAttribute(&cus, hipDeviceAttributeMultiprocessorCount, dev) != hipSuccess) { grid = -1; return; }
        if (hipFuncSetAttribute((const void*)hybrid_fwd, hipFuncAttributeMaxDynamicSharedMemorySize, LDS_BYTES) != hipSuccess) { fprintf(stderr, "kernel_launch: hipFuncSetAttribute failed\n"); grid = -1; return; }
        if (hipOccupancyMaxActiveBlocksPerMultiprocessor(&per_cu, (const void*)hybrid_fwd, NWAVES * 64, LDS_BYTES) != hipSuccess || per_cu < 1) { fprintf(stderr, "kernel_launch: occupancy query says %d blocks per CU\n", per_cu); per_cu = 1; }
        (void)hipGetLastError();
        grid = cus;
    }
    if (grid < 0) return;
    (void)hipMemsetAsync((char*)d_ws + WS_CTL, 0, CTL_ZERO_BYTES, stream);
    Args a{};
    for (int i = 0; i < 32; ++i) a.in[i] = (const float*)d_in[i];
    a.out = (float*)d_out; a.ws = (unsigned char*)d_ws;
    if (N_LAUNCHES == 1) { a.ph_lo = 0; a.ph_hi = N_PHASES; hipLaunchKernelGGL(hybrid_fwd, dim3(grid), dim3(NWAVES * 64), LDS_BYTES, stream, a); }
    else for (int p = 0; p < N_PHASES; ++p) { a.ph_lo = p; a.ph_hi = p + 1; hipLaunchKernelGGL(hybrid_fwd, dim3(grid), dim3(NWAVES * 64), LDS_BYTES, stream, a); }
}
```

```cpp
#include <hip/hip_runtime.h>
#include <hip/hip_bf16.h>
#include <cstdio>
#include <cstdint>
#include <cmath>

#ifndef MK_N_LAUNCHES
#define MK_N_LAUNCHES 1
#endif

constexpr int BATCH = 16, SEQ = 2048, D = 1024, T = BATCH * SEQ;
constexpr int W_IN = 7 * 1024;
constexpr int NEXP = 64, TOPK = 8, DEXP = 256;
constexpr int NCH = 2, TC = T / NCH;
constexpr float EPS = 1e-6f;
constexpr float LOG2E = 1.4426950408889634f;
constexpr float LAM_INIT = 0.2f;

namespace pg8 {
#define PG8_LAS __attribute__((address_space(3)))
typedef unsigned short bf16_t;
typedef short bf16x8 __attribute__((ext_vector_type(8)));
typedef float f32x4 __attribute__((ext_vector_type(4)));
typedef unsigned u32x4 __attribute__((ext_vector_type(4)));
constexpr int BM = 256, BK = 64, HALF = 128, HTB = HALF * BK * 2, STAGE_BYTES = 8 * HTB, NXCD = 8, WGM = 8;

__host__ __device__ __forceinline__ int lds_byte(int r, int c) { const int st = (r >> 4) * 2 + (c >> 5), rr = r & 15, cc = c & 31, ob = rr * 64 + cc * 2; return st * 1024 + (ob ^ (((ob >> 9) & 1) << 5)); }
__host__ __device__ __forceinline__ void stage_rc(int b, int& R, int& C) { const int st = b / 1024, sb = b % 1024, swz = sb ^ (((sb >> 9) & 1) << 5); R = (st >> 1) * 16 + swz / 64; C = (st & 1) * 32 + (swz % 64) / 2; }
__host__ __device__ __forceinline__ int perm32(int rho) { const int n = rho >> 4, i = rho & 15; return 8 * (i >> 2) + 4 * n + (i & 3); }

struct Unit { int pm, pn, z, e; };

__device__ __forceinline__ unsigned cvt_pk_bf16(float lo, float hi) { unsigned r; asm volatile("v_cvt_pk_bf16_f32 %0, %1, %2" : "=v"(r) : "v"(lo), "v"(hi)); return r; }
__device__ __forceinline__ float sigm(float x) { return __builtin_amdgcn_rcpf(1.0f + __builtin_amdgcn_exp2f(-LOG2E * x)); }
__device__ __forceinline__ float gelu_t(float x) { const float u = 0.7978845608028654f * (x + 0.044715f * x * x * x); return x * sigm(2.0f * u); }
__device__ __forceinline__ float bflo(unsigned w) { return __uint_as_float(w << 16); }
__device__ __forceinline__ float bfhi(unsigned w) { return __uint_as_float(w & 0xffff0000u); }

typedef int i32x4 __attribute__((ext_vector_type(4)));
template <class Epi, class Sched, bool ALIGN_EPI, bool GATHER, bool INT8 = false>
__device__ __forceinline__ void gemm_phase(PG8_LAS unsigned char* lds, const int tid, const int K, const Sched& S, const Epi& E) {
    const int wid = __builtin_amdgcn_readfirstlane(tid >> 6), lane = tid & 63, wr = wid >> 2, wc = wid & 3, fr = lane & 15, fq = lane >> 4;
    const int nt = K / BK;
    unsigned voffA[2], voffB[2];
#pragma unroll
    for (int i = 0; i < 2; ++i) { int R, C; stage_rc(tid * 16 + i * 8192, R, C); const int Rb = Epi::PERM ? ((R & ~31) + perm32(R & 31)) : R;
        voffA[i] = (unsigned)(R * K + C) * 2u; voffB[i] = (unsigned)(Rb * K + C) * 2u; }
    const size_t kstep = (size_t)(BK * 2);
    const size_t hstep = (size_t)HALF * K * 2;
    const unsigned ldsw = (unsigned)wid * 1024u;
    const int aoff = lds_byte(wr * 64 + fr, fq * 8), boff = lds_byte(wc * 32 + fr, fq * 8);
#define PG8_SA(b, h) (((b) * 2 + (h)) * HTB)
#define PG8_SB(b, h) ((4 + (b) * 2 + (h)) * HTB)
#define PG8_STAGE(bufoff, gbase, voff) do { _Pragma("unroll") for (int _i = 0; _i < 2; ++_i) \
        __builtin_amdgcn_global_load_lds((const unsigned*)((const char*)(gbase) + (voff)[_i]), (PG8_LAS unsigned*)(lds + (bufoff) + ldsw + _i * 8192), 16, 0, 0); } while (0)
#define PG8_STAGE_A(bufoff, p, h, VG) do { if constexpr (GATHER) { PG8_STAGE(bufoff, p, VG[h]); } else { PG8_STAGE(bufoff, (p) + (h) * hstep, voffA); } } while (0)
#define PG8_LDA(dst, b, h) do { _Pragma("unroll") for (int m = 0; m < 4; ++m) _Pragma("unroll") for (int k = 0; k < 2; ++k) dst[m][k] = *(const PG8_LAS bf16x8*)(lds + PG8_SA(b, h) + aoff + m * 2048 + k * 1024); } while (0)
#define PG8_LDB(dst, b, h) do { _Pragma("unroll") for (int n = 0; n < 2; ++n) _Pragma("unroll") for (int k = 0; k < 2; ++k) dst[n][k] = *(const PG8_LAS bf16x8*)(lds + PG8_SB(b, h) + boff + n * 2048 + k * 1024); } while (0)
#define PG8_MMA(ai, bj, At, Bt) do { __builtin_amdgcn_s_setprio(1); _Pragma("unroll") for (int m = 0; m < 4; ++m) _Pragma("unroll") for (int n = 0; n < 2; ++n) _Pragma("unroll") for (int k = 0; k < 2; ++k) \
        { if constexpr (INT8) acc[ai][bj][m][n] = __builtin_bit_cast(f32x4, __builtin_amdgcn_mfma_i32_16x16x64_i8(__builtin_bit_cast(i32x4, Bt[n][k]), __builtin_bit_cast(i32x4, At[m][k]), __builtin_bit_cast(i32x4, acc[ai][bj][m][n]), 0, 0, 0)); \
          else acc[ai][bj][m][n] = __builtin_amdgcn_mfma_f32_16x16x32_bf16(Bt[n][k], At[m][k], acc[ai][bj][m][n], 0, 0, 0); } __builtin_amdgcn_s_setprio(0); } while (0)
#define PG8_WAIT_V(n) asm volatile("s_waitcnt vmcnt(" #n ")" ::: "memory")
#define PG8_WAIT_L(n) asm volatile("s_waitcnt lgkmcnt(" #n ")" ::: "memory")
#define PG8_BAR __builtin_amdgcn_s_barrier()
#define PG8_SCHED __builtin_amdgcn_sched_barrier(0)
#define PG8_LOADVG(VG, ui_) do { if constexpr (GATHER) { _Pragma("unroll") for (int h_ = 0; h_ < 2; ++h_) _Pragma("unroll") for (int i_ = 0; i_ < 2; ++i_) \
        { int R_, C_; stage_rc(tid * 16 + i_ * 8192, R_, C_); VG[h_][i_] = ((unsigned)S.tok((ui_), h_ * HALF + R_) * (unsigned)K + (unsigned)C_) * 2u; } } } while (0)
    Unit cur, nxt; int ui = 0;
    if (!S.next(0, cur)) return;
    f32x4 acc[2][2][4][2];
#pragma unroll
    for (int a = 0; a < 2; ++a)
#pragma unroll
        for (int b = 0; b < 2; ++b)
#pragma unroll
            for (int m = 0; m < 4; ++m)
#pragma unroll
                for (int n = 0; n < 2; ++n) acc[a][b][m][n] = (f32x4){0.f, 0.f, 0.f, 0.f};
    bf16x8 At[4][2], B0[2][2], B1[2][2];
    unsigned vgc[2][2];
#pragma unroll
    for (int h_ = 0; h_ < 2; ++h_)
#pragma unroll
        for (int i_ = 0; i_ < 2; ++i_) vgc[h_][i_] = 0u;
    PG8_LOADVG(vgc, 0);
    const char *cA, *cB; S.bases(cur, cA, cB);
    PG8_STAGE(PG8_SB(0, 0), cB, voffB); PG8_STAGE(PG8_SB(0, 1), cB + hstep, voffB); PG8_STAGE_A(PG8_SA(0, 0), cA, 0, vgc); PG8_STAGE_A(PG8_SA(0, 1), cA, 1, vgc);
    if (wr == 1) PG8_BAR;
    PG8_WAIT_V(2); PG8_BAR;
    PG8_STAGE(PG8_SB(1, 0), cB + kstep, voffB); PG8_STAGE_A(PG8_SA(1, 0), cA + kstep, 0, vgc); PG8_STAGE(PG8_SB(1, 1), cB + hstep + kstep, voffB);
    PG8_WAIT_V(6); PG8_BAR;
    for (;;) {
        const bool has_next = S.next(ui + 1, nxt);
        const char *nA = cA, *nB = cB;
        if (has_next) S.bases(nxt, nA, nB);
        for (int t = 0; t < nt; t += 2) {
            const bool last = (t == nt - 2);
            const char* a1 = cA + (size_t)(t + 1) * kstep;
            const char* a2 = last ? nA : cA + (size_t)(t + 2) * kstep; const char* b2 = last ? nB : cB + (size_t)(t + 2) * kstep;
            const char* a3 = a2 + kstep; const char* b3 = b2 + kstep;
            unsigned vgs[2][2];
#pragma unroll
            for (int h_ = 0; h_ < 2; ++h_)
#pragma unroll
                for (int i_ = 0; i_ < 2; ++i_) vgs[h_][i_] = vgc[h_][i_];
            if (last && has_next) PG8_LOADVG(vgs, ui + 1);
            PG8_LDB(B0, 0, 0); PG8_LDB(B1, 0, 1); PG8_SCHED; PG8_LDA(At, 0, 0); PG8_STAGE_A(PG8_SA(1, 1), a1, 1, vgc);
            PG8_WAIT_V(8); PG8_WAIT_L(0); PG8_BAR; PG8_MMA(0, 0, At, B0); PG8_MMA(0, 1, At, B1); PG8_BAR; PG8_SCHED;
            PG8_LDA(At, 0, 1); PG8_STAGE(PG8_SB(0, 0), b2, voffB); PG8_STAGE(PG8_SB(0, 1), b2 + hstep, voffB); PG8_STAGE_A(PG8_SA(0, 0), a2, 0, vgs);
            PG8_WAIT_V(8); PG8_WAIT_L(0); PG8_BAR; PG8_MMA(1, 0, At, B0); PG8_MMA(1, 1, At, B1); PG8_BAR; PG8_SCHED;
            PG8_LDB(B0, 1, 0); PG8_LDB(B1, 1, 1); PG8_SCHED; PG8_LDA(At, 1, 0); PG8_STAGE_A(PG8_SA(0, 1), a2, 1, vgs);
            PG8_WAIT_V(8); PG8_WAIT_L(0); PG8_BAR; PG8_MMA(0, 0, At, B0); PG8_MMA(0, 1, At, B1); PG8_BAR; PG8_SCHED;
            PG8_LDA(At, 1, 1); PG8_STAGE(PG8_SB(1, 0), b3, voffB); PG8_STAGE(PG8_SB(1, 1), b3 + hstep, voffB); PG8_STAGE_A(PG8_SA(1, 0), a3, 0, vgs);
            PG8_WAIT_V(8); PG8_WAIT_L(0); PG8_BAR; PG8_MMA(1, 0, At, B0); PG8_MMA(1, 1, At, B1); PG8_BAR; PG8_SCHED;
        }
        if constexpr (ALIGN_EPI) { if (wr == 0) PG8_BAR; }
        E(acc, cur, wr, wc, fr, fq);
#ifdef PROBE_EPI2
        if (Epi::TWICE) { asm volatile("" ::: "memory"); E(acc, cur, wr, wc, fr, fq); }
#endif
        if (!has_next) break;
#pragma unroll
        for (int a = 0; a < 2; ++a)
#pragma unroll
            for (int b = 0; b < 2; ++b)
#pragma unroll
                for (int m = 0; m < 4; ++m)
#pragma unroll
                    for (int n = 0; n < 2; ++n) acc[a][b][m][n] = (f32x4){0.f, 0.f, 0.f, 0.f};
        cur = nxt; cA = nA; cB = nB; ++ui;
        PG8_LOADVG(vgc, ui);
        if constexpr (ALIGN_EPI) { if (wr == 1) PG8_BAR; }
    }
    PG8_WAIT_V(0);
    if constexpr (!ALIGN_EPI) { if (wr == 0) PG8_BAR; }
    PG8_BAR;
#undef PG8_SA
#undef PG8_SB
#undef PG8_STAGE
#undef PG8_STAGE_A
#undef PG8_LDA
#undef PG8_LDB
#undef PG8_MMA
#undef PG8_WAIT_V
#undef PG8_WAIT_L
#undef PG8_BAR
#undef PG8_SCHED
#undef PG8_LOADVG
}
}

namespace attn_body {
using bf16=__hip_bfloat16;
using bf16x8=__attribute__((ext_vector_type(8)))short;
using s16x4=__attribute__((ext_vector_type(4)))short;
using f32x16=__attribute__((ext_vector_type(16)))float;
using u32x4=__attribute__((ext_vector_type(4)))unsigned;
constexpr int NHEAD=16,SEQ=2048,D=64,DM=NHEAD*D;
constexpr int NW=8,QBLK=32,QB=QBLK*NW,KVBLK=64,NQB=SEQ/QB;
__device__ __forceinline__ int crow(int r,int hi){return (r&3)+8*(r>>2)+4*hi;}
#define SBAR() __builtin_amdgcn_sched_barrier(0)
__device__ __forceinline__ void cmask(f32x16&p0,f32x16&p1,int jb,int qrel,int hi){
  const float NEG=-INFINITY; const int dq=qrel-(64*jb+4*hi);
  #pragma unroll
  for(int r=0;r<16;++r){const int kc=(r&3)+8*(r>>2); if(kc>dq)p0[r]=NEG; if(kc+32>dq)p1[r]=NEG;}
}
__device__ __forceinline__ void cinit(f32x16&p0,f32x16&p1,float sl2,float nv){
  #pragma unroll
  for(int r=0;r<16;++r){const float c=(float)((r&3)+8*(r>>2)); p0[r]=__builtin_fmaf(sl2,c,nv); p1[r]=__builtin_fmaf(sl2,c+32.0f,nv);}
}
#define CI_C(r) ((float)(((r)&3)+8*((r)>>2)))

constexpr int NSLOT=3, SLOTB=8192;
constexpr int LDS_K=0, LDS_V=NSLOT*SLOTB, LDS_WS=2*NSLOT*SLOTB, LDS_OST=LDS_WS+NW*64*4, LDS_BYTES=LDS_OST+NW*4096;
constexpr float C2=0.125f*1.4426950408889634f;
__device__ __forceinline__ void glds16(const void*gsrc,unsigned lds_dst){unsigned keep;
  asm volatile("s_mov_b32 %0, m0\n\ts_mov_b32 m0, %2\n\ts_nop 0\n\tglobal_load_lds_dwordx4 %1, off\n\ts_mov_b32 m0, %0":"=&s"(keep):"v"(gsrc),"s"(lds_dst):"memory");}
__device__ __forceinline__ float max3f(float a,float b,float c){float r;asm("v_max3_f32 %0, %1, %2, %3":"=v"(r):"v"(a),"v"(b),"v"(c));return r;}
__device__ __forceinline__ float max2f(float a,float b){float r;asm("v_max_f32_e32 %0, %1, %2":"=v"(r):"v"(a),"v"(b));return r;}
__device__ __forceinline__ float fadd_s(float a,float b){float r;asm("v_add_f32_e32 %0, %1, %2":"=v"(r):"v"(a),"v"(b));return r;}
__device__ __forceinline__ float fsub_s(float a,float b){float r;asm("v_sub_f32_e32 %0, %1, %2":"=v"(r):"v"(a),"v"(b));return r;}
typedef float f32x2_t __attribute__((ext_vector_type(2))); typedef __bf16 bf16x2_t __attribute__((ext_vector_type(2)));
__device__ __forceinline__ unsigned cvtpk_s(float lo,float hi){f32x2_t v={lo,hi};bf16x2_t b=__builtin_convertvector(v,bf16x2_t);return __builtin_bit_cast(unsigned,b);}
#define WAIT_BAR(N) asm volatile("s_waitcnt vmcnt(" #N ") lgkmcnt(0)\n\ts_barrier":::"memory")

__device__ __forceinline__ void qkt(f32x16&p0,f32x16&p1,const char*Kslot,const bf16x8*qr,int r32,int hi){
  const char*kb=Kslot+hi*1024+r32*16;
  #pragma unroll
  for(int d0=0;d0<4;++d0){
    const bf16x8 b0=*reinterpret_cast<const bf16x8*>(kb+d0*2048);
    const bf16x8 b1=*reinterpret_cast<const bf16x8*>(kb+d0*2048+512);
    p0=__builtin_amdgcn_mfma_f32_32x32x16_bf16(b0,qr[d0],p0,0,0,0);p1=__builtin_amdgcn_mfma_f32_32x32x16_bf16(b1,qr[d0],p1,0,0,0);}
}
typedef __attribute__((address_space(3))) const char* lds_cptr;
typedef short v4i16_t __attribute__((ext_vector_type(4)));
__device__ __forceinline__ void kload8(bf16x8*kf,lds_cptr kp){
  kf[0]=*(const __attribute__((address_space(3))) bf16x8*)(kp);      kf[1]=*(const __attribute__((address_space(3))) bf16x8*)(kp+512);
  kf[2]=*(const __attribute__((address_space(3))) bf16x8*)(kp+2048); kf[3]=*(const __attribute__((address_space(3))) bf16x8*)(kp+2560);
  kf[4]=*(const __attribute__((address_space(3))) bf16x8*)(kp+4096); kf[5]=*(const __attribute__((address_space(3))) bf16x8*)(kp+4608);
  kf[6]=*(const __attribute__((address_space(3))) bf16x8*)(kp+6144); kf[7]=*(const __attribute__((address_space(3))) bf16x8*)(kp+6656);
}
__device__ __forceinline__ void kload2(bf16x8*kf,lds_cptr kp,int j){ kf[2*j]=*(const __attribute__((address_space(3))) bf16x8*)(kp+j*2048); kf[2*j+1]=*(const __attribute__((address_space(3))) bf16x8*)(kp+j*2048+512); }
__device__ __forceinline__ s16x4 vtr(lds_cptr p){ return __builtin_bit_cast(s16x4,__builtin_amdgcn_ds_read_tr16_b64_v4i16((__attribute__((address_space(3))) v4i16_t*)p)); }
__device__ __forceinline__ float rowmax(const f32x16&p0,const f32x16&p1){
  float a=max3f(p0[0],p0[1],p1[0]),b=max3f(p0[2],p0[3],p1[1]);a=max3f(a,p1[2],p1[3]);
  #pragma unroll
  for(int r=4;r<16;r+=4){a=max3f(a,p0[r],p0[r+1]);b=max3f(b,p0[r+2],p0[r+3]);a=max3f(a,p1[r],p1[r+1]);b=max3f(b,p1[r+2],p1[r+3]);}
  const float m=max2f(a,b);
  auto rr=__builtin_amdgcn_permlane32_swap(__float_as_uint(m),__float_as_uint(m),false,false);
  return max2f(__uint_as_float(rr[0]),__uint_as_float(rr[1]));
}
__device__ __forceinline__ void pv(f32x16*o,int vb,bf16x8 pa0,bf16x8 pa1,bf16x8 pa2,bf16x8 pa3){
  #pragma unroll
  for(int d0=0;d0<2;++d0){s16x4 lo[4],hi[4];
    #pragma unroll
    for(int ks=0;ks<4;++ks){
      asm volatile("ds_read_b64_tr_b16 %0,%1 offset:%c2":"=&v"(lo[ks]):"v"(vb),"i"(d0*4096+ks*1024):"memory");
      asm volatile("ds_read_b64_tr_b16 %0,%1 offset:%c2":"=&v"(hi[ks]):"v"(vb),"i"(d0*4096+ks*1024+512):"memory");}
    asm volatile("s_waitcnt lgkmcnt(0)":::"memory");SBAR();
    #define PK(k) (bf16x8){lo[k][0],lo[k][1],lo[k][2],lo[k][3],hi[k][0],hi[k][1],hi[k][2],hi[k][3]}
    o[d0]=__builtin_amdgcn_mfma_f32_32x32x16_bf16(pa0,PK(0),o[d0],0,0,0);
    o[d0]=__builtin_amdgcn_mfma_f32_32x32x16_bf16(pa1,PK(1),o[d0],0,0,0);
    o[d0]=__builtin_amdgcn_mfma_f32_32x32x16_bf16(pa2,PK(2),o[d0],0,0,0);
    o[d0]=__builtin_amdgcn_mfma_f32_32x32x16_bf16(pa3,PK(3),o[d0],0,0,0);
    #undef PK
  }
}
#define ATTN_STORE16(p,v) (*(u32x4*)(p)=(v))
constexpr int LDS_K2=0, LDS_V2=4*8192, LDS_WS2=LDS_V2+3*16384, LDS_OST2=LDS_WS2+NW*64*4, LDS_BYTES2=LDS_OST2+NW*4096;
__device__ __forceinline__ void pv4(f32x16*o,int vb,bf16x8 pa0,bf16x8 pa1,bf16x8 pa2,bf16x8 pa3){
  #pragma unroll
  for(int d0=0;d0<4;++d0){s16x4 lo[4],hi[4];
    #pragma unroll
    for(int ks=0;ks<4;++ks){
      asm volatile("ds_read_b64_tr_b16 %0,%1 offset:%c2":"=&v"(lo[ks]):"v"(vb),"i"(d0*4096+ks*1024):"memory");
      asm volatile("ds_read_b64_tr_b16 %0,%1 offset:%c2":"=&v"(hi[ks]):"v"(vb),"i"(d0*4096+ks*1024+512):"memory");}
    asm volatile("s_waitcnt lgkmcnt(0)":::"memory");SBAR();
    #define PK(k) (bf16x8){lo[k][0],lo[k][1],lo[k][2],lo[k][3],hi[k][0],hi[k][1],hi[k][2],hi[k][3]}
    o[d0]=__builtin_amdgcn_mfma_f32_32x32x16_bf16(pa0,PK(0),o[d0],0,0,0);
    o[d0]=__builtin_amdgcn_mfma_f32_32x32x16_bf16(pa1,PK(1),o[d0],0,0,0);
    o[d0]=__builtin_amdgcn_mfma_f32_32x32x16_bf16(pa2,PK(2),o[d0],0,0,0);
    o[d0]=__builtin_amdgcn_mfma_f32_32x32x16_bf16(pa3,PK(3),o[d0],0,0,0);
    #undef PK
  }
}
template<int THRL,bool FUSE> __device__ __forceinline__ void attn_unit2(const int tid,int b,int h,int m,int qb,float sl2,float lam,const float*gsub,const bf16*Q,const bf16*__restrict__ K,const bf16*__restrict__ V,bf16*O,char*shm){
  const int lane=tid&63,r32=lane&31,hi=lane>>5; const int wid=__builtin_amdgcn_readfirstlane(tid>>6);
  const long rowbase=(long)b*SEQ; const int q0=qb*QB;
  const bf16*Qw=Q+(rowbase+q0+wid*QBLK)*DM+(2*h+m)*D;
  const bf16*Kh=K+rowbase*DM+(2*h+m)*D,*Vh=V+rowbase*DM+2*h*D;
  const unsigned lds0=(unsigned)(uintptr_t)shm;
  float*wsf=(float*)(shm+LDS_WS2)+wid*64;
  const bf16*ksrc=Kh+(long)lane*DM+wid*8;
  const bf16*vsrc=Vh+(long)(16*(wid&3)+(lane>>2))*DM+(wid>>2)*32+(lane&3)*8;
  const unsigned kdst=lds0+LDS_K2+wid*1024, vdst=lds0+LDS_V2+wid*1024;
  #define DMA_K(t,slot) glds16(ksrc+(long)(t)*KVBLK*DM,(unsigned)__builtin_amdgcn_readfirstlane(kdst+(slot)))
  #define DMA_V(t,slot) do{ glds16(vsrc+(long)(t)*KVBLK*DM,(unsigned)__builtin_amdgcn_readfirstlane(vdst+2*(slot))); glds16(vsrc+(long)(t)*KVBLK*DM+64,(unsigned)__builtin_amdgcn_readfirstlane(vdst+2*(slot)+8192)); }while(0)
  const int vb0=(int)(lds0+LDS_V2)+((lane>>4)&1)*32+(lane&3)*8+(4*hi+((lane&15)>>2))*64;
  const char*Kbase=shm+LDS_K2;
  const lds_cptr shm3=(lds_cptr)shm; const lds_cptr kp0=shm3+LDS_K2+hi*1024+r32*16; const lds_cptr vp0=shm3+LDS_V2+((lane>>4)&1)*32+(lane&3)*8+(4*hi+((lane&15)>>2))*64;
  const int NT=(q0+QB)/KVBLK;
  const unsigned qdst=lds0+LDS_OST2+wid*4096;
  #pragma unroll
  for(int d0=0;d0<4;++d0)glds16(&Qw[(long)r32*DM+d0*16+hi*8],(unsigned)__builtin_amdgcn_readfirstlane(qdst+d0*1024));
  DMA_K(0,0);DMA_V(0,0);DMA_K(1,SLOTB);
  const lds_cptr qp0=(lds_cptr)shm+LDS_OST2+wid*4096+lane*16;
  #define QF(d0) (*(const __attribute__((address_space(3))) bf16x8*)(qp0+(d0)*1024))
  const float tb0=sl2*(float)(4*hi);
  float mhat=0.f,l_reg=0.f;f32x16 o[4];o[0]=f32x16{};o[1]=f32x16{};o[2]=f32x16{};o[3]=f32x16{};
  const int qrel=wid*QBLK+r32;
  #define CMASK(P0,P1,t) do{int jb_=(t)-(NT-4); if(jb_>=0)cmask(P0,P1,jb_,qrel,hi);}while(0)
  #define NVAL(tt) (__builtin_fmaf(sl2,(float)(64*(tt)),tb0)-mhat)
  bool resc=false;
  #define START(P0,P1) do{ const float rm=rowmax(P0,P1); resc=false; \
    { const float dl=rm; mhat=fadd_s(mhat,dl); \
      _Pragma("unroll") for(int r=0;r<16;++r){P0[r]=fsub_s(P0[r],dl);P1[r]=fsub_s(P1[r],dl);} } \
    _Pragma("unroll") for(int r=0;r<16;++r)P0[r]=__builtin_amdgcn_exp2f(P0[r]); }while(0)
  #define RESC() do{ if(resc){ asm volatile("s_waitcnt lgkmcnt(0)":::"memory"); \
      _Pragma("unroll") for(int d_=0;d_<4;++d_) _Pragma("unroll") for(int r=0;r<16;++r)o[d_][r]*=wsf[crow(r,hi)]; } }while(0)
  f32x16 pA0,pA1,pB0,pB1;
  int sl_prev=0,sl_cur=0,sl_next=SLOTB,ks_cur=0;
  #define ROT() do{sl_prev=sl_cur;sl_cur=sl_next;sl_next=(sl_next==(NSLOT-1)*SLOTB)?0:sl_next+SLOTB;ks_cur=(ks_cur+SLOTB)&(4*SLOTB-1);}while(0)
  DMA_K(2,2*SLOTB);
  WAIT_BAR(4);
  cinit(pA0,pA1,sl2,tb0);
  { bf16x8 qr[4];
    #pragma unroll
    for(int d0=0;d0<4;++d0)qr[d0]=QF(d0);
    qkt(pA0,pA1,Kbase,qr,r32,hi); }asm volatile("s_nop 15\n\ts_nop 7":"+v"(pA0),"+v"(pA1));CMASK(pA0,pA1,0);
  START(pA0,pA1);
  cinit(pB0,pB1,sl2,NVAL(1));
  _Pragma("unroll") for(int r=0;r<16;++r)pA1[r]=__builtin_amdgcn_exp2f(pA1[r]);
  WAIT_BAR(0);
  DMA_K(3,3*SLOTB);DMA_V(1,SLOTB);
  ROT();
  WAIT_BAR(3);
  s16x4 vlo[8],vhi[8]; u32x4 pw0,pw1,pw2,pw3;
  bf16x8 nka=*(const __attribute__((address_space(3))) bf16x8*)(kp0+ks_cur),nkb=*(const __attribute__((address_space(3))) bf16x8*)(kp0+ks_cur+512),nqa=QF(0),nqb=QF(1);
  #define PKW(P,B) cvtpk_s(P[B],P[B+1])
  #define PAF(k) __builtin_bit_cast(bf16x8,pw##k)
  #define VFR(i) (bf16x8){vlo[(i)&7][0],vlo[(i)&7][1],vlo[(i)&7][2],vlo[(i)&7][3],vhi[(i)&7][0],vhi[(i)&7][1],vhi[(i)&7][2],vhi[(i)&7][3]}
  #define PIN(x) asm volatile("":"+v"(x))
  #define MX3(a,b,c) __builtin_fmaxf(__builtin_fmaxf((a),(b)),(c))
  #define GAPA(MF,A0,A1,A2,A3,W0,W1,PW) do{ MF; sacc+=A0; sacc+=A1; sacc+=A2; sacc+=A3; PIN(sacc); W0; W1; PIN(PW); SBAR(); }while(0)
  #define EX(v) __builtin_amdgcn_exp2f(v)
  #define VRD(f) do{ vlo[(f)&7]=vtr(vp_+(((f)&3)*4096+((f)>>2)*1024)); vhi[(f)&7]=vtr(vp_+(((f)&3)*4096+((f)>>2)*1024+512)); }while(0)
  #define GAPB(f,X,B,Y,OFS) do{ o[(f)&3]=__builtin_amdgcn_mfma_f32_32x32x16_bf16(__builtin_bit_cast(bf16x8,(f)<4?pw0:(f)<8?pw1:(f)<12?pw2:pw3),VFR(f),o[(f)&3],0,0,0); \
    X[B]=EX(X[B]); X[B+1]=EX(X[B+1]); PIN(X); \
    Y[B]=__builtin_fmaf(sl2,CI_C(B)+OFS,nvn); Y[B+1]=__builtin_fmaf(sl2,CI_C(B+1)+OFS,nvn); \
    if((f)+4<16){VRD((f)+4);} SBAR(); }while(0)
  #define KF(j) (*(const __attribute__((address_space(3))) bf16x8*)(kp_+((j)>>1)*2048+((j)&1)*512))
  #define STEP(C0,C1,P0,P1,t,GK,GV,GL) do{ SBAR(); \
    const lds_cptr vp_=vp0+2*sl_prev; const lds_cptr kp_=kp0+ks_cur; \
    bf16x8 ka=nka,kb=nkb,qa=nqa,qb_=nqb; SBAR(); \
    float sacc=(P0[0]+P0[1]); \
    GAPA(C0=__builtin_amdgcn_mfma_f32_32x32x16_bf16(ka,qa,C0,0,0,0), P0[2],P0[3],P0[4],P0[5],     pw0[0]=PKW(P0,0), pw0[1]=PKW(P0,2), pw0); \
    ka=KF(2); SBAR(); \
    GAPA(C1=__builtin_amdgcn_mfma_f32_32x32x16_bf16(kb,qa,C1,0,0,0), P0[6],P0[7],P0[8],P0[9],     pw0[2]=PKW(P0,4), pw0[3]=PKW(P0,6), pw0); \
    kb=KF(3); qa=QF(2); SBAR(); \
    GAPA(C0=__builtin_amdgcn_mfma_f32_32x32x16_bf16(ka,qb_,C0,0,0,0),   P0[10],P0[11],P0[12],P0[13], pw1[0]=PKW(P0,8), pw1[1]=PKW(P0,10), pw1); \
    ka=KF(4); SBAR(); \
    GAPA(C1=__builtin_amdgcn_mfma_f32_32x32x16_bf16(kb,qb_,C1,0,0,0),   P0[14],P0[15],P1[0],P1[1],   pw1[2]=PKW(P0,12),pw1[3]=PKW(P0,14), pw1); \
    kb=KF(5); qb_=QF(3); VRD(0); SBAR(); \
    GAPA(C0=__builtin_amdgcn_mfma_f32_32x32x16_bf16(ka,qa,C0,0,0,0),   P1[2],P1[3],P1[4],P1[5],     pw2[0]=PKW(P1,0), pw2[1]=PKW(P1,2), pw2); \
    ka=KF(6); VRD(1); SBAR(); \
    GAPA(C1=__builtin_amdgcn_mfma_f32_32x32x16_bf16(kb,qa,C1,0,0,0),   P1[6],P1[7],P1[8],P1[9],     pw2[2]=PKW(P1,4), pw2[3]=PKW(P1,6), pw2); \
    kb=KF(7); VRD(2); SBAR(); \
    GAPA(C0=__builtin_amdgcn_mfma_f32_32x32x16_bf16(ka,qb_,C0,0,0,0),   P1[10],P1[11],P1[12],P1[13], pw3[0]=PKW(P1,8), pw3[1]=PKW(P1,10), pw3); \
    VRD(3); SBAR(); \
    GAPA(C1=__builtin_amdgcn_mfma_f32_32x32x16_bf16(kb,qb_,C1,0,0,0),   P1[14],P1[15],0.f,0.f,       pw3[2]=PKW(P1,12),pw3[3]=PKW(P1,14), pw3); \
    l_reg+=sacc; \
    if(GK){DMA_K((t)+3,(ks_cur+3*SLOTB)&(4*SLOTB-1));} if(GV){DMA_V((t)+1,sl_next);} \
    CMASK(C0,C1,t); \
    float nvn; \
    { float a=MX3(C0[0],C0[1],C1[0]),b=MX3(C0[2],C0[3],C1[1]); a=MX3(a,C1[2],C1[3]); \
      _Pragma("unroll") for(int r=4;r<16;r+=4){a=MX3(a,C0[r],C0[r+1]);b=MX3(b,C0[r+2],C0[r+3]);a=MX3(a,C1[r],C1[r+1]);b=MX3(b,C1[r+2],C1[r+3]);} \
      float rm=__builtin_fmaxf(a,b); { auto rr=__builtin_amdgcn_permlane32_swap(__float_as_uint(rm),__float_as_uint(rm),false,false); rm=__builtin_fmaxf(__uint_as_float(rr[0]),__uint_as_float(rr[1])); } \
      resc=false; \
      if(__builtin_expect(__any(rm>(float)THRL),0)){ const float dl=__builtin_fmaxf(rm,0.f); mhat+=dl; \
        _Pragma("unroll") for(int r=0;r<16;++r){C0[r]-=dl;C1[r]-=dl;} \
        const float f=__builtin_amdgcn_exp2f(-dl); l_reg*=f; if(hi==0)wsf[r32]=f; resc=true; } \
      nvn=NVAL((t)+1); } \
    SBAR(); \
    GAPB(0,C0,0,P0,0.0f); GAPB(1,C0,2,P0,0.0f); GAPB(2,C0,4,P0,0.0f); GAPB(3,C0,6,P0,0.0f); \
    GAPB(4,C0,8,P0,0.0f); GAPB(5,C0,10,P0,0.0f); GAPB(6,C0,12,P0,0.0f); GAPB(7,C0,14,P0,0.0f); \
    GAPB(8,C1,0,P1,32.0f); GAPB(9,C1,2,P1,32.0f); GAPB(10,C1,4,P1,32.0f); GAPB(11,C1,6,P1,32.0f); \
    GAPB(12,C1,8,P1,32.0f); GAPB(13,C1,10,P1,32.0f); GAPB(14,C1,12,P1,32.0f); \
    { const lds_cptr kn_=kp0+((ks_cur+SLOTB)&(4*SLOTB-1)); nka=*(const __attribute__((address_space(3))) bf16x8*)(kn_); nkb=*(const __attribute__((address_space(3))) bf16x8*)(kn_+512); nqa=QF(0); nqb=QF(1); SBAR(); } \
    GAPB(15,C1,14,P1,32.0f); \
    }while(0)
  int t=1;
  #undef CMASK
  #define CMASK(P0,P1,t) do{}while(0)
  for(;t+5<NT;t+=2){
    STEP(pB0,pB1,pA0,pA1,t,true,true,true);     WAIT_BAR(3); RESC(); ROT();
    STEP(pA0,pA1,pB0,pB1,t+1,true,true,true);   WAIT_BAR(3); RESC(); ROT();
  }
  #undef CMASK
  #define CMASK(P0,P1,t) do{int jb_=(t)-(NT-4); if(jb_>=0)cmask(P0,P1,jb_,qrel,hi);}while(0)
  #define ENDW(tt) do{ if((tt)+3<NT){WAIT_BAR(3);} else if((tt)+2<NT){WAIT_BAR(2);} else {WAIT_BAR(0);} }while(0)
  for(;t+1<NT;t+=2){
    STEP(pB0,pB1,pA0,pA1,t,(t+3<NT),(t+1<NT),(t+1<NT));       ENDW(t);   RESC(); ROT();
    STEP(pA0,pA1,pB0,pB1,t+1,(t+4<NT),(t+2<NT),(t+2<NT));     ENDW(t+1); RESC(); ROT();
  }
  STEP(pB0,pB1,pA0,pA1,NT-1,false,false,false); RESC();
  { float sacc=pB0[0]+pB0[1]; _Pragma("unroll") for(int r=2;r<16;++r)sacc+=pB0[r]; _Pragma("unroll") for(int r=0;r<16;++r)sacc+=pB1[r]; l_reg+=sacc;
    pw0=(u32x4){PKW(pB0,0),PKW(pB0,2),PKW(pB0,4),PKW(pB0,6)};pw1=(u32x4){PKW(pB0,8),PKW(pB0,10),PKW(pB0,12),PKW(pB0,14)};pw2=(u32x4){PKW(pB1,0),PKW(pB1,2),PKW(pB1,4),PKW(pB1,6)};pw3=(u32x4){PKW(pB1,8),PKW(pB1,10),PKW(pB1,12),PKW(pB1,14)};
    SBAR(); pv4(o,vb0+2*sl_cur,PAF(0),PAF(1),PAF(2),PAF(3)); }
  #undef PKW
  #undef PAF
  #undef VFR
  #undef PIN
  #undef MX3
  #undef GAPA
  #undef GAPB
  #undef EX
  #undef VRD
  #undef KF
  #undef STEP
  #undef ENDW
  {auto rr=__builtin_amdgcn_permlane32_swap(__float_as_uint(l_reg),__float_as_uint(l_reg),false,false);l_reg=__uint_as_float(rr[0])+__uint_as_float(rr[1]);}
  if(hi==0)wsf[32+r32]=l_reg;asm volatile("s_waitcnt lgkmcnt(0)":::"memory");
  float rli[16];
  #pragma unroll
  for(int r=0;r<16;++r)rli[r]=__builtin_amdgcn_rcpf(wsf[32+crow(r,hi)]);
  bf16*Ow=O+(rowbase+q0+wid*QBLK)*DM+2*h*D;
  bf16*stg=(bf16*)(shm+LDS_OST2)+wid*2048;
  if constexpr(!FUSE){
    #pragma unroll
    for(int ps=0;ps<2;++ps){
      #pragma unroll
      for(int r=0;r<16;++r){const int orow=crow(r,hi);
        #pragma unroll
        for(int d0=0;d0<2;++d0)stg[orow*64+d0*32+r32]=__float2bfloat16(o[2*ps+d0][r]*rli[r]);}
      asm volatile("s_waitcnt lgkmcnt(0)":::"memory");
      #pragma unroll
      for(int i=0;i<4;++i){const int row=i*8+(lane>>3),ch=lane&7; const u32x4 v=*(const u32x4*)(stg+row*64+ch*8); ATTN_STORE16(Ow+(long)row*DM+ps*64+ch*8,v);}
      asm volatile("s_waitcnt lgkmcnt(0)":::"memory"); }
    asm volatile("s_waitcnt vmcnt(0)":::"memory");
  } else {
    float dv[2][4][8]; float ss[4]={0.f,0.f,0.f,0.f};
    u32x4 v0p[2][4];
    #pragma unroll
    for(int ps=0;ps<2;++ps)
      #pragma unroll
      for(int i=0;i<4;++i){const int row=i*8+(lane>>3),ch=lane&7; v0p[ps][i]=*(const u32x4*)(Ow+(long)row*DM+ps*64+ch*8);}
    #pragma unroll
    for(int ps=0;ps<2;++ps){
      #pragma unroll
      for(int r=0;r<16;++r){const int orow=crow(r,hi);
        #pragma unroll
        for(int d0=0;d0<2;++d0)stg[orow*64+d0*32+r32]=__float2bfloat16(o[2*ps+d0][r]*rli[r]);}
      asm volatile("s_waitcnt lgkmcnt(0)":::"memory");
      #pragma unroll
      for(int i=0;i<4;++i){const int row=i*8+(lane>>3),ch=lane&7; const u32x4 v1=*(const u32x4*)(stg+row*64+ch*8); const u32x4 v0=v0p[ps][i];
        #pragma unroll
        for(int e=0;e<4;++e){ const float a0=__uint_as_float(v0[e]<<16),a1=__uint_as_float(v0[e]&0xffff0000u),b0=__uint_as_float(v1[e]<<16),b1=__uint_as_float(v1[e]&0xffff0000u);
          const float x0=a0-lam*b0,x1=a1-lam*b1; dv[ps][i][2*e]=x0; dv[ps][i][2*e+1]=x1; ss[i]+=x0*x0+x1*x1; } }
      asm volatile("s_waitcnt lgkmcnt(0)":::"memory"); }
    #pragma unroll
    for(int i=0;i<4;++i){ float s_=ss[i];
      { int b_=__float_as_int(s_); s_+=__int_as_float(__builtin_amdgcn_update_dpp(b_,b_,0xB1,0xF,0xF,false)); b_=__float_as_int(s_); s_+=__int_as_float(__builtin_amdgcn_update_dpp(b_,b_,0x4E,0xF,0xF,false)); b_=__float_as_int(s_); s_+=__int_as_float(__builtin_amdgcn_update_dpp(b_,b_,0x141,0xF,0xF,false)); }
      ss[i]=1.0f/sqrtf(s_*(1.0f/128.0f)+1e-6f); }
    #pragma unroll
    for(int ps=0;ps<2;++ps){ float gg[8];
      #pragma unroll
      for(int e=0;e<8;++e)gg[e]=gsub[ps*64+(lane&7)*8+e]*0.8f;
      #pragma unroll
      for(int i=0;i<4;++i){const int row=i*8+(lane>>3),ch=lane&7; u32x4 w;
        #pragma unroll
        for(int e=0;e<4;++e)w[e]=cvtpk_s(dv[ps][i][2*e]*ss[i]*gg[2*e],dv[ps][i][2*e+1]*ss[i]*gg[2*e+1]);
        ATTN_STORE16(Ow+(long)row*DM+ps*64+ch*8,w);} }
  }
  asm volatile("s_waitcnt lgkmcnt(0)\n\ts_barrier":::"memory");
  #undef DMA_K
  #undef DMA_V
  #undef QF
  #undef CMASK
  #undef NVAL
  #undef START
  #undef RESC
  #undef ROT
}
constexpr int ATTN_LDS_BYTES=LDS_BYTES2;
#undef SBAR
#undef WAIT_BAR
}

constexpr int NWAVES = 8;
constexpr int N_LAUNCHES = MK_N_LAUNCHES;
constexpr int N_PHASES = 9 + 2 * NCH + 1;
constexpr bool PER_PHASE = (MK_N_LAUNCHES != 1);

constexpr size_t MiB = 1u << 20;
constexpr size_t ACT = (size_t)T * D * 2;
constexpr size_t WS_CTL = 0, CTL_ZERO_BYTES = 65536;
constexpr size_t WS_MOD = 1 * MiB;
constexpr size_t WS_SH = WS_MOD + 512 * 1024;
constexpr size_t WS_WIN = 2 * MiB;
constexpr size_t WS_WR = 16 * MiB, WS_WA = 18 * MiB, WS_WO = 20 * MiB;
constexpr size_t WS_LW = 22 * MiB;
constexpr size_t WS_WRH = 23 * MiB, WS_WRL = 23 * MiB + 131072;
constexpr size_t WS_H = 24 * MiB;
constexpr size_t WS_XR = WS_H + ACT;
constexpr size_t WS_GR = WS_XR + ACT;
constexpr size_t WS_Q = WS_GR + ACT;
constexpr size_t WS_K = WS_Q + ACT;
constexpr size_t WS_V = WS_K + ACT;
constexpr size_t WS_O1 = WS_V + ACT;
constexpr size_t WS_END = WS_O1 + ACT;
static_assert(WS_END <= 512 * MiB, "ws map");
constexpr size_t WS_W13 = WS_GR;
constexpr size_t WS_W2 = WS_O1;
constexpr size_t WS_W13S = WS_O1 + 32 * MiB;
constexpr size_t WS_W2S = WS_O1 + 33 * MiB;
constexpr size_t WS_LIST = WS_O1 + 34 * MiB;
constexpr size_t WS_WTS = WS_O1 + 42 * MiB;
constexpr size_t WS_RDEST = WS_O1 + 43 * MiB;
constexpr size_t WS_RWT = WS_O1 + 44 * MiB;
constexpr size_t WS_SA = WS_O1 + 45 * MiB;
constexpr int MAXRT = TC * TOPK / 256 + NEXP + TC / 256;
constexpr int MAXROWS = MAXRT * 256;
constexpr size_t WS_HB = WS_H + 32 * MiB;
constexpr size_t WS_SLOT = WS_Q;
constexpr size_t WS_SLOTSC = WS_SLOT + 72 * MiB;
constexpr size_t WS_Y = WS_Q;
static_assert(WS_SLOT + (size_t)(TC * 9) * D <= WS_O1 && WS_HB + (size_t)MAXROWS * 512 <= WS_GR && (size_t)MAXROWS * 4 <= MiB, "moe map");
constexpr int CW_TMO = 0;
constexpr int CW_BAR = 4096;
constexpr int CW_CNT = 8192;
constexpr int CW_AMAX = 8192 + 512;

constexpr int RING_BYTES = 139264;
constexpr int MISC_OFF = RING_BYTES;
constexpr int LDS_BYTES = 155648;
constexpr int MI_BARST = 0;
constexpr int MI_CNT = 64;
constexpr int MI_TBASE = 128;
constexpr int MI_TILE_E = 256;
constexpr int MI_SB = 896;
constexpr int MI_TOK = 1024;
constexpr int MI_SA = 2560;
constexpr int MI_WORDS = 4096;

#define GAS __attribute__((address_space(1)))
#define LAS __attribute__((address_space(3)))
typedef unsigned short bf16;
typedef unsigned v4u __attribute__((ext_vector_type(4)));
typedef unsigned v2u __attribute__((ext_vector_type(2)));
typedef float f32x4 __attribute__((ext_vector_type(4)));
typedef float f32x16 __attribute__((ext_vector_type(16)));
typedef short bf16x8 __attribute__((ext_vector_type(8)));
typedef GAS unsigned gu32;
#define RLX_AGENT __ATOMIC_RELAXED, __HIP_MEMORY_SCOPE_AGENT
#define LDS_WAIT() asm volatile("s_waitcnt lgkmcnt(0)" ::: "memory")
#define VM_WAIT() asm volatile("s_waitcnt vmcnt(0)" ::: "memory")
__device__ __forceinline__ unsigned f2bf(float f) { unsigned u = __builtin_bit_cast(unsigned, f); return (u + 0x7fffu + ((u >> 16) & 1u)) >> 16; }
__device__ __forceinline__ unsigned pk2(float lo, float hi) { return f2bf(lo) | (f2bf(hi) << 16); }
__device__ __forceinline__ float bf2f(unsigned h) { return __uint_as_float(h << 16); }
using pg8::bflo; using pg8::bfhi; using pg8::sigm;

#define XB_TMO      128
#define XB_XCNT(j)  (256  + 64 * (j))
#define XB_XSUB(j)  (1280 + 64 * (j))
#define XB_XGEN(j)  (2304 + 64 * (j))
#define XB_TOP      3328
#define XB_TOPGEN   3392
#define XCD_BAR_WORDS 3456
#define XB_SPIN_CAP (1u << 18)
__device__ __forceinline__ unsigned xb_ld(unsigned* p)              { return __hip_atomic_load(p, __ATOMIC_RELAXED, __HIP_MEMORY_SCOPE_AGENT); }
__device__ __forceinline__ unsigned xb_add(unsigned* p, unsigned v) { return __hip_atomic_fetch_add(p, v, __ATOMIC_RELAXED, __HIP_MEMORY_SCOPE_AGENT); }
__device__ __forceinline__ unsigned xb_xcc_id() { return (unsigned)__builtin_amdgcn_s_getreg((3 << 11) | 20) & 0xFu; }
#define XB_SPIN(cond, bar) do { unsigned _sp = 0; while (cond) { __builtin_amdgcn_s_sleep(1); \
    if ((++_sp & 255u) == 0u) { if (xb_ld(&(bar)[XB_TMO])) break; if (_sp > XB_SPIN_CAP) { atomicAdd(&(bar)[XB_TMO], 1u); break; } } } } while (0)
struct XcdBarrier { unsigned* bar; unsigned x; volatile LAS unsigned* st; };
__device__ __forceinline__ XcdBarrier xcd_barrier_post(unsigned* bar, volatile LAS unsigned* st) {
    XcdBarrier b; b.bar = bar; b.x = xb_xcc_id(); b.st = st;
    if (threadIdx.x == 0) (void)xb_add(&bar[XB_XCNT(b.x)], 1u);
    return b;
}
__device__ __forceinline__ void xcd_barrier_complete(unsigned* bar, unsigned x, unsigned& nloc, unsigned& nx) {
    const unsigned G = gridDim.x * gridDim.y * gridDim.z;
    unsigned sum, cnt, mine, sp = 0u;
    for (;;) {
        sum = 0u; cnt = 0u; mine = 0u;
#pragma unroll 1
        for (unsigned j = 0; j < 16; ++j) { const unsigned c = xb_ld(&bar[XB_XCNT(j)]); sum += c; cnt += (c > 0u) ? 1u : 0u; mine = (j == x) ? c : mine; }
        if (sum == G) break;
        __builtin_amdgcn_s_sleep(1);
        if ((++sp & 255u) == 0u) { if (xb_ld(&bar[XB_TMO])) break; if (sp > XB_SPIN_CAP) { atomicAdd(&bar[XB_TMO], 1u); break; } }
    }
    nloc = mine > 0u ? mine : 1u; nx = cnt > 0u ? cnt : 1u;
}
__device__ __forceinline__ void xcd_barrier(const XcdBarrier& b) {
    asm volatile("s_waitcnt vmcnt(0)" ::: "memory");
    __syncthreads();
    if (threadIdx.x == 0) {
        size_t zb_ = 0; asm volatile("" : "+s"(zb_)); unsigned* bar = b.bar + zb_;
        __builtin_amdgcn_s_waitcnt(0);
        unsigned nloc = b.st[0], nx = b.st[1];
        if (nloc == 0u) { xcd_barrier_complete(bar, b.x, nloc, nx); b.st[0] = nloc; b.st[1] = nx; }
        const unsigned old = xb_add(&bar[XB_XSUB(b.x)], 1u);
        const unsigned gen = old / nloc;
        if (old + 1u == (gen + 1u) * nloc) {
            __builtin_amdgcn_fence(__ATOMIC_RELEASE, "agent");
            asm volatile("s_waitcnt vmcnt(0)" ::: "memory");
            const unsigned og = xb_add(&bar[XB_TOP], 1u);
            const unsigned tg = og / nx;
            if (og + 1u == (tg + 1u) * nx) xb_add(&bar[XB_TOPGEN], 1u);
            else XB_SPIN(xb_ld(&bar[XB_TOPGEN]) == tg, bar);
            __builtin_amdgcn_fence(__ATOMIC_ACQUIRE, "agent");
            xb_add(&bar[XB_XGEN(b.x)], 1u);
            asm volatile("s_waitcnt vmcnt(0)" ::: "memory");
        } else {
            XB_SPIN(xb_ld(&bar[XB_XGEN(b.x)]) == gen, bar);
            __builtin_amdgcn_fence(__ATOMIC_ACQUIRE, "agent");
            asm volatile("s_waitcnt vmcnt(0)" ::: "memory");
        }
    }
    __syncthreads();
}

struct Frame {
    LAS unsigned char* lds;
    volatile LAS int* MI;
    gu32* ctl;
    int tid, lane, wave, vcu, G;
    float* out;
    unsigned char* ws;
};
struct Args { const float* in[32]; float* out; unsigned char* ws; int ph_lo, ph_hi; };
__device__ __forceinline__ float dppf(float x, int ctrl_sel) {
    const int b = __float_as_int(x); int r;
    if (ctrl_sel == 0) r = __builtin_amdgcn_update_dpp(b, b, 0xB1, 0xF, 0xF, false);
    else if (ctrl_sel == 1) r = __builtin_amdgcn_update_dpp(b, b, 0x4E, 0xF, 0xF, false);
    else if (ctrl_sel == 2) r = __builtin_amdgcn_update_dpp(b, b, 0x141, 0xF, 0xF, false);
    else r = __builtin_amdgcn_update_dpp(b, b, 0x140, 0xF, 0xF, false);
    return __int_as_float(r);
}
__device__ __forceinline__ float max8_dpp(float x) { x = fmaxf(x, dppf(x, 0)); x = fmaxf(x, dppf(x, 1)); x = fmaxf(x, dppf(x, 2)); return x; }
__device__ __forceinline__ float rl_f(float x, int l) { return __int_as_float(__builtin_amdgcn_readlane(__float_as_int(x), l)); }
__device__ __forceinline__ float wave_max_dpp(float x) { x = max8_dpp(x); x = fmaxf(x, dppf(x, 3)); return fmaxf(fmaxf(rl_f(x, 0), rl_f(x, 16)), fmaxf(rl_f(x, 32), rl_f(x, 48))); }
__device__ __forceinline__ float wave_sum_dpp(float x) { x += dppf(x, 0); x += dppf(x, 1); x += dppf(x, 2); x += dppf(x, 3); return (rl_f(x, 0) + rl_f(x, 16)) + (rl_f(x, 32) + rl_f(x, 48)); }
__device__ __forceinline__ float wave_sum(float v) { return wave_sum_dpp(v); }

typedef short v4i16_t __attribute__((ext_vector_type(4)));
__device__ __forceinline__ v2u tr8(const LAS unsigned char* p) { return __builtin_bit_cast(v2u, __builtin_amdgcn_ds_read_tr16_b64_v4i16((LAS v4i16_t*)p)); }
__device__ __forceinline__ void transpose_item(const float* W, int K, int N, bf16* WT, int kb, int n0, int drow0, LAS float* scr_, int lane) {
    LAS unsigned char* scr = (LAS unsigned char*)scr_;
    const int k0 = 64 * kb, lr = lane >> 4, lc = lane & 15;
#pragma unroll
    for (int hf = 0; hf < 2; ++hf) {
        f32x4 v[8];
#pragma unroll
        for (int r = 0; r < 8; ++r) v[r] = *(const f32x4*)(W + (size_t)(k0 + 32 * hf + 4 * r + lr) * N + n0 + 4 * lc);
#pragma unroll
        for (int r = 0; r < 8; ++r) { v2u o; o.x = pk2(v[r].x, v[r].y); o.y = pk2(v[r].z, v[r].w); *(LAS v2u*)(scr + (32 * hf + 4 * r + lr) * 144 + lc * 8) = o; }
    }
    LDS_WAIT(); asm volatile("" ::: "memory");
    const int g = lane >> 4, q = (lane & 15) >> 2, p = lane & 3;
#pragma unroll
    for (int nb = 0; nb < 4; ++nb)
#pragma unroll
        for (int kk = 0; kk < 2; ++kk) { const int kblk = 4 * kk + g;
            const v2u a = tr8(scr + (8 * kblk + q) * 144 + (16 * nb + 4 * p) * 2), b = tr8(scr + (8 * kblk + 4 + q) * 144 + (16 * nb + 4 * p) * 2);
            v4u o; o.x = a.x; o.y = a.y; o.z = b.x; o.w = b.y;
            *(GAS v4u*)(WT + (size_t)(drow0 + 16 * nb + lc) * K + k0 + 8 * kblk) = o; }
    LDS_WAIT(); asm volatile("" ::: "memory");
}

__device__ __forceinline__ void p0_phase(Frame& F, const Args& A) {
    unsigned char* ws = F.ws;
    LAS float* sc = (LAS float*)F.lds;
    if (F.vcu < 6 * D / 64) {
#pragma unroll 1
        for (int i0 = F.tid; i0 < BATCH * D; i0 += 8 * NWAVES * 64) { float v[8];
#pragma unroll
            for (int u = 0; u < 8; ++u) v[u] = A.in[1][i0 + u * NWAVES * 64];
#pragma unroll
            for (int u = 0; u < 8; ++u) { const int i = i0 + u * NWAVES * 64, b = i >> 10, k = i & 1023; sc[k * 16 + b] = v[u] * sigm(v[u]); } } }
    __syncthreads();
    const int nada = (F.G > 2 * (6 * D / 64)) ? (6 * D / 64) : 0;
    const int NGW = (F.G - nada) * NWAVES, gw = (F.vcu >= nada) ? (F.vcu - nada) * NWAVES + F.wave : 0x40000000;
    LAS float* part = (LAS float*)(F.lds + 65536);
    for (int task = F.vcu; task < 6 * D / 64; task += F.G) {
        const int col = task * 64 + F.lane;
        float acc[16];
#pragma unroll
        for (int b = 0; b < 16; ++b) acc[b] = 0.f;
        const float* wp = A.in[2] + (size_t)(128 * F.wave) * (6 * D) + col;
        const LAS f32x4* sp = (const LAS f32x4*)(sc + (128 * F.wave) * 16);
#pragma unroll 1
        for (int k0 = 0; k0 < 128; k0 += 32) { float wv[32];
#pragma unroll
            for (int i = 0; i < 32; ++i) wv[i] = wp[(size_t)(k0 + i) * (6 * D)];
#pragma unroll
            for (int i = 0; i < 32; ++i) {
#pragma unroll
                for (int q = 0; q < 4; ++q) { const f32x4 sv = sp[(k0 + i) * 4 + q]; acc[4 * q + 0] += wv[i] * sv.x; acc[4 * q + 1] += wv[i] * sv.y; acc[4 * q + 2] += wv[i] * sv.z; acc[4 * q + 3] += wv[i] * sv.w; } } }
#pragma unroll
        for (int b = 0; b < 16; ++b) part[(F.wave * 16 + b) * 64 + F.lane] = acc[b];
        __syncthreads();
        for (int i = F.tid; i < 16 * 64; i += NWAVES * 64) { const int b = i >> 6, c = i & 63; float v = A.in[3][task * 64 + c];
#pragma unroll
            for (int w8 = 0; w8 < 8; ++w8) v += part[(w8 * 16 + b) * 64 + c];
            ((float*)(ws + WS_MOD))[b * (6 * D) + task * 64 + c] = v; }
        __syncthreads();
    }
    __syncthreads();
    LAS float* scr = (LAS float*)(F.lds + F.wave * 16384);
    constexpr int I_SQ = 16 * 16, I_LW = 16 * 4;
    constexpr int NITEMS = 3 * I_SQ + I_LW;
    for (int it = gw; it < NITEMS; it += NGW) {
        int r = it;
        if (r < I_SQ) { transpose_item(A.in[18], D, D, (bf16*)(ws + WS_WR), r / 16, 64 * (r % 16), 64 * (r % 16), scr, F.lane); continue; } r -= I_SQ;
        if (r < I_SQ) { transpose_item(A.in[19], D, D, (bf16*)(ws + WS_WA), r / 16, 64 * (r % 16), 64 * (r % 16), scr, F.lane); continue; } r -= I_SQ;
        if (r < I_SQ) { transpose_item(A.in[20], D, D, (bf16*)(ws + WS_WO), r / 16, 64 * (r % 16), 64 * (r % 16), scr, F.lane); continue; } r -= I_SQ;
        { const int mat = r >> 2, q = r & 3, gate = mat >> 3, n = mat & 7;
          const float* W = (gate ? A.in[10] : A.in[8]) + (size_t)n * 128 * 128;
          transpose_item(W, 128, 128, (bf16*)(ws + WS_LW) + (size_t)(n * 2 + gate) * 128 * 128, q >> 1, 64 * (q & 1), 64 * (q & 1), scr, F.lane); }
    }
    for (long i = (long)gw * 64 + F.lane; i < D * NEXP; i += NGW * 64) { const int k = i >> 6, e = i & 63; const float wv = A.in[23][i]; const unsigned hb = f2bf(wv); const unsigned lb = f2bf(wv - bf2f(hb));
        ((bf16*)(ws + WS_WRH))[e * D + k] = (bf16)hb; ((bf16*)(ws + WS_WRL))[e * D + k] = (bf16)lb; }
    for (int it = gw; it < 130 * 64 + (D * W_IN) / 4096; it += NGW) { const int mtx = it < 130 * 64 ? it >> 6 : 130, part = it < 130 * 64 ? (it & 63) : it - 130 * 64, e = mtx >> 1, w3 = mtx & 1;
        const float* W = (mtx == 130 ? A.in[5] : e < NEXP ? (w3 ? A.in[26] : A.in[25]) + (size_t)e * D * DEXP : (w3 ? A.in[29] : A.in[28])) + (size_t)part * 4096;
        float mx = 0.f;
#pragma unroll
        for (int i = 0; i < 16; ++i) { const f32x4 v = *((const f32x4*)W + F.lane + 64 * i); mx = fmaxf(mx, fmaxf(fmaxf(fabsf(v.x), fabsf(v.y)), fmaxf(fabsf(v.z), fabsf(v.w)))); }
        mx = wave_max_dpp(mx);
        if (F.lane == 0) atomicMax((unsigned*)(F.ctl + CW_AMAX + mtx), __float_as_uint(mx)); }
}

__device__ __forceinline__ void transpose_item_q(const float* W, int K, int N, signed char* WT, int kb, int n0, int drow0, LAS float* scr_, int lane, float inv) {
    LAS unsigned char* scr = (LAS unsigned char*)scr_;
    const int k0 = 64 * kb, lr = lane >> 4, lc = lane & 15;
#pragma unroll
    for (int hf = 0; hf < 2; ++hf) {
        f32x4 v[8];
#pragma unroll
        for (int r = 0; r < 8; ++r) v[r] = *(const f32x4*)(W + (size_t)(k0 + 32 * hf + 4 * r + lr) * N + n0 + 4 * lc);
#pragma unroll
        for (int r = 0; r < 8; ++r) { v2u o; o.x = pk2(v[r].x, v[r].y); o.y = pk2(v[r].z, v[r].w); *(LAS v2u*)(scr + (32 * hf + 4 * r + lr) * 144 + lc * 8) = o; }
    }
    LDS_WAIT(); asm volatile("" ::: "memory");
    const int g = lane >> 4, q = (lane & 15) >> 2, p = lane & 3;
#pragma unroll
    for (int nb = 0; nb < 4; ++nb)
#pragma unroll
        for (int kk = 0; kk < 2; ++kk) { const int kblk = 4 * kk + g;
            const v2u a = tr8(scr + (8 * kblk + q) * 144 + (16 * nb + 4 * p) * 2), b = tr8(scr + (8 * kblk + 4 + q) * 144 + (16 * nb + 4 * p) * 2);
            const unsigned wv[4] = {a.x, a.y, b.x, b.y}; unsigned ob[2] = {0u, 0u};
#pragma unroll
            for (int j = 0; j < 4; ++j) { const int q0 = (int)rintf(bflo(wv[j]) * inv), q1 = (int)rintf(bfhi(wv[j]) * inv);
                ob[j >> 1] |= ((unsigned)(q0 & 0xff) << (16 * (j & 1))) | ((unsigned)(q1 & 0xff) << (16 * (j & 1) + 8)); }
            v2u o; o.x = ob[0]; o.y = ob[1];
            *(GAS v2u*)(WT + (size_t)(drow0 + 16 * nb + lc) * K + k0 + 8 * kblk) = o; }
    LDS_WAIT(); asm volatile("" ::: "memory");
}

__device__ __forceinline__ void p1_phase(Frame& F, const Args& A) {
    const int gw = F.vcu * NWAVES + F.wave, NGW = F.G * NWAVES;
    const float* mod = (const float*)(F.ws + WS_MOD);
    signed char* H = (signed char*)(F.ws + WS_H); float* SH = (float*)(F.ws + WS_SH);
    for (int grp = gw; grp < T / 16; grp += NGW) {
        const int b = (grp * 16) / SEQ;
        f32x4 g[4], sc[4], sh[4];
#pragma unroll
        for (int j = 0; j < 4; ++j) { const int c = 4 * F.lane + 256 * j; g[j] = *(const f32x4*)(A.in[4] + c); sh[j] = *(const f32x4*)(mod + b * 6 * D + c); sc[j] = *(const f32x4*)(mod + b * 6 * D + D + c);
            g[j] = g[j] * (sc[j] + 1.0f); }
        f32x4 vn[4];
        { const GAS f32x4* xr = (const GAS f32x4*)(A.in[0] + (size_t)grp * 16 * D) + F.lane;
#pragma unroll
          for (int j = 0; j < 4; ++j) vn[j] = xr[64 * j]; }
#pragma unroll 2
        for (int rr = 0; rr < 16; ++rr) {
            const size_t m = (size_t)grp * 16 + rr;
            f32x4 v[4]; float s = 0.f;
#pragma unroll
            for (int j = 0; j < 4; ++j) v[j] = vn[j];
            if (rr + 1 < 16) { const GAS f32x4* xr = (const GAS f32x4*)(A.in[0] + (m + 1) * D) + F.lane;
#pragma unroll
                for (int j = 0; j < 4; ++j) vn[j] = xr[64 * j]; }
#pragma unroll
            for (int j = 0; j < 4; ++j) s += (v[j].x * v[j].x + v[j].y * v[j].y) + (v[j].z * v[j].z + v[j].w * v[j].w);
            const float rstd = 1.f / sqrtf(wave_sum(s) * (1.f / D) + EPS);
            float amx = 0.f;
#pragma unroll
            for (int j = 0; j < 4; ++j) { v[j] = v[j] * rstd * g[j] + sh[j]; amx = fmaxf(amx, fmaxf(fmaxf(fabsf(v[j].x), fabsf(v[j].y)), fmaxf(fabsf(v[j].z), fabsf(v[j].w)))); }
            amx = fmaxf(wave_max_dpp(amx), 1e-20f); const float inv = 127.0f / amx; if (F.lane == 0) SH[m] = amx * (1.0f / 127.0f);
#pragma unroll
            for (int j = 0; j < 4; ++j) { const int q0 = (int)rintf(v[j].x * inv), q1 = (int)rintf(v[j].y * inv), q2 = (int)rintf(v[j].z * inv), q3 = (int)rintf(v[j].w * inv);
                *((GAS unsigned*)(H + m * D) + F.lane + 64 * j) = (unsigned)(q0 & 0xff) | ((unsigned)(q1 & 0xff) << 8) | ((unsigned)(q2 & 0xff) << 16) | ((unsigned)(q3 & 0xff) << 24); }
        }
    }
    { LAS float* scr = (LAS float*)(F.lds + F.wave * 16384);
      const float inv = 127.0f / fmaxf(__uint_as_float(__hip_atomic_load(F.ctl + CW_AMAX + 130, RLX_AGENT)), 1e-30f);
      constexpr int I_IN = 16 * (W_IN / 64);
      for (int it = NGW - 1 - gw; it < I_IN; it += NGW)
          transpose_item_q(A.in[5], D, W_IN, (signed char*)(F.ws + WS_WIN), it / (W_IN / 64), 64 * (it % (W_IN / 64)), 64 * (it % (W_IN / 64)), scr, F.lane, inv); }
}

struct DenseOrder {
    const char* A; const char* Bt; int nM, nN, nwg, G, c; size_t tstep;
    __device__ __forceinline__ void init(const void* A_, const void* Bt_, int M, int N, int K, int G_, int c_) { A = (const char*)A_; Bt = (const char*)Bt_; nM = M / 256; nN = N / 256; nwg = nM * nN; G = G_; c = c_; tstep = (size_t)256 * K * 2; }
    __device__ __forceinline__ bool next(int i, pg8::Unit& u) const {
        const long L = (long)i * G + c; if (L >= nwg) return false;
        int wgid = (int)L; { const int q = nwg / 8, r = nwg % 8, xcd = wgid % 8, off = wgid / 8; wgid = (xcd < r ? xcd * (q + 1) : r * (q + 1) + (xcd - r) * q) + off; }
        const int nig = 8 * nN, gid = wgid / nig, fm = gid * 8, gsz = (nM - fm) < 8 ? (nM - fm) : 8;
        u.pm = fm + ((wgid % nig) % gsz); u.pn = (wgid % nig) / gsz; u.z = i; u.e = 0; return true;
    }
    __device__ __forceinline__ void bases(const pg8::Unit& u, const char*& a, const char*& b) const { a = A + (size_t)u.pm * tstep; b = Bt + (size_t)u.pn * tstep; }
    __device__ __forceinline__ int tok(int, int) const { return 0; }
};
struct MergeOrder {
    DenseOrder d; const char *A1, *B1;
    __device__ __forceinline__ bool next(int i, pg8::Unit& u) const { if (!d.next(i >> 1, u)) return false; u.z = i & 1; return true; }
    __device__ __forceinline__ void bases(const pg8::Unit& u, const char*& a, const char*& b) const { a = (u.z ? A1 : d.A) + (size_t)u.pm * d.tstep; b = (u.z ? B1 : d.Bt) + (size_t)u.pn * d.tstep; }
    __device__ __forceinline__ int tok(int, int) const { return 0; }
};
typedef pg8::f32x4 acc_t[2][2][4][2];
struct EpiProj {
    static constexpr bool PERM = true, TWICE = false;
    bf16* ws5; bf16* dout2; volatile LAS int* MI; float sB;
    __device__ __forceinline__ void operator()(const acc_t& acc, const pg8::Unit& u, int wr, int wc, int fr, int fq) const {
        const int t = u.pn >> 2, colt = (u.pn & 3) * 256;
        bf16* base = ws5 + (size_t)(t < 5 ? t : 0) * T * D;
        const int row0 = u.pm * 256 + wr * 64 + fr, col0 = colt + wc * 32 + 8 * fq;
#pragma unroll
        for (int ai = 0; ai < 2; ++ai)
#pragma unroll
            for (int m = 0; m < 4; ++m) { bf16* rowp = base + (size_t)(row0 + ai * 128 + m * 16) * D + col0;
                const float sc = __int_as_float(MI[512 + u.z * 256 + wr * 64 + fr + ai * 128 + m * 16]) * sB;
#pragma unroll
                for (int bj = 0; bj < 2; ++bj) { const pg8::i32x4 I0 = __builtin_bit_cast(pg8::i32x4, acc[ai][bj][m][0]), I1 = __builtin_bit_cast(pg8::i32x4, acc[ai][bj][m][1]);
                    pg8::f32x4 v0, v1;
#pragma unroll
                    for (int i = 0; i < 4; ++i) { float a = (float)I0[i] * sc, b = (float)I1[i] * sc; asm volatile("" : "+v"(a), "+v"(b)); v0[i] = a; v1[i] = b; }
                    if (t >= 5) {
                        unsigned tb[8];
#pragma unroll
                        for (int i = 0; i < 4; ++i) { tb[i] = __float_as_uint(__builtin_fmaf(sigm(v0[i]), 255.0f, 8388608.0f)); tb[4 + i] = __float_as_uint(__builtin_fmaf(sigm(v1[i]), 255.0f, 8388608.0f)); }
                        v2u w; w.x = __builtin_amdgcn_perm(__builtin_amdgcn_perm(tb[3], tb[2], 0x0c0c0400u), __builtin_amdgcn_perm(tb[1], tb[0], 0x0c0c0400u), 0x05040100u);
                        w.y = __builtin_amdgcn_perm(__builtin_amdgcn_perm(tb[7], tb[6], 0x0c0c0400u), __builtin_amdgcn_perm(tb[5], tb[4], 0x0c0c0400u), 0x05040100u);
                        *(v2u*)((unsigned char*)dout2 + (size_t)(t - 5) * T * D + (size_t)(row0 + ai * 128 + m * 16) * D + col0 + bj * 128) = w; continue; }
                    if (t == 1) { for (int i = 0; i < 4; ++i) { v0[i] = pg8::gelu_t(v0[i]); v1[i] = pg8::gelu_t(v1[i]); } }
                    else if (t == 2) { v0 = v0 * attn_body::C2; v1 = v1 * attn_body::C2; }
                    v4u w; w.x = pg8::cvt_pk_bf16(v0[0], v0[1]); w.y = pg8::cvt_pk_bf16(v0[2], v0[3]); w.z = pg8::cvt_pk_bf16(v1[0], v1[1]); w.w = pg8::cvt_pk_bf16(v1[2], v1[3]);
                    *(v4u*)(rowp + bj * 128) = w; } }
    }
};
struct EpiGate {
    static constexpr bool PERM = true, TWICE = false;
    const unsigned char* GA; const unsigned char* GB; bf16* YA; bf16* MG;
    __device__ __forceinline__ void operator()(const acc_t& acc, const pg8::Unit& u, int wr, int wc, int fr, int fq) const {
        const int row0 = u.pm * 256 + wr * 64 + fr, col0 = u.pn * 256 + wc * 32 + 8 * fq;
        const unsigned char* G = u.z ? GB : GA; bf16* O = u.z ? MG : YA;
#pragma unroll
        for (int ai = 0; ai < 2; ++ai)
#pragma unroll
            for (int mp = 0; mp < 2; ++mp) {
                v2u g[2][2]; v4u y[2][2];
#pragma unroll
                for (int mm = 0; mm < 2; ++mm)
#pragma unroll
                    for (int bj = 0; bj < 2; ++bj) { const size_t off = (size_t)(row0 + ai * 128 + (2 * mp + mm) * 16) * D + col0 + bj * 128; g[mm][bj] = *(const v2u*)(G + off);
                        y[mm][bj] = u.z ? *(const v4u*)(YA + off) : (v4u){0u, 0u, 0u, 0u}; }
#pragma unroll
                for (int mm = 0; mm < 2; ++mm)
#pragma unroll
                    for (int bj = 0; bj < 2; ++bj) { const int m = 2 * mp + mm; const size_t off = (size_t)(row0 + ai * 128 + m * 16) * D + col0 + bj * 128; const v2u gg = g[mm][bj]; const v4u yy = y[mm][bj]; constexpr float Q = 1.0f / 255.0f;
                        pg8::f32x4 v0 = acc[ai][bj][m][0], v1 = acc[ai][bj][m][1];
                        v0[0] = v0[0] * ((float)(gg.x & 0xffu) * Q) + bflo(yy.x); v0[1] = v0[1] * ((float)((gg.x >> 8) & 0xffu) * Q) + bfhi(yy.x); v0[2] = v0[2] * ((float)((gg.x >> 16) & 0xffu) * Q) + bflo(yy.y); v0[3] = v0[3] * ((float)(gg.x >> 24) * Q) + bfhi(yy.y);
                        v1[0] = v1[0] * ((float)(gg.y & 0xffu) * Q) + bflo(yy.z); v1[1] = v1[1] * ((float)((gg.y >> 8) & 0xffu) * Q) + bfhi(yy.z); v1[2] = v1[2] * ((float)((gg.y >> 16) & 0xffu) * Q) + bflo(yy.w); v1[3] = v1[3] * ((float)(gg.y >> 24) * Q) + bfhi(yy.w);
                        v4u w; w.x = pg8::cvt_pk_bf16(v0[0], v0[1]); w.y = pg8::cvt_pk_bf16(v0[2], v0[3]); w.z = pg8::cvt_pk_bf16(v1[0], v1[1]); w.w = pg8::cvt_pk_bf16(v1[2], v1[3]);
                        *(v4u*)(O + off) = w; }
                asm volatile("" ::: "memory"); }
    }
};
struct EpiF32 {
    static constexpr bool PERM = true, TWICE = false;
    bf16* Y;
    __device__ __forceinline__ void operator()(const acc_t& acc, const pg8::Unit& u, int wr, int wc, int fr, int fq) const {
        const int row0 = u.pm * 256 + wr * 64 + fr, col0 = u.pn * 256 + wc * 32 + 8 * fq;
#pragma unroll
        for (int ai = 0; ai < 2; ++ai)
#pragma unroll
            for (int m = 0; m < 4; ++m) { bf16* rowp = Y + (size_t)(row0 + ai * 128 + m * 16) * D + col0;
#pragma unroll
                for (int bj = 0; bj < 2; ++bj) { const pg8::f32x4 v0 = acc[ai][bj][m][0], v1 = acc[ai][bj][m][1];
                    v4u w; w.x = pg8::cvt_pk_bf16(v0[0], v0[1]); w.y = pg8::cvt_pk_bf16(v0[2], v0[3]); w.z = pg8::cvt_pk_bf16(v1[0], v1[1]); w.w = pg8::cvt_pk_bf16(v1[2], v1[3]);
                    *(v4u*)(rowp + bj * 128) = w; } }
    }
};

__device__ __forceinline__ void lru_phase(Frame& F, const Args& A) {
    unsigned char* ws = F.ws;
    const bf16* XR = (const bf16*)(ws + WS_XR); bf16* GR = (bf16*)(ws + WS_GR);
    LAS unsigned char* AT = F.lds;
    LAS unsigned char* BT = F.lds + 34816;
    LAS float* AA = (LAS float*)(F.lds + 69632);
    LAS float* UU = (LAS float*)(F.lds + 102400);
    LAS float* SM = (LAS float*)(F.lds + 135168);
    LAS float* CW = (LAS float*)(F.lds + MISC_OFF + 4096);
    const int tid = F.tid, lane = F.lane, w = F.wave, hi = lane >> 5, l31 = lane & 31;
    for (int item = F.vcu; item < BATCH * 16; item += F.G) {
        const int b = item >> 4, n = (item >> 1) & 7, half = item & 1;
        __syncthreads();
        { const bf16* LW = (const bf16*)(ws + WS_LW) + (size_t)n * 2 * 128 * 128;
#pragma unroll
          for (int p = 0; p < 4; ++p) { const int q = tid + 512 * p, row = q >> 4, pc = q & 15; const int gate = row >> 6, d = 64 * half + (row & 63);
              const v4u v = *(const v4u*)(LW + ((size_t)gate * 128 + d) * 128 + pc * 8); *(LAS v4u*)(BT + row * 272 + pc * 16) = v; }
          for (int i = tid; i < 640; i += NWAVES * 64) { const int k = i >> 7, c = i & 127; CW[i] = (k < 4) ? A.in[6][k * D + 128 * n + c] : A.in[7][128 * n + c]; } }
        const int c8 = (tid & 15) * 8, run = tid >> 4, cg0 = 128 * n + c8;
        const int tg = w & 3, cg = w >> 2, lc = 32 * cg + l31, chg = 128 * n + 64 * half + lc;
        const float ba_c = A.in[9][chg], bx_c = A.in[11][chg];
        const float lam = A.in[12][chg]; const float sp8 = 8.0f * log1pf(expf(-lam)) * LOG2E;
        const int sc_c = tid & 63, seg = tid >> 6;
        float hcarry = 0.f;
        v4u xq[7];
        { const bf16* xp = XR + ((size_t)b * SEQ + 4 * run - 3) * D + cg0;
#pragma unroll
          for (int i = 0; i < 7; ++i) xq[i] = (4 * run - 3 + i >= 0) ? *(const v4u*)(xp + (size_t)i * D) : (v4u){0u, 0u, 0u, 0u}; }
        __syncthreads();
#pragma unroll 1
        for (int ck = 0; ck < SEQ / 128; ++ck) {
            const int t0 = 128 * ck;
            bf16* gp = GR + ((size_t)b * SEQ + t0 + 16 * seg) * D + 128 * n + 64 * half + sc_c;
            { unsigned ow[4][4];
#pragma unroll
              for (int hf = 0; hf < 2; ++hf) { float wv[5][4];
#pragma unroll
                  for (int k = 0; k < 5; ++k) { const f32x4 w0 = *(const LAS f32x4*)(CW + k * 128 + c8 + 4 * hf); wv[k][0] = w0.x; wv[k][1] = w0.y; wv[k][2] = w0.z; wv[k][3] = w0.w; }
#pragma unroll
                  for (int tt = 0; tt < 4; ++tt) { float x0 = wv[4][0], x1 = wv[4][1], x2 = wv[4][2], x3 = wv[4][3];
#pragma unroll
                      for (int k = 0; k < 4; ++k) { const unsigned va = hf ? xq[tt + k].z : xq[tt + k].x, vb = hf ? xq[tt + k].w : xq[tt + k].y;
                          x0 += wv[k][0] * bflo(va); x1 += wv[k][1] * bfhi(va); x2 += wv[k][2] * bflo(vb); x3 += wv[k][3] * bfhi(vb); }
                      ow[tt][2 * hf] = pk2(x0, x1); ow[tt][2 * hf + 1] = pk2(x2, x3); } }
#pragma unroll
              for (int tt = 0; tt < 4; ++tt) { v4u o; o.x = ow[tt][0]; o.y = ow[tt][1]; o.z = ow[tt][2]; o.w = ow[tt][3]; *(LAS v4u*)(AT + (4 * run + tt) * 272 + c8 * 2) = o; } }
            if (ck + 1 < SEQ / 128) { const bf16* xp = XR + ((size_t)b * SEQ + t0 + 128 + 4 * run - 3) * D + cg0;
#pragma unroll
                for (int i = 0; i < 7; ++i) xq[i] = *(const v4u*)(xp + (size_t)i * D); }
            __syncthreads();
            { f32x16 accR = f32x16{}, accI = f32x16{};
#pragma unroll
              for (int ks = 0; ks < 8; ++ks) {
                  const bf16x8 a = *(const LAS bf16x8*)(AT + (32 * tg + l31) * 272 + (16 * ks + 8 * hi) * 2);
                  const bf16x8 bR = *(const LAS bf16x8*)(BT + (32 * cg + l31) * 272 + (16 * ks + 8 * hi) * 2);
                  const bf16x8 bI = *(const LAS bf16x8*)(BT + (64 + 32 * cg + l31) * 272 + (16 * ks + 8 * hi) * 2);
                  accR = __builtin_amdgcn_mfma_f32_32x32x16_bf16(a, bR, accR, 0, 0, 0);
                  accI = __builtin_amdgcn_mfma_f32_32x32x16_bf16(a, bI, accI, 0, 0, 0); }
#pragma unroll
              for (int r = 0; r < 16; ++r) {
                  const int tok = 32 * tg + (r & 3) + 8 * (r >> 2) + 4 * hi;
                  const float rg = sigm(accR[r] + ba_c), ig = sigm(accI[r] + bx_c);
                  const float la2 = -sp8 * rg;
                  const float a = __builtin_amdgcn_exp2f(la2);
                  float mult = __builtin_amdgcn_sqrtf(fmaxf(1.0f - a * a, 0.f));
                  if (t0 + tok == 0) mult = 1.0f;
                  const float xcv = bf2f(*(const LAS unsigned short*)(AT + tok * 272 + (64 * half + lc) * 2));
                  AA[tok * 64 + lc] = a; UU[tok * 64 + lc] = mult * ig * xcv; } }
            __syncthreads();
            unsigned short gq[16];
#pragma unroll
            for (int j = 0; j < 16; ++j) gq[j] = gp[(size_t)j * D];
            float hl[16], pl[16];
            { float h = 0.f, P = 1.f;
#pragma unroll
              for (int j = 0; j < 16; ++j) { const float a = AA[(16 * seg + j) * 64 + sc_c], u = UU[(16 * seg + j) * 64 + sc_c]; h = a * h + u; P = P * a; hl[j] = h; pl[j] = P; }
              SM[(seg * 64 + sc_c) * 2] = P; SM[(seg * 64 + sc_c) * 2 + 1] = h; }
            __syncthreads();
            { float cin = hcarry, tot = hcarry;
#pragma unroll
              for (int s = 0; s < 8; ++s) { const float Ps = SM[(s * 64 + sc_c) * 2], hs = SM[(s * 64 + sc_c) * 2 + 1]; tot = Ps * tot + hs; if (s < seg) cin = tot; }
              hcarry = tot;
#pragma unroll
              for (int j = 0; j < 16; ++j) { const float hv = hl[j] + pl[j] * cin; gp[(size_t)j * D] = (bf16)f2bf(hv * bf2f(gq[j])); } }
        }
    }
    __syncthreads();
}

__device__ __forceinline__ void p5_phase(Frame& F, const Args& A) {
    const int gw = F.vcu * NWAVES + F.wave, NGW = F.G * NWAVES;
    float d1 = A.in[13][F.lane] * A.in[14][F.lane], d2 = A.in[15][F.lane] * A.in[16][F.lane];
    const float lam = expf(wave_sum(d1)) - expf(wave_sum(d2)) + LAM_INIT;
    bf16* O0 = (bf16*)(F.ws + WS_H); const bf16* O1 = (const bf16*)(F.ws + WS_O1);
    float g[16];
#pragma unroll
    for (int i = 0; i < 16; ++i) g[i] = A.in[17][(16 * F.lane + i) & 127] * (1.0f - LAM_INIT);
    for (int m = gw; m < T; m += NGW) {
        const v4u a0 = *(const v4u*)(O0 + (size_t)m * D + 16 * F.lane), a1 = *(const v4u*)(O0 + (size_t)m * D + 16 * F.lane + 8);
        const v4u b0 = *(const v4u*)(O1 + (size_t)m * D + 16 * F.lane), b1 = *(const v4u*)(O1 + (size_t)m * D + 16 * F.lane + 8);
        float o[16];
        o[0] = bflo(a0.x) - lam * bflo(b0.x); o[1] = bfhi(a0.x) - lam * bfhi(b0.x); o[2] = bflo(a0.y) - lam * bflo(b0.y); o[3] = bfhi(a0.y) - lam * bfhi(b0.y);
        o[4] = bflo(a0.z) - lam * bflo(b0.z); o[5] = bfhi(a0.z) - lam * bfhi(b0.z); o[6] = bflo(a0.w) - lam * bflo(b0.w); o[7] = bfhi(a0.w) - lam * bfhi(b0.w);
        o[8] = bflo(a1.x) - lam * bflo(b1.x); o[9] = bfhi(a1.x) - lam * bfhi(b1.x); o[10] = bflo(a1.y) - lam * bflo(b1.y); o[11] = bfhi(a1.y) - lam * bfhi(b1.y);
        o[12] = bflo(a1.z) - lam * bflo(b1.z); o[13] = bfhi(a1.z) - lam * bfhi(b1.z); o[14] = bflo(a1.w) - lam * bflo(b1.w); o[15] = bfhi(a1.w) - lam * bfhi(b1.w);
        float s = 0.f;
#pragma unroll
        for (int i = 0; i < 16; ++i) s += o[i] * o[i];
        s += __shfl_xor(s, 1); s += __shfl_xor(s, 2); s += __shfl_xor(s, 4);
        const float rstd = 1.f / sqrtf(s * (1.f / 128.f) + EPS);
        v4u w0, w1;
        w0.x = pk2(o[0] * rstd * g[0], o[1] * rstd * g[1]); w0.y = pk2(o[2] * rstd * g[2], o[3] * rstd * g[3]); w0.z = pk2(o[4] * rstd * g[4], o[5] * rstd * g[5]); w0.w = pk2(o[6] * rstd * g[6], o[7] * rstd * g[7]);
        w1.x = pk2(o[8] * rstd * g[8], o[9] * rstd * g[9]); w1.y = pk2(o[10] * rstd * g[10], o[11] * rstd * g[11]); w1.z = pk2(o[12] * rstd * g[12], o[13] * rstd * g[13]); w1.w = pk2(o[14] * rstd * g[14], o[15] * rstd * g[15]);
        *(v4u*)(O0 + (size_t)m * D + 16 * F.lane) = w0; *(v4u*)(O0 + (size_t)m * D + 16 * F.lane + 8) = w1;
    }
}

#ifndef PROBE_SEG
#define PROBE_SEG 0
#endif
#define SEG_T0() do { if (PROBE_SEG != 0 && F.tid == 0) { volatile LAS unsigned long long* pp_ = (volatile LAS unsigned long long*)(F.MI + 16); pp_[0] = __builtin_amdgcn_s_memrealtime(); } } while (0)
#define SEG_T1(id) do { if (PROBE_SEG != 0 && F.tid == 0) { volatile LAS unsigned long long* pp_ = (volatile LAS unsigned long long*)(F.MI + 16); const unsigned long long t_ = __builtin_amdgcn_s_memrealtime(); if (PROBE_SEG == (id)) pp_[1] += t_ - pp_[0]; pp_[0] = t_; } } while (0)
__device__ __forceinline__ void p8_phase(Frame& F, const Args& A) {
    unsigned char* ws = F.ws;
    const float* mod = (const float*)(ws + WS_MOD); const bf16* Y = (const bf16*)(ws + WS_Y);
    signed char* H2 = (signed char*)(ws + WS_H); float* SA = (float*)(ws + WS_SA);
    LAS unsigned char* TH = F.lds; LAS unsigned char* TL = F.lds + 66048;
    LAS float* red = (LAS float*)F.lds;
    LAS int* cntl = (LAS int*)(F.lds + 135168);
    const int tid = F.tid, lane = F.lane, w = F.wave, hi = lane >> 5, l31 = lane & 31;
    int* lists = (int*)(ws + WS_LIST); float* wts = (float*)(ws + WS_WTS);
    v2u yn[2][4]; f32x4 xn[2][4];
    if (F.vcu < T / 32) {
#pragma unroll
        for (int q = 0; q < 2; ++q) { const size_t m = (size_t)F.vcu * 32 + w * 4 + q;
#pragma unroll
            for (int j = 0; j < 4; ++j) { yn[q][j] = *((const GAS v2u*)(Y + m * D) + lane + 64 * j); xn[q][j] = *((const GAS f32x4*)(A.in[0] + m * D) + lane + 64 * j); } } }
#pragma unroll 1
    for (int tl = F.vcu; tl < T / 32; tl += F.G) {
        const int tok0 = tl * 32, b = tok0 / SEQ, chunk = tok0 / TC;
        if (tid < 64) cntl[tid] = 0;
        SEG_T0();
        f32x4 c_gp[4], c_g2[4], c_sh[4];
#pragma unroll
        for (int j = 0; j < 4; ++j) { const int c = 4 * lane + 256 * j; c_gp[j] = *(const f32x4*)(A.in[21] + c) * *(const f32x4*)(mod + b * 6 * D + 2 * D + c);
            c_g2[j] = *(const f32x4*)(A.in[22] + c) * (*(const f32x4*)(mod + b * 6 * D + 4 * D + c) + 1.0f); c_sh[j] = *(const f32x4*)(mod + b * 6 * D + 3 * D + c); }
#pragma unroll 1
        for (int rp = 0; rp < 2; ++rp) {
            f32x4 y[2][4], x[2][4]; float s[2] = {0.f, 0.f};
#pragma unroll
            for (int q = 0; q < 2; ++q)
#pragma unroll
                for (int j = 0; j < 4; ++j) { const v2u yv = yn[q][j]; y[q][j] = (f32x4){bflo(yv.x), bfhi(yv.x), bflo(yv.y), bfhi(yv.y)}; x[q][j] = xn[q][j]; }
            { const int ntl = rp ? tl + F.G : tl, nrp = rp ^ 1;
              if (ntl < T / 32) {
#pragma unroll
                  for (int q = 0; q < 2; ++q) { const size_t m = (size_t)ntl * 32 + w * 4 + nrp * 2 + q;
#pragma unroll
                      for (int j = 0; j < 4; ++j) { yn[q][j] = *((const GAS v2u*)(Y + m * D) + lane + 64 * j); xn[q][j] = *((const GAS f32x4*)(A.in[0] + m * D) + lane + 64 * j); } } } }
#pragma unroll
            for (int q = 0; q < 2; ++q)
#pragma unroll
                for (int j = 0; j < 4; ++j) s[q] += (y[q][j].x * y[q][j].x + y[q][j].y * y[q][j].y) + (y[q][j].z * y[q][j].z + y[q][j].w * y[q][j].w);
            float s2[2] = {0.f, 0.f};
#pragma unroll
            for (int q = 0; q < 2; ++q) { const size_t m = (size_t)tok0 + w * 4 + rp * 2 + q; const float rstd = 1.f / sqrtf(wave_sum_dpp(s[q]) * (1.f / D) + EPS);
#pragma unroll
                for (int j = 0; j < 4; ++j) { x[q][j] = x[q][j] + c_gp[j] * (y[q][j] * rstd); { v2u xb; xb.x = pk2(x[q][j].x, x[q][j].y); xb.y = pk2(x[q][j].z, x[q][j].w); *((v2u*)(F.out + m * D) + lane + 64 * j) = xb; }
                    s2[q] += (x[q][j].x * x[q][j].x + x[q][j].y * x[q][j].y) + (x[q][j].z * x[q][j].z + x[q][j].w * x[q][j].w); } }
#pragma unroll
            for (int q = 0; q < 2; ++q) { const size_t m = (size_t)tok0 + w * 4 + rp * 2 + q; const float rstd2 = 1.f / sqrtf(wave_sum_dpp(s2[q]) * (1.f / D) + EPS);
                f32x4 hh[4]; float amx = 0.f;
#pragma unroll
                for (int j = 0; j < 4; ++j) { const int c = 4 * lane + 256 * j; const f32x4 h = (x[q][j] * rstd2) * c_g2[j] + c_sh[j]; hh[j] = h;
                    amx = fmaxf(amx, fmaxf(fmaxf(fabsf(h.x), fabsf(h.y)), fmaxf(fabsf(h.z), fabsf(h.w))));
                    v2u o; o.x = pk2(h.x, h.y); o.y = pk2(h.z, h.w);
                    *(LAS v2u*)(TH + (w * 4 + rp * 2 + q) * 2064 + c * 2) = o; }
                amx = fmaxf(wave_max_dpp(amx), 1e-20f); const float inv = 127.0f / amx; if (lane == 0) SA[m] = amx * (1.0f / 127.0f);
#pragma unroll
                for (int j = 0; j < 4; ++j) { const int q0 = (int)rintf(hh[j].x * inv), q1 = (int)rintf(hh[j].y * inv), q2 = (int)rintf(hh[j].z * inv), q3 = (int)rintf(hh[j].w * inv);
                    *((GAS unsigned*)(H2 + m * D) + lane + 64 * j) = (unsigned)(q0 & 0xff) | ((unsigned)(q1 & 0xff) << 8) | ((unsigned)(q2 & 0xff) << 16) | ((unsigned)(q3 & 0xff) << 24); } }
        }
        bf16x8 bH0[8], bH1[8];
        { const bf16* whp = (const bf16*)(ws + WS_WRH) + (size_t)l31 * D + 128 * w + 8 * hi;
#pragma unroll
          for (int ks = 0; ks < 8; ++ks) { bH0[ks] = *(const GAS bf16x8*)(whp + ks * 16); bH1[ks] = *(const GAS bf16x8*)(whp + 32 * D + ks * 16); } }
        __syncthreads(); SEG_T1(1);
        f32x16 acc0 = f32x16{}, acc1 = f32x16{};
        { const LAS unsigned char* ahp = TH + l31 * 2064 + (128 * w + 8 * hi) * 2;
#pragma unroll
          for (int ks = 0; ks < 8; ++ks) {
              const bf16x8 aH = *(const LAS bf16x8*)(ahp + ks * 32);
              acc0 = __builtin_amdgcn_mfma_f32_32x32x16_bf16(aH, bH0[ks], acc0, 0, 0, 0); acc1 = __builtin_amdgcn_mfma_f32_32x32x16_bf16(aH, bH1[ks], acc1, 0, 0, 0); } }
        __syncthreads(); SEG_T1(2);
#pragma unroll
        for (int r = 0; r < 16; ++r) { const int tk = (r & 3) + 8 * (r >> 2) + 4 * hi; red[(w * 32 + tk) * 64 + l31] = acc0[r]; red[(w * 32 + tk) * 64 + 32 + l31] = acc1[r]; }
        __syncthreads();
        int sel_e[4], sel_lp[4], sel_slot[4]; float sel_wt[4];
        const float eb = A.in[24][lane];
#pragma unroll
        for (int q = 0; q < 4; ++q) {
            const int tk = 4 * w + q; float lg = 0.f;
#pragma unroll
            for (int ww = 0; ww < 8; ++ww) lg += red[(ww * 32 + tk) * 64 + lane];
            const float score = 1.0f / (1.0f + expf(-lg)); const float ch = score + eb;
            const float m1 = max8_dpp(ch);
            const unsigned long long eq = __ballot(ch == m1); const int gsh = lane & ~7; const unsigned ge = (unsigned)((eq >> gsh) & 0xffull);
            const int first = gsh + __builtin_ctz(ge);
            const float m2 = max8_dpp((lane == first) ? -INFINITY : ch);
            const float gs = m1 + m2; const int g = lane >> 3;
            int grank = 0;
#pragma unroll
            for (int gg = 0; gg < 8; ++gg) { const float og = rl_f(gs, gg * 8); grank += (og > gs || (og == gs && gg < g)) ? 1 : 0; }
            float cur = (grank < 4) ? ch : -INFINITY;
            int rank = TOPK;
#pragma unroll
            for (int kk = 0; kk < TOPK; ++kk) { const float mx = wave_max_dpp(cur); const unsigned long long mk = __ballot(cur == mx); const int fl = (int)__builtin_ctzll(mk);
                if (lane == fl) { rank = kk; cur = -INFINITY; } }
            const bool sel = rank < TOPK;
            const float wsum = wave_sum_dpp(sel ? score : 0.f);
            sel_e[q] = sel ? lane : -1; sel_slot[q] = (tok0 + tk) * 8 + rank; sel_wt[q] = score / (wsum + 1e-20f) * 2.5f;
            sel_lp[q] = sel ? atomicAdd((int*)&cntl[lane], 1) : 0;
        }
        __syncthreads(); SEG_T1(3);
        if (tid < 64) { const int c = cntl[tid]; cntl[64 + tid] = c ? (int)__hip_atomic_fetch_add((unsigned*)(F.ctl + CW_CNT + chunk * 64 + tid), (unsigned)c, RLX_AGENT) : 0; }
        __syncthreads();
#pragma unroll
        for (int q = 0; q < 4; ++q) if (sel_e[q] >= 0) { const int pos = cntl[64 + lane] + sel_lp[q]; lists[((size_t)chunk * 64 + lane) * TC + pos] = sel_slot[q]; wts[sel_slot[q]] = sel_wt[q]; }
        __syncthreads(); SEG_T1(4);
    }
    SEG_T0();
    __syncthreads();
    LAS float* scr = (LAS float*)(F.lds + w * 16384);
    const int gw = F.vcu * NWAVES + w, NGW = F.G * NWAVES;
    constexpr int I13 = 16 * 4, I2 = 4 * 16, PER_E = 2 * I13 + I2;
    for (int it = gw; it < (NEXP + 1) * PER_E; it += NGW) {
        const int e = it / PER_E; int r = it % PER_E;
        const bool sh = (e == NEXP);
        if (r < 2 * I13) { const int w3 = r / I13; r %= I13; const int kb = r >> 2, n0 = 64 * (r & 3);
            const float* W = sh ? (w3 ? A.in[29] : A.in[28]) : ((w3 ? A.in[26] : A.in[25]) + (size_t)e * D * DEXP);
            signed char* WT = sh ? (signed char*)(ws + WS_W13S) : (signed char*)(ws + WS_W13) + (size_t)e * 512 * D;
            const float amx = fmaxf(__uint_as_float(__hip_atomic_load(F.ctl + CW_AMAX + 2 * e + w3, RLX_AGENT)), 1e-30f);
            transpose_item_q(W, D, DEXP, WT, kb, n0, (n0 >> 7) * 256 + (w3 ? 128 : 0) + (n0 & 127), scr, lane, 127.0f / amx); }
        else { r -= 2 * I13; const int kb = r >> 4, n0 = 64 * (r & 15);
            const float* W = sh ? A.in[30] : A.in[27] + (size_t)e * DEXP * D;
            bf16* WT = sh ? (bf16*)(ws + WS_W2S) : (bf16*)(ws + WS_W2) + (size_t)e * D * DEXP;
            transpose_item(W, DEXP, D, WT, kb, n0, n0, scr, lane); }
    }
    __syncthreads(); SEG_T1(5);
}

__device__ __forceinline__ int moe_tables(Frame& F, int chunk) {
    __syncthreads();
    if (F.wave == 0) {
        const int cnt = (int)__hip_atomic_load(F.ctl + CW_CNT + chunk * 64 + F.lane, RLX_AGENT);
        const int nt = (cnt + 255) >> 8; int incl = nt;
#pragma unroll
        for (int o = 1; o < 64; o <<= 1) { const int v = __shfl_up(incl, o); if (F.lane >= o) incl += v; }
        const int base = incl - nt;
        F.MI[MI_CNT + F.lane] = cnt; F.MI[MI_TBASE + F.lane] = base; if (F.lane == 63) F.MI[MI_TBASE + NEXP] = incl;
        for (int j = 0; j < nt; ++j) F.MI[MI_TILE_E + base + j] = F.lane; }
    __syncthreads();
    return F.MI[MI_TBASE + NEXP];
}
struct UpOrder {
    const char* ws; volatile LAS int* MI; int nrt_r, nrt, G, c;
    __device__ __forceinline__ bool next(int i, pg8::Unit& u) const { const int L = i * G + c; if (L >= 2 * nrt) return false; u.pm = L >> 1; u.pn = L & 1; u.z = i;
        u.e = (u.pm < nrt_r) ? __builtin_amdgcn_readfirstlane(MI[MI_TILE_E + u.pm]) : NEXP; return true; }
    __device__ __forceinline__ void bases(const pg8::Unit& u, const char*& a, const char*& b) const { a = ws + WS_H; b = (u.e < NEXP ? ws + WS_W13 + (size_t)u.e * 512 * D : ws + WS_W13S) + (size_t)u.pn * 256 * D; }
    __device__ __forceinline__ int tok(int ui, int row) const { return MI[MI_TOK + ui * 256 + row]; }
};
struct EpiSwiglu {
    static constexpr bool PERM = true, TWICE = false;
    bf16* HB; volatile LAS int* MI; gu32* amax;
    __device__ __forceinline__ void operator()(const acc_t& acc, const pg8::Unit& u, int wr, int wc, int fr, int fq) const {
        const int row0 = u.pm * 256 + wr * 64 + fr, col0 = u.pn * 128 + wc * 32 + 8 * fq;
        const float sB1 = __int_as_float(MI[MI_SB + 2 * u.z]), sB3 = __int_as_float(MI[MI_SB + 2 * u.z + 1]);
#pragma unroll
        for (int ai = 0; ai < 2; ++ai)
#pragma unroll
            for (int m = 0; m < 4; ++m) { bf16* rowp = HB + (size_t)(row0 + ai * 128 + m * 16) * DEXP + col0;
                const float sA = __int_as_float(MI[MI_SA + u.z * 256 + wr * 64 + fr + ai * 128 + m * 16]); const float s1 = sA * sB1, s3 = sA * sB3;
                float v[8];
                { const pg8::i32x4 A0 = __builtin_bit_cast(pg8::i32x4, acc[ai][0][m][0]), A1 = __builtin_bit_cast(pg8::i32x4, acc[ai][0][m][1]), G0 = __builtin_bit_cast(pg8::i32x4, acc[ai][1][m][0]), G1 = __builtin_bit_cast(pg8::i32x4, acc[ai][1][m][1]);
#pragma unroll
                  for (int i = 0; i < 4; ++i) { float a = (float)A0[i] * s1, g = (float)G0[i] * s3; asm volatile("" : "+v"(a), "+v"(g)); v[i] = a * sigm(a) * g;
                      float a2 = (float)A1[i] * s1, g2 = (float)G1[i] * s3; asm volatile("" : "+v"(a2), "+v"(g2)); v[4 + i] = a2 * sigm(a2) * g2; } }
                v4u w; w.x = pg8::cvt_pk_bf16(v[0], v[1]); w.y = pg8::cvt_pk_bf16(v[2], v[3]); w.z = pg8::cvt_pk_bf16(v[4], v[5]); w.w = pg8::cvt_pk_bf16(v[6], v[7]);
                *(v4u*)rowp = w; asm volatile("" ::: "memory"); }
    }
};
struct DownOrder {
    const char* ws; volatile LAS int* MI; int nrt_r, nrt, G, c;
    __device__ __forceinline__ bool next(int i, pg8::Unit& u) const { const int L = i * G + c; if (L >= 4 * nrt) return false; u.pm = L >> 2; u.pn = L & 3; u.z = i;
        u.e = (u.pm < nrt_r) ? __builtin_amdgcn_readfirstlane(MI[MI_TILE_E + u.pm]) : NEXP; return true; }
    __device__ __forceinline__ void bases(const pg8::Unit& u, const char*& a, const char*& b) const { a = ws + WS_HB + (size_t)u.pm * 256 * DEXP * 2; b = (u.e < NEXP ? ws + WS_W2 + (size_t)u.e * D * DEXP * 2 : ws + WS_W2S) + (size_t)u.pn * 256 * DEXP * 2; }
    __device__ __forceinline__ int tok(int, int) const { return 0; }
};
struct EpiScatter {
    static constexpr bool PERM = true, TWICE = true;
    unsigned char* SL; volatile LAS int* MI;
    __device__ __forceinline__ void operator()(const acc_t& acc, const pg8::Unit& u, int wr, int wc, int fr, int fq) const {
        const int col0 = u.pn * 256 + wc * 32 + 8 * fq;
#pragma unroll
        for (int ai = 0; ai < 2; ++ai)
#pragma unroll
            for (int m = 0; m < 4; ++m) { const int rl = wr * 64 + fr + ai * 128 + m * 16; const int dest = MI[MI_TOK + u.z * 256 + rl]; const float wt = 16.0f;
                if (dest >= 0) { unsigned char* rowp = SL + (size_t)dest * D + col0;
#pragma unroll
                    for (int bj = 0; bj < 2; ++bj) { const pg8::f32x4 v0 = acc[ai][bj][m][0], v1 = acc[ai][bj][m][1];
                        float q[8];
#pragma unroll
                        for (int i = 0; i < 4; ++i) { q[i] = __builtin_amdgcn_fmed3f(v0[i] * wt, -448.0f, 448.0f); q[4 + i] = __builtin_amdgcn_fmed3f(v1[i] * wt, -448.0f, 448.0f); }
                        v2u w; w.x = (unsigned)__builtin_amdgcn_cvt_pk_fp8_f32(q[0], q[1], 0, false); w.x = (unsigned)__builtin_amdgcn_cvt_pk_fp8_f32(q[2], q[3], (int)w.x, true);
                        w.y = (unsigned)__builtin_amdgcn_cvt_pk_fp8_f32(q[4], q[5], 0, false); w.y = (unsigned)__builtin_amdgcn_cvt_pk_fp8_f32(q[6], q[7], (int)w.y, true);
                        *(v2u*)(rowp + bj * 128) = w; asm volatile("" ::: "memory"); } } }
    }
};
__device__ __forceinline__ void p2_phase(Frame& F, const Args& A) {
    unsigned char* ws = F.ws;
    DenseOrder S; S.init(ws + WS_H, ws + WS_WIN, T, W_IN, D / 2, F.G, (int)blockIdx.x);
    const float* SH = (const float*)(ws + WS_SH);
    { float v[7]; int pmv[7];
#pragma unroll
      for (int k = 0; k < 7; ++k) { pg8::Unit u; pmv[k] = S.next((F.tid >> 8) + 2 * k, u) ? u.pm : -1; v[k] = pmv[k] >= 0 ? SH[pmv[k] * 256 + (F.tid & 255)] : 0.f; }
#pragma unroll
      for (int k = 0; k < 7; ++k) if (pmv[k] >= 0) F.MI[512 + ((F.tid >> 8) + 2 * k) * 256 + (F.tid & 255)] = __float_as_int(v[k]); }
    __syncthreads();
    EpiProj E{(bf16*)(ws + WS_XR), (bf16*)F.out, F.MI, fmaxf(__uint_as_float(__hip_atomic_load(F.ctl + CW_AMAX + 130, RLX_AGENT)), 1e-30f) * (1.0f / 127.0f)};
    int Kk = D / 2; asm volatile("" : "+s"(Kk));
    pg8::gemm_phase<EpiProj, DenseOrder, true, false, true>(F.lds, F.tid, Kk, S, E);
}
__device__ __forceinline__ void moe_up(Frame& F, int chunk) {
    unsigned char* ws = F.ws;
    const int nrt_r = moe_tables(F, chunk), nrt = nrt_r + TC / 256;
    const int* lists = (const int*)(ws + WS_LIST);
    int* rdest = (int*)(ws + WS_RDEST);
    { const int r = F.tid & 255; int tokn[3], dest[3], slot[3]; float sa[3]; bool act[3]; int rt_[3];
#pragma unroll
      for (int k = 0; k < 3; ++k) { const int i = (F.tid >> 8) + 2 * k, L = i * F.G + F.vcu, rt = L >> 1; act[k] = L < 2 * nrt; rt_[k] = rt; slot[k] = -1; tokn[k] = chunk * TC; dest[k] = -1;
          if (act[k]) { if (rt < nrt_r) { const int e = F.MI[MI_TILE_E + rt]; const int idx = (rt - F.MI[MI_TBASE + e]) * 256 + r; if (idx < F.MI[MI_CNT + e]) slot[k] = lists[((size_t)chunk * 64 + e) * TC + idx]; }
              else { tokn[k] = chunk * TC + (rt - nrt_r) * 256 + r; dest[k] = TC * 8 + (rt - nrt_r) * 256 + r; } } }
#pragma unroll
      for (int k = 0; k < 3; ++k) if (slot[k] >= 0) { tokn[k] = slot[k] >> 3; dest[k] = slot[k] - chunk * TC * 8; }
#pragma unroll
      for (int k = 0; k < 3; ++k) sa[k] = ((const float*)(ws + WS_SA))[tokn[k]];
#pragma unroll
      for (int k = 0; k < 3; ++k) if (act[k]) { const int i = (F.tid >> 8) + 2 * k, L = i * F.G + F.vcu;
          F.MI[MI_TOK + i * 256 + r] = tokn[k]; F.MI[MI_SA + i * 256 + r] = __float_as_int(sa[k]);
          if ((L & 1) == 0) rdest[rt_[k] * 256 + r] = dest[k]; }
      if (F.tid < 12) { const int i = F.tid >> 1, rr = F.tid & 1, L = i * F.G + F.vcu;
          if (L < 2 * nrt) { const int rt = L >> 1; const int e_ = (rt < nrt_r) ? F.MI[MI_TILE_E + rt] : NEXP;
              F.MI[MI_SB + 2 * i + rr] = __float_as_int(fmaxf(__uint_as_float(__hip_atomic_load(F.ctl + CW_AMAX + 2 * e_ + rr, RLX_AGENT)), 1e-30f) * (1.0f / 127.0f)); } } }
    __syncthreads();
    UpOrder S{(const char*)ws, F.MI, nrt_r, nrt, F.G, F.vcu};
    EpiSwiglu E{(bf16*)(ws + WS_HB), F.MI, F.ctl + CW_AMAX};
    int Kk = D / 2; asm volatile("" : "+s"(Kk));
    pg8::gemm_phase<EpiSwiglu, UpOrder, true, true, true>(F.lds, F.tid, Kk, S, E);
}
__device__ __forceinline__ void moe_down(Frame& F, int chunk) {
    unsigned char* ws = F.ws;
    __syncthreads();
    const int nrt_r = F.MI[MI_TBASE + NEXP], nrt = nrt_r + TC / 256;
    { const int* rdest = (const int*)(ws + WS_RDEST) + (F.tid & 255); int v[5];
#pragma unroll
      for (int k = 0; k < 5; ++k) { const int L = ((F.tid >> 8) + 2 * k) * F.G + F.vcu; v[k] = (L < 4 * nrt) ? rdest[(L >> 2) * 256] : -1; }
#pragma unroll
      for (int k = 0; k < 5; ++k) { const int i = (F.tid >> 8) + 2 * k, L = i * F.G + F.vcu; if (L < 4 * nrt) F.MI[MI_TOK + i * 256 + (F.tid & 255)] = v[k]; } }
    __syncthreads();
    DownOrder S{(const char*)ws, F.MI, nrt_r, nrt, F.G, F.vcu};
    EpiScatter E{ws + WS_SLOT, F.MI};
    int Kk = DEXP; asm volatile("" : "+s"(Kk));
    pg8::gemm_phase<EpiScatter, DownOrder, false, false>(F.lds, F.tid, Kk, S, E);
}
__device__ __forceinline__ void moe_combine(Frame& F, const Args& A, int chunk, bool poison) {
    unsigned char* ws = F.ws;
    const float* mod = (const float*)(ws + WS_MOD); const unsigned char* SL = ws + WS_SLOT; const float* wts = (const float*)(ws + WS_WTS);
    const int gw = F.vcu * NWAVES + F.wave, NGW = F.G * NWAVES;
    f32x4 gpv[4];
#pragma unroll
    for (int j = 0; j < 4; ++j) gpv[j] = *(const f32x4*)(A.in[31] + 4 * F.lane + 256 * j);
    unsigned dA[9][4], dB[9][4]; v2u xA[4], xB[4];
#define CB_LOAD(tl_, d_, x_) do { const int t_ = __builtin_amdgcn_readfirstlane(tl_);        \
        _Pragma("unroll") for (int j = 0; j < 4; ++j) x_[j] = *((const GAS v2u*)(F.out + ((size_t)chunk * TC + t_) * D) + F.lane + 64 * j); \
        asm volatile("" ::: "memory"); \
        const GAS unsigned* b0_ = (const GAS unsigned*)(SL + (size_t)t_ * 8 * D) + F.lane; const GAS unsigned* b1_ = b0_ + 4 * (D / 4); \
        const GAS unsigned* b2_ = (const GAS unsigned*)(SL + ((size_t)TC * 8 + t_) * D) + F.lane;         \
        _Pragma("unroll") for (int k = 0; k < 9; ++k) \
            _Pragma("unroll") for (int j = 0; j < 4; ++j) d_[k][j] = (k < 4 ? b0_ : k < 8 ? b1_ : b2_)[(k < 8 ? (k & 3) : 0) * (D / 4) + 64 * j]; } while (0)
#define CB_REDUCE(tl_, d_, x_) do { const int t_ = __builtin_amdgcn_readfirstlane(tl_); const size_t m = (size_t)chunk * TC + t_; const int b = (int)(m / SEQ); \
        f32x4 gt[4]; _Pragma("unroll") for (int j = 0; j < 4; ++j) gt[j] = *(const f32x4*)(mod + b * 6 * D + 5 * D + 4 * F.lane + 256 * j); \
        const float wl_ = (F.lane < 8) ? wts[m * 8 + F.lane] : 1.0f;        \
        f32x4 y[4]; \
        _Pragma("unroll") for (int j = 0; j < 4; ++j) y[j] = (f32x4){0.f, 0.f, 0.f, 0.f}; \
        _Pragma("unroll") for (int k = 0; k < 9; ++k) { const float wk_ = (k < 8) ? rl_f(wl_, k) : 1.0f; _Pragma("unroll") for (int j = 0; j < 4; ++j) { const int dd = (int)d_[k][j]; \
            const auto lo_ = __builtin_amdgcn_cvt_pk_f32_fp8(dd, false); const auto hi_ = __builtin_amdgcn_cvt_pk_f32_fp8(dd, true); \
            y[j].x = __builtin_fmaf(lo_[0], wk_, y[j].x); y[j].y = __builtin_fmaf(lo_[1], wk_, y[j].y); y[j].z = __builtin_fmaf(hi_[0], wk_, y[j].z); y[j].w = __builtin_fmaf(hi_[1], wk_, y[j].w); } \
            __builtin_amdgcn_sched_barrier(0); } \
        _Pragma("unroll") for (int j = 0; j < 4; ++j) y[j] = y[j] * 0.0625f; \
        float s = 0.f; \
        _Pragma("unroll") for (int j = 0; j < 4; ++j) s += (y[j].x * y[j].x + y[j].y * y[j].y) + (y[j].z * y[j].z + y[j].w * y[j].w); \
        const float rstd = 1.f / sqrtf(wave_sum(s) * (1.f / D) + EPS); \
        asm volatile("" ::: "memory"); \
        _Pragma("unroll") for (int j = 0; j < 4; ++j) { f32x4* op = (f32x4*)(F.out + m * D) + F.lane + 64 * j; const v2u xb = x_[j]; \
            f32x4 o = (f32x4){bflo(xb.x), bfhi(xb.x), bflo(xb.y), bfhi(xb.y)} + gt[j] * (y[j] * rstd * gpv[j]); \
            if (poison) { const float q_ = __builtin_nanf(""); o = (f32x4){q_, q_, q_, q_}; } \
            *op = o; } } while (0)
    for (int tl = gw; tl < TC; tl += NGW) { CB_LOAD(tl, dA, xA); CB_REDUCE(tl, dA, xA); }
#undef CB_LOAD
#undef CB_REDUCE
}

__device__ __forceinline__ void attn_phase(Frame& F, const Args& A, char* lds_generic) {
    const attn_body::bf16* Q = (const attn_body::bf16*)(F.ws + WS_Q); const attn_body::bf16* K = (const attn_body::bf16*)(F.ws + WS_K); const attn_body::bf16* V = (const attn_body::bf16*)(F.ws + WS_V);
    attn_body::bf16* O = (attn_body::bf16*)(F.ws + WS_H);
    const float d1 = A.in[13][F.lane] * A.in[14][F.lane], d2 = A.in[15][F.lane] * A.in[16][F.lane];
    const float lam = expf(wave_sum(d1)) - expf(wave_sum(d2)) + LAM_INIT;
    const int npr = (BATCH * 16 - F.vcu + F.G - 1) / F.G;
#pragma unroll 1
    for (int it = 0; it < npr * 8; ++it) {
        const int pr = F.vcu + (it >> 3) * F.G, qi = (it >> 1) & 3, m = it & 1;
        const int pair = pr >> 1, st = pr & 1, b = pair >> 3, h = pair & 7;
        const int qb = st ? (qi == 0 ? 6 : qi == 1 ? 5 : qi == 2 ? 2 : 1) : (qi == 0 ? 7 : qi == 1 ? 4 : qi == 2 ? 3 : 0);
        const float sl2 = exp2f(-(float)(h + 1)) * LOG2E;
        if (m == 0) attn_body::attn_unit2<8, false>(F.tid, b, h, 0, qb, sl2, lam, A.in[17], Q, K, V, O, lds_generic);
        else        attn_body::attn_unit2<8, true >(F.tid, b, h, 1, qb, sl2, lam, A.in[17], Q, K, V, O, lds_generic);
    }
}

__global__ void __launch_bounds__(NWAVES * 64, 2) hybrid_fwd(Args args) {
    extern __shared__ __attribute__((aligned(16))) unsigned char lds[];
    Frame F;
    F.lds = (LAS unsigned char*)lds;
    F.MI = (volatile LAS int*)(F.lds + MISC_OFF);
    F.tid = threadIdx.x; F.lane = F.tid & 63; F.wave = __builtin_amdgcn_readfirstlane(F.tid >> 6);
    F.G = gridDim.x; { const int bx = blockIdx.x; F.vcu = (F.G % 8 == 0) ? (bx % 8) * (F.G / 8) + bx / 8 : bx; }
    unsigned char* ws = args.ws; F.ws = ws; F.out = args.out;
    F.ctl = (gu32*)(ws + WS_CTL);
    for (int u = F.tid; u < MI_WORDS; u += NWAVES * 64) F.MI[u] = 0;
    __syncthreads();
    XcdBarrier bar; bar.bar = (unsigned*)(F.ctl + CW_BAR); bar.x = 0; bar.st = nullptr;
    if (!PER_PHASE) bar = xcd_barrier_post((unsigned*)(F.ctl + CW_BAR), (volatile LAS unsigned*)(F.MI + MI_BARST));
    const int lo = args.ph_lo, hi = args.ph_hi;
#ifndef PH_MASK
#define PH_MASK 0xFFFFFFFFu
#endif
#ifndef PROBE_MASK
#define PROBE_MASK 0u
#endif
#define PSTAMP(k) do { if (PROBE_MASK != 0u && F.tid == 0) { const unsigned long long t_ = __builtin_amdgcn_s_memrealtime(); volatile LAS unsigned long long* pp_ = (volatile LAS unsigned long long*)(F.MI + 16); \
        if ((PROBE_MASK >> (k)) & 1u) pp_[1] += t_ - pp_[0]; pp_[0] = t_; } } while (0)
#define FRESH() do { size_t z_ = 0; asm volatile("" : "+s"(z_)); unsigned char* w_ = args.ws + z_;        F.ws = w_; ws = w_; F.ctl = (gu32*)(w_ + WS_CTL); int t_ = threadIdx.x; asm volatile("" : "+v"(t_)); F.tid = t_; F.lane = t_ & 63; F.wave = __builtin_amdgcn_readfirstlane(t_ >> 6); } while (0)
    if ((PROBE_MASK != 0u || PROBE_SEG != 0) && F.tid == 0) { volatile LAS unsigned long long* pp_ = (volatile LAS unsigned long long*)(F.MI + 16); pp_[0] = __builtin_amdgcn_s_memrealtime(); pp_[1] = 0ull; }
#define IN(k) (((PH_MASK >> (k)) & 1u) && lo <= (k) && (k) < hi)
#define SEAM(k) do { if (IN(k) && IN((k) + 1)) { if (PER_PHASE) { if (F.tid == 0) __hip_atomic_store(F.ctl + CW_TMO, 0xBADBA0u, RLX_AGENT); } else xcd_barrier(bar); } PSTAMP(k); } while (0)
    if (IN(0)) { FRESH(); p0_phase(F, args); } SEAM(0);
    if (IN(1)) { FRESH(); p1_phase(F, args); } SEAM(1);
    if (IN(2)) { FRESH(); p2_phase(F, args); } SEAM(2);
    if (IN(3)) { FRESH(); lru_phase(F, args); } if (PER_PHASE) { SEAM(3); } else { PSTAMP(3); }
    if (IN(4)) { FRESH(); attn_phase(F, args, (char*)lds); } SEAM(4);
    if (PER_PHASE) { SEAM(5); }
    if (IN(6)) { FRESH(); MergeOrder S; S.d.init(ws + WS_GR, ws + WS_WR, T, D, D, F.G, (int)blockIdx.x); S.A1 = (const char*)(ws + WS_H); S.B1 = (const char*)(ws + WS_WA);
        EpiGate E{(const unsigned char*)args.out, (const unsigned char*)args.out + (size_t)T * D, (bf16*)(ws + WS_V), (bf16*)(ws + WS_XR)};
        pg8::gemm_phase<EpiGate, MergeOrder, true, false>(F.lds, F.tid, D, S, E); } SEAM(6);
    if (IN(7)) { FRESH(); DenseOrder S; S.init(ws + WS_XR, ws + WS_WO, T, D, D, F.G, (int)blockIdx.x); EpiF32 E{(bf16*)(ws + WS_Y)};
        pg8::gemm_phase<EpiF32, DenseOrder, true, false>(F.lds, F.tid, D, S, E); } SEAM(7);
    if (IN(8)) { FRESH(); p8_phase(F, args); } SEAM(8);
#pragma unroll 1
    for (int c = 0; c < NCH; ++c) {
        const int pa = 9 + 2 * c, pb = 10 + 2 * c;
        if (IN(pa)) { FRESH(); if (c > 0) { int cm = c - 1; asm volatile("" : "+s"(cm)); moe_combine(F, args, cm, false); FRESH(); } int cu = c; asm volatile("" : "+s"(cu)); moe_up(F, cu); } SEAM(pa);
        if (IN(pb)) { FRESH(); int cd = c; asm volatile("" : "+s"(cd)); moe_down(F, cd); } SEAM(pb);
    }
    if (IN(9 + 2 * NCH)) { FRESH();
        bool poison = __hip_atomic_load(F.ctl + CW_TMO, RLX_AGENT) != 0u || __hip_atomic_load(F.ctl + CW_BAR + XB_TMO, RLX_AGENT) != 0u;
        moe_combine(F, args, NCH - 1, poison);
    }
    PSTAMP(17);
#undef IN
#undef SEAM
    if (PROBE_MASK != 0u || PROBE_SEG != 0) { __syncthreads(); if (F.tid == 0) { volatile LAS unsigned long long* pp_ = (volatile LAS unsigned long long*)(F.MI + 16);
        unsigned long long acc_ = pp_[1]; const unsigned long long t2_ = __builtin_amdgcn_s_memrealtime();
        while (__builtin_amdgcn_s_memrealtime() - t2_ < acc_) __builtin_amdgcn_s_sleep(8); } __syncthreads(); }
}

extern "C" void kernel_launch(void* const* d_in, const int* in_sizes, int n_in, void* d_out, int out_size, void* d_ws, size_t ws_size, hipStream_t stream) {
    static int grid = 0;
    if (grid == 0) {
        if (n_in != 32 || out_size != T * D || ws_size < WS_END) { fprintf(stderr, "kernel_launch: unexpected shapes (n_in %d, out %d, ws %zu); nothing launched\n", n_in, out_size, ws_size); grid = -1; return; }
        int dev = 0, cus = 0, per_cu = 0;
        if (hipGetDevice(&dev) != hipSuccess || hipDeviceGetAttribute(&cus, hipDeviceAttributeMultiprocessorCount, dev) != hipSuccess) { grid = -1; return; }
        if (hipFuncSetAttribute((const void*)hybrid_fwd, hipFuncAttributeMaxDynamicSharedMemorySize, LDS_BYTES) != hipSuccess) { fprintf(stderr, "kernel_launch: hipFuncSetAttribute failed\n"); grid = -1; return; }
        if (hipOccupancyMaxActiveBlocksPerMultiprocessor(&per_cu, (const void*)hybrid_fwd, NWAVES * 64, LDS_BYTES) != hipSuccess || per_cu < 1) { fprintf(stderr, "kernel_launch: occupancy query says %d blocks per CU\n", per_cu); per_cu = 1; }
        (void)hipGetLastError();
        grid = cus;
    }
    if (grid < 0) return;
    (void)hipMemsetAsync((char*)d_ws + WS_CTL, 0, CTL_ZERO_BYTES, stream);
    Args a{};
    for (int i = 0; i < 32; ++i) a.in[i] = (const float*)d_in[i];
    a.out = (float*)d_out; a.ws = (unsigned char*)d_ws;
    if (N_LAUNCHES == 1) { a.ph_lo = 0; a.ph_hi = N_PHASES; hipLaunchKernelGGL(hybrid_fwd, dim3(grid), dim3(NWAVES * 64), LDS_BYTES, stream, a); }
    else for (int p = 0; p < N_PHASES; ++p) { a.ph_lo = p; a.ph_hi = p + 1; hipLaunchKernelGGL(hybrid_fwd, dim3(grid), dim3(NWAVES * 64), LDS_BYTES, stream, a); }
}
```

```cpp
#include <hip/hip_runtime.h>
#include <hip/hip_bf16.h>
#include <cstdio>
#include <cstdint>
#include <cmath>

#ifndef MK_N_LAUNCHES
#define MK_N_LAUNCHES 1
#endif

constexpr int BATCH = 16, SEQ = 2048, D = 1024, T = BATCH * SEQ;
constexpr int W_IN = 7 * 1024;
constexpr int NEXP = 64, TOPK = 8, DEXP = 256;
constexpr int NCH = 2, TC = T / NCH;
constexpr float EPS = 1e-6f;
constexpr float LOG2E = 1.4426950408889634f;
constexpr float LAM_INIT = 0.2f;

namespace pg8 {
#define PG8_LAS __attribute__((address_space(3)))
typedef unsigned short bf16_t;
typedef short bf16x8 __attribute__((ext_vector_type(8)));
typedef float f32x4 __attribute__((ext_vector_type(4)));
typedef unsigned u32x4 __attribute__((ext_vector_type(4)));
constexpr int BM = 256, BK = 64, HALF = 128, HTB = HALF * BK * 2, STAGE_BYTES = 8 * HTB, NXCD = 8, WGM = 8;

__host__ __device__ __forceinline__ int lds_byte(int r, int c) { const int st = (r >> 4) * 2 + (c >> 5), rr = r & 15, cc = c & 31, ob = rr * 64 + cc * 2; return st * 1024 + (ob ^ (((ob >> 9) & 1) << 5)); }
__host__ __device__ __forceinline__ void stage_rc(int b, int& R, int& C) { const int st = b / 1024, sb = b % 1024, swz = sb ^ (((sb >> 9) & 1) << 5); R = (st >> 1) * 16 + swz / 64; C = (st & 1) * 32 + (swz % 64) / 2; }
__host__ __device__ __forceinline__ int perm32(int rho) { const int n = rho >> 4, i = rho & 15; return 8 * (i >> 2) + 4 * n + (i & 3); }

struct Unit { int pm, pn, z, e; };

__device__ __forceinline__ unsigned cvt_pk_bf16(float lo, float hi) { unsigned r; asm volatile("v_cvt_pk_bf16_f32 %0, %1, %2" : "=v"(r) : "v"(lo), "v"(hi)); return r; }
__device__ __forceinline__ float sigm(float x) { return __builtin_amdgcn_rcpf(1.0f + __builtin_amdgcn_exp2f(-LOG2E * x)); }
__device__ __forceinline__ float gelu_t(float x) { const float u = 0.7978845608028654f * (x + 0.044715f * x * x * x); return x * sigm(2.0f * u); }
__device__ __forceinline__ float bflo(unsigned w) { return __uint_as_float(w << 16); }
__device__ __forceinline__ float bfhi(unsigned w) { return __uint_as_float(w & 0xffff0000u); }

typedef int i32x4 __attribute__((ext_vector_type(4)));
template <class Epi, class Sched, bool ALIGN_EPI, bool GATHER, bool INT8 = false>
__device__ __forceinline__ void gemm_phase(PG8_LAS unsigned char* lds, const int tid, const int K, const Sched& S, const Epi& E) {
    const int wid = __builtin_amdgcn_readfirstlane(tid >> 6), lane = tid & 63, wr = wid >> 2, wc = wid & 3, fr = lane & 15, fq = lane >> 4;
    const int nt = K / BK;
    unsigned voffA[2], voffB[2];
#pragma unroll
    for (int i = 0; i < 2; ++i) { int R, C; stage_rc(tid * 16 + i * 8192, R, C); const int Rb = Epi::PERM ? ((R & ~31) + perm32(R & 31)) : R;
        voffA[i] = (unsigned)(R * K + C) * 2u; voffB[i] = (unsigned)(Rb * K + C) * 2u; }
    const size_t kstep = (size_t)(BK * 2);
    const size_t hstep = (size_t)HALF * K * 2;
    const unsigned ldsw = (unsigned)wid * 1024u;
    const int aoff = lds_byte(wr * 64 + fr, fq * 8), boff = lds_byte(wc * 32 + fr, fq * 8);
#define PG8_SA(b, h) (((b) * 2 + (h)) * HTB)
#define PG8_SB(b, h) ((4 + (b) * 2 + (h)) * HTB)
#define PG8_STAGE(bufoff, gbase, voff) do { _Pragma("unroll") for (int _i = 0; _i < 2; ++_i) \
        __builtin_amdgcn_global_load_lds((const unsigned*)((const char*)(gbase) + (voff)[_i]), (PG8_LAS unsigned*)(lds + (bufoff) + ldsw + _i * 8192), 16, 0, 0); } while (0)
#define PG8_STAGE_A(bufoff, p, h, VG) do { if constexpr (GATHER) { PG8_STAGE(bufoff, p, VG[h]); } else { PG8_STAGE(bufoff, (p) + (h) * hstep, voffA); } } while (0)
#define PG8_LDA(dst, b, h) do { _Pragma("unroll") for (int m = 0; m < 4; ++m) _Pragma("unroll") for (int k = 0; k < 2; ++k) dst[m][k] = *(const PG8_LAS bf16x8*)(lds + PG8_SA(b, h) + aoff + m * 2048 + k * 1024); } while (0)
#define PG8_LDB(dst, b, h) do { _Pragma("unroll") for (int n = 0; n < 2; ++n) _Pragma("unroll") for (int k = 0; k < 2; ++k) dst[n][k] = *(const PG8_LAS bf16x8*)(lds + PG8_SB(b, h) + boff + n * 2048 + k * 1024); } while (0)
#define PG8_MMA(ai, bj, At, Bt) do { __builtin_amdgcn_s_setprio(1); _Pragma("unroll") for (int m = 0; m < 4; ++m) _Pragma("unroll") for (int n = 0; n < 2; ++n) _Pragma("unroll") for (int k = 0; k < 2; ++k) \
        { if constexpr (INT8) acc[ai][bj][m][n] = __builtin_bit_cast(f32x4, __builtin_amdgcn_mfma_i32_16x16x64_i8(__builtin_bit_cast(i32x4, Bt[n][k]), __builtin_bit_cast(i32x4, At[m][k]), __builtin_bit_cast(i32x4, acc[ai][bj][m][n]), 0, 0, 0)); \
          else acc[ai][bj][m][n] = __builtin_amdgcn_mfma_f32_16x16x32_bf16(Bt[n][k], At[m][k], acc[ai][bj][m][n], 0, 0, 0); } __builtin_amdgcn_s_setprio(0); } while (0)
#define PG8_WAIT_V(n) asm volatile("s_waitcnt vmcnt(" #n ")" ::: "memory")
#define PG8_WAIT_VR(rx) do { if constexpr (Epi::MIN_VM > 0) { const int rx_ = __builtin_amdgcn_readfirstlane((rx) ? 1 : 0); asm volatile("s_waitcnt vmcnt(%1)\n\ts_cmp_lg_u32 %0, 0\n\ts_cbranch_scc1 1\n\ts_waitcnt vmcnt(8)" :: "s"(rx_), "n"(8 + Epi::MIN_VM) : "memory", "scc"); } else PG8_WAIT_V(8); } while (0)
#define PG8_WAIT_L(n) asm volatile("s_waitcnt lgkmcnt(" #n ")" ::: "memory")
#define PG8_BAR __builtin_amdgcn_s_barrier()
#define PG8_SCHED __builtin_amdgcn_sched_barrier(0)
#define PG8_LOADVG(VG, ui_) do { if constexpr (GATHER) { _Pragma("unroll") for (int h_ = 0; h_ < 2; ++h_) _Pragma("unroll") for (int i_ = 0; i_ < 2; ++i_) \
        { int R_, C_; stage_rc(tid * 16 + i_ * 8192, R_, C_); VG[h_][i_] = ((unsigned)S.tok((ui_), h_ * HALF + R_) * (unsigned)K + (unsigned)C_) * 2u; } } } while (0)
    Unit cur, nxt; int ui = 0;
    if (!S.next(0, cur)) return;
    f32x4 acc[2][2][4][2];
#pragma unroll
    for (int a = 0; a < 2; ++a)
#pragma unroll
        for (int b = 0; b < 2; ++b)
#pragma unroll
            for (int m = 0; m < 4; ++m)
#pragma unroll
                for (int n = 0; n < 2; ++n) acc[a][b][m][n] = (f32x4){0.f, 0.f, 0.f, 0.f};
    bf16x8 At[4][2], B0[2][2], B1[2][2];
    unsigned vgc[2][2];
#pragma unroll
    for (int h_ = 0; h_ < 2; ++h_)
#pragma unroll
        for (int i_ = 0; i_ < 2; ++i_) vgc[h_][i_] = 0u;
    PG8_LOADVG(vgc, 0);
    const char *cA, *cB; S.bases(cur, cA, cB);
    PG8_STAGE(PG8_SB(0, 0), cB, voffB); PG8_STAGE(PG8_SB(0, 1), cB + hstep, voffB); PG8_STAGE_A(PG8_SA(0, 0), cA, 0, vgc); PG8_STAGE_A(PG8_SA(0, 1), cA, 1, vgc);
    if (wr == 1) PG8_BAR;
    PG8_WAIT_V(2); PG8_BAR;
    PG8_STAGE(PG8_SB(1, 0), cB + kstep, voffB); PG8_STAGE_A(PG8_SA(1, 0), cA + kstep, 0, vgc); PG8_STAGE(PG8_SB(1, 1), cB + hstep + kstep, voffB);
    PG8_WAIT_V(6); PG8_BAR;
    for (;;) {
        const bool has_next = S.next(ui + 1, nxt);
        const char *nA = cA, *nB = cB;
        if (has_next) S.bases(nxt, nA, nB);
        for (int t = 0; t < nt; t += 2) {
            const bool last = (t == nt - 2);
            const char* a1 = cA + (size_t)(t + 1) * kstep;
            const char* a2 = last ? nA : cA + (size_t)(t + 2) * kstep; const char* b2 = last ? nB : cB + (size_t)(t + 2) * kstep;
            const char* a3 = a2 + kstep; const char* b3 = b2 + kstep;
            unsigned vgs[2][2];
#pragma unroll
            for (int h_ = 0; h_ < 2; ++h_)
#pragma unroll
                for (int i_ = 0; i_ < 2; ++i_) vgs[h_][i_] = vgc[h_][i_];
            if (last && has_next) PG8_LOADVG(vgs, ui + 1);
            const bool relax = (t == 0) && (ui > 0);
            PG8_LDB(B0, 0, 0); PG8_LDB(B1, 0, 1); PG8_SCHED; PG8_LDA(At, 0, 0); PG8_STAGE_A(PG8_SA(1, 1), a1, 1, vgc);
            PG8_WAIT_VR(relax); PG8_WAIT_L(0); PG8_BAR; PG8_MMA(0, 0, At, B0); PG8_MMA(0, 1, At, B1); PG8_BAR; PG8_SCHED;
            PG8_LDA(At, 0, 1); PG8_STAGE(PG8_SB(0, 0), b2, voffB); PG8_STAGE(PG8_SB(0, 1), b2 + hstep, voffB); PG8_STAGE_A(PG8_SA(0, 0), a2, 0, vgs);
            PG8_WAIT_VR(relax); PG8_WAIT_L(0); PG8_BAR; PG8_MMA(1, 0, At, B0); PG8_MMA(1, 1, At, B1); PG8_BAR; PG8_SCHED;
            PG8_LDB(B0, 1, 0); PG8_LDB(B1, 1, 1); PG8_SCHED; PG8_LDA(At, 1, 0); PG8_STAGE_A(PG8_SA(0, 1), a2, 1, vgs);
            PG8_WAIT_V(8); PG8_WAIT_L(0); PG8_BAR; PG8_MMA(0, 0, At, B0); PG8_MMA(0, 1, At, B1); PG8_BAR; PG8_SCHED;
            PG8_LDA(At, 1, 1); PG8_STAGE(PG8_SB(1, 0), b3, voffB); PG8_STAGE(PG8_SB(1, 1), b3 + hstep, voffB); PG8_STAGE_A(PG8_SA(1, 0), a3, 0, vgs);
            PG8_WAIT_V(8); PG8_WAIT_L(0); PG8_BAR; PG8_MMA(1, 0, At, B0); PG8_MMA(1, 1, At, B1); PG8_BAR; PG8_SCHED;
        }
        if constexpr (ALIGN_EPI) { if (wr == 0) PG8_BAR; }
        E(acc, cur, wr, wc, fr, fq);
#ifdef PROBE_EPI2
        if (Epi::TWICE) { asm volatile("" ::: "memory"); E(acc, cur, wr, wc, fr, fq); }
#endif
        if (!has_next) break;
#pragma unroll
        for (int a = 0; a < 2; ++a)
#pragma unroll
            for (int b = 0; b < 2; ++b)
#pragma unroll
                for (int m = 0; m < 4; ++m)
#pragma unroll
                    for (int n = 0; n < 2; ++n) acc[a][b][m][n] = (f32x4){0.f, 0.f, 0.f, 0.f};
        cur = nxt; cA = nA; cB = nB; ++ui;
        PG8_LOADVG(vgc, ui);
        if constexpr (ALIGN_EPI) { if (wr == 1) PG8_BAR; }
    }
    PG8_WAIT_V(0);
    if constexpr (!ALIGN_EPI) { if (wr == 0) PG8_BAR; }
    PG8_BAR;
#undef PG8_SA
#undef PG8_SB
#undef PG8_STAGE
#undef PG8_STAGE_A
#undef PG8_LDA
#undef PG8_LDB
#undef PG8_MMA
#undef PG8_WAIT_V
#undef PG8_WAIT_VR
#undef PG8_WAIT_L
#undef PG8_BAR
#undef PG8_SCHED
#undef PG8_LOADVG
}
}

namespace attn_body {
using bf16=__hip_bfloat16;
using bf16x8=__attribute__((ext_vector_type(8)))short;
using s16x4=__attribute__((ext_vector_type(4)))short;
using f32x16=__attribute__((ext_vector_type(16)))float;
using u32x4=__attribute__((ext_vector_type(4)))unsigned;
constexpr int NHEAD=16,SEQ=2048,D=64,DM=NHEAD*D;
constexpr int NW=8,QBLK=32,QB=QBLK*NW,KVBLK=64,NQB=SEQ/QB;
__device__ __forceinline__ int crow(int r,int hi){return (r&3)+8*(r>>2)+4*hi;}
#define SBAR() __builtin_amdgcn_sched_barrier(0)
__device__ __forceinline__ void cmask(f32x16&p0,f32x16&p1,int jb,int qrel,int hi){
  const float NEG=-INFINITY; const int dq=qrel-(64*jb+4*hi);
  #pragma unroll
  for(int r=0;r<16;++r){const int kc=(r&3)+8*(r>>2); if(kc>dq)p0[r]=NEG; if(kc+32>dq)p1[r]=NEG;}
}
__device__ __forceinline__ void cinit(f32x16&p0,f32x16&p1,float sl2,float nv){
  #pragma unroll
  for(int r=0;r<16;++r){const float c=(float)((r&3)+8*(r>>2)); p0[r]=__builtin_fmaf(sl2,c,nv); p1[r]=__builtin_fmaf(sl2,c+32.0f,nv);}
}
#define CI_C(r) ((float)(((r)&3)+8*((r)>>2)))

constexpr int NSLOT=3, SLOTB=8192;
constexpr int LDS_K=0, LDS_V=NSLOT*SLOTB, LDS_WS=2*NSLOT*SLOTB, LDS_OST=LDS_WS+NW*64*4, LDS_BYTES=LDS_OST+NW*4096;
constexpr float C2=0.125f*1.4426950408889634f;
__device__ __forceinline__ void glds16(const void*gsrc,unsigned lds_dst){unsigned keep;
  asm volatile("s_mov_b32 %0, m0\n\ts_mov_b32 m0, %2\n\ts_nop 0\n\tglobal_load_lds_dwordx4 %1, off\n\ts_mov_b32 m0, %0":"=&s"(keep):"v"(gsrc),"s"(lds_dst):"memory");}
__device__ __forceinline__ float max3f(float a,float b,float c){float r;asm("v_max3_f32 %0, %1, %2, %3":"=v"(r):"v"(a),"v"(b),"v"(c));return r;}
__device__ __forceinline__ float max2f(float a,float b){float r;asm("v_max_f32_e32 %0, %1, %2":"=v"(r):"v"(a),"v"(b));return r;}
__device__ __forceinline__ float fadd_s(float a,float b){float r;asm("v_add_f32_e32 %0, %1, %2":"=v"(r):"v"(a),"v"(b));return r;}
__device__ __forceinline__ float fsub_s(float a,float b){float r;asm("v_sub_f32_e32 %0, %1, %2":"=v"(r):"v"(a),"v"(b));return r;}
typedef float f32x2_t __attribute__((ext_vector_type(2))); typedef __bf16 bf16x2_t __attribute__((ext_vector_type(2)));
__device__ __forceinline__ unsigned cvtpk_s(float lo,float hi){f32x2_t v={lo,hi};bf16x2_t b=__builtin_convertvector(v,bf16x2_t);return __builtin_bit_cast(unsigned,b);}
#define WAIT_BAR(N) asm volatile("s_waitcnt vmcnt(" #N ") lgkmcnt(0)\n\ts_barrier":::"memory")

__device__ __forceinline__ void qkt(f32x16&p0,f32x16&p1,const char*Kslot,const bf16x8*qr,int r32,int hi){
  const char*kb=Kslot+hi*1024+r32*16;
  #pragma unroll
  for(int d0=0;d0<4;++d0){
    const bf16x8 b0=*reinterpret_cast<const bf16x8*>(kb+d0*2048);
    const bf16x8 b1=*reinterpret_cast<const bf16x8*>(kb+d0*2048+512);
    p0=__builtin_amdgcn_mfma_f32_32x32x16_bf16(b0,qr[d0],p0,0,0,0);p1=__builtin_amdgcn_mfma_f32_32x32x16_bf16(b1,qr[d0],p1,0,0,0);}
}
typedef __attribute__((address_space(3))) const char* lds_cptr;
typedef short v4i16_t __attribute__((ext_vector_type(4)));
__device__ __forceinline__ void kload8(bf16x8*kf,lds_cptr kp){
  kf[0]=*(const __attribute__((address_space(3))) bf16x8*)(kp);      kf[1]=*(const __attribute__((address_space(3))) bf16x8*)(kp+512);
  kf[2]=*(const __attribute__((address_space(3))) bf16x8*)(kp+2048); kf[3]=*(const __attribute__((address_space(3))) bf16x8*)(kp+2560);
  kf[4]=*(const __attribute__((address_space(3))) bf16x8*)(kp+4096); kf[5]=*(const __attribute__((address_space(3))) bf16x8*)(kp+4608);
  kf[6]=*(const __attribute__((address_space(3))) bf16x8*)(kp+6144); kf[7]=*(const __attribute__((address_space(3))) bf16x8*)(kp+6656);
}
__device__ __forceinline__ void kload2(bf16x8*kf,lds_cptr kp,int j){ kf[2*j]=*(const __attribute__((address_space(3))) bf16x8*)(kp+j*2048); kf[2*j+1]=*(const __attribute__((address_space(3))) bf16x8*)(kp+j*2048+512); }
__device__ __forceinline__ s16x4 vtr(lds_cptr p){ return __builtin_bit_cast(s16x4,__builtin_amdgcn_ds_read_tr16_b64_v4i16((__attribute__((address_space(3))) v4i16_t*)p)); }
__device__ __forceinline__ float rowmax(const f32x16&p0,const f32x16&p1){
  float a=max3f(p0[0],p0[1],p1[0]),b=max3f(p0[2],p0[3],p1[1]);a=max3f(a,p1[2],p1[3]);
  #pragma unroll
  for(int r=4;r<16;r+=4){a=max3f(a,p0[r],p0[r+1]);b=max3f(b,p0[r+2],p0[r+3]);a=max3f(a,p1[r],p1[r+1]);b=max3f(b,p1[r+2],p1[r+3]);}
  const float m=max2f(a,b);
  auto rr=__builtin_amdgcn_permlane32_swap(__float_as_uint(m),__float_as_uint(m),false,false);
  return max2f(__uint_as_float(rr[0]),__uint_as_float(rr[1]));
}
__device__ __forceinline__ void pv(f32x16*o,int vb,bf16x8 pa0,bf16x8 pa1,bf16x8 pa2,bf16x8 pa3){
  #pragma unroll
  for(int d0=0;d0<2;++d0){s16x4 lo[4],hi[4];
    #pragma unroll
    for(int ks=0;ks<4;++ks){
      asm volatile("ds_read_b64_tr_b16 %0,%1 offset:%c2":"=&v"(lo[ks]):"v"(vb),"i"(d0*4096+ks*1024):"memory");
      asm volatile("ds_read_b64_tr_b16 %0,%1 offset:%c2":"=&v"(hi[ks]):"v"(vb),"i"(d0*4096+ks*1024+512):"memory");}
    asm volatile("s_waitcnt lgkmcnt(0)":::"memory");SBAR();
    #define PK(k) (bf16x8){lo[k][0],lo[k][1],lo[k][2],lo[k][3],hi[k][0],hi[k][1],hi[k][2],hi[k][3]}
    o[d0]=__builtin_amdgcn_mfma_f32_32x32x16_bf16(pa0,PK(0),o[d0],0,0,0);
    o[d0]=__builtin_amdgcn_mfma_f32_32x32x16_bf16(pa1,PK(1),o[d0],0,0,0);
    o[d0]=__builtin_amdgcn_mfma_f32_32x32x16_bf16(pa2,PK(2),o[d0],0,0,0);
    o[d0]=__builtin_amdgcn_mfma_f32_32x32x16_bf16(pa3,PK(3),o[d0],0,0,0);
    #undef PK
  }
}
#define ATTN_STORE16(p,v) (*(u32x4*)(p)=(v))
constexpr int LDS_K2=0, LDS_V2=4*8192, LDS_WS2=LDS_V2+3*16384, LDS_OST2=LDS_WS2+NW*64*4, LDS_BYTES2=LDS_OST2+NW*4096;
__device__ __forceinline__ void pv4(f32x16*o,int vb,bf16x8 pa0,bf16x8 pa1,bf16x8 pa2,bf16x8 pa3){
  #pragma unroll
  for(int d0=0;d0<4;++d0){s16x4 lo[4],hi[4];
    #pragma unroll
    for(int ks=0;ks<4;++ks){
      asm volatile("ds_read_b64_tr_b16 %0,%1 offset:%c2":"=&v"(lo[ks]):"v"(vb),"i"(d0*4096+ks*1024):"memory");
      asm volatile("ds_read_b64_tr_b16 %0,%1 offset:%c2":"=&v"(hi[ks]):"v"(vb),"i"(d0*4096+ks*1024+512):"memory");}
    asm volatile("s_waitcnt lgkmcnt(0)":::"memory");SBAR();
    #define PK(k) (bf16x8){lo[k][0],lo[k][1],lo[k][2],lo[k][3],hi[k][0],hi[k][1],hi[k][2],hi[k][3]}
    o[d0]=__builtin_amdgcn_mfma_f32_32x32x16_bf16(pa0,PK(0),o[d0],0,0,0);
    o[d0]=__builtin_amdgcn_mfma_f32_32x32x16_bf16(pa1,PK(1),o[d0],0,0,0);
    o[d0]=__builtin_amdgcn_mfma_f32_32x32x16_bf16(pa2,PK(2),o[d0],0,0,0);
    o[d0]=__builtin_amdgcn_mfma_f32_32x32x16_bf16(pa3,PK(3),o[d0],0,0,0);
    #undef PK
  }
}
template<int THRL,bool FUSE> __device__ __forceinline__ void attn_unit2(const int tid,int b,int h,int m,int qb,float sl2,float lam,const float*gsub,const bf16*Q,const bf16*__restrict__ K,const bf16*__restrict__ V,bf16*O,char*shm){
  const int lane=tid&63,r32=lane&31,hi=lane>>5; const int wid=__builtin_amdgcn_readfirstlane(tid>>6);
  const long rowbase=(long)b*SEQ; const int q0=qb*QB;
  const bf16*Qw=Q+(rowbase+q0+wid*QBLK)*DM+(2*h+m)*D;
  const bf16*Kh=K+rowbase*DM+(2*h+m)*D,*Vh=V+rowbase*DM+2*h*D;
  const unsigned lds0=(unsigned)(uintptr_t)shm;
  float*wsf=(float*)(shm+LDS_WS2)+wid*64;
  const bf16*ksrc=Kh+(long)lane*DM+wid*8;
  const bf16*vsrc=Vh+(long)(16*(wid&3)+(lane>>2))*DM+(wid>>2)*32+(lane&3)*8;
  const unsigned kdst=lds0+LDS_K2+wid*1024, vdst=lds0+LDS_V2+wid*1024;
  #define DMA_K(t,slot) glds16(ksrc+(long)(t)*KVBLK*DM,(unsigned)__builtin_amdgcn_readfirstlane(kdst+(slot)))
  #define DMA_V(t,slot) do{ glds16(vsrc+(long)(t)*KVBLK*DM,(unsigned)__builtin_amdgcn_readfirstlane(vdst+2*(slot))); glds16(vsrc+(long)(t)*KVBLK*DM+64,(unsigned)__builtin_amdgcn_readfirstlane(vdst+2*(slot)+8192)); }while(0)
  const int vb0=(int)(lds0+LDS_V2)+((lane>>4)&1)*32+(lane&3)*8+(4*hi+((lane&15)>>2))*64;
  const char*Kbase=shm+LDS_K2;
  const lds_cptr shm3=(lds_cptr)shm; const lds_cptr kp0=shm3+LDS_K2+hi*1024+r32*16; const lds_cptr vp0=shm3+LDS_V2+((lane>>4)&1)*32+(lane&3)*8+(4*hi+((lane&15)>>2))*64;
  const int NT=(q0+QB)/KVBLK;
  const unsigned qdst=lds0+LDS_OST2+wid*4096;
  #pragma unroll
  for(int d0=0;d0<4;++d0)glds16(&Qw[(long)r32*DM+d0*16+hi*8],(unsigned)__builtin_amdgcn_readfirstlane(qdst+d0*1024));
  DMA_K(0,0);DMA_V(0,0);DMA_K(1,SLOTB);
  const lds_cptr qp0=(lds_cptr)shm+LDS_OST2+wid*4096+lane*16;
  #define QF(d0) (*(const __attribute__((address_space(3))) bf16x8*)(qp0+(d0)*1024))
  const float tb0=sl2*(float)(4*hi);
  float mhat=0.f,l_reg=0.f;f32x16 o[4];o[0]=f32x16{};o[1]=f32x16{};o[2]=f32x16{};o[3]=f32x16{};
  const int qrel=wid*QBLK+r32;
  #define CMASK(P0,P1,t) do{int jb_=(t)-(NT-4); if(jb_>=0)cmask(P0,P1,jb_,qrel,hi);}while(0)
  #define NVAL(tt) (__builtin_fmaf(sl2,(float)(64*(tt)),tb0)-mhat)
  bool resc=false;
  #define START(P0,P1) do{ const float rm=rowmax(P0,P1); resc=false; \
    { const float dl=rm; mhat=fadd_s(mhat,dl); \
      _Pragma("unroll") for(int r=0;r<16;++r){P0[r]=fsub_s(P0[r],dl);P1[r]=fsub_s(P1[r],dl);} } \
    _Pragma("unroll") for(int r=0;r<16;++r)P0[r]=__builtin_amdgcn_exp2f(P0[r]); }while(0)
  #define RESC() do{ if(resc){ asm volatile("s_waitcnt lgkmcnt(0)":::"memory"); \
      _Pragma("unroll") for(int d_=0;d_<4;++d_) _Pragma("unroll") for(int r=0;r<16;++r)o[d_][r]*=wsf[crow(r,hi)]; } }while(0)
  f32x16 pA0,pA1,pB0,pB1;
  int sl_prev=0,sl_cur=0,sl_next=SLOTB,ks_cur=0;
  #define ROT() do{sl_prev=sl_cur;sl_cur=sl_next;sl_next=(sl_next==(NSLOT-1)*SLOTB)?0:sl_next+SLOTB;ks_cur=(ks_cur+SLOTB)&(4*SLOTB-1);}while(0)
  DMA_K(2,2*SLOTB);
  WAIT_BAR(4);
  cinit(pA0,pA1,sl2,tb0);
  { bf16x8 qr[4];
    #pragma unroll
    for(int d0=0;d0<4;++d0)qr[d0]=QF(d0);
    qkt(pA0,pA1,Kbase,qr,r32,hi); }asm volatile("s_nop 15\n\ts_nop 7":"+v"(pA0),"+v"(pA1));CMASK(pA0,pA1,0);
  START(pA0,pA1);
  cinit(pB0,pB1,sl2,NVAL(1));
  _Pragma("unroll") for(int r=0;r<16;++r)pA1[r]=__builtin_amdgcn_exp2f(pA1[r]);
  WAIT_BAR(0);
  DMA_K(3,3*SLOTB);DMA_V(1,SLOTB);
  ROT();
  WAIT_BAR(3);
  s16x4 vlo[8],vhi[8]; u32x4 pw0,pw1,pw2,pw3;
  bf16x8 nka=*(const __attribute__((address_space(3))) bf16x8*)(kp0+ks_cur),nkb=*(const __attribute__((address_space(3))) bf16x8*)(kp0+ks_cur+512),nqa=QF(0),nqb=QF(1);
  #define PKW(P,B) cvtpk_s(P[B],P[B+1])
  #define PAF(k) __builtin_bit_cast(bf16x8,pw##k)
  #define VFR(i) (bf16x8){vlo[(i)&7][0],vlo[(i)&7][1],vlo[(i)&7][2],vlo[(i)&7][3],vhi[(i)&7][0],vhi[(i)&7][1],vhi[(i)&7][2],vhi[(i)&7][3]}
  #define PIN(x) asm volatile("":"+v"(x))
  #define MX3(a,b,c) __builtin_fmaxf(__builtin_fmaxf((a),(b)),(c))
  #define GAPA(MF,A0,A1,A2,A3,W0,W1,PW) do{ MF; sacc+=A0; sacc+=A1; sacc+=A2; sacc+=A3; PIN(sacc); W0; W1; PIN(PW); SBAR(); }while(0)
  #define EX(v) __builtin_amdgcn_exp2f(v)
  #define VRD(f) do{ vlo[(f)&7]=vtr(vp_+(((f)&3)*4096+((f)>>2)*1024)); vhi[(f)&7]=vtr(vp_+(((f)&3)*4096+((f)>>2)*1024+512)); }while(0)
  #define GAPB(f,X,B,Y,OFS) do{ o[(f)&3]=__builtin_amdgcn_mfma_f32_32x32x16_bf16(__builtin_bit_cast(bf16x8,(f)<4?pw0:(f)<8?pw1:(f)<12?pw2:pw3),VFR(f),o[(f)&3],0,0,0); \
    X[B]=EX(X[B]); X[B+1]=EX(X[B+1]); PIN(X); \
    Y[B]=__builtin_fmaf(sl2,CI_C(B)+OFS,nvn); Y[B+1]=__builtin_fmaf(sl2,CI_C(B+1)+OFS,nvn); \
    if((f)+4<16){VRD((f)+4);} SBAR(); }while(0)
  #define KF(j) (*(const __attribute__((address_space(3))) bf16x8*)(kp_+((j)>>1)*2048+((j)&1)*512))
  #define STEP(C0,C1,P0,P1,t,GK,GV,GL) do{ SBAR(); \
    const lds_cptr vp_=vp0+2*sl_prev; const lds_cptr kp_=kp0+ks_cur; \
    bf16x8 ka=nka,kb=nkb,qa=nqa,qb_=nqb; SBAR(); \
    float sacc=(P0[0]+P0[1]); \
    GAPA(C0=__builtin_amdgcn_mfma_f32_32x32x16_bf16(ka,qa,C0,0,0,0), P0[2],P0[3],P0[4],P0[5],     pw0[0]=PKW(P0,0), pw0[1]=PKW(P0,2), pw0); \
    ka=KF(2); SBAR(); \
    GAPA(C1=__builtin_amdgcn_mfma_f32_32x32x16_bf16(kb,qa,C1,0,0,0), P0[6],P0[7],P0[8],P0[9],     pw0[2]=PKW(P0,4), pw0[3]=PKW(P0,6), pw0); \
    kb=KF(3); qa=QF(2); SBAR(); \
    GAPA(C0=__builtin_amdgcn_mfma_f32_32x32x16_bf16(ka,qb_,C0,0,0,0),   P0[10],P0[11],P0[12],P0[13], pw1[0]=PKW(P0,8), pw1[1]=PKW(P0,10), pw1); \
    ka=KF(4); SBAR(); \
    GAPA(C1=__builtin_amdgcn_mfma_f32_32x32x16_bf16(kb,qb_,C1,0,0,0),   P0[14],P0[15],P1[0],P1[1],   pw1[2]=PKW(P0,12),pw1[3]=PKW(P0,14), pw1); \
    kb=KF(5); qb_=QF(3); VRD(0); SBAR(); \
    GAPA(C0=__builtin_amdgcn_mfma_f32_32x32x16_bf16(ka,qa,C0,0,0,0),   P1[2],P1[3],P1[4],P1[5],     pw2[0]=PKW(P1,0), pw2[1]=PKW(P1,2), pw2); \
    ka=KF(6); VRD(1); SBAR(); \
    GAPA(C1=__builtin_amdgcn_mfma_f32_32x32x16_bf16(kb,qa,C1,0,0,0),   P1[6],P1[7],P1[8],P1[9],     pw2[2]=PKW(P1,4), pw2[3]=PKW(P1,6), pw2); \
    kb=KF(7); VRD(2); SBAR(); \
    GAPA(C0=__builtin_amdgcn_mfma_f32_32x32x16_bf16(ka,qb_,C0,0,0,0),   P1[10],P1[11],P1[12],P1[13], pw3[0]=PKW(P1,8), pw3[1]=PKW(P1,10), pw3); \
    VRD(3); SBAR(); \
    GAPA(C1=__builtin_amdgcn_mfma_f32_32x32x16_bf16(kb,qb_,C1,0,0,0),   P1[14],P1[15],0.f,0.f,       pw3[2]=PKW(P1,12),pw3[3]=PKW(P1,14), pw3); \
    l_reg+=sacc; \
    if(GK){DMA_K((t)+3,(ks_cur+3*SLOTB)&(4*SLOTB-1));} if(GV){DMA_V((t)+1,sl_next);} \
    CMASK(C0,C1,t); \
    float nvn; \
    { float a=MX3(C0[0],C0[1],C1[0]),b=MX3(C0[2],C0[3],C1[1]); a=MX3(a,C1[2],C1[3]); \
      _Pragma("unroll") for(int r=4;r<16;r+=4){a=MX3(a,C0[r],C0[r+1]);b=MX3(b,C0[r+2],C0[r+3]);a=MX3(a,C1[r],C1[r+1]);b=MX3(b,C1[r+2],C1[r+3]);} \
      float rm=__builtin_fmaxf(a,b); { auto rr=__builtin_amdgcn_permlane32_swap(__float_as_uint(rm),__float_as_uint(rm),false,false); rm=__builtin_fmaxf(__uint_as_float(rr[0]),__uint_as_float(rr[1])); } \
      resc=false; \
      if(__builtin_expect(__any(rm>(float)THRL),0)){ const float dl=__builtin_fmaxf(rm,0.f); mhat+=dl; \
        _Pragma("unroll") for(int r=0;r<16;++r){C0[r]-=dl;C1[r]-=dl;} \
        const float f=__builtin_amdgcn_exp2f(-dl); l_reg*=f; if(hi==0)wsf[r32]=f; resc=true; } \
      nvn=NVAL((t)+1); } \
    SBAR(); \
    GAPB(0,C0,0,P0,0.0f); GAPB(1,C0,2,P0,0.0f); GAPB(2,C0,4,P0,0.0f); GAPB(3,C0,6,P0,0.0f); \
    GAPB(4,C0,8,P0,0.0f); GAPB(5,C0,10,P0,0.0f); GAPB(6,C0,12,P0,0.0f); GAPB(7,C0,14,P0,0.0f); \
    GAPB(8,C1,0,P1,32.0f); GAPB(9,C1,2,P1,32.0f); GAPB(10,C1,4,P1,32.0f); GAPB(11,C1,6,P1,32.0f); \
    GAPB(12,C1,8,P1,32.0f); GAPB(13,C1,10,P1,32.0f); GAPB(14,C1,12,P1,32.0f); \
    { const lds_cptr kn_=kp0+((ks_cur+SLOTB)&(4*SLOTB-1)); nka=*(const __attribute__((address_space(3))) bf16x8*)(kn_); nkb=*(const __attribute__((address_space(3))) bf16x8*)(kn_+512); nqa=QF(0); nqb=QF(1); SBAR(); } \
    GAPB(15,C1,14,P1,32.0f); \
    }while(0)
  int t=1;
  #undef CMASK
  #define CMASK(P0,P1,t) do{}while(0)
  for(;t+5<NT;t+=2){
    STEP(pB0,pB1,pA0,pA1,t,true,true,true);     WAIT_BAR(3); RESC(); ROT();
    STEP(pA0,pA1,pB0,pB1,t+1,true,true,true);   WAIT_BAR(3); RESC(); ROT();
  }
  #undef CMASK
  #define CMASK(P0,P1,t) do{int jb_=(t)-(NT-4); if(jb_>=0)cmask(P0,P1,jb_,qrel,hi);}while(0)
  #define ENDW(tt) do{ if((tt)+3<NT){WAIT_BAR(3);} else if((tt)+2<NT){WAIT_BAR(2);} else {WAIT_BAR(0);} }while(0)
  for(;t+1<NT;t+=2){
    STEP(pB0,pB1,pA0,pA1,t,(t+3<NT),(t+1<NT),(t+1<NT));       ENDW(t);   RESC(); ROT();
    STEP(pA0,pA1,pB0,pB1,t+1,(t+4<NT),(t+2<NT),(t+2<NT));     ENDW(t+1); RESC(); ROT();
  }
  STEP(pB0,pB1,pA0,pA1,NT-1,false,false,false); RESC();
  { float sacc=pB0[0]+pB0[1]; _Pragma("unroll") for(int r=2;r<16;++r)sacc+=pB0[r]; _Pragma("unroll") for(int r=0;r<16;++r)sacc+=pB1[r]; l_reg+=sacc;
    pw0=(u32x4){PKW(pB0,0),PKW(pB0,2),PKW(pB0,4),PKW(pB0,6)};pw1=(u32x4){PKW(pB0,8),PKW(pB0,10),PKW(pB0,12),PKW(pB0,14)};pw2=(u32x4){PKW(pB1,0),PKW(pB1,2),PKW(pB1,4),PKW(pB1,6)};pw3=(u32x4){PKW(pB1,8),PKW(pB1,10),PKW(pB1,12),PKW(pB1,14)};
    SBAR(); pv4(o,vb0+2*sl_cur,PAF(0),PAF(1),PAF(2),PAF(3)); }
  #undef PKW
  #undef PAF
  #undef VFR
  #undef PIN
  #undef MX3
  #undef GAPA
  #undef GAPB
  #undef EX
  #undef VRD
  #undef KF
  #undef STEP
  #undef ENDW
  {auto rr=__builtin_amdgcn_permlane32_swap(__float_as_uint(l_reg),__float_as_uint(l_reg),false,false);l_reg=__uint_as_float(rr[0])+__uint_as_float(rr[1]);}
  if(hi==0)wsf[32+r32]=l_reg;asm volatile("s_waitcnt lgkmcnt(0)":::"memory");
  float rli[16];
  #pragma unroll
  for(int r=0;r<16;++r)rli[r]=__builtin_amdgcn_rcpf(wsf[32+crow(r,hi)]);
  bf16*Ow=O+(rowbase+q0+wid*QBLK)*DM+2*h*D;
  bf16*stg=(bf16*)(shm+LDS_OST2)+wid*2048;
  if constexpr(!FUSE){
    #pragma unroll
    for(int ps=0;ps<2;++ps){
      #pragma unroll
      for(int r=0;r<16;++r){const int orow=crow(r,hi);
        #pragma unroll
        for(int d0=0;d0<2;++d0)stg[orow*64+d0*32+r32]=__float2bfloat16(o[2*ps+d0][r]*rli[r]);}
      asm volatile("s_waitcnt lgkmcnt(0)":::"memory");
      #pragma unroll
      for(int i=0;i<4;++i){const int row=i*8+(lane>>3),ch=lane&7; const u32x4 v=*(const u32x4*)(stg+row*64+ch*8); ATTN_STORE16(Ow+(long)row*DM+ps*64+ch*8,v);}
      asm volatile("s_waitcnt lgkmcnt(0)":::"memory"); }
    asm volatile("s_waitcnt vmcnt(0)":::"memory");
  } else {
    float dv[2][4][8]; float ss[4]={0.f,0.f,0.f,0.f};
    u32x4 v0p[2][4];
    #pragma unroll
    for(int ps=0;ps<2;++ps)
      #pragma unroll
      for(int i=0;i<4;++i){const int row=i*8+(lane>>3),ch=lane&7; v0p[ps][i]=*(const u32x4*)(Ow+(long)row*DM+ps*64+ch*8);}
    #pragma unroll
    for(int ps=0;ps<2;++ps){
      #pragma unroll
      for(int r=0;r<16;++r){const int orow=crow(r,hi);
        #pragma unroll
        for(int d0=0;d0<2;++d0)stg[orow*64+d0*32+r32]=__float2bfloat16(o[2*ps+d0][r]*rli[r]);}
      asm volatile("s_waitcnt lgkmcnt(0)":::"memory");
      #pragma unroll
      for(int i=0;i<4;++i){const int row=i*8+(lane>>3),ch=lane&7; const u32x4 v1=*(const u32x4*)(stg+row*64+ch*8); const u32x4 v0=v0p[ps][i];
        #pragma unroll
        for(int e=0;e<4;++e){ const float a0=__uint_as_float(v0[e]<<16),a1=__uint_as_float(v0[e]&0xffff0000u),b0=__uint_as_float(v1[e]<<16),b1=__uint_as_float(v1[e]&0xffff0000u);
          const float x0=a0-lam*b0,x1=a1-lam*b1; dv[ps][i][2*e]=x0; dv[ps][i][2*e+1]=x1; ss[i]+=x0*x0+x1*x1; } }
      asm volatile("s_waitcnt lgkmcnt(0)":::"memory"); }
    #pragma unroll
    for(int i=0;i<4;++i){ float s_=ss[i];
      { int b_=__float_as_int(s_); s_+=__int_as_float(__builtin_amdgcn_update_dpp(b_,b_,0xB1,0xF,0xF,false)); b_=__float_as_int(s_); s_+=__int_as_float(__builtin_amdgcn_update_dpp(b_,b_,0x4E,0xF,0xF,false)); b_=__float_as_int(s_); s_+=__int_as_float(__builtin_amdgcn_update_dpp(b_,b_,0x141,0xF,0xF,false)); }
      ss[i]=1.0f/sqrtf(s_*(1.0f/128.0f)+1e-6f); }
    #pragma unroll
    for(int ps=0;ps<2;++ps){ float gg[8];
      #pragma unroll
      for(int e=0;e<8;++e)gg[e]=gsub[ps*64+(lane&7)*8+e]*0.8f;
      #pragma unroll
      for(int i=0;i<4;++i){const int row=i*8+(lane>>3),ch=lane&7; u32x4 w;
        #pragma unroll
        for(int e=0;e<4;++e)w[e]=cvtpk_s(dv[ps][i][2*e]*ss[i]*gg[2*e],dv[ps][i][2*e+1]*ss[i]*gg[2*e+1]);
        ATTN_STORE16(Ow+(long)row*DM+ps*64+ch*8,w);} }
  }
  asm volatile("s_waitcnt lgkmcnt(0)\n\ts_barrier":::"memory");
  #undef DMA_K
  #undef DMA_V
  #undef QF
  #undef CMASK
  #undef NVAL
  #undef START
  #undef RESC
  #undef ROT
}
constexpr int ATTN_LDS_BYTES=LDS_BYTES2;
#undef SBAR
#undef WAIT_BAR
}

constexpr int NWAVES = 8;
constexpr int N_LAUNCHES = MK_N_LAUNCHES;
constexpr int N_PHASES = 9 + 2 * NCH + 1;
constexpr bool PER_PHASE = (MK_N_LAUNCHES != 1);

constexpr size_t MiB = 1u << 20;
constexpr size_t ACT = (size_t)T * D * 2;
constexpr size_t WS_CTL = 0, CTL_ZERO_BYTES = 65536;
constexpr size_t WS_MOD = 1 * MiB;
constexpr size_t WS_SH = WS_MOD + 512 * 1024;
constexpr size_t WS_WIN = 2 * MiB;
constexpr size_t WS_WR = 16 * MiB, WS_WA = 18 * MiB, WS_WO = 20 * MiB;
constexpr size_t WS_LW = 22 * MiB;
constexpr size_t WS_WRH = 23 * MiB, WS_WRL = 23 * MiB + 131072;
constexpr size_t WS_H = 24 * MiB;
constexpr size_t WS_XR = WS_H + ACT;
constexpr size_t WS_GR = WS_XR + ACT;
constexpr size_t WS_Q = WS_GR + ACT;
constexpr size_t WS_K = WS_Q + ACT;
constexpr size_t WS_V = WS_K + ACT;
constexpr size_t WS_O1 = WS_V + ACT;
constexpr size_t WS_END = WS_O1 + ACT;
static_assert(WS_END <= 512 * MiB, "ws map");
constexpr size_t WS_W13 = WS_GR;
constexpr size_t WS_W2 = WS_O1;
constexpr size_t WS_W13S = WS_O1 + 32 * MiB;
constexpr size_t WS_W2S = WS_O1 + 33 * MiB;
constexpr size_t WS_LIST = WS_O1 + 34 * MiB;
constexpr size_t WS_WTS = WS_O1 + 42 * MiB;
constexpr size_t WS_RDEST = WS_O1 + 43 * MiB;
constexpr size_t WS_RWT = WS_O1 + 44 * MiB;
constexpr size_t WS_SA = WS_O1 + 45 * MiB;
constexpr int MAXRT = TC * TOPK / 256 + NEXP + TC / 256;
constexpr int MAXROWS = MAXRT * 256;
constexpr size_t WS_HB = WS_H + 32 * MiB;
constexpr size_t WS_SLOT = WS_Q;
constexpr size_t WS_SLOTSC = WS_SLOT + 72 * MiB;
constexpr size_t WS_Y = WS_Q;
static_assert(WS_SLOT + (size_t)(TC * 9) * D <= WS_O1 && WS_HB + (size_t)MAXROWS * 512 <= WS_GR && (size_t)MAXROWS * 4 <= MiB, "moe map");
constexpr int CW_TMO = 0;
constexpr int CW_BAR = 4096;
constexpr int CW_CNT = 8192;
constexpr int CW_AMAX = 8192 + 512;

constexpr int RING_BYTES = 139264;
constexpr int MISC_OFF = RING_BYTES;
constexpr int LDS_BYTES = 155648;
constexpr int MI_BARST = 0;
constexpr int MI_CNT = 64;
constexpr int MI_TBASE = 128;
constexpr int MI_TILE_E = 256;
constexpr int MI_SB = 896;
constexpr int MI_TOK = 1024;
constexpr int MI_SA = 2560;
constexpr int MI_WORDS = 4096;

#define GAS __attribute__((address_space(1)))
#define LAS __attribute__((address_space(3)))
typedef unsigned short bf16;
typedef unsigned v4u __attribute__((ext_vector_type(4)));
typedef unsigned v2u __attribute__((ext_vector_type(2)));
typedef float f32x4 __attribute__((ext_vector_type(4)));
typedef float f32x16 __attribute__((ext_vector_type(16)));
typedef short bf16x8 __attribute__((ext_vector_type(8)));
typedef GAS unsigned gu32;
#define RLX_AGENT __ATOMIC_RELAXED, __HIP_MEMORY_SCOPE_AGENT
#define LDS_WAIT() asm volatile("s_waitcnt lgkmcnt(0)" ::: "memory")
#define VM_WAIT() asm volatile("s_waitcnt vmcnt(0)" ::: "memory")
__device__ __forceinline__ unsigned f2bf(float f) { unsigned u = __builtin_bit_cast(unsigned, f); return (u + 0x7fffu + ((u >> 16) & 1u)) >> 16; }
__device__ __forceinline__ unsigned pk2(float lo, float hi) { return f2bf(lo) | (f2bf(hi) << 16); }
__device__ __forceinline__ float bf2f(unsigned h) { return __uint_as_float(h << 16); }
using pg8::bflo; using pg8::bfhi; using pg8::sigm;

#define XB_TMO      128
#define XB_XCNT(j)  (256  + 64 * (j))
#define XB_XSUB(j)  (1280 + 64 * (j))
#define XB_XGEN(j)  (2304 + 64 * (j))
#define XB_TOP      3328
#define XB_TOPGEN   3392
#define XCD_BAR_WORDS 3456
#define XB_SPIN_CAP (1u << 18)
__device__ __forceinline__ unsigned xb_ld(unsigned* p)              { return __hip_atomic_load(p, __ATOMIC_RELAXED, __HIP_MEMORY_SCOPE_AGENT); }
__device__ __forceinline__ unsigned xb_add(unsigned* p, unsigned v) { return __hip_atomic_fetch_add(p, v, __ATOMIC_RELAXED, __HIP_MEMORY_SCOPE_AGENT); }
__device__ __forceinline__ unsigned xb_xcc_id() { return (unsigned)__builtin_amdgcn_s_getreg((3 << 11) | 20) & 0xFu; }
#define XB_SPIN(cond, bar) do { unsigned _sp = 0; while (cond) { __builtin_amdgcn_s_sleep(1); \
    if ((++_sp & 255u) == 0u) { if (xb_ld(&(bar)[XB_TMO])) break; if (_sp > XB_SPIN_CAP) { atomicAdd(&(bar)[XB_TMO], 1u); break; } } } } while (0)
struct XcdBarrier { unsigned* bar; unsigned x; volatile LAS unsigned* st; };
__device__ __forceinline__ XcdBarrier xcd_barrier_post(unsigned* bar, volatile LAS unsigned* st) {
    XcdBarrier b; b.bar = bar; b.x = xb_xcc_id(); b.st = st;
    if (threadIdx.x == 0) (void)xb_add(&bar[XB_XCNT(b.x)], 1u);
    return b;
}
__device__ __forceinline__ void xcd_barrier_complete(unsigned* bar, unsigned x, unsigned& nloc, unsigned& nx) {
    const unsigned G = gridDim.x * gridDim.y * gridDim.z;
    unsigned sum, cnt, mine, sp = 0u;
    for (;;) {
        sum = 0u; cnt = 0u; mine = 0u;
#pragma unroll 1
        for (unsigned j = 0; j < 16; ++j) { const unsigned c = xb_ld(&bar[XB_XCNT(j)]); sum += c; cnt += (c > 0u) ? 1u : 0u; mine = (j == x) ? c : mine; }
        if (sum == G) break;
        __builtin_amdgcn_s_sleep(1);
        if ((++sp & 255u) == 0u) { if (xb_ld(&bar[XB_TMO])) break; if (sp > XB_SPIN_CAP) { atomicAdd(&bar[XB_TMO], 1u); break; } }
    }
    nloc = mine > 0u ? mine : 1u; nx = cnt > 0u ? cnt : 1u;
}
__device__ __forceinline__ void xcd_barrier(const XcdBarrier& b) {
    asm volatile("s_waitcnt vmcnt(0)" ::: "memory");
    __syncthreads();
    if (threadIdx.x == 0) {
        size_t zb_ = 0; asm volatile("" : "+s"(zb_)); unsigned* bar = b.bar + zb_;
        __builtin_amdgcn_s_waitcnt(0);
        unsigned nloc = b.st[0], nx = b.st[1];
        if (nloc == 0u) { xcd_barrier_complete(bar, b.x, nloc, nx); b.st[0] = nloc; b.st[1] = nx; }
        const unsigned old = xb_add(&bar[XB_XSUB(b.x)], 1u);
        const unsigned gen = old / nloc;
        if (old + 1u == (gen + 1u) * nloc) {
            __builtin_amdgcn_fence(__ATOMIC_RELEASE, "agent");
            asm volatile("s_waitcnt vmcnt(0)" ::: "memory");
            const unsigned og = xb_add(&bar[XB_TOP], 1u);
            const unsigned tg = og / nx;
            if (og + 1u == (tg + 1u) * nx) xb_add(&bar[XB_TOPGEN], 1u);
            else XB_SPIN(xb_ld(&bar[XB_TOPGEN]) == tg, bar);
            __builtin_amdgcn_fence(__ATOMIC_ACQUIRE, "agent");
            xb_add(&bar[XB_XGEN(b.x)], 1u);
            asm volatile("s_waitcnt vmcnt(0)" ::: "memory");
        } else {
            XB_SPIN(xb_ld(&bar[XB_XGEN(b.x)]) == gen, bar);
            __builtin_amdgcn_fence(__ATOMIC_ACQUIRE, "agent");
            asm volatile("s_waitcnt vmcnt(0)" ::: "memory");
        }
    }
    __syncthreads();
}

struct Frame {
    LAS unsigned char* lds;
    volatile LAS int* MI;
    gu32* ctl;
    int tid, lane, wave, vcu, G;
    float* out;
    unsigned char* ws;
};
struct Args { const float* in[32]; float* out; unsigned char* ws; int ph_lo, ph_hi; };
__device__ __forceinline__ float dppf(float x, int ctrl_sel) {
    const int b = __float_as_int(x); int r;
    if (ctrl_sel == 0) r = __builtin_amdgcn_update_dpp(b, b, 0xB1, 0xF, 0xF, false);
    else if (ctrl_sel == 1) r = __builtin_amdgcn_update_dpp(b, b, 0x4E, 0xF, 0xF, false);
    else if (ctrl_sel == 2) r = __builtin_amdgcn_update_dpp(b, b, 0x141, 0xF, 0xF, false);
    else r = __builtin_amdgcn_update_dpp(b, b, 0x140, 0xF, 0xF, false);
    return __int_as_float(r);
}
__device__ __forceinline__ float max8_dpp(float x) { x = fmaxf(x, dppf(x, 0)); x = fmaxf(x, dppf(x, 1)); x = fmaxf(x, dppf(x, 2)); return x; }
__device__ __forceinline__ float rl_f(float x, int l) { return __int_as_float(__builtin_amdgcn_readlane(__float_as_int(x), l)); }
__device__ __forceinline__ float wave_max_dpp(float x) { x = max8_dpp(x); x = fmaxf(x, dppf(x, 3)); return fmaxf(fmaxf(rl_f(x, 0), rl_f(x, 16)), fmaxf(rl_f(x, 32), rl_f(x, 48))); }
__device__ __forceinline__ float wave_sum_dpp(float x) { x += dppf(x, 0); x += dppf(x, 1); x += dppf(x, 2); x += dppf(x, 3); return (rl_f(x, 0) + rl_f(x, 16)) + (rl_f(x, 32) + rl_f(x, 48)); }
__device__ __forceinline__ float wave_sum(float v) { return wave_sum_dpp(v); }

typedef short v4i16_t __attribute__((ext_vector_type(4)));
__device__ __forceinline__ v2u tr8(const LAS unsigned char* p) { return __builtin_bit_cast(v2u, __builtin_amdgcn_ds_read_tr16_b64_v4i16((LAS v4i16_t*)p)); }
__device__ __forceinline__ void transpose_item(const float* W, int K, int N, bf16* WT, int kb, int n0, int drow0, LAS float* scr_, int lane) {
    LAS unsigned char* scr = (LAS unsigned char*)scr_;
    const int k0 = 64 * kb, lr = lane >> 4, lc = lane & 15;
#pragma unroll
    for (int hf = 0; hf < 2; ++hf) {
        f32x4 v[8];
#pragma unroll
        for (int r = 0; r < 8; ++r) v[r] = *(const f32x4*)(W + (size_t)(k0 + 32 * hf + 4 * r + lr) * N + n0 + 4 * lc);
#pragma unroll
        for (int r = 0; r < 8; ++r) { v2u o; o.x = pk2(v[r].x, v[r].y); o.y = pk2(v[r].z, v[r].w); *(LAS v2u*)(scr + (32 * hf + 4 * r + lr) * 144 + lc * 8) = o; }
    }
    LDS_WAIT(); asm volatile("" ::: "memory");
    const int g = lane >> 4, q = (lane & 15) >> 2, p = lane & 3;
#pragma unroll
    for (int nb = 0; nb < 4; ++nb)
#pragma unroll
        for (int kk = 0; kk < 2; ++kk) { const int kblk = 4 * kk + g;
            const v2u a = tr8(scr + (8 * kblk + q) * 144 + (16 * nb + 4 * p) * 2), b = tr8(scr + (8 * kblk + 4 + q) * 144 + (16 * nb + 4 * p) * 2);
            v4u o; o.x = a.x; o.y = a.y; o.z = b.x; o.w = b.y;
            *(GAS v4u*)(WT + (size_t)(drow0 + 16 * nb + lc) * K + k0 + 8 * kblk) = o; }
    LDS_WAIT(); asm volatile("" ::: "memory");
}

__device__ __forceinline__ void p0_phase(Frame& F, const Args& A) {
    unsigned char* ws = F.ws;
    LAS float* sc = (LAS float*)F.lds;
    if (F.vcu < 6 * D / 64) {
#pragma unroll 1
        for (int i0 = F.tid; i0 < BATCH * D; i0 += 8 * NWAVES * 64) { float v[8];
#pragma unroll
            for (int u = 0; u < 8; ++u) v[u] = A.in[1][i0 + u * NWAVES * 64];
#pragma unroll
            for (int u = 0; u < 8; ++u) { const int i = i0 + u * NWAVES * 64, b = i >> 10, k = i & 1023; sc[k * 16 + b] = v[u] * sigm(v[u]); } } }
    __syncthreads();
    const int nada = (F.G > 2 * (6 * D / 64)) ? (6 * D / 64) : 0;
    const int NGW = (F.G - nada) * NWAVES, gw = (F.vcu >= nada) ? (F.vcu - nada) * NWAVES + F.wave : 0x40000000;
    LAS float* part = (LAS float*)(F.lds + 65536);
    for (int task = F.vcu; task < 6 * D / 64; task += F.G) {
        const int col = task * 64 + F.lane;
        float acc[16];
#pragma unroll
        for (int b = 0; b < 16; ++b) acc[b] = 0.f;
        const float* wp = A.in[2] + (size_t)(128 * F.wave) * (6 * D) + col;
        const LAS f32x4* sp = (const LAS f32x4*)(sc + (128 * F.wave) * 16);
#pragma unroll 1
        for (int k0 = 0; k0 < 128; k0 += 32) { float wv[32];
#pragma unroll
            for (int i = 0; i < 32; ++i) wv[i] = wp[(size_t)(k0 + i) * (6 * D)];
#pragma unroll
            for (int i = 0; i < 32; ++i) {
#pragma unroll
                for (int q = 0; q < 4; ++q) { const f32x4 sv = sp[(k0 + i) * 4 + q]; acc[4 * q + 0] += wv[i] * sv.x; acc[4 * q + 1] += wv[i] * sv.y; acc[4 * q + 2] += wv[i] * sv.z; acc[4 * q + 3] += wv[i] * sv.w; } } }
#pragma unroll
        for (int b = 0; b < 16; ++b) part[(F.wave * 16 + b) * 64 + F.lane] = acc[b];
        __syncthreads();
        for (int i = F.tid; i < 16 * 64; i += NWAVES * 64) { const int b = i >> 6, c = i & 63; float v = A.in[3][task * 64 + c];
#pragma unroll
            for (int w8 = 0; w8 < 8; ++w8) v += part[(w8 * 16 + b) * 64 + c];
            ((float*)(ws + WS_MOD))[b * (6 * D) + task * 64 + c] = v; }
        __syncthreads();
    }
    __syncthreads();
    LAS float* scr = (LAS float*)(F.lds + F.wave * 16384);
    constexpr int I_SQ = 16 * 16, I_LW = 16 * 4;
    constexpr int NITEMS = 3 * I_SQ + I_LW;
    for (int it = gw; it < NITEMS; it += NGW) {
        int r = it;
        if (r < I_SQ) { transpose_item(A.in[18], D, D, (bf16*)(ws + WS_WR), r / 16, 64 * (r % 16), 64 * (r % 16), scr, F.lane); continue; } r -= I_SQ;
        if (r < I_SQ) { transpose_item(A.in[19], D, D, (bf16*)(ws + WS_WA), r / 16, 64 * (r % 16), 64 * (r % 16), scr, F.lane); continue; } r -= I_SQ;
        if (r < I_SQ) { transpose_item(A.in[20], D, D, (bf16*)(ws + WS_WO), r / 16, 64 * (r % 16), 64 * (r % 16), scr, F.lane); continue; } r -= I_SQ;
        { const int mat = r >> 2, q = r & 3, gate = mat >> 3, n = mat & 7;
          const float* W = (gate ? A.in[10] : A.in[8]) + (size_t)n * 128 * 128;
          transpose_item(W, 128, 128, (bf16*)(ws + WS_LW) + (size_t)(n * 2 + gate) * 128 * 128, q >> 1, 64 * (q & 1), 64 * (q & 1), scr, F.lane); }
    }
    for (long i = (long)gw * 64 + F.lane; i < D * NEXP; i += NGW * 64) { const int k = i >> 6, e = i & 63; const float wv = A.in[23][i]; const unsigned hb = f2bf(wv); const unsigned lb = f2bf(wv - bf2f(hb));
        ((bf16*)(ws + WS_WRH))[e * D + k] = (bf16)hb; ((bf16*)(ws + WS_WRL))[e * D + k] = (bf16)lb; }
    for (int it = gw; it < 130 * 64 + (D * W_IN) / 4096; it += NGW) { const int mtx = it < 130 * 64 ? it >> 6 : 130, part = it < 130 * 64 ? (it & 63) : it - 130 * 64, e = mtx >> 1, w3 = mtx & 1;
        const float* W = (mtx == 130 ? A.in[5] : e < NEXP ? (w3 ? A.in[26] : A.in[25]) + (size_t)e * D * DEXP : (w3 ? A.in[29] : A.in[28])) + (size_t)part * 4096;
        float mx = 0.f;
#pragma unroll
        for (int i = 0; i < 16; ++i) { const f32x4 v = *((const f32x4*)W + F.lane + 64 * i); mx = fmaxf(mx, fmaxf(fmaxf(fabsf(v.x), fabsf(v.y)), fmaxf(fabsf(v.z), fabsf(v.w)))); }
        mx = wave_max_dpp(mx);
        if (F.lane == 0) atomicMax((unsigned*)(F.ctl + CW_AMAX + mtx), __float_as_uint(mx)); }
}

__device__ __forceinline__ void transpose_item_q(const float* W, int K, int N, signed char* WT, int kb, int n0, int drow0, LAS float* scr_, int lane, float inv) {
    LAS unsigned char* scr = (LAS unsigned char*)scr_;
    const int k0 = 64 * kb, lr = lane >> 4, lc = lane & 15;
#pragma unroll
    for (int hf = 0; hf < 2; ++hf) {
        f32x4 v[8];
#pragma unroll
        for (int r = 0; r < 8; ++r) v[r] = *(const f32x4*)(W + (size_t)(k0 + 32 * hf + 4 * r + lr) * N + n0 + 4 * lc);
#pragma unroll
        for (int r = 0; r < 8; ++r) { v2u o; o.x = pk2(v[r].x, v[r].y); o.y = pk2(v[r].z, v[r].w); *(LAS v2u*)(scr + (32 * hf + 4 * r + lr) * 144 + lc * 8) = o; }
    }
    LDS_WAIT(); asm volatile("" ::: "memory");
    const int g = lane >> 4, q = (lane & 15) >> 2, p = lane & 3;
#pragma unroll
    for (int nb = 0; nb < 4; ++nb)
#pragma unroll
        for (int kk = 0; kk < 2; ++kk) { const int kblk = 4 * kk + g;
            const v2u a = tr8(scr + (8 * kblk + q) * 144 + (16 * nb + 4 * p) * 2), b = tr8(scr + (8 * kblk + 4 + q) * 144 + (16 * nb + 4 * p) * 2);
            const unsigned wv[4] = {a.x, a.y, b.x, b.y}; unsigned ob[2] = {0u, 0u};
#pragma unroll
            for (int j = 0; j < 4; ++j) { const int q0 = (int)rintf(bflo(wv[j]) * inv), q1 = (int)rintf(bfhi(wv[j]) * inv);
                ob[j >> 1] |= ((unsigned)(q0 & 0xff) << (16 * (j & 1))) | ((unsigned)(q1 & 0xff) << (16 * (j & 1) + 8)); }
            v2u o; o.x = ob[0]; o.y = ob[1];
            *(GAS v2u*)(WT + (size_t)(drow0 + 16 * nb + lc) * K + k0 + 8 * kblk) = o; }
    LDS_WAIT(); asm volatile("" ::: "memory");
}

__device__ __forceinline__ void p1_phase(Frame& F, const Args& A) {
    const int gw = F.vcu * NWAVES + F.wave, NGW = F.G * NWAVES;
    const float* mod = (const float*)(F.ws + WS_MOD);
    signed char* H = (signed char*)(F.ws + WS_H); float* SH = (float*)(F.ws + WS_SH);
    for (int grp = gw; grp < T / 16; grp += NGW) {
        const int b = (grp * 16) / SEQ;
        f32x4 g[4], sc[4], sh[4];
#pragma unroll
        for (int j = 0; j < 4; ++j) { const int c = 4 * F.lane + 256 * j; g[j] = *(const f32x4*)(A.in[4] + c); sh[j] = *(const f32x4*)(mod + b * 6 * D + c); sc[j] = *(const f32x4*)(mod + b * 6 * D + D + c);
            g[j] = g[j] * (sc[j] + 1.0f); }
        f32x4 vn[4];
        { const GAS f32x4* xr = (const GAS f32x4*)(A.in[0] + (size_t)grp * 16 * D) + F.lane;
#pragma unroll
          for (int j = 0; j < 4; ++j) vn[j] = xr[64 * j]; }
#pragma unroll 2
        for (int rr = 0; rr < 16; ++rr) {
            const size_t m = (size_t)grp * 16 + rr;
            f32x4 v[4]; float s = 0.f;
#pragma unroll
            for (int j = 0; j < 4; ++j) v[j] = vn[j];
            if (rr + 1 < 16) { const GAS f32x4* xr = (const GAS f32x4*)(A.in[0] + (m + 1) * D) + F.lane;
#pragma unroll
                for (int j = 0; j < 4; ++j) vn[j] = xr[64 * j]; }
#pragma unroll
            for (int j = 0; j < 4; ++j) s += (v[j].x * v[j].x + v[j].y * v[j].y) + (v[j].z * v[j].z + v[j].w * v[j].w);
            const float rstd = 1.f / sqrtf(wave_sum(s) * (1.f / D) + EPS);
            float amx = 0.f;
#pragma unroll
            for (int j = 0; j < 4; ++j) { v[j] = v[j] * rstd * g[j] + sh[j]; amx = fmaxf(amx, fmaxf(fmaxf(fabsf(v[j].x), fabsf(v[j].y)), fmaxf(fabsf(v[j].z), fabsf(v[j].w)))); }
            amx = fmaxf(wave_max_dpp(amx), 1e-20f); const float inv = 127.0f / amx; if (F.lane == 0) SH[m] = amx * (1.0f / 127.0f);
#pragma unroll
            for (int j = 0; j < 4; ++j) { const int q0 = (int)rintf(v[j].x * inv), q1 = (int)rintf(v[j].y * inv), q2 = (int)rintf(v[j].z * inv), q3 = (int)rintf(v[j].w * inv);
                *((GAS unsigned*)(H + m * D) + F.lane + 64 * j) = (unsigned)(q0 & 0xff) | ((unsigned)(q1 & 0xff) << 8) | ((unsigned)(q2 & 0xff) << 16) | ((unsigned)(q3 & 0xff) << 24); }
        }
    }
    { LAS float* scr = (LAS float*)(F.lds + F.wave * 16384);
      const float inv = 127.0f / fmaxf(__uint_as_float(__hip_atomic_load(F.ctl + CW_AMAX + 130, RLX_AGENT)), 1e-30f);
      constexpr int I_IN = 16 * (W_IN / 64);
      for (int it = NGW - 1 - gw; it < I_IN; it += NGW)
          transpose_item_q(A.in[5], D, W_IN, (signed char*)(F.ws + WS_WIN), it / (W_IN / 64), 64 * (it % (W_IN / 64)), 64 * (it % (W_IN / 64)), scr, F.lane, inv); }
}

struct DenseOrder {
    const char* A; const char* Bt; int nM, nN, nwg, G, c; size_t tstep;
    __device__ __forceinline__ void init(const void* A_, const void* Bt_, int M, int N, int K, int G_, int c_) { A = (const char*)A_; Bt = (const char*)Bt_; nM = M / 256; nN = N / 256; nwg = nM * nN; G = G_; c = c_; tstep = (size_t)256 * K * 2; }
    __device__ __forceinline__ bool next(int i, pg8::Unit& u) const {
        const long L = (long)i * G + c; if (L >= nwg) return false;
        int wgid = (int)L; { const int q = nwg / 8, r = nwg % 8, xcd = wgid % 8, off = wgid / 8; wgid = (xcd < r ? xcd * (q + 1) : r * (q + 1) + (xcd - r) * q) + off; }
        const int nig = 8 * nN, gid = wgid / nig, fm = gid * 8, gsz = (nM - fm) < 8 ? (nM - fm) : 8;
        u.pm = fm + ((wgid % nig) % gsz); u.pn = (wgid % nig) / gsz; u.z = i; u.e = 0; return true;
    }
    __device__ __forceinline__ void bases(const pg8::Unit& u, const char*& a, const char*& b) const { a = A + (size_t)u.pm * tstep; b = Bt + (size_t)u.pn * tstep; }
    __device__ __forceinline__ int tok(int, int) const { return 0; }
};
struct MergeOrder {
    DenseOrder d; const char *A1, *B1;
    __device__ __forceinline__ bool next(int i, pg8::Unit& u) const { if (!d.next(i >> 1, u)) return false; u.z = i & 1; return true; }
    __device__ __forceinline__ void bases(const pg8::Unit& u, const char*& a, const char*& b) const { a = (u.z ? A1 : d.A) + (size_t)u.pm * d.tstep; b = (u.z ? B1 : d.Bt) + (size_t)u.pn * d.tstep; }
    __device__ __forceinline__ int tok(int, int) const { return 0; }
};
typedef pg8::f32x4 acc_t[2][2][4][2];
struct EpiProj {
    static constexpr bool PERM = true, TWICE = false; static constexpr int MIN_VM = 16;
    bf16* ws5; bf16* dout2; volatile LAS int* MI; float sB;
    __device__ __forceinline__ void operator()(const acc_t& acc, const pg8::Unit& u, int wr, int wc, int fr, int fq) const {
        const int t = u.pn >> 2, colt = (u.pn & 3) * 256;
        bf16* base = ws5 + (size_t)(t < 5 ? t : 0) * T * D;
        const int row0 = u.pm * 256 + wr * 64 + fr, col0 = colt + wc * 32 + 8 * fq;
#pragma unroll
        for (int ai = 0; ai < 2; ++ai)
#pragma unroll
            for (int m = 0; m < 4; ++m) { bf16* rowp = base + (size_t)(row0 + ai * 128 + m * 16) * D + col0;
                const float sc = __int_as_float(MI[512 + u.z * 256 + wr * 64 + fr + ai * 128 + m * 16]) * sB;
#pragma unroll
                for (int bj = 0; bj < 2; ++bj) { const pg8::i32x4 I0 = __builtin_bit_cast(pg8::i32x4, acc[ai][bj][m][0]), I1 = __builtin_bit_cast(pg8::i32x4, acc[ai][bj][m][1]);
                    pg8::f32x4 v0, v1;
#pragma unroll
                    for (int i = 0; i < 4; ++i) { float a = (float)I0[i] * sc, b = (float)I1[i] * sc; asm volatile("" : "+v"(a), "+v"(b)); v0[i] = a; v1[i] = b; }
                    if (t >= 5) {
                        unsigned tb[8];
#pragma unroll
                        for (int i = 0; i < 4; ++i) { tb[i] = __float_as_uint(__builtin_fmaf(sigm(v0[i]), 255.0f, 8388608.0f)); tb[4 + i] = __float_as_uint(__builtin_fmaf(sigm(v1[i]), 255.0f, 8388608.0f)); }
                        v2u w; w.x = __builtin_amdgcn_perm(__builtin_amdgcn_perm(tb[3], tb[2], 0x0c0c0400u), __builtin_amdgcn_perm(tb[1], tb[0], 0x0c0c0400u), 0x05040100u);
                        w.y = __builtin_amdgcn_perm(__builtin_amdgcn_perm(tb[7], tb[6], 0x0c0c0400u), __builtin_amdgcn_perm(tb[5], tb[4], 0x0c0c0400u), 0x05040100u);
                        *(v2u*)((unsigned char*)dout2 + (size_t)(t - 5) * T * D + (size_t)(row0 + ai * 128 + m * 16) * D + col0 + bj * 128) = w; continue; }
                    if (t == 1) { for (int i = 0; i < 4; ++i) { v0[i] = pg8::gelu_t(v0[i]); v1[i] = pg8::gelu_t(v1[i]); } }
                    else if (t == 2) { v0 = v0 * attn_body::C2; v1 = v1 * attn_body::C2; }
                    v4u w; w.x = pg8::cvt_pk_bf16(v0[0], v0[1]); w.y = pg8::cvt_pk_bf16(v0[2], v0[3]); w.z = pg8::cvt_pk_bf16(v1[0], v1[1]); w.w = pg8::cvt_pk_bf16(v1[2], v1[3]);
                    *(v4u*)(rowp + bj * 128) = w; } }
    }
};
struct EpiGate {
    static constexpr bool PERM = true, TWICE = false; static constexpr int MIN_VM = 16;
    const unsigned char* GA; const unsigned char* GB; bf16* YA; bf16* MG;
    __device__ __forceinline__ void operator()(const acc_t& acc, const pg8::Unit& u, int wr, int wc, int fr, int fq) const {
        const int row0 = u.pm * 256 + wr * 64 + fr, col0 = u.pn * 256 + wc * 32 + 8 * fq;
        const unsigned char* G = u.z ? GB : GA; bf16* O = u.z ? MG : YA;
#pragma unroll
        for (int ai = 0; ai < 2; ++ai)
#pragma unroll
            for (int mp = 0; mp < 2; ++mp) {
                v2u g[2][2]; v4u y[2][2];
#pragma unroll
                for (int mm = 0; mm < 2; ++mm)
#pragma unroll
                    for (int bj = 0; bj < 2; ++bj) { const size_t off = (size_t)(row0 + ai * 128 + (2 * mp + mm) * 16) * D + col0 + bj * 128; g[mm][bj] = *(const v2u*)(G + off);
                        y[mm][bj] = u.z ? *(const v4u*)(YA + off) : (v4u){0u, 0u, 0u, 0u}; }
#pragma unroll
                for (int mm = 0; mm < 2; ++mm)
#pragma unroll
                    for (int bj = 0; bj < 2; ++bj) { const int m = 2 * mp + mm; const size_t off = (size_t)(row0 + ai * 128 + m * 16) * D + col0 + bj * 128; const v2u gg = g[mm][bj]; const v4u yy = y[mm][bj]; constexpr float Q = 1.0f / 255.0f;
                        pg8::f32x4 v0 = acc[ai][bj][m][0], v1 = acc[ai][bj][m][1];
                        v0[0] = v0[0] * ((float)(gg.x & 0xffu) * Q) + bflo(yy.x); v0[1] = v0[1] * ((float)((gg.x >> 8) & 0xffu) * Q) + bfhi(yy.x); v0[2] = v0[2] * ((float)((gg.x >> 16) & 0xffu) * Q) + bflo(yy.y); v0[3] = v0[3] * ((float)(gg.x >> 24) * Q) + bfhi(yy.y);
                        v1[0] = v1[0] * ((float)(gg.y & 0xffu) * Q) + bflo(yy.z); v1[1] = v1[1] * ((float)((gg.y >> 8) & 0xffu) * Q) + bfhi(yy.z); v1[2] = v1[2] * ((float)((gg.y >> 16) & 0xffu) * Q) + bflo(yy.w); v1[3] = v1[3] * ((float)(gg.y >> 24) * Q) + bfhi(yy.w);
                        v4u w; w.x = pg8::cvt_pk_bf16(v0[0], v0[1]); w.y = pg8::cvt_pk_bf16(v0[2], v0[3]); w.z = pg8::cvt_pk_bf16(v1[0], v1[1]); w.w = pg8::cvt_pk_bf16(v1[2], v1[3]);
                        *(v4u*)(O + off) = w; }
                asm volatile("" ::: "memory"); }
    }
};
struct EpiF32 {
    static constexpr bool PERM = true, TWICE = false; static constexpr int MIN_VM = 16;
    bf16* Y;
    __device__ __forceinline__ void operator()(const acc_t& acc, const pg8::Unit& u, int wr, int wc, int fr, int fq) const {
        const int row0 = u.pm * 256 + wr * 64 + fr, col0 = u.pn * 256 + wc * 32 + 8 * fq;
#pragma unroll
        for (int ai = 0; ai < 2; ++ai)
#pragma unroll
            for (int m = 0; m < 4; ++m) { bf16* rowp = Y + (size_t)(row0 + ai * 128 + m * 16) * D + col0;
#pragma unroll
                for (int bj = 0; bj < 2; ++bj) { const pg8::f32x4 v0 = acc[ai][bj][m][0], v1 = acc[ai][bj][m][1];
                    v4u w; w.x = pg8::cvt_pk_bf16(v0[0], v0[1]); w.y = pg8::cvt_pk_bf16(v0[2], v0[3]); w.z = pg8::cvt_pk_bf16(v1[0], v1[1]); w.w = pg8::cvt_pk_bf16(v1[2], v1[3]);
                    *(v4u*)(rowp + bj * 128) = w; } }
    }
};

__device__ __forceinline__ void lru_phase(Frame& F, const Args& A) {
    unsigned char* ws = F.ws;
    const bf16* XR = (const bf16*)(ws + WS_XR); bf16* GR = (bf16*)(ws + WS_GR);
    LAS unsigned char* AT = F.lds;
    LAS unsigned char* BT = F.lds + 34816;
    LAS float* AA = (LAS float*)(F.lds + 69632);
    LAS float* UU = (LAS float*)(F.lds + 102400);
    LAS float* SM = (LAS float*)(F.lds + 135168);
    LAS float* CW = (LAS float*)(F.lds + MISC_OFF + 4096);
    const int tid = F.tid, lane = F.lane, w = F.wave, hi = lane >> 5, l31 = lane & 31;
    for (int item = F.vcu; item < BATCH * 16; item += F.G) {
        const int b = item >> 4, n = (item >> 1) & 7, half = item & 1;
        __syncthreads();
        { const bf16* LW = (const bf16*)(ws + WS_LW) + (size_t)n * 2 * 128 * 128;
#pragma unroll
          for (int p = 0; p < 4; ++p) { const int q = tid + 512 * p, row = q >> 4, pc = q & 15; const int gate = row >> 6, d = 64 * half + (row & 63);
              const v4u v = *(const v4u*)(LW + ((size_t)gate * 128 + d) * 128 + pc * 8); *(LAS v4u*)(BT + row * 272 + pc * 16) = v; }
          for (int i = tid; i < 640; i += NWAVES * 64) { const int k = i >> 7, c = i & 127; CW[i] = (k < 4) ? A.in[6][k * D + 128 * n + c] : A.in[7][128 * n + c]; } }
        const int c8 = (tid & 15) * 8, run = tid >> 4, cg0 = 128 * n + c8;
        const int tg = w & 3, cg = w >> 2, lc = 32 * cg + l31, chg = 128 * n + 64 * half + lc;
        const float ba_c = A.in[9][chg], bx_c = A.in[11][chg];
        const float lam = A.in[12][chg]; const float sp8 = 8.0f * log1pf(expf(-lam)) * LOG2E;
        const int sc_c = tid & 63, seg = tid >> 6;
        float hcarry = 0.f;
        v4u xq[7];
        { const bf16* xp = XR + ((size_t)b * SEQ + 4 * run - 3) * D + cg0;
#pragma unroll
          for (int i = 0; i < 7; ++i) xq[i] = (4 * run - 3 + i >= 0) ? *(const v4u*)(xp + (size_t)i * D) : (v4u){0u, 0u, 0u, 0u}; }
        __syncthreads();
#pragma unroll 1
        for (int ck = 0; ck < SEQ / 128; ++ck) {
            const int t0 = 128 * ck;
            bf16* gp = GR + ((size_t)b * SEQ + t0 + 16 * seg) * D + 128 * n + 64 * half + sc_c;
            { unsigned ow[4][4];
#pragma unroll
              for (int hf = 0; hf < 2; ++hf) { float wv[5][4];
#pragma unroll
                  for (int k = 0; k < 5; ++k) { const f32x4 w0 = *(const LAS f32x4*)(CW + k * 128 + c8 + 4 * hf); wv[k][0] = w0.x; wv[k][1] = w0.y; wv[k][2] = w0.z; wv[k][3] = w0.w; }
#pragma unroll
                  for (int tt = 0; tt < 4; ++tt) { float x0 = wv[4][0], x1 = wv[4][1], x2 = wv[4][2], x3 = wv[4][3];
#pragma unroll
                      for (int k = 0; k < 4; ++k) { const unsigned va = hf ? xq[tt + k].z : xq[tt + k].x, vb = hf ? xq[tt + k].w : xq[tt + k].y;
                          x0 += wv[k][0] * bflo(va); x1 += wv[k][1] * bfhi(va); x2 += wv[k][2] * bflo(vb); x3 += wv[k][3] * bfhi(vb); }
                      ow[tt][2 * hf] = pk2(x0, x1); ow[tt][2 * hf + 1] = pk2(x2, x3); } }
#pragma unroll
              for (int tt = 0; tt < 4; ++tt) { v4u o; o.x = ow[tt][0]; o.y = ow[tt][1]; o.z = ow[tt][2]; o.w = ow[tt][3]; *(LAS v4u*)(AT + (4 * run + tt) * 272 + c8 * 2) = o; } }
            if (ck + 1 < SEQ / 128) { const bf16* xp = XR + ((size_t)b * SEQ + t0 + 128 + 4 * run - 3) * D + cg0;
#pragma unroll
                for (int i = 0; i < 7; ++i) xq[i] = *(const v4u*)(xp + (size_t)i * D); }
            __syncthreads();
            { f32x16 accR = f32x16{}, accI = f32x16{};
#pragma unroll
              for (int ks = 0; ks < 8; ++ks) {
                  const bf16x8 a = *(const LAS bf16x8*)(AT + (32 * tg + l31) * 272 + (16 * ks + 8 * hi) * 2);
                  const bf16x8 bR = *(const LAS bf16x8*)(BT + (32 * cg + l31) * 272 + (16 * ks + 8 * hi) * 2);
                  const bf16x8 bI = *(const LAS bf16x8*)(BT + (64 + 32 * cg + l31) * 272 + (16 * ks + 8 * hi) * 2);
                  accR = __builtin_amdgcn_mfma_f32_32x32x16_bf16(a, bR, accR, 0, 0, 0);
                  accI = __builtin_amdgcn_mfma_f32_32x32x16_bf16(a, bI, accI, 0, 0, 0); }
#pragma unroll
              for (int r = 0; r < 16; ++r) {
                  const int tok = 32 * tg + (r & 3) + 8 * (r >> 2) + 4 * hi;
                  const float rg = sigm(accR[r] + ba_c), ig = sigm(accI[r] + bx_c);
                  const float la2 = -sp8 * rg;
                  const float a = __builtin_amdgcn_exp2f(la2);
                  float mult = __builtin_amdgcn_sqrtf(fmaxf(1.0f - a * a, 0.f));
                  if (t0 + tok == 0) mult = 1.0f;
                  const float xcv = bf2f(*(const LAS unsigned short*)(AT + tok * 272 + (64 * half + lc) * 2));
                  AA[tok * 64 + lc] = a; UU[tok * 64 + lc] = mult * ig * xcv; } }
            __syncthreads();
            unsigned short gq[16];
#pragma unroll
            for (int j = 0; j < 16; ++j) gq[j] = gp[(size_t)j * D];
            float hl[16], pl[16];
            { float h = 0.f, P = 1.f;
#pragma unroll
              for (int j = 0; j < 16; ++j) { const float a = AA[(16 * seg + j) * 64 + sc_c], u = UU[(16 * seg + j) * 64 + sc_c]; h = a * h + u; P = P * a; hl[j] = h; pl[j] = P; }
              SM[(seg * 64 + sc_c) * 2] = P; SM[(seg * 64 + sc_c) * 2 + 1] = h; }
            __syncthreads();
            { float cin = hcarry, tot = hcarry;
#pragma unroll
              for (int s = 0; s < 8; ++s) { const float Ps = SM[(s * 64 + sc_c) * 2], hs = SM[(s * 64 + sc_c) * 2 + 1]; tot = Ps * tot + hs; if (s < seg) cin = tot; }
              hcarry = tot;
#pragma unroll
              for (int j = 0; j < 16; ++j) { const float hv = hl[j] + pl[j] * cin; gp[(size_t)j * D] = (bf16)f2bf(hv * bf2f(gq[j])); } }
        }
    }
    __syncthreads();
}

__device__ __forceinline__ void p5_phase(Frame& F, const Args& A) {
    const int gw = F.vcu * NWAVES + F.wave, NGW = F.G * NWAVES;
    float d1 = A.in[13][F.lane] * A.in[14][F.lane], d2 = A.in[15][F.lane] * A.in[16][F.lane];
    const float lam = expf(wave_sum(d1)) - expf(wave_sum(d2)) + LAM_INIT;
    bf16* O0 = (bf16*)(F.ws + WS_H); const bf16* O1 = (const bf16*)(F.ws + WS_O1);
    float g[16];
#pragma unroll
    for (int i = 0; i < 16; ++i) g[i] = A.in[17][(16 * F.lane + i) & 127] * (1.0f - LAM_INIT);
    for (int m = gw; m < T; m += NGW) {
        const v4u a0 = *(const v4u*)(O0 + (size_t)m * D + 16 * F.lane), a1 = *(const v4u*)(O0 + (size_t)m * D + 16 * F.lane + 8);
        const v4u b0 = *(const v4u*)(O1 + (size_t)m * D + 16 * F.lane), b1 = *(const v4u*)(O1 + (size_t)m * D + 16 * F.lane + 8);
        float o[16];
        o[0] = bflo(a0.x) - lam * bflo(b0.x); o[1] = bfhi(a0.x) - lam * bfhi(b0.x); o[2] = bflo(a0.y) - lam * bflo(b0.y); o[3] = bfhi(a0.y) - lam * bfhi(b0.y);
        o[4] = bflo(a0.z) - lam * bflo(b0.z); o[5] = bfhi(a0.z) - lam * bfhi(b0.z); o[6] = bflo(a0.w) - lam * bflo(b0.w); o[7] = bfhi(a0.w) - lam * bfhi(b0.w);
        o[8] = bflo(a1.x) - lam * bflo(b1.x); o[9] = bfhi(a1.x) - lam * bfhi(b1.x); o[10] = bflo(a1.y) - lam * bflo(b1.y); o[11] = bfhi(a1.y) - lam * bfhi(b1.y);
        o[12] = bflo(a1.z) - lam * bflo(b1.z); o[13] = bfhi(a1.z) - lam * bfhi(b1.z); o[14] = bflo(a1.w) - lam * bflo(b1.w); o[15] = bfhi(a1.w) - lam * bfhi(b1.w);
        float s = 0.f;
#pragma unroll
        for (int i = 0; i < 16; ++i) s += o[i] * o[i];
        s += __shfl_xor(s, 1); s += __shfl_xor(s, 2); s += __shfl_xor(s, 4);
        const float rstd = 1.f / sqrtf(s * (1.f / 128.f) + EPS);
        v4u w0, w1;
        w0.x = pk2(o[0] * rstd * g[0], o[1] * rstd * g[1]); w0.y = pk2(o[2] * rstd * g[2], o[3] * rstd * g[3]); w0.z = pk2(o[4] * rstd * g[4], o[5] * rstd * g[5]); w0.w = pk2(o[6] * rstd * g[6], o[7] * rstd * g[7]);
        w1.x = pk2(o[8] * rstd * g[8], o[9] * rstd * g[9]); w1.y = pk2(o[10] * rstd * g[10], o[11] * rstd * g[11]); w1.z = pk2(o[12] * rstd * g[12], o[13] * rstd * g[13]); w1.w = pk2(o[14] * rstd * g[14], o[15] * rstd * g[15]);
        *(v4u*)(O0 + (size_t)m * D + 16 * F.lane) = w0; *(v4u*)(O0 + (size_t)m * D + 16 * F.lane + 8) = w1;
    }
}

#ifndef PROBE_SEG
#define PROBE_SEG 0
#endif
#define SEG_T0() do { if (PROBE_SEG != 0 && F.tid == 0) { volatile LAS unsigned long long* pp_ = (volatile LAS unsigned long long*)(F.MI + 16); pp_[0] = __builtin_amdgcn_s_memrealtime(); } } while (0)
#define SEG_T1(id) do { if (PROBE_SEG != 0 && F.tid == 0) { volatile LAS unsigned long long* pp_ = (volatile LAS unsigned long long*)(F.MI + 16); const unsigned long long t_ = __builtin_amdgcn_s_memrealtime(); if (PROBE_SEG == (id)) pp_[1] += t_ - pp_[0]; pp_[0] = t_; } } while (0)
__device__ __forceinline__ void p8_phase(Frame& F, const Args& A) {
    unsigned char* ws = F.ws;
    const float* mod = (const float*)(ws + WS_MOD); const bf16* Y = (const bf16*)(ws + WS_Y);
    signed char* H2 = (signed char*)(ws + WS_H); float* SA = (float*)(ws + WS_SA);
    LAS unsigned char* TH = F.lds; LAS unsigned char* TL = F.lds + 66048;
    LAS float* red = (LAS float*)F.lds;
    LAS int* cntl = (LAS int*)(F.lds + 135168);
    const int tid = F.tid, lane = F.lane, w = F.wave, hi = lane >> 5, l31 = lane & 31;
    int* lists = (int*)(ws + WS_LIST); float* wts = (float*)(ws + WS_WTS);
    v2u yn[2][4]; f32x4 xn[2][4];
    if (F.vcu < T / 32) {
#pragma unroll
        for (int q = 0; q < 2; ++q) { const size_t m = (size_t)F.vcu * 32 + w * 4 + q;
#pragma unroll
            for (int j = 0; j < 4; ++j) { yn[q][j] = *((const GAS v2u*)(Y + m * D) + lane + 64 * j); xn[q][j] = *((const GAS f32x4*)(A.in[0] + m * D) + lane + 64 * j); } } }
#pragma unroll 1
    for (int tl = F.vcu; tl < T / 32; tl += F.G) {
        const int tok0 = tl * 32, b = tok0 / SEQ, chunk = tok0 / TC;
        if (tid < 64) cntl[tid] = 0;
        SEG_T0();
        f32x4 c_gp[4], c_g2[4], c_sh[4];
#pragma unroll
        for (int j = 0; j < 4; ++j) { const int c = 4 * lane + 256 * j; c_gp[j] = *(const f32x4*)(A.in[21] + c) * *(const f32x4*)(mod + b * 6 * D + 2 * D + c);
            c_g2[j] = *(const f32x4*)(A.in[22] + c) * (*(const f32x4*)(mod + b * 6 * D + 4 * D + c) + 1.0f); c_sh[j] = *(const f32x4*)(mod + b * 6 * D + 3 * D + c); }
#pragma unroll 1
        for (int rp = 0; rp < 2; ++rp) {
            f32x4 y[2][4], x[2][4]; float s[2] = {0.f, 0.f};
#pragma unroll
            for (int q = 0; q < 2; ++q)
#pragma unroll
                for (int j = 0; j < 4; ++j) { const v2u yv = yn[q][j]; y[q][j] = (f32x4){bflo(yv.x), bfhi(yv.x), bflo(yv.y), bfhi(yv.y)}; x[q][j] = xn[q][j]; }
            { const int ntl = rp ? tl + F.G : tl, nrp = rp ^ 1;
              if (ntl < T / 32) {
#pragma unroll
                  for (int q = 0; q < 2; ++q) { const size_t m = (size_t)ntl * 32 + w * 4 + nrp * 2 + q;
#pragma unroll
                      for (int j = 0; j < 4; ++j) { yn[q][j] = *((const GAS v2u*)(Y + m * D) + lane + 64 * j); xn[q][j] = *((const GAS f32x4*)(A.in[0] + m * D) + lane + 64 * j); } } } }
#pragma unroll
            for (int q = 0; q < 2; ++q)
#pragma unroll
                for (int j = 0; j < 4; ++j) s[q] += (y[q][j].x * y[q][j].x + y[q][j].y * y[q][j].y) + (y[q][j].z * y[q][j].z + y[q][j].w * y[q][j].w);
            float s2[2] = {0.f, 0.f};
#pragma unroll
            for (int q = 0; q < 2; ++q) { const size_t m = (size_t)tok0 + w * 4 + rp * 2 + q; const float rstd = 1.f / sqrtf(wave_sum_dpp(s[q]) * (1.f / D) + EPS);
#pragma unroll
                for (int j = 0; j < 4; ++j) { x[q][j] = x[q][j] + c_gp[j] * (y[q][j] * rstd); { v2u xb; xb.x = pk2(x[q][j].x, x[q][j].y); xb.y = pk2(x[q][j].z, x[q][j].w); *((v2u*)(F.out + m * D) + lane + 64 * j) = xb; }
                    s2[q] += (x[q][j].x * x[q][j].x + x[q][j].y * x[q][j].y) + (x[q][j].z * x[q][j].z + x[q][j].w * x[q][j].w); } }
#pragma unroll
            for (int q = 0; q < 2; ++q) { const size_t m = (size_t)tok0 + w * 4 + rp * 2 + q; const float rstd2 = 1.f / sqrtf(wave_sum_dpp(s2[q]) * (1.f / D) + EPS);
                f32x4 hh[4]; float amx = 0.f;
#pragma unroll
                for (int j = 0; j < 4; ++j) { const int c = 4 * lane + 256 * j; const f32x4 h = (x[q][j] * rstd2) * c_g2[j] + c_sh[j]; hh[j] = h;
                    amx = fmaxf(amx, fmaxf(fmaxf(fabsf(h.x), fabsf(h.y)), fmaxf(fabsf(h.z), fabsf(h.w))));
                    v2u o; o.x = pk2(h.x, h.y); o.y = pk2(h.z, h.w);
                    *(LAS v2u*)(TH + (w * 4 + rp * 2 + q) * 2064 + c * 2) = o; }
                amx = fmaxf(wave_max_dpp(amx), 1e-20f); const float inv = 127.0f / amx; if (lane == 0) SA[m] = amx * (1.0f / 127.0f);
#pragma unroll
                for (int j = 0; j < 4; ++j) { const int q0 = (int)rintf(hh[j].x * inv), q1 = (int)rintf(hh[j].y * inv), q2 = (int)rintf(hh[j].z * inv), q3 = (int)rintf(hh[j].w * inv);
                    *((GAS unsigned*)(H2 + m * D) + lane + 64 * j) = (unsigned)(q0 & 0xff) | ((unsigned)(q1 & 0xff) << 8) | ((unsigned)(q2 & 0xff) << 16) | ((unsigned)(q3 & 0xff) << 24); } }
        }
        bf16x8 bH0[8], bH1[8];
        { const bf16* whp = (const bf16*)(ws + WS_WRH) + (size_t)l31 * D + 128 * w + 8 * hi;
#pragma unroll
          for (int ks = 0; ks < 8; ++ks) { bH0[ks] = *(const GAS bf16x8*)(whp + ks * 16); bH1[ks] = *(const GAS bf16x8*)(whp + 32 * D + ks * 16); } }
        __syncthreads(); SEG_T1(1);
        f32x16 acc0 = f32x16{}, acc1 = f32x16{};
        { const LAS unsigned char* ahp = TH + l31 * 2064 + (128 * w + 8 * hi) * 2;
#pragma unroll
          for (int ks = 0; ks < 8; ++ks) {
              const bf16x8 aH = *(const LAS bf16x8*)(ahp + ks * 32);
              acc0 = __builtin_amdgcn_mfma_f32_32x32x16_bf16(aH, bH0[ks], acc0, 0, 0, 0); acc1 = __builtin_amdgcn_mfma_f32_32x32x16_bf16(aH, bH1[ks], acc1, 0, 0, 0); } }
        __syncthreads(); SEG_T1(2);
#pragma unroll
        for (int r = 0; r < 16; ++r) { const int tk = (r & 3) + 8 * (r >> 2) + 4 * hi; red[(w * 32 + tk) * 64 + l31] = acc0[r]; red[(w * 32 + tk) * 64 + 32 + l31] = acc1[r]; }
        __syncthreads();
        int sel_e[4], sel_lp[4], sel_slot[4]; float sel_wt[4];
        const float eb = A.in[24][lane];
#pragma unroll
        for (int q = 0; q < 4; ++q) {
            const int tk = 4 * w + q; float lg = 0.f;
#pragma unroll
            for (int ww = 0; ww < 8; ++ww) lg += red[(ww * 32 + tk) * 64 + lane];
            const float score = 1.0f / (1.0f + expf(-lg)); const float ch = score + eb;
            const float m1 = max8_dpp(ch);
            const unsigned long long eq = __ballot(ch == m1); const int gsh = lane & ~7; const unsigned ge = (unsigned)((eq >> gsh) & 0xffull);
            const int first = gsh + __builtin_ctz(ge);
            const float m2 = max8_dpp((lane == first) ? -INFINITY : ch);
            const float gs = m1 + m2; const int g = lane >> 3;
            int grank = 0;
#pragma unroll
            for (int gg = 0; gg < 8; ++gg) { const float og = rl_f(gs, gg * 8); grank += (og > gs || (og == gs && gg < g)) ? 1 : 0; }
            float cur = (grank < 4) ? ch : -INFINITY;
            int rank = TOPK;
#pragma unroll
            for (int kk = 0; kk < TOPK; ++kk) { const float mx = wave_max_dpp(cur); const unsigned long long mk = __ballot(cur == mx); const int fl = (int)__builtin_ctzll(mk);
                if (lane == fl) { rank = kk; cur = -INFINITY; } }
            const bool sel = rank < TOPK;
            const float wsum = wave_sum_dpp(sel ? score : 0.f);
            sel_e[q] = sel ? lane : -1; sel_slot[q] = (tok0 + tk) * 8 + rank; sel_wt[q] = score / (wsum + 1e-20f) * 2.5f;
            sel_lp[q] = sel ? atomicAdd((int*)&cntl[lane], 1) : 0;
        }
        __syncthreads(); SEG_T1(3);
        if (tid < 64) { const int c = cntl[tid]; cntl[64 + tid] = c ? (int)__hip_atomic_fetch_add((unsigned*)(F.ctl + CW_CNT + chunk * 64 + tid), (unsigned)c, RLX_AGENT) : 0; }
        __syncthreads();
#pragma unroll
        for (int q = 0; q < 4; ++q) if (sel_e[q] >= 0) { const int pos = cntl[64 + lane] + sel_lp[q]; lists[((size_t)chunk * 64 + lane) * TC + pos] = sel_slot[q]; wts[sel_slot[q]] = sel_wt[q]; }
        __syncthreads(); SEG_T1(4);
    }
    SEG_T0();
    __syncthreads();
    LAS float* scr = (LAS float*)(F.lds + w * 16384);
    const int gw = F.vcu * NWAVES + w, NGW = F.G * NWAVES;
    constexpr int I13 = 16 * 4, I2 = 4 * 16, PER_E = 2 * I13 + I2;
    for (int it = gw; it < (NEXP + 1) * PER_E; it += NGW) {
        const int e = it / PER_E; int r = it % PER_E;
        const bool sh = (e == NEXP);
        if (r < 2 * I13) { const int w3 = r / I13; r %= I13; const int kb = r >> 2, n0 = 64 * (r & 3);
            const float* W = sh ? (w3 ? A.in[29] : A.in[28]) : ((w3 ? A.in[26] : A.in[25]) + (size_t)e * D * DEXP);
            signed char* WT = sh ? (signed char*)(ws + WS_W13S) : (signed char*)(ws + WS_W13) + (size_t)e * 512 * D;
            const float amx = fmaxf(__uint_as_float(__hip_atomic_load(F.ctl + CW_AMAX + 2 * e + w3, RLX_AGENT)), 1e-30f);
            transpose_item_q(W, D, DEXP, WT, kb, n0, (n0 >> 7) * 256 + (w3 ? 128 : 0) + (n0 & 127), scr, lane, 127.0f / amx); }
        else { r -= 2 * I13; const int kb = r >> 4, n0 = 64 * (r & 15);
            const float* W = sh ? A.in[30] : A.in[27] + (size_t)e * DEXP * D;
            bf16* WT = sh ? (bf16*)(ws + WS_W2S) : (bf16*)(ws + WS_W2) + (size_t)e * D * DEXP;
            transpose_item(W, DEXP, D, WT, kb, n0, n0, scr, lane); }
    }
    __syncthreads(); SEG_T1(5);
}

__device__ __forceinline__ int moe_tables(Frame& F, int chunk) {
    __syncthreads();
    if (F.wave == 0) {
        const int cnt = (int)__hip_atomic_load(F.ctl + CW_CNT + chunk * 64 + F.lane, RLX_AGENT);
        const int nt = (cnt + 255) >> 8; int incl = nt;
#pragma unroll
        for (int o = 1; o < 64; o <<= 1) { const int v = __shfl_up(incl, o); if (F.lane >= o) incl += v; }
        const int base = incl - nt;
        F.MI[MI_CNT + F.lane] = cnt; F.MI[MI_TBASE + F.lane] = base; if (F.lane == 63) F.MI[MI_TBASE + NEXP] = incl;
        for (int j = 0; j < nt; ++j) F.MI[MI_TILE_E + base + j] = F.lane; }
    __syncthreads();
    return F.MI[MI_TBASE + NEXP];
}
struct UpOrder {
    const char* ws; volatile LAS int* MI; int nrt_r, nrt, G, c;
    __device__ __forceinline__ bool next(int i, pg8::Unit& u) const { const int L = i * G + c; if (L >= 2 * nrt) return false; u.pm = L >> 1; u.pn = L & 1; u.z = i;
        u.e = (u.pm < nrt_r) ? __builtin_amdgcn_readfirstlane(MI[MI_TILE_E + u.pm]) : NEXP; return true; }
    __device__ __forceinline__ void bases(const pg8::Unit& u, const char*& a, const char*& b) const { a = ws + WS_H; b = (u.e < NEXP ? ws + WS_W13 + (size_t)u.e * 512 * D : ws + WS_W13S) + (size_t)u.pn * 256 * D; }
    __device__ __forceinline__ int tok(int ui, int row) const { return MI[MI_TOK + ui * 256 + row]; }
};
struct EpiSwiglu {
    static constexpr bool PERM = true, TWICE = false; static constexpr int MIN_VM = 8;
    bf16* HB; volatile LAS int* MI; gu32* amax;
    __device__ __forceinline__ void operator()(const acc_t& acc, const pg8::Unit& u, int wr, int wc, int fr, int fq) const {
        const int row0 = u.pm * 256 + wr * 64 + fr, col0 = u.pn * 128 + wc * 32 + 8 * fq;
        const float sB1 = __int_as_float(MI[MI_SB + 2 * u.z]), sB3 = __int_as_float(MI[MI_SB + 2 * u.z + 1]);
#pragma unroll
        for (int ai = 0; ai < 2; ++ai)
#pragma unroll
            for (int m = 0; m < 4; ++m) { bf16* rowp = HB + (size_t)(row0 + ai * 128 + m * 16) * DEXP + col0;
                const float sA = __int_as_float(MI[MI_SA + u.z * 256 + wr * 64 + fr + ai * 128 + m * 16]); const float s1 = sA * sB1, s3 = sA * sB3;
                float v[8];
                { const pg8::i32x4 A0 = __builtin_bit_cast(pg8::i32x4, acc[ai][0][m][0]), A1 = __builtin_bit_cast(pg8::i32x4, acc[ai][0][m][1]), G0 = __builtin_bit_cast(pg8::i32x4, acc[ai][1][m][0]), G1 = __builtin_bit_cast(pg8::i32x4, acc[ai][1][m][1]);
#pragma unroll
                  for (int i = 0; i < 4; ++i) { float a = (float)A0[i] * s1, g = (float)G0[i] * s3; asm volatile("" : "+v"(a), "+v"(g)); v[i] = a * sigm(a) * g;
                      float a2 = (float)A1[i] * s1, g2 = (float)G1[i] * s3; asm volatile("" : "+v"(a2), "+v"(g2)); v[4 + i] = a2 * sigm(a2) * g2; } }
                v4u w; w.x = pg8::cvt_pk_bf16(v[0], v[1]); w.y = pg8::cvt_pk_bf16(v[2], v[3]); w.z = pg8::cvt_pk_bf16(v[4], v[5]); w.w = pg8::cvt_pk_bf16(v[6], v[7]);
                *(v4u*)rowp = w; asm volatile("" ::: "memory"); }
    }
};
struct DownOrder {
    const char* ws; volatile LAS int* MI; int nrt_r, nrt, G, c;
    __device__ __forceinline__ bool next(int i, pg8::Unit& u) const { const int L = i * G + c; if (L >= 4 * nrt) return false; u.pm = L >> 2; u.pn = L & 3; u.z = i;
        u.e = (u.pm < nrt_r) ? __builtin_amdgcn_readfirstlane(MI[MI_TILE_E + u.pm]) : NEXP; return true; }
    __device__ __forceinline__ void bases(const pg8::Unit& u, const char*& a, const char*& b) const { a = ws + WS_HB + (size_t)u.pm * 256 * DEXP * 2; b = (u.e < NEXP ? ws + WS_W2 + (size_t)u.e * D * DEXP * 2 : ws + WS_W2S) + (size_t)u.pn * 256 * DEXP * 2; }
    __device__ __forceinline__ int tok(int, int) const { return 0; }
};
struct EpiScatter {
    static constexpr bool PERM = true, TWICE = true; static constexpr int MIN_VM = 0;
    unsigned char* SL; volatile LAS int* MI;
    __device__ __forceinline__ void operator()(const acc_t& acc, const pg8::Unit& u, int wr, int wc, int fr, int fq) const {
        const int col0 = u.pn * 256 + wc * 32 + 8 * fq;
#pragma unroll
        for (int ai = 0; ai < 2; ++ai)
#pragma unroll
            for (int m = 0; m < 4; ++m) { const int rl = wr * 64 + fr + ai * 128 + m * 16; const int dest = MI[MI_TOK + u.z * 256 + rl]; const float wt = 16.0f;
                if (dest >= 0) { unsigned char* rowp = SL + (size_t)dest * D + col0;
#pragma unroll
                    for (int bj = 0; bj < 2; ++bj) { const pg8::f32x4 v0 = acc[ai][bj][m][0], v1 = acc[ai][bj][m][1];
                        float q[8];
#pragma unroll
                        for (int i = 0; i < 4; ++i) { q[i] = __builtin_amdgcn_fmed3f(v0[i] * wt, -448.0f, 448.0f); q[4 + i] = __builtin_amdgcn_fmed3f(v1[i] * wt, -448.0f, 448.0f); }
                        v2u w; w.x = (unsigned)__builtin_amdgcn_cvt_pk_fp8_f32(q[0], q[1], 0, false); w.x = (unsigned)__builtin_amdgcn_cvt_pk_fp8_f32(q[2], q[3], (int)w.x, true);
                        w.y = (unsigned)__builtin_amdgcn_cvt_pk_fp8_f32(q[4], q[5], 0, false); w.y = (unsigned)__builtin_amdgcn_cvt_pk_fp8_f32(q[6], q[7], (int)w.y, true);
                        *(v2u*)(rowp + bj * 128) = w; asm volatile("" ::: "memory"); } } }
    }
};
__device__ __forceinline__ void p2_phase(Frame& F, const Args& A) {
    unsigned char* ws = F.ws;
    DenseOrder S; S.init(ws + WS_H, ws + WS_WIN, T, W_IN, D / 2, F.G, (int)blockIdx.x);
    const float* SH = (const float*)(ws + WS_SH);
    { float v[7]; int pmv[7];
#pragma unroll
      for (int k = 0; k < 7; ++k) { pg8::Unit u; pmv[k] = S.next((F.tid >> 8) + 2 * k, u) ? u.pm : -1; v[k] = pmv[k] >= 0 ? SH[pmv[k] * 256 + (F.tid & 255)] : 0.f; }
#pragma unroll
      for (int k = 0; k < 7; ++k) if (pmv[k] >= 0) F.MI[512 + ((F.tid >> 8) + 2 * k) * 256 + (F.tid & 255)] = __float_as_int(v[k]); }
    __syncthreads();
    EpiProj E{(bf16*)(ws + WS_XR), (bf16*)F.out, F.MI, fmaxf(__uint_as_float(__hip_atomic_load(F.ctl + CW_AMAX + 130, RLX_AGENT)), 1e-30f) * (1.0f / 127.0f)};
    int Kk = D / 2; asm volatile("" : "+s"(Kk));
    pg8::gemm_phase<EpiProj, DenseOrder, true, false, true>(F.lds, F.tid, Kk, S, E);
}
__device__ __forceinline__ void moe_up(Frame& F, int chunk) {
    unsigned char* ws = F.ws;
    const int nrt_r = moe_tables(F, chunk), nrt = nrt_r + TC / 256;
    const int* lists = (const int*)(ws + WS_LIST);
    int* rdest = (int*)(ws + WS_RDEST);
    { const int r = F.tid & 255; int tokn[3], dest[3], slot[3]; float sa[3]; bool act[3]; int rt_[3];
#pragma unroll
      for (int k = 0; k < 3; ++k) { const int i = (F.tid >> 8) + 2 * k, L = i * F.G + F.vcu, rt = L >> 1; act[k] = L < 2 * nrt; rt_[k] = rt; slot[k] = -1; tokn[k] = chunk * TC; dest[k] = -1;
          if (act[k]) { if (rt < nrt_r) { const int e = F.MI[MI_TILE_E + rt]; const int idx = (rt - F.MI[MI_TBASE + e]) * 256 + r; if (idx < F.MI[MI_CNT + e]) slot[k] = lists[((size_t)chunk * 64 + e) * TC + idx]; }
              else { tokn[k] = chunk * TC + (rt - nrt_r) * 256 + r; dest[k] = TC * 8 + (rt - nrt_r) * 256 + r; } } }
#pragma unroll
      for (int k = 0; k < 3; ++k) if (slot[k] >= 0) { tokn[k] = slot[k] >> 3; dest[k] = slot[k] - chunk * TC * 8; }
#pragma unroll
      for (int k = 0; k < 3; ++k) sa[k] = ((const float*)(ws + WS_SA))[tokn[k]];
#pragma unroll
      for (int k = 0; k < 3; ++k) if (act[k]) { const int i = (F.tid >> 8) + 2 * k, L = i * F.G + F.vcu;
          F.MI[MI_TOK + i * 256 + r] = tokn[k]; F.MI[MI_SA + i * 256 + r] = __float_as_int(sa[k]);
          if ((L & 1) == 0) rdest[rt_[k] * 256 + r] = dest[k]; }
      if (F.tid < 12) { const int i = F.tid >> 1, rr = F.tid & 1, L = i * F.G + F.vcu;
          if (L < 2 * nrt) { const int rt = L >> 1; const int e_ = (rt < nrt_r) ? F.MI[MI_TILE_E + rt] : NEXP;
              F.MI[MI_SB + 2 * i + rr] = __float_as_int(fmaxf(__uint_as_float(__hip_atomic_load(F.ctl + CW_AMAX + 2 * e_ + rr, RLX_AGENT)), 1e-30f) * (1.0f / 127.0f)); } } }
    __syncthreads();
    UpOrder S{(const char*)ws, F.MI, nrt_r, nrt, F.G, F.vcu};
    EpiSwiglu E{(bf16*)(ws + WS_HB), F.MI, F.ctl + CW_AMAX};
    int Kk = D / 2; asm volatile("" : "+s"(Kk));
    pg8::gemm_phase<EpiSwiglu, UpOrder, true, true, true>(F.lds, F.tid, Kk, S, E);
}
__device__ __forceinline__ void moe_down(Frame& F, int chunk) {
    unsigned char* ws = F.ws;
    __syncthreads();
    const int nrt_r = F.MI[MI_TBASE + NEXP], nrt = nrt_r + TC / 256;
    { const int* rdest = (const int*)(ws + WS_RDEST) + (F.tid & 255); int v[5];
#pragma unroll
      for (int k = 0; k < 5; ++k) { const int L = ((F.tid >> 8) + 2 * k) * F.G + F.vcu; v[k] = (L < 4 * nrt) ? rdest[(L >> 2) * 256] : -1; }
#pragma unroll
      for (int k = 0; k < 5; ++k) { const int i = (F.tid >> 8) + 2 * k, L = i * F.G + F.vcu; if (L < 4 * nrt) F.MI[MI_TOK + i * 256 + (F.tid & 255)] = v[k]; } }
    __syncthreads();
    DownOrder S{(const char*)ws, F.MI, nrt_r, nrt, F.G, F.vcu};
    EpiScatter E{ws + WS_SLOT, F.MI};
    int Kk = DEXP; asm volatile("" : "+s"(Kk));
    pg8::gemm_phase<EpiScatter, DownOrder, false, false>(F.lds, F.tid, Kk, S, E);
}
__device__ __forceinline__ void moe_combine(Frame& F, const Args& A, int chunk, bool poison) {
    unsigned char* ws = F.ws;
    const float* mod = (const float*)(ws + WS_MOD); const unsigned char* SL = ws + WS_SLOT; const float* wts = (const float*)(ws + WS_WTS);
    const int gw = F.vcu * NWAVES + F.wave, NGW = F.G * NWAVES;
    f32x4 gpv[4];
#pragma unroll
    for (int j = 0; j < 4; ++j) gpv[j] = *(const f32x4*)(A.in[31] + 4 * F.lane + 256 * j);
    unsigned dA[9][4], dB[9][4]; v2u xA[4], xB[4];
#define CB_LOAD(tl_, d_, x_) do { const int t_ = __builtin_amdgcn_readfirstlane(tl_);        \
        _Pragma("unroll") for (int j = 0; j < 4; ++j) x_[j] = *((const GAS v2u*)(F.out + ((size_t)chunk * TC + t_) * D) + F.lane + 64 * j); \
        asm volatile("" ::: "memory"); \
        const GAS unsigned* b0_ = (const GAS unsigned*)(SL + (size_t)t_ * 8 * D) + F.lane; const GAS unsigned* b1_ = b0_ + 4 * (D / 4); \
        const GAS unsigned* b2_ = (const GAS unsigned*)(SL + ((size_t)TC * 8 + t_) * D) + F.lane;         \
        _Pragma("unroll") for (int k = 0; k < 9; ++k) \
            _Pragma("unroll") for (int j = 0; j < 4; ++j) d_[k][j] = (k < 4 ? b0_ : k < 8 ? b1_ : b2_)[(k < 8 ? (k & 3) : 0) * (D / 4) + 64 * j]; } while (0)
#define CB_REDUCE(tl_, d_, x_) do { const int t_ = __builtin_amdgcn_readfirstlane(tl_); const size_t m = (size_t)chunk * TC + t_; const int b = (int)(m / SEQ); \
        f32x4 gt[4]; _Pragma("unroll") for (int j = 0; j < 4; ++j) gt[j] = *(const f32x4*)(mod + b * 6 * D + 5 * D + 4 * F.lane + 256 * j); \
        const float wl_ = (F.lane < 8) ? wts[m * 8 + F.lane] : 1.0f;        \
        f32x4 y[4]; \
        _Pragma("unroll") for (int j = 0; j < 4; ++j) y[j] = (f32x4){0.f, 0.f, 0.f, 0.f}; \
        _Pragma("unroll") for (int k = 0; k < 9; ++k) { const float wk_ = (k < 8) ? rl_f(wl_, k) : 1.0f; _Pragma("unroll") for (int j = 0; j < 4; ++j) { const int dd = (int)d_[k][j]; \
            const auto lo_ = __builtin_amdgcn_cvt_pk_f32_fp8(dd, false); const auto hi_ = __builtin_amdgcn_cvt_pk_f32_fp8(dd, true); \
            y[j].x = __builtin_fmaf(lo_[0], wk_, y[j].x); y[j].y = __builtin_fmaf(lo_[1], wk_, y[j].y); y[j].z = __builtin_fmaf(hi_[0], wk_, y[j].z); y[j].w = __builtin_fmaf(hi_[1], wk_, y[j].w); } \
            __builtin_amdgcn_sched_barrier(0); } \
        _Pragma("unroll") for (int j = 0; j < 4; ++j) y[j] = y[j] * 0.0625f; \
        float s = 0.f; \
        _Pragma("unroll") for (int j = 0; j < 4; ++j) s += (y[j].x * y[j].x + y[j].y * y[j].y) + (y[j].z * y[j].z + y[j].w * y[j].w); \
        const float rstd = 1.f / sqrtf(wave_sum(s) * (1.f / D) + EPS); \
        asm volatile("" ::: "memory"); \
        _Pragma("unroll") for (int j = 0; j < 4; ++j) { f32x4* op = (f32x4*)(F.out + m * D) + F.lane + 64 * j; const v2u xb = x_[j]; \
            f32x4 o = (f32x4){bflo(xb.x), bfhi(xb.x), bflo(xb.y), bfhi(xb.y)} + gt[j] * (y[j] * rstd * gpv[j]); \
            if (poison) { const float q_ = __builtin_nanf(""); o = (f32x4){q_, q_, q_, q_}; } \
            *op = o; } } while (0)
    for (int tl = gw; tl < TC; tl += NGW) { CB_LOAD(tl, dA, xA); CB_REDUCE(tl, dA, xA); }
#undef CB_LOAD
#undef CB_REDUCE
}

__device__ __forceinline__ void attn_phase(Frame& F, const Args& A, char* lds_generic) {
    const attn_body::bf16* Q = (const attn_body::bf16*)(F.ws + WS_Q); const attn_body::bf16* K = (const attn_body::bf16*)(F.ws + WS_K); const attn_body::bf16* V = (const attn_body::bf16*)(F.ws + WS_V);
    attn_body::bf16* O = (attn_body::bf16*)(F.ws + WS_H);
    const float d1 = A.in[13][F.lane] * A.in[14][F.lane], d2 = A.in[15][F.lane] * A.in[16][F.lane];
    const float lam = expf(wave_sum(d1)) - expf(wave_sum(d2)) + LAM_INIT;
    const int npr = (BATCH * 16 - F.vcu + F.G - 1) / F.G;
#pragma unroll 1
    for (int it = 0; it < npr * 8; ++it) {
        const int pr = F.vcu + (it >> 3) * F.G, qi = (it >> 1) & 3, m = it & 1;
        const int pair = pr >> 1, st = pr & 1, b = pair >> 3, h = pair & 7;
        const int qb = st ? (qi == 0 ? 6 : qi == 1 ? 5 : qi == 2 ? 2 : 1) : (qi == 0 ? 7 : qi == 1 ? 4 : qi == 2 ? 3 : 0);
        const float sl2 = exp2f(-(float)(h + 1)) * LOG2E;
        if (m == 0) attn_body::attn_unit2<8, false>(F.tid, b, h, 0, qb, sl2, lam, A.in[17], Q, K, V, O, lds_generic);
        else        attn_body::attn_unit2<8, true >(F.tid, b, h, 1, qb, sl2, lam, A.in[17], Q, K, V, O, lds_generic);
    }
}

__global__ void __launch_bounds__(NWAVES * 64, 2) hybrid_fwd(Args args) {
    extern __shared__ __attribute__((aligned(16))) unsigned char lds[];
    Frame F;
    F.lds = (LAS unsigned char*)lds;
    F.MI = (volatile LAS int*)(F.lds + MISC_OFF);
    F.tid = threadIdx.x; F.lane = F.tid & 63; F.wave = __builtin_amdgcn_readfirstlane(F.tid >> 6);
    F.G = gridDim.x; { const int bx = blockIdx.x; F.vcu = (F.G % 8 == 0) ? (bx % 8) * (F.G / 8) + bx / 8 : bx; }
    unsigned char* ws = args.ws; F.ws = ws; F.out = args.out;
    F.ctl = (gu32*)(ws + WS_CTL);
    for (int u = F.tid; u < MI_WORDS; u += NWAVES * 64) F.MI[u] = 0;
    __syncthreads();
    XcdBarrier bar; bar.bar = (unsigned*)(F.ctl + CW_BAR); bar.x = 0; bar.st = nullptr;
    if (!PER_PHASE) bar = xcd_barrier_post((unsigned*)(F.ctl + CW_BAR), (volatile LAS unsigned*)(F.MI + MI_BARST));
    const int lo = args.ph_lo, hi = args.ph_hi;
#ifndef PH_MASK
#define PH_MASK 0xFFFFFFFFu
#endif
#ifndef PROBE_MASK
#define PROBE_MASK 0u
#endif
#define PSTAMP(k) do { if (PROBE_MASK != 0u && F.tid == 0) { const unsigned long long t_ = __builtin_amdgcn_s_memrealtime(); volatile LAS unsigned long long* pp_ = (volatile LAS unsigned long long*)(F.MI + 16); \
        if ((PROBE_MASK >> (k)) & 1u) pp_[1] += t_ - pp_[0]; pp_[0] = t_; } } while (0)
#define FRESH() do { size_t z_ = 0; asm volatile("" : "+s"(z_)); unsigned char* w_ = args.ws + z_;        F.ws = w_; ws = w_; F.ctl = (gu32*)(w_ + WS_CTL); int t_ = threadIdx.x; asm volatile("" : "+v"(t_)); F.tid = t_; F.lane = t_ & 63; F.wave = __builtin_amdgcn_readfirstlane(t_ >> 6); } while (0)
    if ((PROBE_MASK != 0u || PROBE_SEG != 0) && F.tid == 0) { volatile LAS unsigned long long* pp_ = (volatile LAS unsigned long long*)(F.MI + 16); pp_[0] = __builtin_amdgcn_s_memrealtime(); pp_[1] = 0ull; }
#define IN(k) (((PH_MASK >> (k)) & 1u) && lo <= (k) && (k) < hi)
#define SEAM(k) do { if (IN(k) && IN((k) + 1)) { if (PER_PHASE) { if (F.tid == 0) __hip_atomic_store(F.ctl + CW_TMO, 0xBADBA0u, RLX_AGENT); } else xcd_barrier(bar); } PSTAMP(k); } while (0)
    if (IN(0)) { FRESH(); p0_phase(F, args); } SEAM(0);
    if (IN(1)) { FRESH(); p1_phase(F, args); } SEAM(1);
    if (IN(2)) { FRESH(); p2_phase(F, args); } SEAM(2);
    if (IN(3)) { FRESH(); lru_phase(F, args); } if (PER_PHASE) { SEAM(3); } else { PSTAMP(3); }
    if (IN(4)) { FRESH(); attn_phase(F, args, (char*)lds); } SEAM(4);
    if (PER_PHASE) { SEAM(5); }
    if (IN(6)) { FRESH(); MergeOrder S; S.d.init(ws + WS_GR, ws + WS_WR, T, D, D, F.G, (int)blockIdx.x); S.A1 = (const char*)(ws + WS_H); S.B1 = (const char*)(ws + WS_WA);
        EpiGate E{(const unsigned char*)args.out, (const unsigned char*)args.out + (size_t)T * D, (bf16*)(ws + WS_V), (bf16*)(ws + WS_XR)};
        pg8::gemm_phase<EpiGate, MergeOrder, true, false>(F.lds, F.tid, D, S, E); } SEAM(6);
    if (IN(7)) { FRESH(); DenseOrder S; S.init(ws + WS_XR, ws + WS_WO, T, D, D, F.G, (int)blockIdx.x); EpiF32 E{(bf16*)(ws + WS_Y)};
        pg8::gemm_phase<EpiF32, DenseOrder, true, false>(F.lds, F.tid, D, S, E); } SEAM(7);
    if (IN(8)) { FRESH(); p8_phase(F, args); } SEAM(8);
#pragma unroll 1
    for (int c = 0; c < NCH; ++c) {
        const int pa = 9 + 2 * c, pb = 10 + 2 * c;
        if (IN(pa)) { FRESH(); if (c > 0) { int cm = c - 1; asm volatile("" : "+s"(cm)); moe_combine(F, args, cm, false); FRESH(); } int cu = c; asm volatile("" : "+s"(cu)); moe_up(F, cu); } SEAM(pa);
        if (IN(pb)) { FRESH(); int cd = c; asm volatile("" : "+s"(cd)); moe_down(F, cd); } SEAM(pb);
    }
    if (IN(9 + 2 * NCH)) { FRESH();
        bool poison = __hip_atomic_load(F.ctl + CW_TMO, RLX_AGENT) != 0u || __hip_atomic_load(F.ctl + CW_BAR + XB_TMO, RLX_AGENT) != 0u;
        moe_combine(F, args, NCH - 1, poison);
    }
    PSTAMP(17);
#undef IN
#undef SEAM
    if (PROBE_MASK != 0u || PROBE_SEG != 0) { __syncthreads(); if (F.tid == 0) { volatile LAS unsigned long long* pp_ = (volatile LAS unsigned long long*)(F.MI + 16);
        unsigned long long acc_ = pp_[1]; const unsigned long long t2_ = __builtin_amdgcn_s_memrealtime();
        while (__builtin_amdgcn_s_memrealtime() - t2_ < acc_) __builtin_amdgcn_s_sleep(8); } __syncthreads(); }
}

extern "C" void kernel_launch(void* const* d_in, const int* in_sizes, int n_in, void* d_out, int out_size, void* d_ws, size_t ws_size, hipStream_t stream) {
    static int grid = 0;
    if (grid == 0) {
        if (n_in != 32 || out_size != T * D || ws_size < WS_END) { fprintf(stderr, "kernel_launch: unexpected shapes (n_in %d, out %d, ws %zu); nothing launched\n", n_in, out_size, ws_size); grid = -1; return; }
        int dev = 0, cus = 0, per_cu = 0;
        if (hipGetDevice(&dev) != hipSuccess || hipDeviceGetAttribute(&cus, hipDeviceAttributeMultiprocessorCount, dev) != hipSuccess) { grid = -1; return; }
        if (hipFuncSetAttribute((const void*)hybrid_fwd, hipFuncAttributeMaxDynamicSharedMemorySize, LDS_BYTES) != hipSuccess) { fprintf(stderr, "kernel_launch: hipFuncSetAttribute failed\n"); grid = -1; return; }
        if (hipOccupancyMaxActiveBlocksPerMultiprocessor(&per_cu, (const void*)hybrid_fwd, NWAVES * 64, LDS_BYTES) != hipSuccess || per_cu < 1) { fprintf(stderr, "kernel_launch: occupancy query says %d blocks per CU\n", per_cu); per_cu = 1; }
        (void)hipGetLastError();
        grid = cus;
    }
    if (grid < 0) return;
    (void)hipMemsetAsync((char*)d_ws + WS_CTL, 0, CTL_ZERO_BYTES, stream);
    Args a{};
    for (int i = 0; i < 32; ++i) a.in[i] = (const float*)d_in[i];
    a.out = (float*)d_out; a.ws = (unsigned char*)d_ws;
    if (N_LAUNCHES == 1) { a.ph_lo = 0; a.ph_hi = N_PHASES; hipLaunchKernelGGL(hybrid_fwd, dim3(grid), dim3(NWAVES * 64), LDS_BYTES, stream, a); }
    else for (int p = 0; p < N_PHASES; ++p) { a.ph_lo = p; a.ph_hi = p + 1; hipLaunchKernelGGL(hybrid_fwd, dim3(grid), dim3(NWAVES * 64), LDS_BYTES, stream, a); }
}
```

```cpp
#include <hip/hip_runtime.h>
#include <hip/hip_bf16.h>
#include <cstdio>
#include <cstdint>
#include <cmath>

#ifndef MK_N_LAUNCHES
#define MK_N_LAUNCHES 1
#endif

constexpr int BATCH = 16, SEQ = 2048, D = 1024, T = BATCH * SEQ;
constexpr int W_IN = 7 * 1024;
constexpr int NEXP = 64, TOPK = 8, DEXP = 256;
constexpr int NCH = 2, TC = T / NCH;
constexpr float EPS = 1e-6f;
constexpr float LOG2E = 1.4426950408889634f;
constexpr float LAM_INIT = 0.2f;

namespace pg8 {
#define PG8_LAS __attribute__((address_space(3)))
typedef unsigned short bf16_t;
typedef short bf16x8 __attribute__((ext_vector_type(8)));
typedef float f32x4 __attribute__((ext_vector_type(4)));
typedef unsigned u32x4 __attribute__((ext_vector_type(4)));
constexpr int BM = 256, BK = 64, HALF = 128, HTB = HALF * BK * 2, STAGE_BYTES = 8 * HTB, NXCD = 8, WGM = 8;

__host__ __device__ __forceinline__ int lds_byte(int r, int c) { const int st = (r >> 4) * 2 + (c >> 5), rr = r & 15, cc = c & 31, ob = rr * 64 + cc * 2; return st * 1024 + (ob ^ (((ob >> 9) & 1) << 5)); }
__host__ __device__ __forceinline__ void stage_rc(int b, int& R, int& C) { const int st = b / 1024, sb = b % 1024, swz = sb ^ (((sb >> 9) & 1) << 5); R = (st >> 1) * 16 + swz / 64; C = (st & 1) * 32 + (swz % 64) / 2; }
__host__ __device__ __forceinline__ int perm32(int rho) { const int n = rho >> 4, i = rho & 15; return 8 * (i >> 2) + 4 * n + (i & 3); }

struct Unit { int pm, pn, z, e; };

__device__ __forceinline__ unsigned cvt_pk_bf16(float lo, float hi) { unsigned r; asm volatile("v_cvt_pk_bf16_f32 %0, %1, %2" : "=v"(r) : "v"(lo), "v"(hi)); return r; }
__device__ __forceinline__ float sigm(float x) { return __builtin_amdgcn_rcpf(1.0f + __builtin_amdgcn_exp2f(-LOG2E * x)); }
__device__ __forceinline__ float gelu_t(float x) { const float u = 0.7978845608028654f * (x + 0.044715f * x * x * x); return x * sigm(2.0f * u); }
__device__ __forceinline__ float bflo(unsigned w) { return __uint_as_float(w << 16); }
__device__ __forceinline__ float bfhi(unsigned w) { return __uint_as_float(w & 0xffff0000u); }

typedef int i32x4 __attribute__((ext_vector_type(4)));
typedef int i32x8 __attribute__((ext_vector_type(8)));
template <class Epi, class Sched, bool ALIGN_EPI, bool GATHER, int INT8 = 0>
__device__ __forceinline__ void gemm_phase(PG8_LAS unsigned char* lds, const int tid, const int K, const Sched& S, const Epi& E) {
    const int wid = __builtin_amdgcn_readfirstlane(tid >> 6), lane = tid & 63, wr = wid >> 2, wc = wid & 3, fr = lane & 15, fq = lane >> 4;
    const int nt = K / BK;
    unsigned voffA[2], voffB[2];
#pragma unroll
    for (int i = 0; i < 2; ++i) { int R, C; stage_rc(tid * 16 + i * 8192, R, C); const int Rb = Epi::PERM ? ((R & ~31) + perm32(R & 31)) : R;
        voffA[i] = (unsigned)(R * K + C) * 2u; voffB[i] = (unsigned)(Rb * K + C) * 2u; }
    const size_t kstep = (size_t)(BK * 2);
    const size_t hstep = (size_t)HALF * K * 2;
    const unsigned ldsw = (unsigned)wid * 1024u;
    const int aoff = lds_byte(wr * 64 + fr, fq * 8), boff = lds_byte(wc * 32 + fr, fq * 8);
#define PG8_SA(b, h) (((b) * 2 + (h)) * HTB)
#define PG8_SB(b, h) ((4 + (b) * 2 + (h)) * HTB)
#define PG8_STAGE(bufoff, gbase, voff) do { _Pragma("unroll") for (int _i = 0; _i < 2; ++_i) \
        __builtin_amdgcn_global_load_lds((const unsigned*)((const char*)(gbase) + (voff)[_i]), (PG8_LAS unsigned*)(lds + (bufoff) + ldsw + _i * 8192), 16, 0, 0); } while (0)
#define PG8_STAGE_A(bufoff, p, h, VG) do { if constexpr (GATHER) { PG8_STAGE(bufoff, p, VG[h]); } else { PG8_STAGE(bufoff, (p) + (h) * hstep, voffA); } } while (0)
#define PG8_LDA(dst, b, h) do { _Pragma("unroll") for (int m = 0; m < 4; ++m) _Pragma("unroll") for (int k = 0; k < 2; ++k) dst[m][k] = *(const PG8_LAS bf16x8*)(lds + PG8_SA(b, h) + aoff + m * 2048 + k * 1024); } while (0)
#define PG8_LDB(dst, b, h) do { _Pragma("unroll") for (int n = 0; n < 2; ++n) _Pragma("unroll") for (int k = 0; k < 2; ++k) dst[n][k] = *(const PG8_LAS bf16x8*)(lds + PG8_SB(b, h) + boff + n * 2048 + k * 1024); } while (0)
#define PG8_MMA(ai, bj, At, Bt) do { __builtin_amdgcn_s_setprio(1); _Pragma("unroll") for (int m = 0; m < 4; ++m) _Pragma("unroll") for (int n = 0; n < 2; ++n) _Pragma("unroll") for (int k = 0; k < 2; ++k) \
        { if constexpr (INT8 == 2) { if (k == 0) { const i32x4 b0_ = __builtin_bit_cast(i32x4, Bt[n][0]), b1_ = __builtin_bit_cast(i32x4, Bt[n][1]), a0_ = __builtin_bit_cast(i32x4, At[m][0]), a1_ = __builtin_bit_cast(i32x4, At[m][1]); \
              const i32x8 b8_ = __builtin_shufflevector(b0_, b1_, 0, 1, 2, 3, 4, 5, 6, 7), a8_ = __builtin_shufflevector(a0_, a1_, 0, 1, 2, 3, 4, 5, 6, 7); \
              asm volatile("v_mfma_f32_16x16x128_f8f6f4 %0, %1, %2, %0" : "+v"(acc[ai][bj][m][n]) : "v"(b8_), "v"(a8_)); } }        \
          else if constexpr (INT8 == 1) acc[ai][bj][m][n] = __builtin_bit_cast(f32x4, __builtin_amdgcn_mfma_i32_16x16x64_i8(__builtin_bit_cast(i32x4, Bt[n][k]), __builtin_bit_cast(i32x4, At[m][k]), __builtin_bit_cast(i32x4, acc[ai][bj][m][n]), 0, 0, 0)); \
          else acc[ai][bj][m][n] = __builtin_amdgcn_mfma_f32_16x16x32_bf16(Bt[n][k], At[m][k], acc[ai][bj][m][n], 0, 0, 0); } __builtin_amdgcn_s_setprio(0); } while (0)
#define PG8_WAIT_V(n) asm volatile("s_waitcnt vmcnt(" #n ")" ::: "memory")
#define PG8_WAIT_VR(rx) do { if constexpr (Epi::MIN_VM > 0) { const int rx_ = __builtin_amdgcn_readfirstlane((rx) ? 1 : 0); asm volatile("s_waitcnt vmcnt(%1)\n\ts_cmp_lg_u32 %0, 0\n\ts_cbranch_scc1 1\n\ts_waitcnt vmcnt(8)" :: "s"(rx_), "n"(8 + Epi::MIN_VM) : "memory", "scc"); } else PG8_WAIT_V(8); } while (0)
#define PG8_WAIT_L(n) asm volatile("s_waitcnt lgkmcnt(" #n ")" ::: "memory")
#define PG8_BAR __builtin_amdgcn_s_barrier()
#define PG8_SCHED __builtin_amdgcn_sched_barrier(0)
#define PG8_LOADVG(VG, ui_) do { if constexpr (GATHER) { _Pragma("unroll") for (int h_ = 0; h_ < 2; ++h_) _Pragma("unroll") for (int i_ = 0; i_ < 2; ++i_) \
        { int R_, C_; stage_rc(tid * 16 + i_ * 8192, R_, C_); VG[h_][i_] = ((unsigned)S.tok((ui_), h_ * HALF + R_) * (unsigned)K + (unsigned)C_) * 2u; } } } while (0)
    Unit cur, nxt; int ui = 0;
    if (!S.next(0, cur)) return;
    f32x4 acc[2][2][4][2];
#pragma unroll
    for (int a = 0; a < 2; ++a)
#pragma unroll
        for (int b = 0; b < 2; ++b)
#pragma unroll
            for (int m = 0; m < 4; ++m)
#pragma unroll
                for (int n = 0; n < 2; ++n) acc[a][b][m][n] = (f32x4){0.f, 0.f, 0.f, 0.f};
    bf16x8 At[4][2], B0[2][2], B1[2][2];
    unsigned vgc[2][2];
#pragma unroll
    for (int h_ = 0; h_ < 2; ++h_)
#pragma unroll
        for (int i_ = 0; i_ < 2; ++i_) vgc[h_][i_] = 0u;
    PG8_LOADVG(vgc, 0);
    const char *cA, *cB; S.bases(cur, cA, cB);
    PG8_STAGE(PG8_SB(0, 0), cB, voffB); PG8_STAGE(PG8_SB(0, 1), cB + hstep, voffB); PG8_STAGE_A(PG8_SA(0, 0), cA, 0, vgc); PG8_STAGE_A(PG8_SA(0, 1), cA, 1, vgc);
    if (wr == 1) PG8_BAR;
    PG8_WAIT_V(2); PG8_BAR;
    PG8_STAGE(PG8_SB(1, 0), cB + kstep, voffB); PG8_STAGE_A(PG8_SA(1, 0), cA + kstep, 0, vgc); PG8_STAGE(PG8_SB(1, 1), cB + hstep + kstep, voffB);
    PG8_WAIT_V(6); PG8_BAR;
    for (;;) {
        const bool has_next = S.next(ui + 1, nxt);
        const char *nA = cA, *nB = cB;
        if (has_next) S.bases(nxt, nA, nB);
        for (int t = 0; t < nt; t += 2) {
            const bool last = (t == nt - 2);
            const char* a1 = cA + (size_t)(t + 1) * kstep;
            const char* a2 = last ? nA : cA + (size_t)(t + 2) * kstep; const char* b2 = last ? nB : cB + (size_t)(t + 2) * kstep;
            const char* a3 = a2 + kstep; const char* b3 = b2 + kstep;
            unsigned vgs[2][2];
#pragma unroll
            for (int h_ = 0; h_ < 2; ++h_)
#pragma unroll
                for (int i_ = 0; i_ < 2; ++i_) vgs[h_][i_] = vgc[h_][i_];
            if (last && has_next) PG8_LOADVG(vgs, ui + 1);
            const bool relax = (t == 0) && (ui > 0);
            PG8_LDB(B0, 0, 0); PG8_LDB(B1, 0, 1); PG8_SCHED; PG8_LDA(At, 0, 0); PG8_STAGE_A(PG8_SA(1, 1), a1, 1, vgc);
            PG8_WAIT_VR(relax); PG8_WAIT_L(0); PG8_BAR; PG8_MMA(0, 0, At, B0); PG8_MMA(0, 1, At, B1); PG8_BAR; PG8_SCHED;
            PG8_LDA(At, 0, 1); PG8_STAGE(PG8_SB(0, 0), b2, voffB); PG8_STAGE(PG8_SB(0, 1), b2 + hstep, voffB); PG8_STAGE_A(PG8_SA(0, 0), a2, 0, vgs);
            PG8_WAIT_VR(relax); PG8_WAIT_L(0); PG8_BAR; PG8_MMA(1, 0, At, B0); PG8_MMA(1, 1, At, B1); PG8_BAR; PG8_SCHED;
            PG8_LDB(B0, 1, 0); PG8_LDB(B1, 1, 1); PG8_SCHED; PG8_LDA(At, 1, 0); PG8_STAGE_A(PG8_SA(0, 1), a2, 1, vgs);
            PG8_WAIT_V(8); PG8_WAIT_L(0); PG8_BAR; PG8_MMA(0, 0, At, B0); PG8_MMA(0, 1, At, B1); PG8_BAR; PG8_SCHED;
            PG8_LDA(At, 1, 1); PG8_STAGE(PG8_SB(1, 0), b3, voffB); PG8_STAGE(PG8_SB(1, 1), b3 + hstep, voffB); PG8_STAGE_A(PG8_SA(1, 0), a3, 0, vgs);
            PG8_WAIT_V(8); PG8_WAIT_L(0); PG8_BAR; PG8_MMA(1, 0, At, B0); PG8_MMA(1, 1, At, B1); PG8_BAR; PG8_SCHED;
        }
        if constexpr (ALIGN_EPI) { if (wr == 0) PG8_BAR; }
        E(acc, cur, wr, wc, fr, fq);
#ifdef PROBE_EPI2
        if (Epi::TWICE) { asm volatile("" ::: "memory"); E(acc, cur, wr, wc, fr, fq); }
#endif
        if (!has_next) break;
#pragma unroll
        for (int a = 0; a < 2; ++a)
#pragma unroll
            for (int b = 0; b < 2; ++b)
#pragma unroll
                for (int m = 0; m < 4; ++m)
#pragma unroll
                    for (int n = 0; n < 2; ++n) acc[a][b][m][n] = (f32x4){0.f, 0.f, 0.f, 0.f};
        cur = nxt; cA = nA; cB = nB; ++ui;
        PG8_LOADVG(vgc, ui);
        if constexpr (ALIGN_EPI) { if (wr == 1) PG8_BAR; }
    }
    PG8_WAIT_V(0);
    if constexpr (!ALIGN_EPI) { if (wr == 0) PG8_BAR; }
    PG8_BAR;
#undef PG8_SA
#undef PG8_SB
#undef PG8_STAGE
#undef PG8_STAGE_A
#undef PG8_LDA
#undef PG8_LDB
#undef PG8_MMA
#undef PG8_WAIT_V
#undef PG8_WAIT_VR
#undef PG8_WAIT_L
#undef PG8_BAR
#undef PG8_SCHED
#undef PG8_LOADVG
}
}

namespace attn_body {
using bf16=__hip_bfloat16;
using bf16x8=__attribute__((ext_vector_type(8)))short;
using s16x4=__attribute__((ext_vector_type(4)))short;
using f32x16=__attribute__((ext_vector_type(16)))float;
using u32x4=__attribute__((ext_vector_type(4)))unsigned;
constexpr int NHEAD=16,SEQ=2048,D=64,DM=NHEAD*D;
constexpr int NW=8,QBLK=32,QB=QBLK*NW,KVBLK=64,NQB=SEQ/QB;
__device__ __forceinline__ int crow(int r,int hi){return (r&3)+8*(r>>2)+4*hi;}
#define SBAR() __builtin_amdgcn_sched_barrier(0)
__device__ __forceinline__ void cmask(f32x16&p0,f32x16&p1,int jb,int qrel,int hi){
  const float NEG=-INFINITY; const int dq=qrel-(64*jb+4*hi);
  #pragma unroll
  for(int r=0;r<16;++r){const int kc=(r&3)+8*(r>>2); if(kc>dq)p0[r]=NEG; if(kc+32>dq)p1[r]=NEG;}
}
__device__ __forceinline__ void cinit(f32x16&p0,f32x16&p1,float sl2,float nv){
  #pragma unroll
  for(int r=0;r<16;++r){const float c=(float)((r&3)+8*(r>>2)); p0[r]=__builtin_fmaf(sl2,c,nv); p1[r]=__builtin_fmaf(sl2,c+32.0f,nv);}
}
#define CI_C(r) ((float)(((r)&3)+8*((r)>>2)))

constexpr int NSLOT=3, SLOTB=8192;
constexpr int LDS_K=0, LDS_V=NSLOT*SLOTB, LDS_WS=2*NSLOT*SLOTB, LDS_OST=LDS_WS+NW*64*4, LDS_BYTES=LDS_OST+NW*4096;
constexpr float C2=0.125f*1.4426950408889634f;
__device__ __forceinline__ void glds16(const void*gsrc,unsigned lds_dst){unsigned keep;
  asm volatile("s_mov_b32 %0, m0\n\ts_mov_b32 m0, %2\n\ts_nop 0\n\tglobal_load_lds_dwordx4 %1, off\n\ts_mov_b32 m0, %0":"=&s"(keep):"v"(gsrc),"s"(lds_dst):"memory");}
__device__ __forceinline__ float max3f(float a,float b,float c){float r;asm("v_max3_f32 %0, %1, %2, %3":"=v"(r):"v"(a),"v"(b),"v"(c));return r;}
__device__ __forceinline__ float max2f(float a,float b){float r;asm("v_max_f32_e32 %0, %1, %2":"=v"(r):"v"(a),"v"(b));return r;}
__device__ __forceinline__ float fadd_s(float a,float b){float r;asm("v_add_f32_e32 %0, %1, %2":"=v"(r):"v"(a),"v"(b));return r;}
__device__ __forceinline__ float fsub_s(float a,float b){float r;asm("v_sub_f32_e32 %0, %1, %2":"=v"(r):"v"(a),"v"(b));return r;}
typedef float f32x2_t __attribute__((ext_vector_type(2))); typedef __bf16 bf16x2_t __attribute__((ext_vector_type(2)));
__device__ __forceinline__ unsigned cvtpk_s(float lo,float hi){f32x2_t v={lo,hi};bf16x2_t b=__builtin_convertvector(v,bf16x2_t);return __builtin_bit_cast(unsigned,b);}
#define WAIT_BAR(N) asm volatile("s_waitcnt vmcnt(" #N ") lgkmcnt(0)\n\ts_barrier":::"memory")

__device__ __forceinline__ void qkt(f32x16&p0,f32x16&p1,const char*Kslot,const bf16x8*qr,int r32,int hi){
  const char*kb=Kslot+hi*1024+r32*16;
  #pragma unroll
  for(int d0=0;d0<4;++d0){
    const bf16x8 b0=*reinterpret_cast<const bf16x8*>(kb+d0*2048);
    const bf16x8 b1=*reinterpret_cast<const bf16x8*>(kb+d0*2048+512);
    p0=__builtin_amdgcn_mfma_f32_32x32x16_bf16(b0,qr[d0],p0,0,0,0);p1=__builtin_amdgcn_mfma_f32_32x32x16_bf16(b1,qr[d0],p1,0,0,0);}
}
typedef __attribute__((address_space(3))) const char* lds_cptr;
typedef short v4i16_t __attribute__((ext_vector_type(4)));
__device__ __forceinline__ void kload8(bf16x8*kf,lds_cptr kp){
  kf[0]=*(const __attribute__((address_space(3))) bf16x8*)(kp);      kf[1]=*(const __attribute__((address_space(3))) bf16x8*)(kp+512);
  kf[2]=*(const __attribute__((address_space(3))) bf16x8*)(kp+2048); kf[3]=*(const __attribute__((address_space(3))) bf16x8*)(kp+2560);
  kf[4]=*(const __attribute__((address_space(3))) bf16x8*)(kp+4096); kf[5]=*(const __attribute__((address_space(3))) bf16x8*)(kp+4608);
  kf[6]=*(const __attribute__((address_space(3))) bf16x8*)(kp+6144); kf[7]=*(const __attribute__((address_space(3))) bf16x8*)(kp+6656);
}
__device__ __forceinline__ void kload2(bf16x8*kf,lds_cptr kp,int j){ kf[2*j]=*(const __attribute__((address_space(3))) bf16x8*)(kp+j*2048); kf[2*j+1]=*(const __attribute__((address_space(3))) bf16x8*)(kp+j*2048+512); }
__device__ __forceinline__ s16x4 vtr(lds_cptr p){ return __builtin_bit_cast(s16x4,__builtin_amdgcn_ds_read_tr16_b64_v4i16((__attribute__((address_space(3))) v4i16_t*)p)); }
__device__ __forceinline__ float rowmax(const f32x16&p0,const f32x16&p1){
  float a=max3f(p0[0],p0[1],p1[0]),b=max3f(p0[2],p0[3],p1[1]);a=max3f(a,p1[2],p1[3]);
  #pragma unroll
  for(int r=4;r<16;r+=4){a=max3f(a,p0[r],p0[r+1]);b=max3f(b,p0[r+2],p0[r+3]);a=max3f(a,p1[r],p1[r+1]);b=max3f(b,p1[r+2],p1[r+3]);}
  const float m=max2f(a,b);
  auto rr=__builtin_amdgcn_permlane32_swap(__float_as_uint(m),__float_as_uint(m),false,false);
  return max2f(__uint_as_float(rr[0]),__uint_as_float(rr[1]));
}
__device__ __forceinline__ void pv(f32x16*o,int vb,bf16x8 pa0,bf16x8 pa1,bf16x8 pa2,bf16x8 pa3){
  #pragma unroll
  for(int d0=0;d0<2;++d0){s16x4 lo[4],hi[4];
    #pragma unroll
    for(int ks=0;ks<4;++ks){
      asm volatile("ds_read_b64_tr_b16 %0,%1 offset:%c2":"=&v"(lo[ks]):"v"(vb),"i"(d0*4096+ks*1024):"memory");
      asm volatile("ds_read_b64_tr_b16 %0,%1 offset:%c2":"=&v"(hi[ks]):"v"(vb),"i"(d0*4096+ks*1024+512):"memory");}
    asm volatile("s_waitcnt lgkmcnt(0)":::"memory");SBAR();
    #define PK(k) (bf16x8){lo[k][0],lo[k][1],lo[k][2],lo[k][3],hi[k][0],hi[k][1],hi[k][2],hi[k][3]}
    o[d0]=__builtin_amdgcn_mfma_f32_32x32x16_bf16(pa0,PK(0),o[d0],0,0,0);
    o[d0]=__builtin_amdgcn_mfma_f32_32x32x16_bf16(pa1,PK(1),o[d0],0,0,0);
    o[d0]=__builtin_amdgcn_mfma_f32_32x32x16_bf16(pa2,PK(2),o[d0],0,0,0);
    o[d0]=__builtin_amdgcn_mfma_f32_32x32x16_bf16(pa3,PK(3),o[d0],0,0,0);
    #undef PK
  }
}
#define ATTN_STORE16(p,v) (*(u32x4*)(p)=(v))
constexpr int LDS_K2=0, LDS_V2=4*8192, LDS_WS2=LDS_V2+3*16384, LDS_OST2=LDS_WS2+NW*64*4, LDS_BYTES2=LDS_OST2+NW*4096;
__device__ __forceinline__ void pv4(f32x16*o,int vb,bf16x8 pa0,bf16x8 pa1,bf16x8 pa2,bf16x8 pa3){
  #pragma unroll
  for(int d0=0;d0<4;++d0){s16x4 lo[4],hi[4];
    #pragma unroll
    for(int ks=0;ks<4;++ks){
      asm volatile("ds_read_b64_tr_b16 %0,%1 offset:%c2":"=&v"(lo[ks]):"v"(vb),"i"(d0*4096+ks*1024):"memory");
      asm volatile("ds_read_b64_tr_b16 %0,%1 offset:%c2":"=&v"(hi[ks]):"v"(vb),"i"(d0*4096+ks*1024+512):"memory");}
    asm volatile("s_waitcnt lgkmcnt(0)":::"memory");SBAR();
    #define PK(k) (bf16x8){lo[k][0],lo[k][1],lo[k][2],lo[k][3],hi[k][0],hi[k][1],hi[k][2],hi[k][3]}
    o[d0]=__builtin_amdgcn_mfma_f32_32x32x16_bf16(pa0,PK(0),o[d0],0,0,0);
    o[d0]=__builtin_amdgcn_mfma_f32_32x32x16_bf16(pa1,PK(1),o[d0],0,0,0);
    o[d0]=__builtin_amdgcn_mfma_f32_32x32x16_bf16(pa2,PK(2),o[d0],0,0,0);
    o[d0]=__builtin_amdgcn_mfma_f32_32x32x16_bf16(pa3,PK(3),o[d0],0,0,0);
    #undef PK
  }
}
template<int THRL,bool FUSE> __device__ __forceinline__ void attn_unit2(const int tid,int b,int h,int m,int qb,float sl2,float lam,const float*gsub,const bf16*Q,const bf16*__restrict__ K,const bf16*__restrict__ V,bf16*O,char*shm){
  const int lane=tid&63,r32=lane&31,hi=lane>>5; const int wid=__builtin_amdgcn_readfirstlane(tid>>6);
  const long rowbase=(long)b*SEQ; const int q0=qb*QB;
  const bf16*Qw=Q+(rowbase+q0+wid*QBLK)*DM+(2*h+m)*D;
  const bf16*Kh=K+rowbase*DM+(2*h+m)*D,*Vh=V+rowbase*DM+2*h*D;
  const unsigned lds0=(unsigned)(uintptr_t)shm;
  float*wsf=(float*)(shm+LDS_WS2)+wid*64;
  const bf16*ksrc=Kh+(long)lane*DM+wid*8;
  const bf16*vsrc=Vh+(long)(16*(wid&3)+(lane>>2))*DM+(wid>>2)*32+(lane&3)*8;
  const unsigned kdst=lds0+LDS_K2+wid*1024, vdst=lds0+LDS_V2+wid*1024;
  #define DMA_K(t,slot) glds16(ksrc+(long)(t)*KVBLK*DM,(unsigned)__builtin_amdgcn_readfirstlane(kdst+(slot)))
  #define DMA_V(t,slot) do{ glds16(vsrc+(long)(t)*KVBLK*DM,(unsigned)__builtin_amdgcn_readfirstlane(vdst+2*(slot))); glds16(vsrc+(long)(t)*KVBLK*DM+64,(unsigned)__builtin_amdgcn_readfirstlane(vdst+2*(slot)+8192)); }while(0)
  const int vb0=(int)(lds0+LDS_V2)+((lane>>4)&1)*32+(lane&3)*8+(4*hi+((lane&15)>>2))*64;
  const char*Kbase=shm+LDS_K2;
  const lds_cptr shm3=(lds_cptr)shm; const lds_cptr kp0=shm3+LDS_K2+hi*1024+r32*16; const lds_cptr vp0=shm3+LDS_V2+((lane>>4)&1)*32+(lane&3)*8+(4*hi+((lane&15)>>2))*64;
  const int NT=(q0+QB)/KVBLK;
  const unsigned qdst=lds0+LDS_OST2+wid*4096;
  #pragma unroll
  for(int d0=0;d0<4;++d0)glds16(&Qw[(long)r32*DM+d0*16+hi*8],(unsigned)__builtin_amdgcn_readfirstlane(qdst+d0*1024));
  DMA_K(0,0);DMA_V(0,0);DMA_K(1,SLOTB);
  const lds_cptr qp0=(lds_cptr)shm+LDS_OST2+wid*4096+lane*16;
  #define QF(d0) (*(const __attribute__((address_space(3))) bf16x8*)(qp0+(d0)*1024))
  const float tb0=sl2*(float)(4*hi);
  float mhat=0.f,l_reg=0.f;f32x16 o[4];o[0]=f32x16{};o[1]=f32x16{};o[2]=f32x16{};o[3]=f32x16{};
  const int qrel=wid*QBLK+r32;
  #define CMASK(P0,P1,t) do{int jb_=(t)-(NT-4); if(jb_>=0)cmask(P0,P1,jb_,qrel,hi);}while(0)
  #define NVAL(tt) (__builtin_fmaf(sl2,(float)(64*(tt)),tb0)-mhat)
  bool resc=false;
  #define START(P0,P1) do{ const float rm=rowmax(P0,P1); resc=false; \
    { const float dl=rm; mhat=fadd_s(mhat,dl); \
      _Pragma("unroll") for(int r=0;r<16;++r){P0[r]=fsub_s(P0[r],dl);P1[r]=fsub_s(P1[r],dl);} } \
    _Pragma("unroll") for(int r=0;r<16;++r)P0[r]=__builtin_amdgcn_exp2f(P0[r]); }while(0)
  #define RESC() do{ if(resc){ asm volatile("s_waitcnt lgkmcnt(0)":::"memory"); \
      _Pragma("unroll") for(int d_=0;d_<4;++d_) _Pragma("unroll") for(int r=0;r<16;++r)o[d_][r]*=wsf[crow(r,hi)]; } }while(0)
  f32x16 pA0,pA1,pB0,pB1;
  int sl_prev=0,sl_cur=0,sl_next=SLOTB,ks_cur=0;
  #define ROT() do{sl_prev=sl_cur;sl_cur=sl_next;sl_next=(sl_next==(NSLOT-1)*SLOTB)?0:sl_next+SLOTB;ks_cur=(ks_cur+SLOTB)&(4*SLOTB-1);}while(0)
  DMA_K(2,2*SLOTB);
  WAIT_BAR(4);
  cinit(pA0,pA1,sl2,tb0);
  { bf16x8 qr[4];
    #pragma unroll
    for(int d0=0;d0<4;++d0)qr[d0]=QF(d0);
    qkt(pA0,pA1,Kbase,qr,r32,hi); }asm volatile("s_nop 15\n\ts_nop 7":"+v"(pA0),"+v"(pA1));CMASK(pA0,pA1,0);
  START(pA0,pA1);
  cinit(pB0,pB1,sl2,NVAL(1));
  _Pragma("unroll") for(int r=0;r<16;++r)pA1[r]=__builtin_amdgcn_exp2f(pA1[r]);
  WAIT_BAR(0);
  DMA_K(3,3*SLOTB);DMA_V(1,SLOTB);
  ROT();
  WAIT_BAR(3);
  s16x4 vlo[8],vhi[8]; u32x4 pw0,pw1,pw2,pw3;
  bf16x8 nka=*(const __attribute__((address_space(3))) bf16x8*)(kp0+ks_cur),nkb=*(const __attribute__((address_space(3))) bf16x8*)(kp0+ks_cur+512),nqa=QF(0),nqb=QF(1);
  #define PKW(P,B) cvtpk_s(P[B],P[B+1])
  #define PAF(k) __builtin_bit_cast(bf16x8,pw##k)
  #define VFR(i) (bf16x8){vlo[(i)&7][0],vlo[(i)&7][1],vlo[(i)&7][2],vlo[(i)&7][3],vhi[(i)&7][0],vhi[(i)&7][1],vhi[(i)&7][2],vhi[(i)&7][3]}
  #define PIN(x) asm volatile("":"+v"(x))
  #define MX3(a,b,c) __builtin_fmaxf(__builtin_fmaxf((a),(b)),(c))
  #define GAPA(MF,A0,A1,A2,A3,W0,W1,PW) do{ MF; sacc+=A0; sacc+=A1; sacc+=A2; sacc+=A3; PIN(sacc); W0; W1; PIN(PW); SBAR(); }while(0)
  #define EX(v) __builtin_amdgcn_exp2f(v)
  #define VRD(f) do{ vlo[(f)&7]=vtr(vp_+(((f)&3)*4096+((f)>>2)*1024)); vhi[(f)&7]=vtr(vp_+(((f)&3)*4096+((f)>>2)*1024+512)); }while(0)
  #define GAPB(f,X,B,Y,OFS) do{ o[(f)&3]=__builtin_amdgcn_mfma_f32_32x32x16_bf16(__builtin_bit_cast(bf16x8,(f)<4?pw0:(f)<8?pw1:(f)<12?pw2:pw3),VFR(f),o[(f)&3],0,0,0); \
    X[B]=EX(X[B]); X[B+1]=EX(X[B+1]); PIN(X); \
    Y[B]=__builtin_fmaf(sl2,CI_C(B)+OFS,nvn); Y[B+1]=__builtin_fmaf(sl2,CI_C(B+1)+OFS,nvn); \
    if((f)+4<16){VRD((f)+4);} SBAR(); }while(0)
  #define KF(j) (*(const __attribute__((address_space(3))) bf16x8*)(kp_+((j)>>1)*2048+((j)&1)*512))
  #define STEP(C0,C1,P0,P1,t,GK,GV,GL) do{ SBAR(); \
    const lds_cptr vp_=vp0+2*sl_prev; const lds_cptr kp_=kp0+ks_cur; \
    bf16x8 ka=nka,kb=nkb,qa=nqa,qb_=nqb; SBAR(); \
    float sacc=(P0[0]+P0[1]); \
    GAPA(C0=__builtin_amdgcn_mfma_f32_32x32x16_bf16(ka,qa,C0,0,0,0), P0[2],P0[3],P0[4],P0[5],     pw0[0]=PKW(P0,0), pw0[1]=PKW(P0,2), pw0); \
    ka=KF(2); SBAR(); \
    GAPA(C1=__builtin_amdgcn_mfma_f32_32x32x16_bf16(kb,qa,C1,0,0,0), P0[6],P0[7],P0[8],P0[9],     pw0[2]=PKW(P0,4), pw0[3]=PKW(P0,6), pw0); \
    kb=KF(3); qa=QF(2); SBAR(); \
    GAPA(C0=__builtin_amdgcn_mfma_f32_32x32x16_bf16(ka,qb_,C0,0,0,0),   P0[10],P0[11],P0[12],P0[13], pw1[0]=PKW(P0,8), pw1[1]=PKW(P0,10), pw1); \
    ka=KF(4); SBAR(); \
    GAPA(C1=__builtin_amdgcn_mfma_f32_32x32x16_bf16(kb,qb_,C1,0,0,0),   P0[14],P0[15],P1[0],P1[1],   pw1[2]=PKW(P0,12),pw1[3]=PKW(P0,14), pw1); \
    kb=KF(5); qb_=QF(3); VRD(0); SBAR(); \
    GAPA(C0=__builtin_amdgcn_mfma_f32_32x32x16_bf16(ka,qa,C0,0,0,0),   P1[2],P1[3],P1[4],P1[5],     pw2[0]=PKW(P1,0), pw2[1]=PKW(P1,2), pw2); \
    ka=KF(6); VRD(1); SBAR(); \
    GAPA(C1=__builtin_amdgcn_mfma_f32_32x32x16_bf16(kb,qa,C1,0,0,0),   P1[6],P1[7],P1[8],P1[9],     pw2[2]=PKW(P1,4), pw2[3]=PKW(P1,6), pw2); \
    kb=KF(7); VRD(2); SBAR(); \
    GAPA(C0=__builtin_amdgcn_mfma_f32_32x32x16_bf16(ka,qb_,C0,0,0,0),   P1[10],P1[11],P1[12],P1[13], pw3[0]=PKW(P1,8), pw3[1]=PKW(P1,10), pw3); \
    VRD(3); SBAR(); \
    GAPA(C1=__builtin_amdgcn_mfma_f32_32x32x16_bf16(kb,qb_,C1,0,0,0),   P1[14],P1[15],0.f,0.f,       pw3[2]=PKW(P1,12),pw3[3]=PKW(P1,14), pw3); \
    l_reg+=sacc; \
    if(GK){DMA_K((t)+3,(ks_cur+3*SLOTB)&(4*SLOTB-1));} if(GV){DMA_V((t)+1,sl_next);} \
    CMASK(C0,C1,t); \
    float nvn; \
    { float a=MX3(C0[0],C0[1],C1[0]),b=MX3(C0[2],C0[3],C1[1]); a=MX3(a,C1[2],C1[3]); \
      _Pragma("unroll") for(int r=4;r<16;r+=4){a=MX3(a,C0[r],C0[r+1]);b=MX3(b,C0[r+2],C0[r+3]);a=MX3(a,C1[r],C1[r+1]);b=MX3(b,C1[r+2],C1[r+3]);} \
      float rm=__builtin_fmaxf(a,b); { auto rr=__builtin_amdgcn_permlane32_swap(__float_as_uint(rm),__float_as_uint(rm),false,false); rm=__builtin_fmaxf(__uint_as_float(rr[0]),__uint_as_float(rr[1])); } \
      resc=false; \
      if(__builtin_expect(__any(rm>(float)THRL),0)){ const float dl=__builtin_fmaxf(rm,0.f); mhat+=dl; \
        _Pragma("unroll") for(int r=0;r<16;++r){C0[r]-=dl;C1[r]-=dl;} \
        const float f=__builtin_amdgcn_exp2f(-dl); l_reg*=f; if(hi==0)wsf[r32]=f; resc=true; } \
      nvn=NVAL((t)+1); } \
    SBAR(); \
    GAPB(0,C0,0,P0,0.0f); GAPB(1,C0,2,P0,0.0f); GAPB(2,C0,4,P0,0.0f); GAPB(3,C0,6,P0,0.0f); \
    GAPB(4,C0,8,P0,0.0f); GAPB(5,C0,10,P0,0.0f); GAPB(6,C0,12,P0,0.0f); GAPB(7,C0,14,P0,0.0f); \
    GAPB(8,C1,0,P1,32.0f); GAPB(9,C1,2,P1,32.0f); GAPB(10,C1,4,P1,32.0f); GAPB(11,C1,6,P1,32.0f); \
    GAPB(12,C1,8,P1,32.0f); GAPB(13,C1,10,P1,32.0f); GAPB(14,C1,12,P1,32.0f); \
    { const lds_cptr kn_=kp0+((ks_cur+SLOTB)&(4*SLOTB-1)); nka=*(const __attribute__((address_space(3))) bf16x8*)(kn_); nkb=*(const __attribute__((address_space(3))) bf16x8*)(kn_+512); nqa=QF(0); nqb=QF(1); SBAR(); } \
    GAPB(15,C1,14,P1,32.0f); \
    }while(0)
  int t=1;
  #undef CMASK
  #define CMASK(P0,P1,t) do{}while(0)
  for(;t+5<NT;t+=2){
    STEP(pB0,pB1,pA0,pA1,t,true,true,true);     WAIT_BAR(3); RESC(); ROT();
    STEP(pA0,pA1,pB0,pB1,t+1,true,true,true);   WAIT_BAR(3); RESC(); ROT();
  }
  #undef CMASK
  #define CMASK(P0,P1,t) do{int jb_=(t)-(NT-4); if(jb_>=0)cmask(P0,P1,jb_,qrel,hi);}while(0)
  #define ENDW(tt) do{ if((tt)+3<NT){WAIT_BAR(3);} else if((tt)+2<NT){WAIT_BAR(2);} else {WAIT_BAR(0);} }while(0)
  for(;t+1<NT;t+=2){
    STEP(pB0,pB1,pA0,pA1,t,(t+3<NT),(t+1<NT),(t+1<NT));       ENDW(t);   RESC(); ROT();
    STEP(pA0,pA1,pB0,pB1,t+1,(t+4<NT),(t+2<NT),(t+2<NT));     ENDW(t+1); RESC(); ROT();
  }
  STEP(pB0,pB1,pA0,pA1,NT-1,false,false,false); RESC();
  { float sacc=pB0[0]+pB0[1]; _Pragma("unroll") for(int r=2;r<16;++r)sacc+=pB0[r]; _Pragma("unroll") for(int r=0;r<16;++r)sacc+=pB1[r]; l_reg+=sacc;
    pw0=(u32x4){PKW(pB0,0),PKW(pB0,2),PKW(pB0,4),PKW(pB0,6)};pw1=(u32x4){PKW(pB0,8),PKW(pB0,10),PKW(pB0,12),PKW(pB0,14)};pw2=(u32x4){PKW(pB1,0),PKW(pB1,2),PKW(pB1,4),PKW(pB1,6)};pw3=(u32x4){PKW(pB1,8),PKW(pB1,10),PKW(pB1,12),PKW(pB1,14)};
    SBAR(); pv4(o,vb0+2*sl_cur,PAF(0),PAF(1),PAF(2),PAF(3)); }
  #undef PKW
  #undef PAF
  #undef VFR
  #undef PIN
  #undef MX3
  #undef GAPA
  #undef GAPB
  #undef EX
  #undef VRD
  #undef KF
  #undef STEP
  #undef ENDW
  {auto rr=__builtin_amdgcn_permlane32_swap(__float_as_uint(l_reg),__float_as_uint(l_reg),false,false);l_reg=__uint_as_float(rr[0])+__uint_as_float(rr[1]);}
  if(hi==0)wsf[32+r32]=l_reg;asm volatile("s_waitcnt lgkmcnt(0)":::"memory");
  float rli[16];
  #pragma unroll
  for(int r=0;r<16;++r)rli[r]=__builtin_amdgcn_rcpf(wsf[32+crow(r,hi)]);
  bf16*Ow=O+(rowbase+q0+wid*QBLK)*DM+2*h*D;
  bf16*stg=(bf16*)(shm+LDS_OST2)+wid*2048;
  if constexpr(!FUSE){
    #pragma unroll
    for(int ps=0;ps<2;++ps){
      #pragma unroll
      for(int r=0;r<16;++r){const int orow=crow(r,hi);
        #pragma unroll
        for(int d0=0;d0<2;++d0)stg[orow*64+d0*32+r32]=__float2bfloat16(o[2*ps+d0][r]*rli[r]);}
      asm volatile("s_waitcnt lgkmcnt(0)":::"memory");
      #pragma unroll
      for(int i=0;i<4;++i){const int row=i*8+(lane>>3),ch=lane&7; const u32x4 v=*(const u32x4*)(stg+row*64+ch*8); ATTN_STORE16(Ow+(long)row*DM+ps*64+ch*8,v);}
      asm volatile("s_waitcnt lgkmcnt(0)":::"memory"); }
    asm volatile("s_waitcnt vmcnt(0)":::"memory");
  } else {
    float dv[2][4][8]; float ss[4]={0.f,0.f,0.f,0.f};
    u32x4 v0p[2][4];
    #pragma unroll
    for(int ps=0;ps<2;++ps)
      #pragma unroll
      for(int i=0;i<4;++i){const int row=i*8+(lane>>3),ch=lane&7; v0p[ps][i]=*(const u32x4*)(Ow+(long)row*DM+ps*64+ch*8);}
    #pragma unroll
    for(int ps=0;ps<2;++ps){
      #pragma unroll
      for(int r=0;r<16;++r){const int orow=crow(r,hi);
        #pragma unroll
        for(int d0=0;d0<2;++d0)stg[orow*64+d0*32+r32]=__float2bfloat16(o[2*ps+d0][r]*rli[r]);}
      asm volatile("s_waitcnt lgkmcnt(0)":::"memory");
      #pragma unroll
      for(int i=0;i<4;++i){const int row=i*8+(lane>>3),ch=lane&7; const u32x4 v1=*(const u32x4*)(stg+row*64+ch*8); const u32x4 v0=v0p[ps][i];
        #pragma unroll
        for(int e=0;e<4;++e){ const float a0=__uint_as_float(v0[e]<<16),a1=__uint_as_float(v0[e]&0xffff0000u),b0=__uint_as_float(v1[e]<<16),b1=__uint_as_float(v1[e]&0xffff0000u);
          const float x0=a0-lam*b0,x1=a1-lam*b1; dv[ps][i][2*e]=x0; dv[ps][i][2*e+1]=x1; ss[i]+=x0*x0+x1*x1; } }
      asm volatile("s_waitcnt lgkmcnt(0)":::"memory"); }
    #pragma unroll
    for(int i=0;i<4;++i){ float s_=ss[i];
      { int b_=__float_as_int(s_); s_+=__int_as_float(__builtin_amdgcn_update_dpp(b_,b_,0xB1,0xF,0xF,false)); b_=__float_as_int(s_); s_+=__int_as_float(__builtin_amdgcn_update_dpp(b_,b_,0x4E,0xF,0xF,false)); b_=__float_as_int(s_); s_+=__int_as_float(__builtin_amdgcn_update_dpp(b_,b_,0x141,0xF,0xF,false)); }
      ss[i]=1.0f/sqrtf(s_*(1.0f/128.0f)+1e-6f); }
    #pragma unroll
    for(int ps=0;ps<2;++ps){ float gg[8];
      #pragma unroll
      for(int e=0;e<8;++e)gg[e]=gsub[ps*64+(lane&7)*8+e]*0.8f;
      #pragma unroll
      for(int i=0;i<4;++i){const int row=i*8+(lane>>3),ch=lane&7; u32x4 w;
        #pragma unroll
        for(int e=0;e<4;++e)w[e]=cvtpk_s(dv[ps][i][2*e]*ss[i]*gg[2*e],dv[ps][i][2*e+1]*ss[i]*gg[2*e+1]);
        ATTN_STORE16(Ow+(long)row*DM+ps*64+ch*8,w);} }
  }
  asm volatile("s_waitcnt lgkmcnt(0)\n\ts_barrier":::"memory");
  #undef DMA_K
  #undef DMA_V
  #undef QF
  #undef CMASK
  #undef NVAL
  #undef START
  #undef RESC
  #undef ROT
}
constexpr int ATTN_LDS_BYTES=LDS_BYTES2;
#undef SBAR
#undef WAIT_BAR
}

constexpr int NWAVES = 8;
constexpr int N_LAUNCHES = MK_N_LAUNCHES;
constexpr int N_PHASES = 9 + 2 * NCH + 1;
constexpr bool PER_PHASE = (MK_N_LAUNCHES != 1);

constexpr size_t MiB = 1u << 20;
constexpr size_t ACT = (size_t)T * D * 2;
constexpr size_t WS_CTL = 0, CTL_ZERO_BYTES = 65536;
constexpr size_t WS_MOD = 1 * MiB;
constexpr size_t WS_SH = WS_MOD + 512 * 1024;
constexpr size_t WS_WIN = 2 * MiB;
constexpr size_t WS_WR = 16 * MiB, WS_WA = 18 * MiB, WS_WO = 20 * MiB;
constexpr size_t WS_LW = 22 * MiB;
constexpr size_t WS_WRH = 23 * MiB, WS_WRL = 23 * MiB + 131072;
constexpr size_t WS_H = 24 * MiB;
constexpr size_t WS_XR = WS_H + ACT;
constexpr size_t WS_GR = WS_XR + ACT;
constexpr size_t WS_Q = WS_GR + ACT;
constexpr size_t WS_K = WS_Q + ACT;
constexpr size_t WS_V = WS_K + ACT;
constexpr size_t WS_O1 = WS_V + ACT;
constexpr size_t WS_END = WS_O1 + ACT;
static_assert(WS_END <= 512 * MiB, "ws map");
constexpr size_t WS_W13 = WS_GR;
constexpr size_t WS_W2 = WS_O1;
constexpr size_t WS_W13S = WS_O1 + 32 * MiB;
constexpr size_t WS_W2S = WS_O1 + 33 * MiB;
constexpr size_t WS_LIST = WS_O1 + 34 * MiB;
constexpr size_t WS_WTS = WS_O1 + 42 * MiB;
constexpr size_t WS_RDEST = WS_O1 + 43 * MiB;
constexpr size_t WS_RWT = WS_O1 + 44 * MiB;
constexpr size_t WS_SA = WS_O1 + 45 * MiB;
constexpr int MAXRT = TC * TOPK / 256 + NEXP + TC / 256;
constexpr int MAXROWS = MAXRT * 256;
constexpr size_t WS_HB = WS_H + 32 * MiB;
constexpr size_t WS_SLOT = WS_Q;
constexpr size_t WS_SLOTSC = WS_SLOT + 72 * MiB;
constexpr size_t WS_Y = WS_Q;
static_assert(WS_SLOT + (size_t)(TC * 9) * D <= WS_O1 && WS_HB + (size_t)MAXROWS * 512 <= WS_GR && (size_t)MAXROWS * 4 <= MiB, "moe map");
constexpr int CW_TMO = 0;
constexpr int CW_BAR = 4096;
constexpr int CW_CNT = 8192;
constexpr int CW_AMAX = 8192 + 512;

constexpr int RING_BYTES = 139264;
constexpr int MISC_OFF = RING_BYTES;
constexpr int LDS_BYTES = 155648;
constexpr int MI_BARST = 0;
constexpr int MI_CNT = 64;
constexpr int MI_TBASE = 128;
constexpr int MI_TILE_E = 256;
constexpr int MI_SB = 896;
constexpr int MI_TOK = 1024;
constexpr int MI_SA = 2560;
constexpr int MI_WORDS = 4096;

#define GAS __attribute__((address_space(1)))
#define LAS __attribute__((address_space(3)))
typedef unsigned short bf16;
typedef unsigned v4u __attribute__((ext_vector_type(4)));
typedef unsigned v2u __attribute__((ext_vector_type(2)));
typedef float f32x4 __attribute__((ext_vector_type(4)));
typedef float f32x16 __attribute__((ext_vector_type(16)));
typedef short bf16x8 __attribute__((ext_vector_type(8)));
typedef GAS unsigned gu32;
#define RLX_AGENT __ATOMIC_RELAXED, __HIP_MEMORY_SCOPE_AGENT
#define LDS_WAIT() asm volatile("s_waitcnt lgkmcnt(0)" ::: "memory")
#define VM_WAIT() asm volatile("s_waitcnt vmcnt(0)" ::: "memory")
__device__ __forceinline__ unsigned f2bf(float f) { unsigned u = __builtin_bit_cast(unsigned, f); return (u + 0x7fffu + ((u >> 16) & 1u)) >> 16; }
__device__ __forceinline__ unsigned pk2(float lo, float hi) { return f2bf(lo) | (f2bf(hi) << 16); }
__device__ __forceinline__ float bf2f(unsigned h) { return __uint_as_float(h << 16); }
using pg8::bflo; using pg8::bfhi; using pg8::sigm;

#define XB_TMO      128
#define XB_XCNT(j)  (256  + 64 * (j))
#define XB_XSUB(j)  (1280 + 64 * (j))
#define XB_XGEN(j)  (2304 + 64 * (j))
#define XB_TOP      3328
#define XB_TOPGEN   3392
#define XCD_BAR_WORDS 3456
#define XB_SPIN_CAP (1u << 18)
__device__ __forceinline__ unsigned xb_ld(unsigned* p)              { return __hip_atomic_load(p, __ATOMIC_RELAXED, __HIP_MEMORY_SCOPE_AGENT); }
__device__ __forceinline__ unsigned xb_add(unsigned* p, unsigned v) { return __hip_atomic_fetch_add(p, v, __ATOMIC_RELAXED, __HIP_MEMORY_SCOPE_AGENT); }
__device__ __forceinline__ unsigned xb_xcc_id() { return (unsigned)__builtin_amdgcn_s_getreg((3 << 11) | 20) & 0xFu; }
#define XB_SPIN(cond, bar) do { unsigned _sp = 0; while (cond) { __builtin_amdgcn_s_sleep(1); \
    if ((++_sp & 255u) == 0u) { if (xb_ld(&(bar)[XB_TMO])) break; if (_sp > XB_SPIN_CAP) { atomicAdd(&(bar)[XB_TMO], 1u); break; } } } } while (0)
struct XcdBarrier { unsigned* bar; unsigned x; volatile LAS unsigned* st; };
__device__ __forceinline__ XcdBarrier xcd_barrier_post(unsigned* bar, volatile LAS unsigned* st) {
    XcdBarrier b; b.bar = bar; b.x = xb_xcc_id(); b.st = st;
    if (threadIdx.x == 0) (void)xb_add(&bar[XB_XCNT(b.x)], 1u);
    return b;
}
__device__ __forceinline__ void xcd_barrier_complete(unsigned* bar, unsigned x, unsigned& nloc, unsigned& nx) {
    const unsigned G = gridDim.x * gridDim.y * gridDim.z;
    unsigned sum, cnt, mine, sp = 0u;
    for (;;) {
        sum = 0u; cnt = 0u; mine = 0u;
#pragma unroll 1
        for (unsigned j = 0; j < 16; ++j) { const unsigned c = xb_ld(&bar[XB_XCNT(j)]); sum += c; cnt += (c > 0u) ? 1u : 0u; mine = (j == x) ? c : mine; }
        if (sum == G) break;
        __builtin_amdgcn_s_sleep(1);
        if ((++sp & 255u) == 0u) { if (xb_ld(&bar[XB_TMO])) break; if (sp > XB_SPIN_CAP) { atomicAdd(&bar[XB_TMO], 1u); break; } }
    }
    nloc = mine > 0u ? mine : 1u; nx = cnt > 0u ? cnt : 1u;
}
__device__ __forceinline__ void xcd_barrier(const XcdBarrier& b) {
    asm volatile("s_waitcnt vmcnt(0)" ::: "memory");
    __syncthreads();
    if (threadIdx.x == 0) {
        size_t zb_ = 0; asm volatile("" : "+s"(zb_)); unsigned* bar = b.bar + zb_;
        __builtin_amdgcn_s_waitcnt(0);
        unsigned nloc = b.st[0], nx = b.st[1];
        if (nloc == 0u) { xcd_barrier_complete(bar, b.x, nloc, nx); b.st[0] = nloc; b.st[1] = nx; }
        const unsigned old = xb_add(&bar[XB_XSUB(b.x)], 1u);
        const unsigned gen = old / nloc;
        if (old + 1u == (gen + 1u) * nloc) {
            __builtin_amdgcn_fence(__ATOMIC_RELEASE, "agent");
            asm volatile("s_waitcnt vmcnt(0)" ::: "memory");
            const unsigned og = xb_add(&bar[XB_TOP], 1u);
            const unsigned tg = og / nx;
            if (og + 1u == (tg + 1u) * nx) xb_add(&bar[XB_TOPGEN], 1u);
            else XB_SPIN(xb_ld(&bar[XB_TOPGEN]) == tg, bar);
            __builtin_amdgcn_fence(__ATOMIC_ACQUIRE, "agent");
            xb_add(&bar[XB_XGEN(b.x)], 1u);
            asm volatile("s_waitcnt vmcnt(0)" ::: "memory");
        } else {
            XB_SPIN(xb_ld(&bar[XB_XGEN(b.x)]) == gen, bar);
            __builtin_amdgcn_fence(__ATOMIC_ACQUIRE, "agent");
            asm volatile("s_waitcnt vmcnt(0)" ::: "memory");
        }
    }
    __syncthreads();
}

struct Frame {
    LAS unsigned char* lds;
    volatile LAS int* MI;
    gu32* ctl;
    int tid, lane, wave, vcu, G;
    float* out;
    unsigned char* ws;
};
struct Args { const float* in[32]; float* out; unsigned char* ws; int ph_lo, ph_hi; };
__device__ __forceinline__ float dppf(float x, int ctrl_sel) {
    const int b = __float_as_int(x); int r;
    if (ctrl_sel == 0) r = __builtin_amdgcn_update_dpp(b, b, 0xB1, 0xF, 0xF, false);
    else if (ctrl_sel == 1) r = __builtin_amdgcn_update_dpp(b, b, 0x4E, 0xF, 0xF, false);
    else if (ctrl_sel == 2) r = __builtin_amdgcn_update_dpp(b, b, 0x141, 0xF, 0xF, false);
    else r = __builtin_amdgcn_update_dpp(b, b, 0x140, 0xF, 0xF, false);
    return __int_as_float(r);
}
__device__ __forceinline__ float max8_dpp(float x) { x = fmaxf(x, dppf(x, 0)); x = fmaxf(x, dppf(x, 1)); x = fmaxf(x, dppf(x, 2)); return x; }
__device__ __forceinline__ float rl_f(float x, int l) { return __int_as_float(__builtin_amdgcn_readlane(__float_as_int(x), l)); }
__device__ __forceinline__ float wave_max_dpp(float x) { x = max8_dpp(x); x = fmaxf(x, dppf(x, 3)); return fmaxf(fmaxf(rl_f(x, 0), rl_f(x, 16)), fmaxf(rl_f(x, 32), rl_f(x, 48))); }
__device__ __forceinline__ float wave_sum_dpp(float x) { x += dppf(x, 0); x += dppf(x, 1); x += dppf(x, 2); x += dppf(x, 3); return (rl_f(x, 0) + rl_f(x, 16)) + (rl_f(x, 32) + rl_f(x, 48)); }
__device__ __forceinline__ float wave_sum(float v) { return wave_sum_dpp(v); }

typedef short v4i16_t __attribute__((ext_vector_type(4)));
__device__ __forceinline__ v2u tr8(const LAS unsigned char* p) { return __builtin_bit_cast(v2u, __builtin_amdgcn_ds_read_tr16_b64_v4i16((LAS v4i16_t*)p)); }
__device__ __forceinline__ void transpose_item(const float* W, int K, int N, bf16* WT, int kb, int n0, int drow0, LAS float* scr_, int lane) {
    LAS unsigned char* scr = (LAS unsigned char*)scr_;
    const int k0 = 64 * kb, lr = lane >> 4, lc = lane & 15;
#pragma unroll
    for (int hf = 0; hf < 2; ++hf) {
        f32x4 v[8];
#pragma unroll
        for (int r = 0; r < 8; ++r) v[r] = *(const f32x4*)(W + (size_t)(k0 + 32 * hf + 4 * r + lr) * N + n0 + 4 * lc);
#pragma unroll
        for (int r = 0; r < 8; ++r) { v2u o; o.x = pk2(v[r].x, v[r].y); o.y = pk2(v[r].z, v[r].w); *(LAS v2u*)(scr + (32 * hf + 4 * r + lr) * 144 + lc * 8) = o; }
    }
    LDS_WAIT(); asm volatile("" ::: "memory");
    const int g = lane >> 4, q = (lane & 15) >> 2, p = lane & 3;
#pragma unroll
    for (int nb = 0; nb < 4; ++nb)
#pragma unroll
        for (int kk = 0; kk < 2; ++kk) { const int kblk = 4 * kk + g;
            const v2u a = tr8(scr + (8 * kblk + q) * 144 + (16 * nb + 4 * p) * 2), b = tr8(scr + (8 * kblk + 4 + q) * 144 + (16 * nb + 4 * p) * 2);
            v4u o; o.x = a.x; o.y = a.y; o.z = b.x; o.w = b.y;
            *(GAS v4u*)(WT + (size_t)(drow0 + 16 * nb + lc) * K + k0 + 8 * kblk) = o; }
    LDS_WAIT(); asm volatile("" ::: "memory");
}

__device__ __forceinline__ void p0_phase(Frame& F, const Args& A) {
    unsigned char* ws = F.ws;
    LAS float* sc = (LAS float*)F.lds;
    if (F.vcu < 6 * D / 64) {
#pragma unroll 1
        for (int i0 = F.tid; i0 < BATCH * D; i0 += 8 * NWAVES * 64) { float v[8];
#pragma unroll
            for (int u = 0; u < 8; ++u) v[u] = A.in[1][i0 + u * NWAVES * 64];
#pragma unroll
            for (int u = 0; u < 8; ++u) { const int i = i0 + u * NWAVES * 64, b = i >> 10, k = i & 1023; sc[k * 16 + b] = v[u] * sigm(v[u]); } } }
    __syncthreads();
    const int nada = (F.G > 2 * (6 * D / 64)) ? (6 * D / 64) : 0;
    const int NGW = (F.G - nada) * NWAVES, gw = (F.vcu >= nada) ? (F.vcu - nada) * NWAVES + F.wave : 0x40000000;
    LAS float* part = (LAS float*)(F.lds + 65536);
    for (int task = F.vcu; task < 6 * D / 64; task += F.G) {
        const int col = task * 64 + F.lane;
        float acc[16];
#pragma unroll
        for (int b = 0; b < 16; ++b) acc[b] = 0.f;
        const float* wp = A.in[2] + (size_t)(128 * F.wave) * (6 * D) + col;
        const LAS f32x4* sp = (const LAS f32x4*)(sc + (128 * F.wave) * 16);
#pragma unroll 1
        for (int k0 = 0; k0 < 128; k0 += 32) { float wv[32];
#pragma unroll
            for (int i = 0; i < 32; ++i) wv[i] = wp[(size_t)(k0 + i) * (6 * D)];
#pragma unroll
            for (int i = 0; i < 32; ++i) {
#pragma unroll
                for (int q = 0; q < 4; ++q) { const f32x4 sv = sp[(k0 + i) * 4 + q]; acc[4 * q + 0] += wv[i] * sv.x; acc[4 * q + 1] += wv[i] * sv.y; acc[4 * q + 2] += wv[i] * sv.z; acc[4 * q + 3] += wv[i] * sv.w; } } }
#pragma unroll
        for (int b = 0; b < 16; ++b) part[(F.wave * 16 + b) * 64 + F.lane] = acc[b];
        __syncthreads();
        for (int i = F.tid; i < 16 * 64; i += NWAVES * 64) { const int b = i >> 6, c = i & 63; float v = A.in[3][task * 64 + c];
#pragma unroll
            for (int w8 = 0; w8 < 8; ++w8) v += part[(w8 * 16 + b) * 64 + c];
            ((float*)(ws + WS_MOD))[b * (6 * D) + task * 64 + c] = v; }
        __syncthreads();
    }
    __syncthreads();
    LAS float* scr = (LAS float*)(F.lds + F.wave * 16384);
    constexpr int I_SQ = 16 * 16, I_LW = 16 * 4;
    constexpr int NITEMS = 3 * I_SQ + I_LW;
    for (int it = gw; it < NITEMS; it += NGW) {
        int r = it;
        if (r < I_SQ) { transpose_item(A.in[18], D, D, (bf16*)(ws + WS_WR), r / 16, 64 * (r % 16), 64 * (r % 16), scr, F.lane); continue; } r -= I_SQ;
        if (r < I_SQ) { transpose_item(A.in[19], D, D, (bf16*)(ws + WS_WA), r / 16, 64 * (r % 16), 64 * (r % 16), scr, F.lane); continue; } r -= I_SQ;
        if (r < I_SQ) { transpose_item(A.in[20], D, D, (bf16*)(ws + WS_WO), r / 16, 64 * (r % 16), 64 * (r % 16), scr, F.lane); continue; } r -= I_SQ;
        { const int mat = r >> 2, q = r & 3, gate = mat >> 3, n = mat & 7;
          const float* W = (gate ? A.in[10] : A.in[8]) + (size_t)n * 128 * 128;
          transpose_item(W, 128, 128, (bf16*)(ws + WS_LW) + (size_t)(n * 2 + gate) * 128 * 128, q >> 1, 64 * (q & 1), 64 * (q & 1), scr, F.lane); }
    }
    for (long i = (long)gw * 64 + F.lane; i < D * NEXP; i += NGW * 64) { const int k = i >> 6, e = i & 63; const float wv = A.in[23][i]; const unsigned hb = f2bf(wv); const unsigned lb = f2bf(wv - bf2f(hb));
        ((bf16*)(ws + WS_WRH))[e * D + k] = (bf16)hb; ((bf16*)(ws + WS_WRL))[e * D + k] = (bf16)lb; }
    for (int it = gw; it < 130 * 64 + (D * W_IN) / 4096; it += NGW) { const int mtx = it < 130 * 64 ? it >> 6 : 130, part = it < 130 * 64 ? (it & 63) : it - 130 * 64, e = mtx >> 1, w3 = mtx & 1;
        const float* W = (mtx == 130 ? A.in[5] : e < NEXP ? (w3 ? A.in[26] : A.in[25]) + (size_t)e * D * DEXP : (w3 ? A.in[29] : A.in[28])) + (size_t)part * 4096;
        float mx = 0.f;
#pragma unroll
        for (int i = 0; i < 16; ++i) { const f32x4 v = *((const f32x4*)W + F.lane + 64 * i); mx = fmaxf(mx, fmaxf(fmaxf(fabsf(v.x), fabsf(v.y)), fmaxf(fabsf(v.z), fabsf(v.w)))); }
        mx = wave_max_dpp(mx);
        if (F.lane == 0) atomicMax((unsigned*)(F.ctl + CW_AMAX + mtx), __float_as_uint(mx)); }
}

template <bool FP8 = false>
__device__ __forceinline__ void transpose_item_q(const float* W, int K, int N, signed char* WT, int kb, int n0, int drow0, LAS float* scr_, int lane, float inv) {
    LAS unsigned char* scr = (LAS unsigned char*)scr_;
    const int k0 = 64 * kb, lr = lane >> 4, lc = lane & 15;
#pragma unroll
    for (int hf = 0; hf < 2; ++hf) {
        f32x4 v[8];
#pragma unroll
        for (int r = 0; r < 8; ++r) v[r] = *(const f32x4*)(W + (size_t)(k0 + 32 * hf + 4 * r + lr) * N + n0 + 4 * lc);
#pragma unroll
        for (int r = 0; r < 8; ++r) { v2u o; o.x = pk2(v[r].x, v[r].y); o.y = pk2(v[r].z, v[r].w); *(LAS v2u*)(scr + (32 * hf + 4 * r + lr) * 144 + lc * 8) = o; }
    }
    LDS_WAIT(); asm volatile("" ::: "memory");
    const int g = lane >> 4, q = (lane & 15) >> 2, p = lane & 3;
#pragma unroll
    for (int nb = 0; nb < 4; ++nb)
#pragma unroll
        for (int kk = 0; kk < 2; ++kk) { const int kblk = 4 * kk + g;
            const v2u a = tr8(scr + (8 * kblk + q) * 144 + (16 * nb + 4 * p) * 2), b = tr8(scr + (8 * kblk + 4 + q) * 144 + (16 * nb + 4 * p) * 2);
            const unsigned wv[4] = {a.x, a.y, b.x, b.y}; unsigned ob[2] = {0u, 0u};
#pragma unroll
            for (int j = 0; j < 4; ++j) {
                if constexpr (FP8) { const float f0 = __builtin_amdgcn_fmed3f(bflo(wv[j]) * inv, -448.0f, 448.0f), f1 = __builtin_amdgcn_fmed3f(bfhi(wv[j]) * inv, -448.0f, 448.0f);
                    ob[j >> 1] = (j & 1) ? (unsigned)__builtin_amdgcn_cvt_pk_fp8_f32(f0, f1, (int)ob[j >> 1], true) : (unsigned)__builtin_amdgcn_cvt_pk_fp8_f32(f0, f1, 0, false); }
                else { const int q0 = (int)rintf(bflo(wv[j]) * inv), q1 = (int)rintf(bfhi(wv[j]) * inv);
                    ob[j >> 1] |= ((unsigned)(q0 & 0xff) << (16 * (j & 1))) | ((unsigned)(q1 & 0xff) << (16 * (j & 1) + 8)); } }
            v2u o; o.x = ob[0]; o.y = ob[1];
            *(GAS v2u*)(WT + (size_t)(drow0 + 16 * nb + lc) * K + k0 + 8 * kblk) = o; }
    LDS_WAIT(); asm volatile("" ::: "memory");
}

__device__ __forceinline__ void p1_phase(Frame& F, const Args& A) {
    const int gw = F.vcu * NWAVES + F.wave, NGW = F.G * NWAVES;
    const float* mod = (const float*)(F.ws + WS_MOD);
    signed char* H = (signed char*)(F.ws + WS_H); float* SH = (float*)(F.ws + WS_SH);
    for (int grp = gw; grp < T / 16; grp += NGW) {
        const int b = (grp * 16) / SEQ;
        f32x4 g[4], sc[4], sh[4];
#pragma unroll
        for (int j = 0; j < 4; ++j) { const int c = 4 * F.lane + 256 * j; g[j] = *(const f32x4*)(A.in[4] + c); sh[j] = *(const f32x4*)(mod + b * 6 * D + c); sc[j] = *(const f32x4*)(mod + b * 6 * D + D + c);
            g[j] = g[j] * (sc[j] + 1.0f); }
        f32x4 vn[4];
        { const GAS f32x4* xr = (const GAS f32x4*)(A.in[0] + (size_t)grp * 16 * D) + F.lane;
#pragma unroll
          for (int j = 0; j < 4; ++j) vn[j] = xr[64 * j]; }
#pragma unroll 2
        for (int rr = 0; rr < 16; ++rr) {
            const size_t m = (size_t)grp * 16 + rr;
            f32x4 v[4]; float s = 0.f;
#pragma unroll
            for (int j = 0; j < 4; ++j) v[j] = vn[j];
            if (rr + 1 < 16) { const GAS f32x4* xr = (const GAS f32x4*)(A.in[0] + (m + 1) * D) + F.lane;
#pragma unroll
                for (int j = 0; j < 4; ++j) vn[j] = xr[64 * j]; }
#pragma unroll
            for (int j = 0; j < 4; ++j) s += (v[j].x * v[j].x + v[j].y * v[j].y) + (v[j].z * v[j].z + v[j].w * v[j].w);
            const float rstd = 1.f / sqrtf(wave_sum(s) * (1.f / D) + EPS);
            float amx = 0.f;
#pragma unroll
            for (int j = 0; j < 4; ++j) { v[j] = v[j] * rstd * g[j] + sh[j]; amx = fmaxf(amx, fmaxf(fmaxf(fabsf(v[j].x), fabsf(v[j].y)), fmaxf(fabsf(v[j].z), fabsf(v[j].w)))); }
            amx = fmaxf(wave_max_dpp(amx), 1e-20f); const float inv = 127.0f / amx; if (F.lane == 0) SH[m] = amx * (1.0f / 127.0f);
#pragma unroll
            for (int j = 0; j < 4; ++j) { const int q0 = (int)rintf(v[j].x * inv), q1 = (int)rintf(v[j].y * inv), q2 = (int)rintf(v[j].z * inv), q3 = (int)rintf(v[j].w * inv);
                *((GAS unsigned*)(H + m * D) + F.lane + 64 * j) = (unsigned)(q0 & 0xff) | ((unsigned)(q1 & 0xff) << 8) | ((unsigned)(q2 & 0xff) << 16) | ((unsigned)(q3 & 0xff) << 24); }
        }
    }
    { LAS float* scr = (LAS float*)(F.lds + F.wave * 16384);
      const float inv = 127.0f / fmaxf(__uint_as_float(__hip_atomic_load(F.ctl + CW_AMAX + 130, RLX_AGENT)), 1e-30f);
      constexpr int I_IN = 16 * (W_IN / 64);
      for (int it = NGW - 1 - gw; it < I_IN; it += NGW)
          transpose_item_q(A.in[5], D, W_IN, (signed char*)(F.ws + WS_WIN), it / (W_IN / 64), 64 * (it % (W_IN / 64)), 64 * (it % (W_IN / 64)), scr, F.lane, inv); }
}

struct DenseOrder {
    const char* A; const char* Bt; int nM, nN, nwg, G, c; size_t tstep;
    __device__ __forceinline__ void init(const void* A_, const void* Bt_, int M, int N, int K, int G_, int c_) { A = (const char*)A_; Bt = (const char*)Bt_; nM = M / 256; nN = N / 256; nwg = nM * nN; G = G_; c = c_; tstep = (size_t)256 * K * 2; }
    __device__ __forceinline__ bool next(int i, pg8::Unit& u) const {
        const long L = (long)i * G + c; if (L >= nwg) return false;
        int wgid = (int)L; { const int q = nwg / 8, r = nwg % 8, xcd = wgid % 8, off = wgid / 8; wgid = (xcd < r ? xcd * (q + 1) : r * (q + 1) + (xcd - r) * q) + off; }
        const int nig = 8 * nN, gid = wgid / nig, fm = gid * 8, gsz = (nM - fm) < 8 ? (nM - fm) : 8;
        u.pm = fm + ((wgid % nig) % gsz); u.pn = (wgid % nig) / gsz; u.z = i; u.e = 0; return true;
    }
    __device__ __forceinline__ void bases(const pg8::Unit& u, const char*& a, const char*& b) const { a = A + (size_t)u.pm * tstep; b = Bt + (size_t)u.pn * tstep; }
    __device__ __forceinline__ int tok(int, int) const { return 0; }
};
struct MergeOrder {
    DenseOrder d; const char *A1, *B1;
    __device__ __forceinline__ bool next(int i, pg8::Unit& u) const { if (!d.next(i >> 1, u)) return false; u.z = i & 1; return true; }
    __device__ __forceinline__ void bases(const pg8::Unit& u, const char*& a, const char*& b) const { a = (u.z ? A1 : d.A) + (size_t)u.pm * d.tstep; b = (u.z ? B1 : d.Bt) + (size_t)u.pn * d.tstep; }
    __device__ __forceinline__ int tok(int, int) const { return 0; }
};
typedef pg8::f32x4 acc_t[2][2][4][2];
struct EpiProj {
    static constexpr bool PERM = true, TWICE = false; static constexpr int MIN_VM = 16;
    bf16* ws5; bf16* dout2; volatile LAS int* MI; float sB;
    __device__ __forceinline__ void operator()(const acc_t& acc, const pg8::Unit& u, int wr, int wc, int fr, int fq) const {
        const int t = u.pn >> 2, colt = (u.pn & 3) * 256;
        bf16* base = ws5 + (size_t)(t < 5 ? t : 0) * T * D;
        const int row0 = u.pm * 256 + wr * 64 + fr, col0 = colt + wc * 32 + 8 * fq;
#pragma unroll
        for (int ai = 0; ai < 2; ++ai)
#pragma unroll
            for (int m = 0; m < 4; ++m) { bf16* rowp = base + (size_t)(row0 + ai * 128 + m * 16) * D + col0;
                const float sc = __int_as_float(MI[512 + u.z * 256 + wr * 64 + fr + ai * 128 + m * 16]) * sB;
#pragma unroll
                for (int bj = 0; bj < 2; ++bj) { const pg8::i32x4 I0 = __builtin_bit_cast(pg8::i32x4, acc[ai][bj][m][0]), I1 = __builtin_bit_cast(pg8::i32x4, acc[ai][bj][m][1]);
                    pg8::f32x4 v0, v1;
#pragma unroll
                    for (int i = 0; i < 4; ++i) { float a = (float)I0[i] * sc, b = (float)I1[i] * sc; asm volatile("" : "+v"(a), "+v"(b)); v0[i] = a; v1[i] = b; }
                    if (t >= 5) {
                        unsigned tb[8];
#pragma unroll
                        for (int i = 0; i < 4; ++i) { tb[i] = __float_as_uint(__builtin_fmaf(sigm(v0[i]), 255.0f, 8388608.0f)); tb[4 + i] = __float_as_uint(__builtin_fmaf(sigm(v1[i]), 255.0f, 8388608.0f)); }
                        v2u w; w.x = __builtin_amdgcn_perm(__builtin_amdgcn_perm(tb[3], tb[2], 0x0c0c0400u), __builtin_amdgcn_perm(tb[1], tb[0], 0x0c0c0400u), 0x05040100u);
                        w.y = __builtin_amdgcn_perm(__builtin_amdgcn_perm(tb[7], tb[6], 0x0c0c0400u), __builtin_amdgcn_perm(tb[5], tb[4], 0x0c0c0400u), 0x05040100u);
                        *(v2u*)((unsigned char*)dout2 + (size_t)(t - 5) * T * D + (size_t)(row0 + ai * 128 + m * 16) * D + col0 + bj * 128) = w; continue; }
                    if (t == 1) { for (int i = 0; i < 4; ++i) { v0[i] = pg8::gelu_t(v0[i]); v1[i] = pg8::gelu_t(v1[i]); } }
                    else if (t == 2) { v0 = v0 * attn_body::C2; v1 = v1 * attn_body::C2; }
                    v4u w; w.x = pg8::cvt_pk_bf16(v0[0], v0[1]); w.y = pg8::cvt_pk_bf16(v0[2], v0[3]); w.z = pg8::cvt_pk_bf16(v1[0], v1[1]); w.w = pg8::cvt_pk_bf16(v1[2], v1[3]);
                    *(v4u*)(rowp + bj * 128) = w; } }
    }
};
struct EpiGate {
    static constexpr bool PERM = true, TWICE = false; static constexpr int MIN_VM = 16;
    const unsigned char* GA; const unsigned char* GB; bf16* YA; bf16* MG;
    __device__ __forceinline__ void operator()(const acc_t& acc, const pg8::Unit& u, int wr, int wc, int fr, int fq) const {
        const int row0 = u.pm * 256 + wr * 64 + fr, col0 = u.pn * 256 + wc * 32 + 8 * fq;
        const unsigned char* G = u.z ? GB : GA; bf16* O = u.z ? MG : YA;
#pragma unroll
        for (int ai = 0; ai < 2; ++ai)
#pragma unroll
            for (int mp = 0; mp < 2; ++mp) {
                v2u g[2][2]; v4u y[2][2];
#pragma unroll
                for (int mm = 0; mm < 2; ++mm)
#pragma unroll
                    for (int bj = 0; bj < 2; ++bj) { const size_t off = (size_t)(row0 + ai * 128 + (2 * mp + mm) * 16) * D + col0 + bj * 128; g[mm][bj] = *(const v2u*)(G + off);
                        y[mm][bj] = u.z ? *(const v4u*)(YA + off) : (v4u){0u, 0u, 0u, 0u}; }
#pragma unroll
                for (int mm = 0; mm < 2; ++mm)
#pragma unroll
                    for (int bj = 0; bj < 2; ++bj) { const int m = 2 * mp + mm; const size_t off = (size_t)(row0 + ai * 128 + m * 16) * D + col0 + bj * 128; const v2u gg = g[mm][bj]; const v4u yy = y[mm][bj]; constexpr float Q = 1.0f / 255.0f;
                        pg8::f32x4 v0 = acc[ai][bj][m][0], v1 = acc[ai][bj][m][1];
                        v0[0] = v0[0] * ((float)(gg.x & 0xffu) * Q) + bflo(yy.x); v0[1] = v0[1] * ((float)((gg.x >> 8) & 0xffu) * Q) + bfhi(yy.x); v0[2] = v0[2] * ((float)((gg.x >> 16) & 0xffu) * Q) + bflo(yy.y); v0[3] = v0[3] * ((float)(gg.x >> 24) * Q) + bfhi(yy.y);
                        v1[0] = v1[0] * ((float)(gg.y & 0xffu) * Q) + bflo(yy.z); v1[1] = v1[1] * ((float)((gg.y >> 8) & 0xffu) * Q) + bfhi(yy.z); v1[2] = v1[2] * ((float)((gg.y >> 16) & 0xffu) * Q) + bflo(yy.w); v1[3] = v1[3] * ((float)(gg.y >> 24) * Q) + bfhi(yy.w);
                        v4u w; w.x = pg8::cvt_pk_bf16(v0[0], v0[1]); w.y = pg8::cvt_pk_bf16(v0[2], v0[3]); w.z = pg8::cvt_pk_bf16(v1[0], v1[1]); w.w = pg8::cvt_pk_bf16(v1[2], v1[3]);
                        *(v4u*)(O + off) = w; }
                asm volatile("" ::: "memory"); }
    }
};
struct EpiF32 {
    static constexpr bool PERM = true, TWICE = false; static constexpr int MIN_VM = 16;
    bf16* Y;
    __device__ __forceinline__ void operator()(const acc_t& acc, const pg8::Unit& u, int wr, int wc, int fr, int fq) const {
        const int row0 = u.pm * 256 + wr * 64 + fr, col0 = u.pn * 256 + wc * 32 + 8 * fq;
#pragma unroll
        for (int ai = 0; ai < 2; ++ai)
#pragma unroll
            for (int m = 0; m < 4; ++m) { bf16* rowp = Y + (size_t)(row0 + ai * 128 + m * 16) * D + col0;
#pragma unroll
                for (int bj = 0; bj < 2; ++bj) { const pg8::f32x4 v0 = acc[ai][bj][m][0], v1 = acc[ai][bj][m][1];
                    v4u w; w.x = pg8::cvt_pk_bf16(v0[0], v0[1]); w.y = pg8::cvt_pk_bf16(v0[2], v0[3]); w.z = pg8::cvt_pk_bf16(v1[0], v1[1]); w.w = pg8::cvt_pk_bf16(v1[2], v1[3]);
                    *(v4u*)(rowp + bj * 128) = w; } }
    }
};

__device__ __forceinline__ void lru_phase(Frame& F, const Args& A) {
    unsigned char* ws = F.ws;
    const bf16* XR = (const bf16*)(ws + WS_XR); bf16* GR = (bf16*)(ws + WS_GR);
    LAS unsigned char* AT = F.lds;
    LAS unsigned char* BT = F.lds + 34816;
    LAS float* AA = (LAS float*)(F.lds + 69632);
    LAS float* UU = (LAS float*)(F.lds + 102400);
    LAS float* SM = (LAS float*)(F.lds + 135168);
    LAS float* CW = (LAS float*)(F.lds + MISC_OFF + 4096);
    const int tid = F.tid, lane = F.lane, w = F.wave, hi = lane >> 5, l31 = lane & 31;
    for (int item = F.vcu; item < BATCH * 16; item += F.G) {
        const int b = item >> 4, n = (item >> 1) & 7, half = item & 1;
        __syncthreads();
        { const bf16* LW = (const bf16*)(ws + WS_LW) + (size_t)n * 2 * 128 * 128;
#pragma unroll
          for (int p = 0; p < 4; ++p) { const int q = tid + 512 * p, row = q >> 4, pc = q & 15; const int gate = row >> 6, d = 64 * half + (row & 63);
              const v4u v = *(const v4u*)(LW + ((size_t)gate * 128 + d) * 128 + pc * 8); *(LAS v4u*)(BT + row * 272 + pc * 16) = v; }
          for (int i = tid; i < 640; i += NWAVES * 64) { const int k = i >> 7, c = i & 127; CW[i] = (k < 4) ? A.in[6][k * D + 128 * n + c] : A.in[7][128 * n + c]; } }
        const int c8 = (tid & 15) * 8, run = tid >> 4, cg0 = 128 * n + c8;
        const int tg = w & 3, cg = w >> 2, lc = 32 * cg + l31, chg = 128 * n + 64 * half + lc;
        const float ba_c = A.in[9][chg], bx_c = A.in[11][chg];
        const float lam = A.in[12][chg]; const float sp8 = 8.0f * log1pf(expf(-lam)) * LOG2E;
        const int sc_c = tid & 63, seg = tid >> 6;
        float hcarry = 0.f;
        v4u xq[7];
        { const bf16* xp = XR + ((size_t)b * SEQ + 4 * run - 3) * D + cg0;
#pragma unroll
          for (int i = 0; i < 7; ++i) xq[i] = (4 * run - 3 + i >= 0) ? *(const v4u*)(xp + (size_t)i * D) : (v4u){0u, 0u, 0u, 0u}; }
        __syncthreads();
#pragma unroll 1
        for (int ck = 0; ck < SEQ / 128; ++ck) {
            const int t0 = 128 * ck;
            bf16* gp = GR + ((size_t)b * SEQ + t0 + 16 * seg) * D + 128 * n + 64 * half + sc_c;
            { unsigned ow[4][4];
#pragma unroll
              for (int hf = 0; hf < 2; ++hf) { float wv[5][4];
#pragma unroll
                  for (int k = 0; k < 5; ++k) { const f32x4 w0 = *(const LAS f32x4*)(CW + k * 128 + c8 + 4 * hf); wv[k][0] = w0.x; wv[k][1] = w0.y; wv[k][2] = w0.z; wv[k][3] = w0.w; }
#pragma unroll
                  for (int tt = 0; tt < 4; ++tt) { float x0 = wv[4][0], x1 = wv[4][1], x2 = wv[4][2], x3 = wv[4][3];
#pragma unroll
                      for (int k = 0; k < 4; ++k) { const unsigned va = hf ? xq[tt + k].z : xq[tt + k].x, vb = hf ? xq[tt + k].w : xq[tt + k].y;
                          x0 += wv[k][0] * bflo(va); x1 += wv[k][1] * bfhi(va); x2 += wv[k][2] * bflo(vb); x3 += wv[k][3] * bfhi(vb); }
                      ow[tt][2 * hf] = pk2(x0, x1); ow[tt][2 * hf + 1] = pk2(x2, x3); } }
#pragma unroll
              for (int tt = 0; tt < 4; ++tt) { v4u o; o.x = ow[tt][0]; o.y = ow[tt][1]; o.z = ow[tt][2]; o.w = ow[tt][3]; *(LAS v4u*)(AT + (4 * run + tt) * 272 + c8 * 2) = o; } }
            if (ck + 1 < SEQ / 128) { const bf16* xp = XR + ((size_t)b * SEQ + t0 + 128 + 4 * run - 3) * D + cg0;
#pragma unroll
                for (int i = 0; i < 7; ++i) xq[i] = *(const v4u*)(xp + (size_t)i * D); }
            __syncthreads();
            { f32x16 accR = f32x16{}, accI = f32x16{};
#pragma unroll
              for (int ks = 0; ks < 8; ++ks) {
                  const bf16x8 a = *(const LAS bf16x8*)(AT + (32 * tg + l31) * 272 + (16 * ks + 8 * hi) * 2);
                  const bf16x8 bR = *(const LAS bf16x8*)(BT + (32 * cg + l31) * 272 + (16 * ks + 8 * hi) * 2);
                  const bf16x8 bI = *(const LAS bf16x8*)(BT + (64 + 32 * cg + l31) * 272 + (16 * ks + 8 * hi) * 2);
                  accR = __builtin_amdgcn_mfma_f32_32x32x16_bf16(a, bR, accR, 0, 0, 0);
                  accI = __builtin_amdgcn_mfma_f32_32x32x16_bf16(a, bI, accI, 0, 0, 0); }
#pragma unroll
              for (int r = 0; r < 16; ++r) {
                  const int tok = 32 * tg + (r & 3) + 8 * (r >> 2) + 4 * hi;
                  const float rg = sigm(accR[r] + ba_c), ig = sigm(accI[r] + bx_c);
                  const float la2 = -sp8 * rg;
                  const float a = __builtin_amdgcn_exp2f(la2);
                  float mult = __builtin_amdgcn_sqrtf(fmaxf(1.0f - a * a, 0.f));
                  if (t0 + tok == 0) mult = 1.0f;
                  const float xcv = bf2f(*(const LAS unsigned short*)(AT + tok * 272 + (64 * half + lc) * 2));
                  AA[tok * 64 + lc] = a; UU[tok * 64 + lc] = mult * ig * xcv; } }
            __syncthreads();
            unsigned short gq[16];
#pragma unroll
            for (int j = 0; j < 16; ++j) gq[j] = gp[(size_t)j * D];
            float hl[16], pl[16];
            { float h = 0.f, P = 1.f;
#pragma unroll
              for (int j = 0; j < 16; ++j) { const float a = AA[(16 * seg + j) * 64 + sc_c], u = UU[(16 * seg + j) * 64 + sc_c]; h = a * h + u; P = P * a; hl[j] = h; pl[j] = P; }
              SM[(seg * 64 + sc_c) * 2] = P; SM[(seg * 64 + sc_c) * 2 + 1] = h; }
            __syncthreads();
            { float cin = hcarry, tot = hcarry;
#pragma unroll
              for (int s = 0; s < 8; ++s) { const float Ps = SM[(s * 64 + sc_c) * 2], hs = SM[(s * 64 + sc_c) * 2 + 1]; tot = Ps * tot + hs; if (s < seg) cin = tot; }
              hcarry = tot;
#pragma unroll
              for (int j = 0; j < 16; ++j) { const float hv = hl[j] + pl[j] * cin; gp[(size_t)j * D] = (bf16)f2bf(hv * bf2f(gq[j])); } }
        }
    }
    __syncthreads();
}

__device__ __forceinline__ void p5_phase(Frame& F, const Args& A) {
    const int gw = F.vcu * NWAVES + F.wave, NGW = F.G * NWAVES;
    float d1 = A.in[13][F.lane] * A.in[14][F.lane], d2 = A.in[15][F.lane] * A.in[16][F.lane];
    const float lam = expf(wave_sum(d1)) - expf(wave_sum(d2)) + LAM_INIT;
    bf16* O0 = (bf16*)(F.ws + WS_H); const bf16* O1 = (const bf16*)(F.ws + WS_O1);
    float g[16];
#pragma unroll
    for (int i = 0; i < 16; ++i) g[i] = A.in[17][(16 * F.lane + i) & 127] * (1.0f - LAM_INIT);
    for (int m = gw; m < T; m += NGW) {
        const v4u a0 = *(const v4u*)(O0 + (size_t)m * D + 16 * F.lane), a1 = *(const v4u*)(O0 + (size_t)m * D + 16 * F.lane + 8);
        const v4u b0 = *(const v4u*)(O1 + (size_t)m * D + 16 * F.lane), b1 = *(const v4u*)(O1 + (size_t)m * D + 16 * F.lane + 8);
        float o[16];
        o[0] = bflo(a0.x) - lam * bflo(b0.x); o[1] = bfhi(a0.x) - lam * bfhi(b0.x); o[2] = bflo(a0.y) - lam * bflo(b0.y); o[3] = bfhi(a0.y) - lam * bfhi(b0.y);
        o[4] = bflo(a0.z) - lam * bflo(b0.z); o[5] = bfhi(a0.z) - lam * bfhi(b0.z); o[6] = bflo(a0.w) - lam * bflo(b0.w); o[7] = bfhi(a0.w) - lam * bfhi(b0.w);
        o[8] = bflo(a1.x) - lam * bflo(b1.x); o[9] = bfhi(a1.x) - lam * bfhi(b1.x); o[10] = bflo(a1.y) - lam * bflo(b1.y); o[11] = bfhi(a1.y) - lam * bfhi(b1.y);
        o[12] = bflo(a1.z) - lam * bflo(b1.z); o[13] = bfhi(a1.z) - lam * bfhi(b1.z); o[14] = bflo(a1.w) - lam * bflo(b1.w); o[15] = bfhi(a1.w) - lam * bfhi(b1.w);
        float s = 0.f;
#pragma unroll
        for (int i = 0; i < 16; ++i) s += o[i] * o[i];
        s += __shfl_xor(s, 1); s += __shfl_xor(s, 2); s += __shfl_xor(s, 4);
        const float rstd = 1.f / sqrtf(s * (1.f / 128.f) + EPS);
        v4u w0, w1;
        w0.x = pk2(o[0] * rstd * g[0], o[1] * rstd * g[1]); w0.y = pk2(o[2] * rstd * g[2], o[3] * rstd * g[3]); w0.z = pk2(o[4] * rstd * g[4], o[5] * rstd * g[5]); w0.w = pk2(o[6] * rstd * g[6], o[7] * rstd * g[7]);
        w1.x = pk2(o[8] * rstd * g[8], o[9] * rstd * g[9]); w1.y = pk2(o[10] * rstd * g[10], o[11] * rstd * g[11]); w1.z = pk2(o[12] * rstd * g[12], o[13] * rstd * g[13]); w1.w = pk2(o[14] * rstd * g[14], o[15] * rstd * g[15]);
        *(v4u*)(O0 + (size_t)m * D + 16 * F.lane) = w0; *(v4u*)(O0 + (size_t)m * D + 16 * F.lane + 8) = w1;
    }
}

#ifndef PROBE_SEG
#define PROBE_SEG 0
#endif
#define SEG_T0() do { if (PROBE_SEG != 0 && F.tid == 0) { volatile LAS unsigned long long* pp_ = (volatile LAS unsigned long long*)(F.MI + 16); pp_[0] = __builtin_amdgcn_s_memrealtime(); } } while (0)
#define SEG_T1(id) do { if (PROBE_SEG != 0 && F.tid == 0) { volatile LAS unsigned long long* pp_ = (volatile LAS unsigned long long*)(F.MI + 16); const unsigned long long t_ = __builtin_amdgcn_s_memrealtime(); if (PROBE_SEG == (id)) pp_[1] += t_ - pp_[0]; pp_[0] = t_; } } while (0)
__device__ __forceinline__ void p8_phase(Frame& F, const Args& A) {
    unsigned char* ws = F.ws;
    const float* mod = (const float*)(ws + WS_MOD); const bf16* Y = (const bf16*)(ws + WS_Y);
    signed char* H2 = (signed char*)(ws + WS_H); float* SA = (float*)(ws + WS_SA);
    LAS unsigned char* TH = F.lds; LAS unsigned char* TL = F.lds + 66048;
    LAS float* red = (LAS float*)F.lds;
    LAS int* cntl = (LAS int*)(F.lds + 135168);
    const int tid = F.tid, lane = F.lane, w = F.wave, hi = lane >> 5, l31 = lane & 31;
    int* lists = (int*)(ws + WS_LIST); float* wts = (float*)(ws + WS_WTS);
    v2u yn[2][4]; f32x4 xn[2][4];
    if (F.vcu < T / 32) {
#pragma unroll
        for (int q = 0; q < 2; ++q) { const size_t m = (size_t)F.vcu * 32 + w * 4 + q;
#pragma unroll
            for (int j = 0; j < 4; ++j) { yn[q][j] = *((const GAS v2u*)(Y + m * D) + lane + 64 * j); xn[q][j] = *((const GAS f32x4*)(A.in[0] + m * D) + lane + 64 * j); } } }
#pragma unroll 1
    for (int tl = F.vcu; tl < T / 32; tl += F.G) {
        const int tok0 = tl * 32, b = tok0 / SEQ, chunk = tok0 / TC;
        if (tid < 64) cntl[tid] = 0;
        SEG_T0();
        f32x4 c_gp[4], c_g2[4], c_sh[4];
#pragma unroll
        for (int j = 0; j < 4; ++j) { const int c = 4 * lane + 256 * j; c_gp[j] = *(const f32x4*)(A.in[21] + c) * *(const f32x4*)(mod + b * 6 * D + 2 * D + c);
            c_g2[j] = *(const f32x4*)(A.in[22] + c) * (*(const f32x4*)(mod + b * 6 * D + 4 * D + c) + 1.0f); c_sh[j] = *(const f32x4*)(mod + b * 6 * D + 3 * D + c); }
#pragma unroll 1
        for (int rp = 0; rp < 2; ++rp) {
            f32x4 y[2][4], x[2][4]; float s[2] = {0.f, 0.f};
#pragma unroll
            for (int q = 0; q < 2; ++q)
#pragma unroll
                for (int j = 0; j < 4; ++j) { const v2u yv = yn[q][j]; y[q][j] = (f32x4){bflo(yv.x), bfhi(yv.x), bflo(yv.y), bfhi(yv.y)}; x[q][j] = xn[q][j]; }
            { const int ntl = rp ? tl + F.G : tl, nrp = rp ^ 1;
              if (ntl < T / 32) {
#pragma unroll
                  for (int q = 0; q < 2; ++q) { const size_t m = (size_t)ntl * 32 + w * 4 + nrp * 2 + q;
#pragma unroll
                      for (int j = 0; j < 4; ++j) { yn[q][j] = *((const GAS v2u*)(Y + m * D) + lane + 64 * j); xn[q][j] = *((const GAS f32x4*)(A.in[0] + m * D) + lane + 64 * j); } } } }
#pragma unroll
            for (int q = 0; q < 2; ++q)
#pragma unroll
                for (int j = 0; j < 4; ++j) s[q] += (y[q][j].x * y[q][j].x + y[q][j].y * y[q][j].y) + (y[q][j].z * y[q][j].z + y[q][j].w * y[q][j].w);
            float s2[2] = {0.f, 0.f};
#pragma unroll
            for (int q = 0; q < 2; ++q) { const size_t m = (size_t)tok0 + w * 4 + rp * 2 + q; const float rstd = 1.f / sqrtf(wave_sum_dpp(s[q]) * (1.f / D) + EPS);
#pragma unroll
                for (int j = 0; j < 4; ++j) { x[q][j] = x[q][j] + c_gp[j] * (y[q][j] * rstd); { v2u xb; xb.x = pk2(x[q][j].x, x[q][j].y); xb.y = pk2(x[q][j].z, x[q][j].w); *((v2u*)(F.out + m * D) + lane + 64 * j) = xb; }
                    s2[q] += (x[q][j].x * x[q][j].x + x[q][j].y * x[q][j].y) + (x[q][j].z * x[q][j].z + x[q][j].w * x[q][j].w); } }
#pragma unroll
            for (int q = 0; q < 2; ++q) { const size_t m = (size_t)tok0 + w * 4 + rp * 2 + q; const float rstd2 = 1.f / sqrtf(wave_sum_dpp(s2[q]) * (1.f / D) + EPS);
                f32x4 hh[4]; float amx = 0.f;
#pragma unroll
                for (int j = 0; j < 4; ++j) { const int c = 4 * lane + 256 * j; const f32x4 h = (x[q][j] * rstd2) * c_g2[j] + c_sh[j]; hh[j] = h;
                    amx = fmaxf(amx, fmaxf(fmaxf(fabsf(h.x), fabsf(h.y)), fmaxf(fabsf(h.z), fabsf(h.w))));
                    v2u o; o.x = pk2(h.x, h.y); o.y = pk2(h.z, h.w);
                    *(LAS v2u*)(TH + (w * 4 + rp * 2 + q) * 2064 + c * 2) = o; }
                amx = fmaxf(wave_max_dpp(amx), 1e-20f); const float inv = 127.0f / amx; if (lane == 0) SA[m] = amx * (1.0f / 127.0f);
#pragma unroll
                for (int j = 0; j < 4; ++j) { const int q0 = (int)rintf(hh[j].x * inv), q1 = (int)rintf(hh[j].y * inv), q2 = (int)rintf(hh[j].z * inv), q3 = (int)rintf(hh[j].w * inv);
                    *((GAS unsigned*)(H2 + m * D) + lane + 64 * j) = (unsigned)(q0 & 0xff) | ((unsigned)(q1 & 0xff) << 8) | ((unsigned)(q2 & 0xff) << 16) | ((unsigned)(q3 & 0xff) << 24); } }
        }
        bf16x8 bH0[8], bH1[8];
        { const bf16* whp = (const bf16*)(ws + WS_WRH) + (size_t)l31 * D + 128 * w + 8 * hi;
#pragma unroll
          for (int ks = 0; ks < 8; ++ks) { bH0[ks] = *(const GAS bf16x8*)(whp + ks * 16); bH1[ks] = *(const GAS bf16x8*)(whp + 32 * D + ks * 16); } }
        __syncthreads(); SEG_T1(1);
        f32x16 acc0 = f32x16{}, acc1 = f32x16{};
        { const LAS unsigned char* ahp = TH + l31 * 2064 + (128 * w + 8 * hi) * 2;
#pragma unroll
          for (int ks = 0; ks < 8; ++ks) {
              const bf16x8 aH = *(const LAS bf16x8*)(ahp + ks * 32);
              acc0 = __builtin_amdgcn_mfma_f32_32x32x16_bf16(aH, bH0[ks], acc0, 0, 0, 0); acc1 = __builtin_amdgcn_mfma_f32_32x32x16_bf16(aH, bH1[ks], acc1, 0, 0, 0); } }
        __syncthreads(); SEG_T1(2);
#pragma unroll
        for (int r = 0; r < 16; ++r) { const int tk = (r & 3) + 8 * (r >> 2) + 4 * hi; red[(w * 32 + tk) * 64 + l31] = acc0[r]; red[(w * 32 + tk) * 64 + 32 + l31] = acc1[r]; }
        __syncthreads();
        int sel_e[4], sel_lp[4], sel_slot[4]; float sel_wt[4];
        const float eb = A.in[24][lane];
#pragma unroll
        for (int q = 0; q < 4; ++q) {
            const int tk = 4 * w + q; float lg = 0.f;
#pragma unroll
            for (int ww = 0; ww < 8; ++ww) lg += red[(ww * 32 + tk) * 64 + lane];
            const float score = 1.0f / (1.0f + expf(-lg)); const float ch = score + eb;
            const float m1 = max8_dpp(ch);
            const unsigned long long eq = __ballot(ch == m1); const int gsh = lane & ~7; const unsigned ge = (unsigned)((eq >> gsh) & 0xffull);
            const int first = gsh + __builtin_ctz(ge);
            const float m2 = max8_dpp((lane == first) ? -INFINITY : ch);
            const float gs = m1 + m2; const int g = lane >> 3;
            int grank = 0;
#pragma unroll
            for (int gg = 0; gg < 8; ++gg) { const float og = rl_f(gs, gg * 8); grank += (og > gs || (og == gs && gg < g)) ? 1 : 0; }
            float cur = (grank < 4) ? ch : -INFINITY;
            int rank = TOPK;
#pragma unroll
            for (int kk = 0; kk < TOPK; ++kk) { const float mx = wave_max_dpp(cur); const unsigned long long mk = __ballot(cur == mx); const int fl = (int)__builtin_ctzll(mk);
                if (lane == fl) { rank = kk; cur = -INFINITY; } }
            const bool sel = rank < TOPK;
            const float wsum = wave_sum_dpp(sel ? score : 0.f);
            sel_e[q] = sel ? lane : -1; sel_slot[q] = (tok0 + tk) * 8 + rank; sel_wt[q] = score / (wsum + 1e-20f) * 2.5f;
            sel_lp[q] = sel ? atomicAdd((int*)&cntl[lane], 1) : 0;
        }
        __syncthreads(); SEG_T1(3);
        if (tid < 64) { const int c = cntl[tid]; cntl[64 + tid] = c ? (int)__hip_atomic_fetch_add((unsigned*)(F.ctl + CW_CNT + chunk * 64 + tid), (unsigned)c, RLX_AGENT) : 0; }
        __syncthreads();
#pragma unroll
        for (int q = 0; q < 4; ++q) if (sel_e[q] >= 0) { const int pos = cntl[64 + lane] + sel_lp[q]; lists[((size_t)chunk * 64 + lane) * TC + pos] = sel_slot[q]; wts[sel_slot[q]] = sel_wt[q]; }
        __syncthreads(); SEG_T1(4);
    }
    SEG_T0();
    __syncthreads();
    LAS float* scr = (LAS float*)(F.lds + w * 16384);
    const int gw = F.vcu * NWAVES + w, NGW = F.G * NWAVES;
    constexpr int I13 = 16 * 4, I2 = 4 * 16, PER_E = 2 * I13 + I2;
    for (int it = gw; it < (NEXP + 1) * PER_E; it += NGW) {
        const int e = it / PER_E; int r = it % PER_E;
        const bool sh = (e == NEXP);
        if (r < 2 * I13) { const int w3 = r / I13; r %= I13; const int kb = r >> 2, n0 = 64 * (r & 3);
            const float* W = sh ? (w3 ? A.in[29] : A.in[28]) : ((w3 ? A.in[26] : A.in[25]) + (size_t)e * D * DEXP);
            signed char* WT = sh ? (signed char*)(ws + WS_W13S) : (signed char*)(ws + WS_W13) + (size_t)e * 512 * D;
            const float amx = fmaxf(__uint_as_float(__hip_atomic_load(F.ctl + CW_AMAX + 2 * e + w3, RLX_AGENT)), 1e-30f);
            transpose_item_q(W, D, DEXP, WT, kb, n0, (n0 >> 7) * 256 + (w3 ? 128 : 0) + (n0 & 127), scr, lane, 127.0f / amx); }
        else { r -= 2 * I13; const int kb = r >> 4, n0 = 64 * (r & 15);
            const float* W = sh ? A.in[30] : A.in[27] + (size_t)e * DEXP * D;
            signed char* WT = sh ? (signed char*)(ws + WS_W2S) : (signed char*)(ws + WS_W2) + (size_t)e * D * DEXP;
            transpose_item_q<true>(W, DEXP, D, WT, kb, n0, n0, scr, lane, 16.0f); }
    }
    __syncthreads(); SEG_T1(5);
}

__device__ __forceinline__ int moe_tables(Frame& F, int chunk) {
    __syncthreads();
    if (F.wave == 0) {
        const int cnt = (int)__hip_atomic_load(F.ctl + CW_CNT + chunk * 64 + F.lane, RLX_AGENT);
        const int nt = (cnt + 255) >> 8; int incl = nt;
#pragma unroll
        for (int o = 1; o < 64; o <<= 1) { const int v = __shfl_up(incl, o); if (F.lane >= o) incl += v; }
        const int base = incl - nt;
        F.MI[MI_CNT + F.lane] = cnt; F.MI[MI_TBASE + F.lane] = base; if (F.lane == 63) F.MI[MI_TBASE + NEXP] = incl;
        for (int j = 0; j < nt; ++j) F.MI[MI_TILE_E + base + j] = F.lane; }
    __syncthreads();
    return F.MI[MI_TBASE + NEXP];
}
struct UpOrder {
    const char* ws; volatile LAS int* MI; int nrt_r, nrt, G, c;
    __device__ __forceinline__ bool next(int i, pg8::Unit& u) const { const int L = i * G + c; if (L >= 2 * nrt) return false; u.pm = L >> 1; u.pn = L & 1; u.z = i;
        u.e = (u.pm < nrt_r) ? __builtin_amdgcn_readfirstlane(MI[MI_TILE_E + u.pm]) : NEXP; return true; }
    __device__ __forceinline__ void bases(const pg8::Unit& u, const char*& a, const char*& b) const { a = ws + WS_H; b = (u.e < NEXP ? ws + WS_W13 + (size_t)u.e * 512 * D : ws + WS_W13S) + (size_t)u.pn * 256 * D; }
    __device__ __forceinline__ int tok(int ui, int row) const { return MI[MI_TOK + ui * 256 + row]; }
};
struct EpiSwiglu {
    static constexpr bool PERM = true, TWICE = false; static constexpr int MIN_VM = 8;
    unsigned char* HB; volatile LAS int* MI; gu32* amax;
    __device__ __forceinline__ void operator()(const acc_t& acc, const pg8::Unit& u, int wr, int wc, int fr, int fq) const {
        const int row0 = u.pm * 256 + wr * 64 + fr, col0 = u.pn * 128 + wc * 32 + 8 * fq;
        const float sB1 = __int_as_float(MI[MI_SB + 2 * u.z]), sB3 = __int_as_float(MI[MI_SB + 2 * u.z + 1]);
#pragma unroll
        for (int ai = 0; ai < 2; ++ai)
#pragma unroll
            for (int m = 0; m < 4; ++m) { unsigned char* rowp = HB + (size_t)(row0 + ai * 128 + m * 16) * DEXP + col0;
                const float sA = __int_as_float(MI[MI_SA + u.z * 256 + wr * 64 + fr + ai * 128 + m * 16]); const float s1 = sA * sB1, s3 = sA * sB3;
                float v[8];
                { const pg8::i32x4 A0 = __builtin_bit_cast(pg8::i32x4, acc[ai][0][m][0]), A1 = __builtin_bit_cast(pg8::i32x4, acc[ai][0][m][1]), G0 = __builtin_bit_cast(pg8::i32x4, acc[ai][1][m][0]), G1 = __builtin_bit_cast(pg8::i32x4, acc[ai][1][m][1]);
#pragma unroll
                  for (int i = 0; i < 4; ++i) { float a = (float)A0[i] * s1, g = (float)G0[i] * s3; asm volatile("" : "+v"(a), "+v"(g)); v[i] = a * sigm(a) * g;
                      float a2 = (float)A1[i] * s1, g2 = (float)G1[i] * s3; asm volatile("" : "+v"(a2), "+v"(g2)); v[4 + i] = a2 * sigm(a2) * g2; } }
#pragma unroll
                for (int i = 0; i < 8; ++i) v[i] = __builtin_amdgcn_fmed3f(v[i], -448.0f, 448.0f);
                v2u w; w.x = (unsigned)__builtin_amdgcn_cvt_pk_fp8_f32(v[0], v[1], 0, false); w.x = (unsigned)__builtin_amdgcn_cvt_pk_fp8_f32(v[2], v[3], (int)w.x, true);
                w.y = (unsigned)__builtin_amdgcn_cvt_pk_fp8_f32(v[4], v[5], 0, false); w.y = (unsigned)__builtin_amdgcn_cvt_pk_fp8_f32(v[6], v[7], (int)w.y, true);
                *(v2u*)rowp = w; asm volatile("" ::: "memory"); }
    }
};
struct DownOrder {
    const char* ws; volatile LAS int* MI; int nrt_r, nrt, G, c;
    __device__ __forceinline__ bool next(int i, pg8::Unit& u) const { const int L = i * G + c; if (L >= 4 * nrt) return false; u.pm = L >> 2; u.pn = L & 3; u.z = i;
        u.e = (u.pm < nrt_r) ? __builtin_amdgcn_readfirstlane(MI[MI_TILE_E + u.pm]) : NEXP; return true; }
    __device__ __forceinline__ void bases(const pg8::Unit& u, const char*& a, const char*& b) const { a = ws + WS_HB + (size_t)u.pm * 256 * DEXP; b = (u.e < NEXP ? ws + WS_W2 + (size_t)u.e * D * DEXP : ws + WS_W2S) + (size_t)u.pn * 256 * DEXP; }
    __device__ __forceinline__ int tok(int, int) const { return 0; }
};
struct EpiScatter {
    static constexpr bool PERM = true, TWICE = true; static constexpr int MIN_VM = 0;
    unsigned char* SL; volatile LAS int* MI;
    __device__ __forceinline__ void operator()(const acc_t& acc, const pg8::Unit& u, int wr, int wc, int fr, int fq) const {
        const int col0 = u.pn * 256 + wc * 32 + 8 * fq;
#pragma unroll
        for (int ai = 0; ai < 2; ++ai)
#pragma unroll
            for (int m = 0; m < 4; ++m) { const int rl = wr * 64 + fr + ai * 128 + m * 16; const int dest = MI[MI_TOK + u.z * 256 + rl]; const float wt = 1.0f;
                if (dest >= 0) { unsigned char* rowp = SL + (size_t)dest * D + col0;
#pragma unroll
                    for (int bj = 0; bj < 2; ++bj) { const pg8::f32x4 v0 = acc[ai][bj][m][0], v1 = acc[ai][bj][m][1];
                        float q[8];
#pragma unroll
                        for (int i = 0; i < 4; ++i) { q[i] = __builtin_amdgcn_fmed3f(v0[i] * wt, -448.0f, 448.0f); q[4 + i] = __builtin_amdgcn_fmed3f(v1[i] * wt, -448.0f, 448.0f); }
                        v2u w; w.x = (unsigned)__builtin_amdgcn_cvt_pk_fp8_f32(q[0], q[1], 0, false); w.x = (unsigned)__builtin_amdgcn_cvt_pk_fp8_f32(q[2], q[3], (int)w.x, true);
                        w.y = (unsigned)__builtin_amdgcn_cvt_pk_fp8_f32(q[4], q[5], 0, false); w.y = (unsigned)__builtin_amdgcn_cvt_pk_fp8_f32(q[6], q[7], (int)w.y, true);
                        *(v2u*)(rowp + bj * 128) = w; asm volatile("" ::: "memory"); } } }
    }
};
__device__ __forceinline__ void p2_phase(Frame& F, const Args& A) {
    unsigned char* ws = F.ws;
    DenseOrder S; S.init(ws + WS_H, ws + WS_WIN, T, W_IN, D / 2, F.G, (int)blockIdx.x);
    const float* SH = (const float*)(ws + WS_SH);
    { float v[7]; int pmv[7];
#pragma unroll
      for (int k = 0; k < 7; ++k) { pg8::Unit u; pmv[k] = S.next((F.tid >> 8) + 2 * k, u) ? u.pm : -1; v[k] = pmv[k] >= 0 ? SH[pmv[k] * 256 + (F.tid & 255)] : 0.f; }
#pragma unroll
      for (int k = 0; k < 7; ++k) if (pmv[k] >= 0) F.MI[512 + ((F.tid >> 8) + 2 * k) * 256 + (F.tid & 255)] = __float_as_int(v[k]); }
    __syncthreads();
    EpiProj E{(bf16*)(ws + WS_XR), (bf16*)F.out, F.MI, fmaxf(__uint_as_float(__hip_atomic_load(F.ctl + CW_AMAX + 130, RLX_AGENT)), 1e-30f) * (1.0f / 127.0f)};
    int Kk = D / 2; asm volatile("" : "+s"(Kk));
    pg8::gemm_phase<EpiProj, DenseOrder, true, false, true>(F.lds, F.tid, Kk, S, E);
}
__device__ __forceinline__ void moe_up(Frame& F, int chunk) {
    unsigned char* ws = F.ws;
    const int nrt_r = moe_tables(F, chunk), nrt = nrt_r + TC / 256;
    const int* lists = (const int*)(ws + WS_LIST);
    int* rdest = (int*)(ws + WS_RDEST);
    { const int r = F.tid & 255; int tokn[3], dest[3], slot[3]; float sa[3]; bool act[3]; int rt_[3];
#pragma unroll
      for (int k = 0; k < 3; ++k) { const int i = (F.tid >> 8) + 2 * k, L = i * F.G + F.vcu, rt = L >> 1; act[k] = L < 2 * nrt; rt_[k] = rt; slot[k] = -1; tokn[k] = chunk * TC; dest[k] = -1;
          if (act[k]) { if (rt < nrt_r) { const int e = F.MI[MI_TILE_E + rt]; const int idx = (rt - F.MI[MI_TBASE + e]) * 256 + r; if (idx < F.MI[MI_CNT + e]) slot[k] = lists[((size_t)chunk * 64 + e) * TC + idx]; }
              else { tokn[k] = chunk * TC + (rt - nrt_r) * 256 + r; dest[k] = TC * 8 + (rt - nrt_r) * 256 + r; } } }
#pragma unroll
      for (int k = 0; k < 3; ++k) if (slot[k] >= 0) { tokn[k] = slot[k] >> 3; dest[k] = slot[k] - chunk * TC * 8; }
#pragma unroll
      for (int k = 0; k < 3; ++k) sa[k] = ((const float*)(ws + WS_SA))[tokn[k]];
#pragma unroll
      for (int k = 0; k < 3; ++k) if (act[k]) { const int i = (F.tid >> 8) + 2 * k, L = i * F.G + F.vcu;
          F.MI[MI_TOK + i * 256 + r] = tokn[k]; F.MI[MI_SA + i * 256 + r] = __float_as_int(sa[k]);
          if ((L & 1) == 0) rdest[rt_[k] * 256 + r] = dest[k]; }
      if (F.tid < 12) { const int i = F.tid >> 1, rr = F.tid & 1, L = i * F.G + F.vcu;
          if (L < 2 * nrt) { const int rt = L >> 1; const int e_ = (rt < nrt_r) ? F.MI[MI_TILE_E + rt] : NEXP;
              F.MI[MI_SB + 2 * i + rr] = __float_as_int(fmaxf(__uint_as_float(__hip_atomic_load(F.ctl + CW_AMAX + 2 * e_ + rr, RLX_AGENT)), 1e-30f) * (1.0f / 127.0f)); } } }
    __syncthreads();
    UpOrder S{(const char*)ws, F.MI, nrt_r, nrt, F.G, F.vcu};
    EpiSwiglu E{ws + WS_HB, F.MI, F.ctl + CW_AMAX};
    int Kk = D / 2; asm volatile("" : "+s"(Kk));
    pg8::gemm_phase<EpiSwiglu, UpOrder, true, true, true>(F.lds, F.tid, Kk, S, E);
}
__device__ __forceinline__ void moe_down(Frame& F, int chunk) {
    unsigned char* ws = F.ws;
    __syncthreads();
    const int nrt_r = F.MI[MI_TBASE + NEXP], nrt = nrt_r + TC / 256;
    { const int* rdest = (const int*)(ws + WS_RDEST) + (F.tid & 255); int v[5];
#pragma unroll
      for (int k = 0; k < 5; ++k) { const int L = ((F.tid >> 8) + 2 * k) * F.G + F.vcu; v[k] = (L < 4 * nrt) ? rdest[(L >> 2) * 256] : -1; }
#pragma unroll
      for (int k = 0; k < 5; ++k) { const int i = (F.tid >> 8) + 2 * k, L = i * F.G + F.vcu; if (L < 4 * nrt) F.MI[MI_TOK + i * 256 + (F.tid & 255)] = v[k]; } }
    __syncthreads();
    DownOrder S{(const char*)ws, F.MI, nrt_r, nrt, F.G, F.vcu};
    EpiScatter E{ws + WS_SLOT, F.MI};
    int Kk = DEXP / 2; asm volatile("" : "+s"(Kk));
    pg8::gemm_phase<EpiScatter, DownOrder, false, false, 2>(F.lds, F.tid, Kk, S, E);
}
__device__ __forceinline__ void moe_combine(Frame& F, const Args& A, int chunk, bool poison) {
    unsigned char* ws = F.ws;
    const float* mod = (const float*)(ws + WS_MOD); const unsigned char* SL = ws + WS_SLOT; const float* wts = (const float*)(ws + WS_WTS);
    const int gw = F.vcu * NWAVES + F.wave, NGW = F.G * NWAVES;
    f32x4 gpv[4];
#pragma unroll
    for (int j = 0; j < 4; ++j) gpv[j] = *(const f32x4*)(A.in[31] + 4 * F.lane + 256 * j);
    unsigned dA[9][4], dB[9][4]; v2u xA[4], xB[4];
#define CB_LOAD(tl_, d_, x_) do { const int t_ = __builtin_amdgcn_readfirstlane(tl_);        \
        _Pragma("unroll") for (int j = 0; j < 4; ++j) x_[j] = *((const GAS v2u*)(F.out + ((size_t)chunk * TC + t_) * D) + F.lane + 64 * j); \
        asm volatile("" ::: "memory"); \
        const GAS unsigned* b0_ = (const GAS unsigned*)(SL + (size_t)t_ * 8 * D) + F.lane; const GAS unsigned* b1_ = b0_ + 4 * (D / 4); \
        const GAS unsigned* b2_ = (const GAS unsigned*)(SL + ((size_t)TC * 8 + t_) * D) + F.lane;         \
        _Pragma("unroll") for (int k = 0; k < 9; ++k) \
            _Pragma("unroll") for (int j = 0; j < 4; ++j) d_[k][j] = (k < 4 ? b0_ : k < 8 ? b1_ : b2_)[(k < 8 ? (k & 3) : 0) * (D / 4) + 64 * j]; } while (0)
#define CB_REDUCE(tl_, d_, x_) do { const int t_ = __builtin_amdgcn_readfirstlane(tl_); const size_t m = (size_t)chunk * TC + t_; const int b = (int)(m / SEQ); \
        f32x4 gt[4]; _Pragma("unroll") for (int j = 0; j < 4; ++j) gt[j] = *(const f32x4*)(mod + b * 6 * D + 5 * D + 4 * F.lane + 256 * j); \
        const float wl_ = (F.lane < 8) ? wts[m * 8 + F.lane] : 1.0f;        \
        f32x4 y[4]; \
        _Pragma("unroll") for (int j = 0; j < 4; ++j) y[j] = (f32x4){0.f, 0.f, 0.f, 0.f}; \
        _Pragma("unroll") for (int k = 0; k < 9; ++k) { const float wk_ = (k < 8) ? rl_f(wl_, k) : 1.0f; _Pragma("unroll") for (int j = 0; j < 4; ++j) { const int dd = (int)d_[k][j]; \
            const auto lo_ = __builtin_amdgcn_cvt_pk_f32_fp8(dd, false); const auto hi_ = __builtin_amdgcn_cvt_pk_f32_fp8(dd, true); \
            y[j].x = __builtin_fmaf(lo_[0], wk_, y[j].x); y[j].y = __builtin_fmaf(lo_[1], wk_, y[j].y); y[j].z = __builtin_fmaf(hi_[0], wk_, y[j].z); y[j].w = __builtin_fmaf(hi_[1], wk_, y[j].w); } \
            __builtin_amdgcn_sched_barrier(0); } \
        _Pragma("unroll") for (int j = 0; j < 4; ++j) y[j] = y[j] * 0.0625f; \
        float s = 0.f; \
        _Pragma("unroll") for (int j = 0; j < 4; ++j) s += (y[j].x * y[j].x + y[j].y * y[j].y) + (y[j].z * y[j].z + y[j].w * y[j].w); \
        const float rstd = 1.f / sqrtf(wave_sum(s) * (1.f / D) + EPS); \
        asm volatile("" ::: "memory"); \
        _Pragma("unroll") for (int j = 0; j < 4; ++j) { f32x4* op = (f32x4*)(F.out + m * D) + F.lane + 64 * j; const v2u xb = x_[j]; \
            f32x4 o = (f32x4){bflo(xb.x), bfhi(xb.x), bflo(xb.y), bfhi(xb.y)} + gt[j] * (y[j] * rstd * gpv[j]); \
            if (poison) { const float q_ = __builtin_nanf(""); o = (f32x4){q_, q_, q_, q_}; } \
            *op = o; } } while (0)
    for (int tl = gw; tl < TC; tl += NGW) { CB_LOAD(tl, dA, xA); CB_REDUCE(tl, dA, xA); }
#undef CB_LOAD
#undef CB_REDUCE
}

__device__ __forceinline__ void attn_phase(Frame& F, const Args& A, char* lds_generic) {
    const attn_body::bf16* Q = (const attn_body::bf16*)(F.ws + WS_Q); const attn_body::bf16* K = (const attn_body::bf16*)(F.ws + WS_K); const attn_body::bf16* V = (const attn_body::bf16*)(F.ws + WS_V);
    attn_body::bf16* O = (attn_body::bf16*)(F.ws + WS_H);
    const float d1 = A.in[13][F.lane] * A.in[14][F.lane], d2 = A.in[15][F.lane] * A.in[16][F.lane];
    const float lam = expf(wave_sum(d1)) - expf(wave_sum(d2)) + LAM_INIT;
    const int npr = (BATCH * 16 - F.vcu + F.G - 1) / F.G;
#pragma unroll 1
    for (int it = 0; it < npr * 8; ++it) {
        const int pr = F.vcu + (it >> 3) * F.G, qi = (it >> 1) & 3, m = it & 1;
        const int pair = pr >> 1, st = pr & 1, b = pair >> 3, h = pair & 7;
        const int qb = st ? (qi == 0 ? 6 : qi == 1 ? 5 : qi == 2 ? 2 : 1) : (qi == 0 ? 7 : qi == 1 ? 4 : qi == 2 ? 3 : 0);
        const float sl2 = exp2f(-(float)(h + 1)) * LOG2E;
        if (m == 0) attn_body::attn_unit2<8, false>(F.tid, b, h, 0, qb, sl2, lam, A.in[17], Q, K, V, O, lds_generic);
        else        attn_body::attn_unit2<8, true >(F.tid, b, h, 1, qb, sl2, lam, A.in[17], Q, K, V, O, lds_generic);
    }
}

__global__ void __launch_bounds__(NWAVES * 64, 2) hybrid_fwd(Args args) {
    extern __shared__ __attribute__((aligned(16))) unsigned char lds[];
    Frame F;
    F.lds = (LAS unsigned char*)lds;
    F.MI = (volatile LAS int*)(F.lds + MISC_OFF);
    F.tid = threadIdx.x; F.lane = F.tid & 63; F.wave = __builtin_amdgcn_readfirstlane(F.tid >> 6);
    F.G = gridDim.x; { const int bx = blockIdx.x; F.vcu = (F.G % 8 == 0) ? (bx % 8) * (F.G / 8) + bx / 8 : bx; }
    unsigned char* ws = args.ws; F.ws = ws; F.out = args.out;
    F.ctl = (gu32*)(ws + WS_CTL);
    for (int u = F.tid; u < MI_WORDS; u += NWAVES * 64) F.MI[u] = 0;
    __syncthreads();
    XcdBarrier bar; bar.bar = (unsigned*)(F.ctl + CW_BAR); bar.x = 0; bar.st = nullptr;
    if (!PER_PHASE) bar = xcd_barrier_post((unsigned*)(F.ctl + CW_BAR), (volatile LAS unsigned*)(F.MI + MI_BARST));
    const int lo = args.ph_lo, hi = args.ph_hi;
#ifndef PH_MASK
#define PH_MASK 0xFFFFFFFFu
#endif
#ifndef PROBE_MASK
#define PROBE_MASK 0u
#endif
#define PSTAMP(k) do { if (PROBE_MASK != 0u && F.tid == 0) { const unsigned long long t_ = __builtin_amdgcn_s_memrealtime(); volatile LAS unsigned long long* pp_ = (volatile LAS unsigned long long*)(F.MI + 16); \
        if ((PROBE_MASK >> (k)) & 1u) pp_[1] += t_ - pp_[0]; pp_[0] = t_; } } while (0)
#define FRESH() do { size_t z_ = 0; asm volatile("" : "+s"(z_)); unsigned char* w_ = args.ws + z_;        F.ws = w_; ws = w_; F.ctl = (gu32*)(w_ + WS_CTL); int t_ = threadIdx.x; asm volatile("" : "+v"(t_)); F.tid = t_; F.lane = t_ & 63; F.wave = __builtin_amdgcn_readfirstlane(t_ >> 6); } while (0)
    if ((PROBE_MASK != 0u || PROBE_SEG != 0) && F.tid == 0) { volatile LAS unsigned long long* pp_ = (volatile LAS unsigned long long*)(F.MI + 16); pp_[0] = __builtin_amdgcn_s_memrealtime(); pp_[1] = 0ull; }
#define IN(k) (((PH_MASK >> (k)) & 1u) && lo <= (k) && (k) < hi)
#define SEAM(k) do { if (IN(k) && IN((k) + 1)) { if (PER_PHASE) { if (F.tid == 0) __hip_atomic_store(F.ctl + CW_TMO, 0xBADBA0u, RLX_AGENT); } else xcd_barrier(bar); } PSTAMP(k); } while (0)
    if (IN(0)) { FRESH(); p0_phase(F, args); } SEAM(0);
    if (IN(1)) { FRESH(); p1_phase(F, args); } SEAM(1);
    if (IN(2)) { FRESH(); p2_phase(F, args); } SEAM(2);
    if (IN(3)) { FRESH(); lru_phase(F, args); } if (PER_PHASE) { SEAM(3); } else { PSTAMP(3); }
    if (IN(4)) { FRESH(); attn_phase(F, args, (char*)lds); } SEAM(4);
    if (PER_PHASE) { SEAM(5); }
    if (IN(6)) { FRESH(); MergeOrder S; S.d.init(ws + WS_GR, ws + WS_WR, T, D, D, F.G, (int)blockIdx.x); S.A1 = (const char*)(ws + WS_H); S.B1 = (const char*)(ws + WS_WA);
        EpiGate E{(const unsigned char*)args.out, (const unsigned char*)args.out + (size_t)T * D, (bf16*)(ws + WS_V), (bf16*)(ws + WS_XR)};
        pg8::gemm_phase<EpiGate, MergeOrder, true, false>(F.lds, F.tid, D, S, E); } SEAM(6);
    if (IN(7)) { FRESH(); DenseOrder S; S.init(ws + WS_XR, ws + WS_WO, T, D, D, F.G, (int)blockIdx.x); EpiF32 E{(bf16*)(ws + WS_Y)};
        pg8::gemm_phase<EpiF32, DenseOrder, true, false>(F.lds, F.tid, D, S, E); } SEAM(7);
    if (IN(8)) { FRESH(); p8_phase(F, args); } SEAM(8);
#pragma unroll 1
    for (int c = 0; c < NCH; ++c) {
        const int pa = 9 + 2 * c, pb = 10 + 2 * c;
        if (IN(pa)) { FRESH(); if (c > 0) { int cm = c - 1; asm volatile("" : "+s"(cm)); moe_combine(F, args, cm, false); FRESH(); } int cu = c; asm volatile("" : "+s"(cu)); moe_up(F, cu); } SEAM(pa);
        if (IN(pb)) { FRESH(); int cd = c; asm volatile("" : "+s"(cd)); moe_down(F, cd); } SEAM(pb);
    }
    if (IN(9 + 2 * NCH)) { FRESH();
        bool poison = __hip_atomic_load(F.ctl + CW_TMO, RLX_AGENT) != 0u || __hip_atomic_load(F.ctl + CW_BAR + XB_TMO, RLX_AGENT) != 0u;
        moe_combine(F, args, NCH - 1, poison);
    }
    PSTAMP(17);
#undef IN
#undef SEAM
    if (PROBE_MASK != 0u || PROBE_SEG != 0) { __syncthreads(); if (F.tid == 0) { volatile LAS unsigned long long* pp_ = (volatile LAS unsigned long long*)(F.MI + 16);
        unsigned long long acc_ = pp_[1]; const unsigned long long t2_ = __builtin_amdgcn_s_memrealtime();
        while (__builtin_amdgcn_s_memrealtime() - t2_ < acc_) __builtin_amdgcn_s_sleep(8); } __syncthreads(); }
}

extern "C" void kernel_launch(void* const* d_in, const int* in_sizes, int n_in, void* d_out, int out_size, void* d_ws, size_t ws_size, hipStream_t stream) {
    static int grid = 0;
    if (grid == 0) {
        if (n_in != 32 || out_size != T * D || ws_size < WS_END) { fprintf(stderr, "kernel_launch: unexpected shapes (n_in %d, out %d, ws %zu); nothing launched\n", n_in, out_size, ws_size); grid = -1; return; }
        int dev = 0, cus = 0, per_cu = 0;
        if (hipGetDevice(&dev) != hipSuccess || hipDeviceGetAttribute(&cus, hipDeviceAttributeMultiprocessorCount, dev) != hipSuccess) { grid = -1; return; }
        if (hipFuncSetAttribute((const void*)hybrid_fwd, hipFuncAttributeMaxDynamicSharedMemorySize, LDS_BYTES) != hipSuccess) { fprintf(stderr, "kernel_launch: hipFuncSetAttribute failed\n"); grid = -1; return; }
        if (hipOccupancyMaxActiveBlocksPerMultiprocessor(&per_cu, (const void*)hybrid_fwd, NWAVES * 64, LDS_BYTES) != hipSuccess || per_cu < 1) { fprintf(stderr, "kernel_launch: occupancy query says %d blocks per CU\n", per_cu); per_cu = 1; }
        (void)hipGetLastError();
        grid = cus;
    }
    if (grid < 0) return;
    (void)hipMemsetAsync((char*)d_ws + WS_CTL, 0, CTL_ZERO_BYTES, stream);
    Args a{};
    for (int i = 0; i < 32; ++i) a.in[i] = (const float*)d_in[i];
    a.out = (float*)d_out; a.ws = (unsigned char*)d_ws;
    if (N_LAUNCHES == 1) { a.ph_lo = 0; a.ph_hi = N_PHASES; hipLaunchKernelGGL(hybrid_fwd, dim3(grid), dim3(NWAVES * 64), LDS_BYTES, stream, a); }
    else for (int p = 0; p < N_PHASES; ++p) { a.ph_lo = p; a.ph_hi = p + 1; hipLaunchKernelGGL(hybrid_fwd, dim3(grid), dim3(NWAVES * 64), LDS_BYTES, stream, a); }
}
```

```cpp
#include <hip/hip_runtime.h>
#include <hip/hip_bf16.h>
#include <cstdio>
#include <cstdint>
#include <cmath>

#ifndef MK_N_LAUNCHES
#define MK_N_LAUNCHES 1
#endif

constexpr int BATCH = 16, SEQ = 2048, D = 1024, T = BATCH * SEQ;
constexpr int W_IN = 7 * 1024;
constexpr int NEXP = 64, TOPK = 8, DEXP = 256;
constexpr int NCH = 1, TC = T / NCH;
constexpr float EPS = 1e-6f;
constexpr float LOG2E = 1.4426950408889634f;
constexpr float LAM_INIT = 0.2f;

namespace pg8 {
#define PG8_LAS __attribute__((address_space(3)))
typedef unsigned short bf16_t;
typedef short bf16x8 __attribute__((ext_vector_type(8)));
typedef float f32x4 __attribute__((ext_vector_type(4)));
typedef unsigned u32x4 __attribute__((ext_vector_type(4)));
constexpr int BM = 256, BK = 64, HALF = 128, HTB = HALF * BK * 2, STAGE_BYTES = 8 * HTB, NXCD = 8, WGM = 8;

__host__ __device__ __forceinline__ int lds_byte(int r, int c) { const int st = (r >> 4) * 2 + (c >> 5), rr = r & 15, cc = c & 31, ob = rr * 64 + cc * 2; return st * 1024 + (ob ^ (((ob >> 9) & 1) << 5)); }
__host__ __device__ __forceinline__ void stage_rc(int b, int& R, int& C) { const int st = b / 1024, sb = b % 1024, swz = sb ^ (((sb >> 9) & 1) << 5); R = (st >> 1) * 16 + swz / 64; C = (st & 1) * 32 + (swz % 64) / 2; }
__host__ __device__ __forceinline__ int perm32(int rho) { const int n = rho >> 4, i = rho & 15; return 8 * (i >> 2) + 4 * n + (i & 3); }

struct Unit { int pm, pn, z, e; };

__device__ __forceinline__ unsigned cvt_pk_bf16(float lo, float hi) { unsigned r; asm volatile("v_cvt_pk_bf16_f32 %0, %1, %2" : "=v"(r) : "v"(lo), "v"(hi)); return r; }
__device__ __forceinline__ float sigm(float x) { return __builtin_amdgcn_rcpf(1.0f + __builtin_amdgcn_exp2f(-LOG2E * x)); }
__device__ __forceinline__ float gelu_t(float x) { const float u = 0.7978845608028654f * (x + 0.044715f * x * x * x); return x * sigm(2.0f * u); }
__device__ __forceinline__ float bflo(unsigned w) { return __uint_as_float(w << 16); }
__device__ __forceinline__ float bfhi(unsigned w) { return __uint_as_float(w & 0xffff0000u); }

typedef int i32x4 __attribute__((ext_vector_type(4)));
typedef int i32x8 __attribute__((ext_vector_type(8)));
template <class Epi, class Sched, bool ALIGN_EPI, bool GATHER, int INT8 = 0>
__device__ __forceinline__ void gemm_phase(PG8_LAS unsigned char* lds, const int tid, const int K, const Sched& S, const Epi& E) {
    const int wid = __builtin_amdgcn_readfirstlane(tid >> 6), lane = tid & 63, wr = wid >> 2, wc = wid & 3, fr = lane & 15, fq = lane >> 4;
    const int nt = K / BK;
    unsigned voffA[2], voffB[2];
#pragma unroll
    for (int i = 0; i < 2; ++i) { int R, C; stage_rc(tid * 16 + i * 8192, R, C); const int Rb = Epi::PERM ? ((R & ~31) + perm32(R & 31)) : R;
        voffA[i] = (unsigned)(R * K + C) * 2u; voffB[i] = (unsigned)(Rb * K + C) * 2u; }
    const size_t kstep = (size_t)(BK * 2);
    const size_t hstep = (size_t)HALF * K * 2;
    const unsigned ldsw = (unsigned)wid * 1024u;
    const int aoff = lds_byte(wr * 64 + fr, fq * 8), boff = lds_byte(wc * 32 + fr, fq * 8);
#define PG8_SA(b, h) (((b) * 2 + (h)) * HTB)
#define PG8_SB(b, h) ((4 + (b) * 2 + (h)) * HTB)
#define PG8_STAGE(bufoff, gbase, voff) do { _Pragma("unroll") for (int _i = 0; _i < 2; ++_i) \
        __builtin_amdgcn_global_load_lds((const unsigned*)((const char*)(gbase) + (voff)[_i]), (PG8_LAS unsigned*)(lds + (bufoff) + ldsw + _i * 8192), 16, 0, 0); } while (0)
#define PG8_STAGE_A(bufoff, p, h, VG) do { if constexpr (GATHER) { PG8_STAGE(bufoff, p, VG[h]); } else { PG8_STAGE(bufoff, (p) + (h) * hstep, voffA); } } while (0)
#define PG8_LDA(dst, b, h) do { _Pragma("unroll") for (int m = 0; m < 4; ++m) _Pragma("unroll") for (int k = 0; k < 2; ++k) dst[m][k] = *(const PG8_LAS bf16x8*)(lds + PG8_SA(b, h) + aoff + m * 2048 + k * 1024); } while (0)
#define PG8_LDB(dst, b, h) do { _Pragma("unroll") for (int n = 0; n < 2; ++n) _Pragma("unroll") for (int k = 0; k < 2; ++k) dst[n][k] = *(const PG8_LAS bf16x8*)(lds + PG8_SB(b, h) + boff + n * 2048 + k * 1024); } while (0)
#define PG8_MMA(ai, bj, At, Bt) do { __builtin_amdgcn_s_setprio(1); _Pragma("unroll") for (int m = 0; m < 4; ++m) _Pragma("unroll") for (int n = 0; n < 2; ++n) _Pragma("unroll") for (int k = 0; k < 2; ++k) \
        { if constexpr (INT8 == 2) { if (k == 0) { const i32x4 b0_ = __builtin_bit_cast(i32x4, Bt[n][0]), b1_ = __builtin_bit_cast(i32x4, Bt[n][1]), a0_ = __builtin_bit_cast(i32x4, At[m][0]), a1_ = __builtin_bit_cast(i32x4, At[m][1]); \
              const i32x8 b8_ = __builtin_shufflevector(b0_, b1_, 0, 1, 2, 3, 4, 5, 6, 7), a8_ = __builtin_shufflevector(a0_, a1_, 0, 1, 2, 3, 4, 5, 6, 7); \
              asm volatile("v_mfma_f32_16x16x128_f8f6f4 %0, %1, %2, %0" : "+v"(acc[ai][bj][m][n]) : "v"(b8_), "v"(a8_)); } }        \
          else if constexpr (INT8 == 1) acc[ai][bj][m][n] = __builtin_bit_cast(f32x4, __builtin_amdgcn_mfma_i32_16x16x64_i8(__builtin_bit_cast(i32x4, Bt[n][k]), __builtin_bit_cast(i32x4, At[m][k]), __builtin_bit_cast(i32x4, acc[ai][bj][m][n]), 0, 0, 0)); \
          else acc[ai][bj][m][n] = __builtin_amdgcn_mfma_f32_16x16x32_bf16(Bt[n][k], At[m][k], acc[ai][bj][m][n], 0, 0, 0); } __builtin_amdgcn_s_setprio(0); } while (0)
#define PG8_WAIT_V(n) asm volatile("s_waitcnt vmcnt(" #n ")" ::: "memory")
#define PG8_WAIT_VR(rx) do { if constexpr (Epi::MIN_VM > 0) { const int rx_ = __builtin_amdgcn_readfirstlane((rx) ? 1 : 0); asm volatile("s_waitcnt vmcnt(%1)\n\ts_cmp_lg_u32 %0, 0\n\ts_cbranch_scc1 1\n\ts_waitcnt vmcnt(8)" :: "s"(rx_), "n"(8 + Epi::MIN_VM) : "memory", "scc"); } else PG8_WAIT_V(8); } while (0)
#define PG8_WAIT_L(n) asm volatile("s_waitcnt lgkmcnt(" #n ")" ::: "memory")
#define PG8_BAR __builtin_amdgcn_s_barrier()
#define PG8_SCHED __builtin_amdgcn_sched_barrier(0)
#define PG8_LOADVG(VG, ui_) do { if constexpr (GATHER) { _Pragma("unroll") for (int h_ = 0; h_ < 2; ++h_) _Pragma("unroll") for (int i_ = 0; i_ < 2; ++i_) \
        { int R_, C_; stage_rc(tid * 16 + i_ * 8192, R_, C_); VG[h_][i_] = ((unsigned)S.tok((ui_), h_ * HALF + R_) * (unsigned)K + (unsigned)C_) * 2u; } } } while (0)
    Unit cur, nxt; int ui = 0;
    if (!S.next(0, cur)) return;
    f32x4 acc[2][2][4][2];
#pragma unroll
    for (int a = 0; a < 2; ++a)
#pragma unroll
        for (int b = 0; b < 2; ++b)
#pragma unroll
            for (int m = 0; m < 4; ++m)
#pragma unroll
                for (int n = 0; n < 2; ++n) acc[a][b][m][n] = (f32x4){0.f, 0.f, 0.f, 0.f};
    bf16x8 At[4][2], B0[2][2], B1[2][2];
    unsigned vgc[2][2];
#pragma unroll
    for (int h_ = 0; h_ < 2; ++h_)
#pragma unroll
        for (int i_ = 0; i_ < 2; ++i_) vgc[h_][i_] = 0u;
    PG8_LOADVG(vgc, 0);
    const char *cA, *cB; S.bases(cur, cA, cB);
    PG8_STAGE(PG8_SB(0, 0), cB, voffB); PG8_STAGE(PG8_SB(0, 1), cB + hstep, voffB); PG8_STAGE_A(PG8_SA(0, 0), cA, 0, vgc); PG8_STAGE_A(PG8_SA(0, 1), cA, 1, vgc);
    if (wr == 1) PG8_BAR;
    PG8_WAIT_V(2); PG8_BAR;
    PG8_STAGE(PG8_SB(1, 0), cB + kstep, voffB); PG8_STAGE_A(PG8_SA(1, 0), cA + kstep, 0, vgc); PG8_STAGE(PG8_SB(1, 1), cB + hstep + kstep, voffB);
    PG8_WAIT_V(6); PG8_BAR;
    for (;;) {
        const bool has_next = S.next(ui + 1, nxt);
        const char *nA = cA, *nB = cB;
        if (has_next) S.bases(nxt, nA, nB);
        for (int t = 0; t < nt; t += 2) {
            const bool last = (t == nt - 2);
            const char* a1 = cA + (size_t)(t + 1) * kstep;
            const char* a2 = last ? nA : cA + (size_t)(t + 2) * kstep; const char* b2 = last ? nB : cB + (size_t)(t + 2) * kstep;
            const char* a3 = a2 + kstep; const char* b3 = b2 + kstep;
            unsigned vgs[2][2];
#pragma unroll
            for (int h_ = 0; h_ < 2; ++h_)
#pragma unroll
                for (int i_ = 0; i_ < 2; ++i_) vgs[h_][i_] = vgc[h_][i_];
            if (last && has_next) PG8_LOADVG(vgs, ui + 1);
            const bool relax = (t == 0) && (ui > 0);
            PG8_LDB(B0, 0, 0); PG8_LDB(B1, 0, 1); PG8_SCHED; PG8_LDA(At, 0, 0); PG8_STAGE_A(PG8_SA(1, 1), a1, 1, vgc);
            PG8_WAIT_VR(relax); PG8_WAIT_L(0); PG8_BAR; PG8_MMA(0, 0, At, B0); PG8_MMA(0, 1, At, B1); PG8_BAR; PG8_SCHED;
            PG8_LDA(At, 0, 1); PG8_STAGE(PG8_SB(0, 0), b2, voffB); PG8_STAGE(PG8_SB(0, 1), b2 + hstep, voffB); PG8_STAGE_A(PG8_SA(0, 0), a2, 0, vgs);
            PG8_WAIT_VR(relax); PG8_WAIT_L(0); PG8_BAR; PG8_MMA(1, 0, At, B0); PG8_MMA(1, 1, At, B1); PG8_BAR; PG8_SCHED;
            PG8_LDB(B0, 1, 0); PG8_LDB(B1, 1, 1); PG8_SCHED; PG8_LDA(At, 1, 0); PG8_STAGE_A(PG8_SA(0, 1), a2, 1, vgs);
            PG8_WAIT_V(8); PG8_WAIT_L(0); PG8_BAR; PG8_MMA(0, 0, At, B0); PG8_MMA(0, 1, At, B1); PG8_BAR; PG8_SCHED;
            PG8_LDA(At, 1, 1); PG8_STAGE(PG8_SB(1, 0), b3, voffB); PG8_STAGE(PG8_SB(1, 1), b3 + hstep, voffB); PG8_STAGE_A(PG8_SA(1, 0), a3, 0, vgs);
            PG8_WAIT_V(8); PG8_WAIT_L(0); PG8_BAR; PG8_MMA(1, 0, At, B0); PG8_MMA(1, 1, At, B1); PG8_BAR; PG8_SCHED;
        }
        if constexpr (ALIGN_EPI) { if (wr == 0) PG8_BAR; }
        E(acc, cur, wr, wc, fr, fq);
#ifdef PROBE_EPI2
        if (Epi::TWICE) { asm volatile("" ::: "memory"); E(acc, cur, wr, wc, fr, fq); }
#endif
        if (!has_next) break;
#pragma unroll
        for (int a = 0; a < 2; ++a)
#pragma unroll
            for (int b = 0; b < 2; ++b)
#pragma unroll
                for (int m = 0; m < 4; ++m)
#pragma unroll
                    for (int n = 0; n < 2; ++n) acc[a][b][m][n] = (f32x4){0.f, 0.f, 0.f, 0.f};
        cur = nxt; cA = nA; cB = nB; ++ui;
        PG8_LOADVG(vgc, ui);
        if constexpr (ALIGN_EPI) { if (wr == 1) PG8_BAR; }
    }
    PG8_WAIT_V(0);
    if constexpr (!ALIGN_EPI) { if (wr == 0) PG8_BAR; }
    PG8_BAR;
#undef PG8_SA
#undef PG8_SB
#undef PG8_STAGE
#undef PG8_STAGE_A
#undef PG8_LDA
#undef PG8_LDB
#undef PG8_MMA
#undef PG8_WAIT_V
#undef PG8_WAIT_VR
#undef PG8_WAIT_L
#undef PG8_BAR
#undef PG8_SCHED
#undef PG8_LOADVG
}
}

namespace attn_body {
using bf16=__hip_bfloat16;
using bf16x8=__attribute__((ext_vector_type(8)))short;
using s16x4=__attribute__((ext_vector_type(4)))short;
using f32x16=__attribute__((ext_vector_type(16)))float;
using u32x4=__attribute__((ext_vector_type(4)))unsigned;
constexpr int NHEAD=16,SEQ=2048,D=64,DM=NHEAD*D;
constexpr int NW=8,QBLK=32,QB=QBLK*NW,KVBLK=64,NQB=SEQ/QB;
__device__ __forceinline__ int crow(int r,int hi){return (r&3)+8*(r>>2)+4*hi;}
#define SBAR() __builtin_amdgcn_sched_barrier(0)
__device__ __forceinline__ void cmask(f32x16&p0,f32x16&p1,int jb,int qrel,int hi){
  const float NEG=-INFINITY; const int dq=qrel-(64*jb+4*hi);
  #pragma unroll
  for(int r=0;r<16;++r){const int kc=(r&3)+8*(r>>2); if(kc>dq)p0[r]=NEG; if(kc+32>dq)p1[r]=NEG;}
}
__device__ __forceinline__ void cinit(f32x16&p0,f32x16&p1,float sl2,float nv){
  #pragma unroll
  for(int r=0;r<16;++r){const float c=(float)((r&3)+8*(r>>2)); p0[r]=__builtin_fmaf(sl2,c,nv); p1[r]=__builtin_fmaf(sl2,c+32.0f,nv);}
}
#define CI_C(r) ((float)(((r)&3)+8*((r)>>2)))

constexpr int NSLOT=3, SLOTB=8192;
constexpr int LDS_K=0, LDS_V=NSLOT*SLOTB, LDS_WS=2*NSLOT*SLOTB, LDS_OST=LDS_WS+NW*64*4, LDS_BYTES=LDS_OST+NW*4096;
constexpr float C2=0.125f*1.4426950408889634f;
__device__ __forceinline__ void glds16(const void*gsrc,unsigned lds_dst){unsigned keep;
  asm volatile("s_mov_b32 %0, m0\n\ts_mov_b32 m0, %2\n\ts_nop 0\n\tglobal_load_lds_dwordx4 %1, off\n\ts_mov_b32 m0, %0":"=&s"(keep):"v"(gsrc),"s"(lds_dst):"memory");}
__device__ __forceinline__ float max3f(float a,float b,float c){float r;asm("v_max3_f32 %0, %1, %2, %3":"=v"(r):"v"(a),"v"(b),"v"(c));return r;}
__device__ __forceinline__ float max2f(float a,float b){float r;asm("v_max_f32_e32 %0, %1, %2":"=v"(r):"v"(a),"v"(b));return r;}
__device__ __forceinline__ float fadd_s(float a,float b){float r;asm("v_add_f32_e32 %0, %1, %2":"=v"(r):"v"(a),"v"(b));return r;}
__device__ __forceinline__ float fsub_s(float a,float b){float r;asm("v_sub_f32_e32 %0, %1, %2":"=v"(r):"v"(a),"v"(b));return r;}
typedef float f32x2_t __attribute__((ext_vector_type(2))); typedef __bf16 bf16x2_t __attribute__((ext_vector_type(2)));
__device__ __forceinline__ unsigned cvtpk_s(float lo,float hi){f32x2_t v={lo,hi};bf16x2_t b=__builtin_convertvector(v,bf16x2_t);return __builtin_bit_cast(unsigned,b);}
#define WAIT_BAR(N) asm volatile("s_waitcnt vmcnt(" #N ") lgkmcnt(0)\n\ts_barrier":::"memory")

__device__ __forceinline__ void qkt(f32x16&p0,f32x16&p1,const char*Kslot,const bf16x8*qr,int r32,int hi){
  const char*kb=Kslot+hi*1024+r32*16;
  #pragma unroll
  for(int d0=0;d0<4;++d0){
    const bf16x8 b0=*reinterpret_cast<const bf16x8*>(kb+d0*2048);
    const bf16x8 b1=*reinterpret_cast<const bf16x8*>(kb+d0*2048+512);
    p0=__builtin_amdgcn_mfma_f32_32x32x16_bf16(b0,qr[d0],p0,0,0,0);p1=__builtin_amdgcn_mfma_f32_32x32x16_bf16(b1,qr[d0],p1,0,0,0);}
}
typedef __attribute__((address_space(3))) const char* lds_cptr;
typedef short v4i16_t __attribute__((ext_vector_type(4)));
__device__ __forceinline__ void kload8(bf16x8*kf,lds_cptr kp){
  kf[0]=*(const __attribute__((address_space(3))) bf16x8*)(kp);      kf[1]=*(const __attribute__((address_space(3))) bf16x8*)(kp+512);
  kf[2]=*(const __attribute__((address_space(3))) bf16x8*)(kp+2048); kf[3]=*(const __attribute__((address_space(3))) bf16x8*)(kp+2560);
  kf[4]=*(const __attribute__((address_space(3))) bf16x8*)(kp+4096); kf[5]=*(const __attribute__((address_space(3))) bf16x8*)(kp+4608);
  kf[6]=*(const __attribute__((address_space(3))) bf16x8*)(kp+6144); kf[7]=*(const __attribute__((address_space(3))) bf16x8*)(kp+6656);
}
__device__ __forceinline__ void kload2(bf16x8*kf,lds_cptr kp,int j){ kf[2*j]=*(const __attribute__((address_space(3))) bf16x8*)(kp+j*2048); kf[2*j+1]=*(const __attribute__((address_space(3))) bf16x8*)(kp+j*2048+512); }
__device__ __forceinline__ s16x4 vtr(lds_cptr p){ return __builtin_bit_cast(s16x4,__builtin_amdgcn_ds_read_tr16_b64_v4i16((__attribute__((address_space(3))) v4i16_t*)p)); }
__device__ __forceinline__ float rowmax(const f32x16&p0,const f32x16&p1){
  float a=max3f(p0[0],p0[1],p1[0]),b=max3f(p0[2],p0[3],p1[1]);a=max3f(a,p1[2],p1[3]);
  #pragma unroll
  for(int r=4;r<16;r+=4){a=max3f(a,p0[r],p0[r+1]);b=max3f(b,p0[r+2],p0[r+3]);a=max3f(a,p1[r],p1[r+1]);b=max3f(b,p1[r+2],p1[r+3]);}
  const float m=max2f(a,b);
  auto rr=__builtin_amdgcn_permlane32_swap(__float_as_uint(m),__float_as_uint(m),false,false);
  return max2f(__uint_as_float(rr[0]),__uint_as_float(rr[1]));
}
__device__ __forceinline__ void pv(f32x16*o,int vb,bf16x8 pa0,bf16x8 pa1,bf16x8 pa2,bf16x8 pa3){
  #pragma unroll
  for(int d0=0;d0<2;++d0){s16x4 lo[4],hi[4];
    #pragma unroll
    for(int ks=0;ks<4;++ks){
      asm volatile("ds_read_b64_tr_b16 %0,%1 offset:%c2":"=&v"(lo[ks]):"v"(vb),"i"(d0*4096+ks*1024):"memory");
      asm volatile("ds_read_b64_tr_b16 %0,%1 offset:%c2":"=&v"(hi[ks]):"v"(vb),"i"(d0*4096+ks*1024+512):"memory");}
    asm volatile("s_waitcnt lgkmcnt(0)":::"memory");SBAR();
    #define PK(k) (bf16x8){lo[k][0],lo[k][1],lo[k][2],lo[k][3],hi[k][0],hi[k][1],hi[k][2],hi[k][3]}
    o[d0]=__builtin_amdgcn_mfma_f32_32x32x16_bf16(pa0,PK(0),o[d0],0,0,0);
    o[d0]=__builtin_amdgcn_mfma_f32_32x32x16_bf16(pa1,PK(1),o[d0],0,0,0);
    o[d0]=__builtin_amdgcn_mfma_f32_32x32x16_bf16(pa2,PK(2),o[d0],0,0,0);
    o[d0]=__builtin_amdgcn_mfma_f32_32x32x16_bf16(pa3,PK(3),o[d0],0,0,0);
    #undef PK
  }
}
#define ATTN_STORE16(p,v) (*(u32x4*)(p)=(v))
constexpr int LDS_K2=0, LDS_V2=4*8192, LDS_WS2=LDS_V2+3*16384, LDS_OST2=LDS_WS2+NW*64*4, LDS_BYTES2=LDS_OST2+NW*4096;
__device__ __forceinline__ void pv4(f32x16*o,int vb,bf16x8 pa0,bf16x8 pa1,bf16x8 pa2,bf16x8 pa3){
  #pragma unroll
  for(int d0=0;d0<4;++d0){s16x4 lo[4],hi[4];
    #pragma unroll
    for(int ks=0;ks<4;++ks){
      asm volatile("ds_read_b64_tr_b16 %0,%1 offset:%c2":"=&v"(lo[ks]):"v"(vb),"i"(d0*4096+ks*1024):"memory");
      asm volatile("ds_read_b64_tr_b16 %0,%1 offset:%c2":"=&v"(hi[ks]):"v"(vb),"i"(d0*4096+ks*1024+512):"memory");}
    asm volatile("s_waitcnt lgkmcnt(0)":::"memory");SBAR();
    #define PK(k) (bf16x8){lo[k][0],lo[k][1],lo[k][2],lo[k][3],hi[k][0],hi[k][1],hi[k][2],hi[k][3]}
    o[d0]=__builtin_amdgcn_mfma_f32_32x32x16_bf16(pa0,PK(0),o[d0],0,0,0);
    o[d0]=__builtin_amdgcn_mfma_f32_32x32x16_bf16(pa1,PK(1),o[d0],0,0,0);
    o[d0]=__builtin_amdgcn_mfma_f32_32x32x16_bf16(pa2,PK(2),o[d0],0,0,0);
    o[d0]=__builtin_amdgcn_mfma_f32_32x32x16_bf16(pa3,PK(3),o[d0],0,0,0);
    #undef PK
  }
}
template<int THRL,bool FUSE> __device__ __forceinline__ void attn_unit2(const int tid,int b,int h,int m,int qb,float sl2,float lam,const float*gsub,const bf16*Q,const bf16*__restrict__ K,const bf16*__restrict__ V,bf16*O,char*shm){
  const int lane=tid&63,r32=lane&31,hi=lane>>5; const int wid=__builtin_amdgcn_readfirstlane(tid>>6);
  const long rowbase=(long)b*SEQ; const int q0=qb*QB;
  const bf16*Qw=Q+(rowbase+q0+wid*QBLK)*DM+(2*h+m)*D;
  const bf16*Kh=K+rowbase*DM+(2*h+m)*D,*Vh=V+rowbase*DM+2*h*D;
  const unsigned lds0=(unsigned)(uintptr_t)shm;
  float*wsf=(float*)(shm+LDS_WS2)+wid*64;
  const bf16*ksrc=Kh+(long)lane*DM+wid*8;
  const bf16*vsrc=Vh+(long)(16*(wid&3)+(lane>>2))*DM+(wid>>2)*32+(lane&3)*8;
  const unsigned kdst=lds0+LDS_K2+wid*1024, vdst=lds0+LDS_V2+wid*1024;
  #define DMA_K(t,slot) glds16(ksrc+(long)(t)*KVBLK*DM,(unsigned)__builtin_amdgcn_readfirstlane(kdst+(slot)))
  #define DMA_V(t,slot) do{ glds16(vsrc+(long)(t)*KVBLK*DM,(unsigned)__builtin_amdgcn_readfirstlane(vdst+2*(slot))); glds16(vsrc+(long)(t)*KVBLK*DM+64,(unsigned)__builtin_amdgcn_readfirstlane(vdst+2*(slot)+8192)); }while(0)
  const int vb0=(int)(lds0+LDS_V2)+((lane>>4)&1)*32+(lane&3)*8+(4*hi+((lane&15)>>2))*64;
  const char*Kbase=shm+LDS_K2;
  const lds_cptr shm3=(lds_cptr)shm; const lds_cptr kp0=shm3+LDS_K2+hi*1024+r32*16; const lds_cptr vp0=shm3+LDS_V2+((lane>>4)&1)*32+(lane&3)*8+(4*hi+((lane&15)>>2))*64;
  const int NT=(q0+QB)/KVBLK;
  const unsigned qdst=lds0+LDS_OST2+wid*4096;
  #pragma unroll
  for(int d0=0;d0<4;++d0)glds16(&Qw[(long)r32*DM+d0*16+hi*8],(unsigned)__builtin_amdgcn_readfirstlane(qdst+d0*1024));
  DMA_K(0,0);DMA_V(0,0);DMA_K(1,SLOTB);
  const lds_cptr qp0=(lds_cptr)shm+LDS_OST2+wid*4096+lane*16;
  #define QF(d0) (*(const __attribute__((address_space(3))) bf16x8*)(qp0+(d0)*1024))
  const float tb0=sl2*(float)(4*hi);
  float mhat=0.f,l_reg=0.f;f32x16 o[4];o[0]=f32x16{};o[1]=f32x16{};o[2]=f32x16{};o[3]=f32x16{};
  const int qrel=wid*QBLK+r32;
  #define CMASK(P0,P1,t) do{int jb_=(t)-(NT-4); if(jb_>=0)cmask(P0,P1,jb_,qrel,hi);}while(0)
  #define NVAL(tt) (__builtin_fmaf(sl2,(float)(64*(tt)),tb0)-mhat)
  bool resc=false;
  #define START(P0,P1) do{ const float rm=rowmax(P0,P1); resc=false; \
    { const float dl=rm; mhat=fadd_s(mhat,dl); \
      _Pragma("unroll") for(int r=0;r<16;++r){P0[r]=fsub_s(P0[r],dl);P1[r]=fsub_s(P1[r],dl);} } \
    _Pragma("unroll") for(int r=0;r<16;++r)P0[r]=__builtin_amdgcn_exp2f(P0[r]); }while(0)
  #define RESC() do{ if(resc){ asm volatile("s_waitcnt lgkmcnt(0)":::"memory"); \
      _Pragma("unroll") for(int d_=0;d_<4;++d_) _Pragma("unroll") for(int r=0;r<16;++r)o[d_][r]*=wsf[crow(r,hi)]; } }while(0)
  f32x16 pA0,pA1,pB0,pB1;
  int sl_prev=0,sl_cur=0,sl_next=SLOTB,ks_cur=0;
  #define ROT() do{sl_prev=sl_cur;sl_cur=sl_next;sl_next=(sl_next==(NSLOT-1)*SLOTB)?0:sl_next+SLOTB;ks_cur=(ks_cur+SLOTB)&(4*SLOTB-1);}while(0)
  DMA_K(2,2*SLOTB);
  WAIT_BAR(4);
  cinit(pA0,pA1,sl2,tb0);
  { bf16x8 qr[4];
    #pragma unroll
    for(int d0=0;d0<4;++d0)qr[d0]=QF(d0);
    qkt(pA0,pA1,Kbase,qr,r32,hi); }asm volatile("s_nop 15\n\ts_nop 7":"+v"(pA0),"+v"(pA1));CMASK(pA0,pA1,0);
  START(pA0,pA1);
  cinit(pB0,pB1,sl2,NVAL(1));
  _Pragma("unroll") for(int r=0;r<16;++r)pA1[r]=__builtin_amdgcn_exp2f(pA1[r]);
  WAIT_BAR(0);
  DMA_K(3,3*SLOTB);DMA_V(1,SLOTB);
  ROT();
  WAIT_BAR(3);
  s16x4 vlo[8],vhi[8]; u32x4 pw0,pw1,pw2,pw3;
  bf16x8 nka=*(const __attribute__((address_space(3))) bf16x8*)(kp0+ks_cur),nkb=*(const __attribute__((address_space(3))) bf16x8*)(kp0+ks_cur+512),nqa=QF(0),nqb=QF(1);
  #define PKW(P,B) cvtpk_s(P[B],P[B+1])
  #define PAF(k) __builtin_bit_cast(bf16x8,pw##k)
  #define VFR(i) (bf16x8){vlo[(i)&7][0],vlo[(i)&7][1],vlo[(i)&7][2],vlo[(i)&7][3],vhi[(i)&7][0],vhi[(i)&7][1],vhi[(i)&7][2],vhi[(i)&7][3]}
  #define PIN(x) asm volatile("":"+v"(x))
  #define MX3(a,b,c) __builtin_fmaxf(__builtin_fmaxf((a),(b)),(c))
  #define GAPA(MF,A0,A1,A2,A3,W0,W1,PW) do{ MF; sacc+=A0; sacc+=A1; sacc+=A2; sacc+=A3; PIN(sacc); W0; W1; PIN(PW); SBAR(); }while(0)
  #define EX(v) __builtin_amdgcn_exp2f(v)
  #define VRD(f) do{ vlo[(f)&7]=vtr(vp_+(((f)&3)*4096+((f)>>2)*1024)); vhi[(f)&7]=vtr(vp_+(((f)&3)*4096+((f)>>2)*1024+512)); }while(0)
  #define GAPB(f,X,B,Y,OFS) do{ o[(f)&3]=__builtin_amdgcn_mfma_f32_32x32x16_bf16(__builtin_bit_cast(bf16x8,(f)<4?pw0:(f)<8?pw1:(f)<12?pw2:pw3),VFR(f),o[(f)&3],0,0,0); \
    X[B]=EX(X[B]); X[B+1]=EX(X[B+1]); PIN(X); \
    Y[B]=__builtin_fmaf(sl2,CI_C(B)+OFS,nvn); Y[B+1]=__builtin_fmaf(sl2,CI_C(B+1)+OFS,nvn); \
    if((f)+4<16){VRD((f)+4);} SBAR(); }while(0)
  #define KF(j) (*(const __attribute__((address_space(3))) bf16x8*)(kp_+((j)>>1)*2048+((j)&1)*512))
  #define STEP(C0,C1,P0,P1,t,GK,GV,GL) do{ SBAR(); \
    const lds_cptr vp_=vp0+2*sl_prev; const lds_cptr kp_=kp0+ks_cur; \
    bf16x8 ka=nka,kb=nkb,qa=nqa,qb_=nqb; SBAR(); \
    float sacc=(P0[0]+P0[1]); \
    GAPA(C0=__builtin_amdgcn_mfma_f32_32x32x16_bf16(ka,qa,C0,0,0,0), P0[2],P0[3],P0[4],P0[5],     pw0[0]=PKW(P0,0), pw0[1]=PKW(P0,2), pw0); \
    ka=KF(2); SBAR(); \
    GAPA(C1=__builtin_amdgcn_mfma_f32_32x32x16_bf16(kb,qa,C1,0,0,0), P0[6],P0[7],P0[8],P0[9],     pw0[2]=PKW(P0,4), pw0[3]=PKW(P0,6), pw0); \
    kb=KF(3); qa=QF(2); SBAR(); \
    GAPA(C0=__builtin_amdgcn_mfma_f32_32x32x16_bf16(ka,qb_,C0,0,0,0),   P0[10],P0[11],P0[12],P0[13], pw1[0]=PKW(P0,8), pw1[1]=PKW(P0,10), pw1); \
    ka=KF(4); SBAR(); \
    GAPA(C1=__builtin_amdgcn_mfma_f32_32x32x16_bf16(kb,qb_,C1,0,0,0),   P0[14],P0[15],P1[0],P1[1],   pw1[2]=PKW(P0,12),pw1[3]=PKW(P0,14), pw1); \
    kb=KF(5); qb_=QF(3); VRD(0); SBAR(); \
    GAPA(C0=__builtin_amdgcn_mfma_f32_32x32x16_bf16(ka,qa,C0,0,0,0),   P1[2],P1[3],P1[4],P1[5],     pw2[0]=PKW(P1,0), pw2[1]=PKW(P1,2), pw2); \
    ka=KF(6); VRD(1); SBAR(); \
    GAPA(C1=__builtin_amdgcn_mfma_f32_32x32x16_bf16(kb,qa,C1,0,0,0),   P1[6],P1[7],P1[8],P1[9],     pw2[2]=PKW(P1,4), pw2[3]=PKW(P1,6), pw2); \
    kb=KF(7); VRD(2); SBAR(); \
    GAPA(C0=__builtin_amdgcn_mfma_f32_32x32x16_bf16(ka,qb_,C0,0,0,0),   P1[10],P1[11],P1[12],P1[13], pw3[0]=PKW(P1,8), pw3[1]=PKW(P1,10), pw3); \
    VRD(3); SBAR(); \
    GAPA(C1=__builtin_amdgcn_mfma_f32_32x32x16_bf16(kb,qb_,C1,0,0,0),   P1[14],P1[15],0.f,0.f,       pw3[2]=PKW(P1,12),pw3[3]=PKW(P1,14), pw3); \
    l_reg+=sacc; \
    if(GK){DMA_K((t)+3,(ks_cur+3*SLOTB)&(4*SLOTB-1));} if(GV){DMA_V((t)+1,sl_next);} \
    CMASK(C0,C1,t); \
    float nvn; \
    { float a=MX3(C0[0],C0[1],C1[0]),b=MX3(C0[2],C0[3],C1[1]); a=MX3(a,C1[2],C1[3]); \
      _Pragma("unroll") for(int r=4;r<16;r+=4){a=MX3(a,C0[r],C0[r+1]);b=MX3(b,C0[r+2],C0[r+3]);a=MX3(a,C1[r],C1[r+1]);b=MX3(b,C1[r+2],C1[r+3]);} \
      float rm=__builtin_fmaxf(a,b); { auto rr=__builtin_amdgcn_permlane32_swap(__float_as_uint(rm),__float_as_uint(rm),false,false); rm=__builtin_fmaxf(__uint_as_float(rr[0]),__uint_as_float(rr[1])); } \
      resc=false; \
      if(__builtin_expect(__any(rm>(float)THRL),0)){ const float dl=__builtin_fmaxf(rm,0.f); mhat+=dl; \
        _Pragma("unroll") for(int r=0;r<16;++r){C0[r]-=dl;C1[r]-=dl;} \
        const float f=__builtin_amdgcn_exp2f(-dl); l_reg*=f; if(hi==0)wsf[r32]=f; resc=true; } \
      nvn=NVAL((t)+1); } \
    SBAR(); \
    GAPB(0,C0,0,P0,0.0f); GAPB(1,C0,2,P0,0.0f); GAPB(2,C0,4,P0,0.0f); GAPB(3,C0,6,P0,0.0f); \
    GAPB(4,C0,8,P0,0.0f); GAPB(5,C0,10,P0,0.0f); GAPB(6,C0,12,P0,0.0f); GAPB(7,C0,14,P0,0.0f); \
    GAPB(8,C1,0,P1,32.0f); GAPB(9,C1,2,P1,32.0f); GAPB(10,C1,4,P1,32.0f); GAPB(11,C1,6,P1,32.0f); \
    GAPB(12,C1,8,P1,32.0f); GAPB(13,C1,10,P1,32.0f); GAPB(14,C1,12,P1,32.0f); \
    { const lds_cptr kn_=kp0+((ks_cur+SLOTB)&(4*SLOTB-1)); nka=*(const __attribute__((address_space(3))) bf16x8*)(kn_); nkb=*(const __attribute__((address_space(3))) bf16x8*)(kn_+512); nqa=QF(0); nqb=QF(1); SBAR(); } \
    GAPB(15,C1,14,P1,32.0f); \
    }while(0)
  int t=1;
  #undef CMASK
  #define CMASK(P0,P1,t) do{}while(0)
  for(;t+5<NT;t+=2){
    STEP(pB0,pB1,pA0,pA1,t,true,true,true);     WAIT_BAR(3); RESC(); ROT();
    STEP(pA0,pA1,pB0,pB1,t+1,true,true,true);   WAIT_BAR(3); RESC(); ROT();
  }
  #undef CMASK
  #define CMASK(P0,P1,t) do{int jb_=(t)-(NT-4); if(jb_>=0)cmask(P0,P1,jb_,qrel,hi);}while(0)
  #define ENDW(tt) do{ if((tt)+3<NT){WAIT_BAR(3);} else if((tt)+2<NT){WAIT_BAR(2);} else {WAIT_BAR(0);} }while(0)
  for(;t+1<NT;t+=2){
    STEP(pB0,pB1,pA0,pA1,t,(t+3<NT),(t+1<NT),(t+1<NT));       ENDW(t);   RESC(); ROT();
    STEP(pA0,pA1,pB0,pB1,t+1,(t+4<NT),(t+2<NT),(t+2<NT));     ENDW(t+1); RESC(); ROT();
  }
  STEP(pB0,pB1,pA0,pA1,NT-1,false,false,false); RESC();
  { float sacc=pB0[0]+pB0[1]; _Pragma("unroll") for(int r=2;r<16;++r)sacc+=pB0[r]; _Pragma("unroll") for(int r=0;r<16;++r)sacc+=pB1[r]; l_reg+=sacc;
    pw0=(u32x4){PKW(pB0,0),PKW(pB0,2),PKW(pB0,4),PKW(pB0,6)};pw1=(u32x4){PKW(pB0,8),PKW(pB0,10),PKW(pB0,12),PKW(pB0,14)};pw2=(u32x4){PKW(pB1,0),PKW(pB1,2),PKW(pB1,4),PKW(pB1,6)};pw3=(u32x4){PKW(pB1,8),PKW(pB1,10),PKW(pB1,12),PKW(pB1,14)};
    SBAR(); pv4(o,vb0+2*sl_cur,PAF(0),PAF(1),PAF(2),PAF(3)); }
  #undef PKW
  #undef PAF
  #undef VFR
  #undef PIN
  #undef MX3
  #undef GAPA
  #undef GAPB
  #undef EX
  #undef VRD
  #undef KF
  #undef STEP
  #undef ENDW
  {auto rr=__builtin_amdgcn_permlane32_swap(__float_as_uint(l_reg),__float_as_uint(l_reg),false,false);l_reg=__uint_as_float(rr[0])+__uint_as_float(rr[1]);}
  if(hi==0)wsf[32+r32]=l_reg;asm volatile("s_waitcnt lgkmcnt(0)":::"memory");
  float rli[16];
  #pragma unroll
  for(int r=0;r<16;++r)rli[r]=__builtin_amdgcn_rcpf(wsf[32+crow(r,hi)]);
  bf16*Ow=O+(rowbase+q0+wid*QBLK)*DM+2*h*D;
  bf16*stg=(bf16*)(shm+LDS_OST2)+wid*2048;
  if constexpr(!FUSE){
    #pragma unroll
    for(int ps=0;ps<2;++ps){
      #pragma unroll
      for(int r=0;r<16;++r){const int orow=crow(r,hi);
        #pragma unroll
        for(int d0=0;d0<2;++d0)stg[orow*64+d0*32+r32]=__float2bfloat16(o[2*ps+d0][r]*rli[r]);}
      asm volatile("s_waitcnt lgkmcnt(0)":::"memory");
      #pragma unroll
      for(int i=0;i<4;++i){const int row=i*8+(lane>>3),ch=lane&7; const u32x4 v=*(const u32x4*)(stg+row*64+ch*8); ATTN_STORE16(Ow+(long)row*DM+ps*64+ch*8,v);}
      asm volatile("s_waitcnt lgkmcnt(0)":::"memory"); }
    asm volatile("s_waitcnt vmcnt(0)":::"memory");
  } else {
    float dv[2][4][8]; float ss[4]={0.f,0.f,0.f,0.f};
    u32x4 v0p[2][4];
    #pragma unroll
    for(int ps=0;ps<2;++ps)
      #pragma unroll
      for(int i=0;i<4;++i){const int row=i*8+(lane>>3),ch=lane&7; v0p[ps][i]=*(const u32x4*)(Ow+(long)row*DM+ps*64+ch*8);}
    #pragma unroll
    for(int ps=0;ps<2;++ps){
      #pragma unroll
      for(int r=0;r<16;++r){const int orow=crow(r,hi);
        #pragma unroll
        for(int d0=0;d0<2;++d0)stg[orow*64+d0*32+r32]=__float2bfloat16(o[2*ps+d0][r]*rli[r]);}
      asm volatile("s_waitcnt lgkmcnt(0)":::"memory");
      #pragma unroll
      for(int i=0;i<4;++i){const int row=i*8+(lane>>3),ch=lane&7; const u32x4 v1=*(const u32x4*)(stg+row*64+ch*8); const u32x4 v0=v0p[ps][i];
        #pragma unroll
        for(int e=0;e<4;++e){ const float a0=__uint_as_float(v0[e]<<16),a1=__uint_as_float(v0[e]&0xffff0000u),b0=__uint_as_float(v1[e]<<16),b1=__uint_as_float(v1[e]&0xffff0000u);
          const float x0=a0-lam*b0,x1=a1-lam*b1; dv[ps][i][2*e]=x0; dv[ps][i][2*e+1]=x1; ss[i]+=x0*x0+x1*x1; } }
      asm volatile("s_waitcnt lgkmcnt(0)":::"memory"); }
    #pragma unroll
    for(int i=0;i<4;++i){ float s_=ss[i];
      { int b_=__float_as_int(s_); s_+=__int_as_float(__builtin_amdgcn_update_dpp(b_,b_,0xB1,0xF,0xF,false)); b_=__float_as_int(s_); s_+=__int_as_float(__builtin_amdgcn_update_dpp(b_,b_,0x4E,0xF,0xF,false)); b_=__float_as_int(s_); s_+=__int_as_float(__builtin_amdgcn_update_dpp(b_,b_,0x141,0xF,0xF,false)); }
      ss[i]=1.0f/sqrtf(s_*(1.0f/128.0f)+1e-6f); }
    #pragma unroll
    for(int ps=0;ps<2;++ps){ float gg[8];
      #pragma unroll
      for(int e=0;e<8;++e)gg[e]=gsub[ps*64+(lane&7)*8+e]*0.8f;
      #pragma unroll
      for(int i=0;i<4;++i){const int row=i*8+(lane>>3),ch=lane&7; u32x4 w;
        #pragma unroll
        for(int e=0;e<4;++e)w[e]=cvtpk_s(dv[ps][i][2*e]*ss[i]*gg[2*e],dv[ps][i][2*e+1]*ss[i]*gg[2*e+1]);
        ATTN_STORE16(Ow+(long)row*DM+ps*64+ch*8,w);} }
  }
  asm volatile("s_waitcnt lgkmcnt(0)\n\ts_barrier":::"memory");
  #undef DMA_K
  #undef DMA_V
  #undef QF
  #undef CMASK
  #undef NVAL
  #undef START
  #undef RESC
  #undef ROT
}
constexpr int ATTN_LDS_BYTES=LDS_BYTES2;
#undef SBAR
#undef WAIT_BAR
}

constexpr int NWAVES = 8;
constexpr int N_LAUNCHES = MK_N_LAUNCHES;
constexpr int N_PHASES = 9 + 2 * NCH + 1;
constexpr bool PER_PHASE = (MK_N_LAUNCHES != 1);

constexpr size_t MiB = 1u << 20;
constexpr size_t ACT = (size_t)T * D * 2;
constexpr size_t WS_CTL = 0, CTL_ZERO_BYTES = 65536;
constexpr size_t WS_MOD = 1 * MiB;
constexpr size_t WS_SH = WS_MOD + 512 * 1024;
constexpr size_t WS_WIN = 2 * MiB;
constexpr size_t WS_WR = 16 * MiB, WS_WA = 18 * MiB, WS_WO = 20 * MiB;
constexpr size_t WS_LW = 22 * MiB;
constexpr size_t WS_WRH = 23 * MiB, WS_WRL = 23 * MiB + 131072;
constexpr size_t WS_H = 24 * MiB;
constexpr size_t WS_XR = WS_H + ACT;
constexpr size_t WS_GR = WS_XR + ACT;
constexpr size_t WS_Q = WS_GR + ACT;
constexpr size_t WS_K = WS_Q + ACT;
constexpr size_t WS_V = WS_K + ACT;
constexpr size_t WS_O1 = WS_V + ACT;
constexpr size_t WS_HQ = WS_O1;
constexpr size_t WS_END = WS_O1 + ACT;
static_assert(WS_END <= 512 * MiB, "ws map");
constexpr size_t WS_W13 = WS_GR;
constexpr size_t WS_W2 = WS_GR + 32 * MiB;
constexpr size_t WS_W13S = WS_GR + 48 * MiB;
constexpr size_t WS_W2S = WS_GR + 49 * MiB;
constexpr size_t WS_LIST = 2 * MiB;
constexpr size_t WS_WTS = 10 * MiB;
constexpr size_t WS_RDEST = 11 * MiB;
constexpr size_t WS_RWT = WS_O1 + 44 * MiB;
constexpr size_t WS_SA = 13 * MiB;
constexpr int MAXRT = TC * TOPK / 256 + NEXP + TC / 256;
constexpr int MAXROWS = MAXRT * 256;
constexpr size_t WS_HB = WS_H + 32 * MiB;
constexpr size_t WS_SLOT = WS_Q;
constexpr size_t WS_SLOTSC = WS_SLOT + 72 * MiB;
constexpr size_t WS_Y = WS_Q;
static_assert(WS_SLOT + (size_t)(TC * 9) * D <= 504 * MiB && WS_HB + (size_t)MAXROWS * 256 <= WS_GR && (size_t)MAXROWS * 4 <= 2 * MiB, "moe map");
constexpr size_t WS_TOTAL = 504 * MiB;
constexpr int CW_TMO = 0;
constexpr int CW_BAR = 4096;
constexpr int CW_CNT = 8192;
constexpr int CW_AMAX = 8192 + 512;

constexpr int RING_BYTES = 139264;
constexpr int MISC_OFF = RING_BYTES;
constexpr int LDS_BYTES = 163840;
constexpr int MI_BARST = 0;
constexpr int MI_CNT = 64;
constexpr int MI_TBASE = 128;
constexpr int MI_TILE_E = 256;
constexpr int MI_SB = 544;
constexpr int MI_TOK = 576;
constexpr int MI_SA = 576 + 2560;
constexpr int MI_WORDS = 6144;

#define GAS __attribute__((address_space(1)))
#define LAS __attribute__((address_space(3)))
typedef unsigned short bf16;
typedef unsigned v4u __attribute__((ext_vector_type(4)));
typedef unsigned v2u __attribute__((ext_vector_type(2)));
typedef float f32x4 __attribute__((ext_vector_type(4)));
typedef float f32x16 __attribute__((ext_vector_type(16)));
typedef short bf16x8 __attribute__((ext_vector_type(8)));
typedef GAS unsigned gu32;
#define RLX_AGENT __ATOMIC_RELAXED, __HIP_MEMORY_SCOPE_AGENT
#define LDS_WAIT() asm volatile("s_waitcnt lgkmcnt(0)" ::: "memory")
#define VM_WAIT() asm volatile("s_waitcnt vmcnt(0)" ::: "memory")
__device__ __forceinline__ unsigned f2bf(float f) { unsigned u = __builtin_bit_cast(unsigned, f); return (u + 0x7fffu + ((u >> 16) & 1u)) >> 16; }
__device__ __forceinline__ unsigned pk2(float lo, float hi) { return f2bf(lo) | (f2bf(hi) << 16); }
__device__ __forceinline__ float bf2f(unsigned h) { return __uint_as_float(h << 16); }
using pg8::bflo; using pg8::bfhi; using pg8::sigm;

#define XB_TMO      128
#define XB_XCNT(j)  (256  + 64 * (j))
#define XB_XSUB(j)  (1280 + 64 * (j))
#define XB_XGEN(j)  (2304 + 64 * (j))
#define XB_TOP      3328
#define XB_TOPGEN   3392
#define XCD_BAR_WORDS 3456
#define XB_SPIN_CAP (1u << 18)
__device__ __forceinline__ unsigned xb_ld(unsigned* p)              { return __hip_atomic_load(p, __ATOMIC_RELAXED, __HIP_MEMORY_SCOPE_AGENT); }
__device__ __forceinline__ unsigned xb_add(unsigned* p, unsigned v) { return __hip_atomic_fetch_add(p, v, __ATOMIC_RELAXED, __HIP_MEMORY_SCOPE_AGENT); }
__device__ __forceinline__ unsigned xb_xcc_id() { return (unsigned)__builtin_amdgcn_s_getreg((3 << 11) | 20) & 0xFu; }
#define XB_SPIN(cond, bar) do { unsigned _sp = 0; while (cond) { __builtin_amdgcn_s_sleep(1); \
    if ((++_sp & 255u) == 0u) { if (xb_ld(&(bar)[XB_TMO])) break; if (_sp > XB_SPIN_CAP) { atomicAdd(&(bar)[XB_TMO], 1u); break; } } } } while (0)
struct XcdBarrier { unsigned* bar; unsigned x; volatile LAS unsigned* st; };
__device__ __forceinline__ XcdBarrier xcd_barrier_post(unsigned* bar, volatile LAS unsigned* st) {
    XcdBarrier b; b.bar = bar; b.x = xb_xcc_id(); b.st = st;
    if (threadIdx.x == 0) st[2] = xb_add(&bar[XB_XCNT(b.x)], 1u);
    return b;
}
__device__ __forceinline__ void xcd_barrier_complete(unsigned* bar, unsigned x, unsigned& nloc, unsigned& nx) {
    const unsigned G = gridDim.x * gridDim.y * gridDim.z;
    unsigned sum, cnt, mine, sp = 0u;
    for (;;) {
        sum = 0u; cnt = 0u; mine = 0u;
#pragma unroll 1
        for (unsigned j = 0; j < 16; ++j) { const unsigned c = xb_ld(&bar[XB_XCNT(j)]); sum += c; cnt += (c > 0u) ? 1u : 0u; mine = (j == x) ? c : mine; }
        if (sum == G) break;
        __builtin_amdgcn_s_sleep(1);
        if ((++sp & 255u) == 0u) { if (xb_ld(&bar[XB_TMO])) break; if (sp > XB_SPIN_CAP) { atomicAdd(&bar[XB_TMO], 1u); break; } }
    }
    nloc = mine > 0u ? mine : 1u; nx = cnt > 0u ? cnt : 1u;
}
__device__ __forceinline__ void xcd_barrier(const XcdBarrier& b) {
    asm volatile("s_waitcnt vmcnt(0)" ::: "memory");
    __syncthreads();
    if (threadIdx.x == 0) {
        size_t zb_ = 0; asm volatile("" : "+s"(zb_)); unsigned* bar = b.bar + zb_;
        __builtin_amdgcn_s_waitcnt(0);
        unsigned nloc = b.st[0], nx = b.st[1];
        if (nloc == 0u) { xcd_barrier_complete(bar, b.x, nloc, nx); b.st[0] = nloc; b.st[1] = nx; }
        const unsigned old = xb_add(&bar[XB_XSUB(b.x)], 1u);
        const unsigned gen = old / nloc;
        if (old + 1u == (gen + 1u) * nloc) {
            __builtin_amdgcn_fence(__ATOMIC_RELEASE, "agent");
            asm volatile("s_waitcnt vmcnt(0)" ::: "memory");
            const unsigned og = xb_add(&bar[XB_TOP], 1u);
            const unsigned tg = og / nx;
            if (og + 1u == (tg + 1u) * nx) xb_add(&bar[XB_TOPGEN], 1u);
            else XB_SPIN(xb_ld(&bar[XB_TOPGEN]) == tg, bar);
            xb_add(&bar[XB_XGEN(b.x)], 1u);
            __builtin_amdgcn_fence(__ATOMIC_ACQUIRE, "agent");
            asm volatile("s_waitcnt vmcnt(0)" ::: "memory");
        } else {
            XB_SPIN(xb_ld(&bar[XB_XGEN(b.x)]) == gen, bar);
            __builtin_amdgcn_fence(__ATOMIC_ACQUIRE, "agent");
            asm volatile("s_waitcnt vmcnt(0)" ::: "memory");
        }
    }
    __syncthreads();
}

#define XB_LCNT(j)  (5120 + 64 * (j))
__device__ __forceinline__ void xcd_local_barrier(const XcdBarrier& b, unsigned nloc) {
    asm volatile("s_waitcnt vmcnt(0)" ::: "memory");
    __syncthreads();
    if (threadIdx.x == 0) {
        size_t zb_ = 0; asm volatile("" : "+s"(zb_)); unsigned* bar = b.bar + zb_;
        __builtin_amdgcn_s_waitcnt(0);
        const unsigned old = xb_add(&bar[XB_LCNT(b.x)], 1u);
        const unsigned target = (old / nloc + 1u) * nloc;
        XB_SPIN(xb_ld(&bar[XB_LCNT(b.x)]) < target, bar);
        __builtin_amdgcn_fence(__ATOMIC_ACQUIRE, "agent");
        asm volatile("s_waitcnt vmcnt(0)" ::: "memory");
    }
    __syncthreads();
}

struct Frame {
    LAS unsigned char* lds;
    volatile LAS int* MI;
    gu32* ctl;
    int tid, lane, wave, vcu, G, cidx;
    float* out;
    unsigned char* ws;
};
struct Args { const float* in[32]; float* out; unsigned char* ws; int ph_lo, ph_hi; };
__device__ __forceinline__ float dppf(float x, int ctrl_sel) {
    const int b = __float_as_int(x); int r;
    if (ctrl_sel == 0) r = __builtin_amdgcn_update_dpp(b, b, 0xB1, 0xF, 0xF, false);
    else if (ctrl_sel == 1) r = __builtin_amdgcn_update_dpp(b, b, 0x4E, 0xF, 0xF, false);
    else if (ctrl_sel == 2) r = __builtin_amdgcn_update_dpp(b, b, 0x141, 0xF, 0xF, false);
    else r = __builtin_amdgcn_update_dpp(b, b, 0x140, 0xF, 0xF, false);
    return __int_as_float(r);
}
__device__ __forceinline__ float max8_dpp(float x) { x = fmaxf(x, dppf(x, 0)); x = fmaxf(x, dppf(x, 1)); x = fmaxf(x, dppf(x, 2)); return x; }
__device__ __forceinline__ float rl_f(float x, int l) { return __int_as_float(__builtin_amdgcn_readlane(__float_as_int(x), l)); }
__device__ __forceinline__ float wave_max_dpp(float x) { x = max8_dpp(x); x = fmaxf(x, dppf(x, 3)); return fmaxf(fmaxf(rl_f(x, 0), rl_f(x, 16)), fmaxf(rl_f(x, 32), rl_f(x, 48))); }
__device__ __forceinline__ float wave_sum_dpp(float x) { x += dppf(x, 0); x += dppf(x, 1); x += dppf(x, 2); x += dppf(x, 3); return (rl_f(x, 0) + rl_f(x, 16)) + (rl_f(x, 32) + rl_f(x, 48)); }
__device__ __forceinline__ float wave_sum(float v) { return wave_sum_dpp(v); }

typedef short v4i16_t __attribute__((ext_vector_type(4)));
__device__ __forceinline__ v2u tr8(const LAS unsigned char* p) { return __builtin_bit_cast(v2u, __builtin_amdgcn_ds_read_tr16_b64_v4i16((LAS v4i16_t*)p)); }
__device__ __forceinline__ void transpose_item(const float* W, int K, int N, bf16* WT, int kb, int n0, int drow0, LAS float* scr_, int lane) {
    LAS unsigned char* scr = (LAS unsigned char*)scr_;
    const int k0 = 64 * kb, lr = lane >> 4, lc = lane & 15;
#pragma unroll
    for (int hf = 0; hf < 2; ++hf) {
        f32x4 v[8];
#pragma unroll
        for (int r = 0; r < 8; ++r) v[r] = __builtin_nontemporal_load((const f32x4*)(W + (size_t)(k0 + 32 * hf + 4 * r + lr) * N + n0 + 4 * lc));
#pragma unroll
        for (int r = 0; r < 8; ++r) { v2u o; o.x = pk2(v[r].x, v[r].y); o.y = pk2(v[r].z, v[r].w); *(LAS v2u*)(scr + (32 * hf + 4 * r + lr) * 144 + lc * 8) = o; }
    }
    LDS_WAIT(); asm volatile("" ::: "memory");
    const int g = lane >> 4, q = (lane & 15) >> 2, p = lane & 3;
#pragma unroll
    for (int nb = 0; nb < 4; ++nb)
#pragma unroll
        for (int kk = 0; kk < 2; ++kk) { const int kblk = 4 * kk + g;
            const v2u a = tr8(scr + (8 * kblk + q) * 144 + (16 * nb + 4 * p) * 2), b = tr8(scr + (8 * kblk + 4 + q) * 144 + (16 * nb + 4 * p) * 2);
            v4u o; o.x = a.x; o.y = a.y; o.z = b.x; o.w = b.y;
            *(GAS v4u*)(WT + (size_t)(drow0 + 16 * nb + lc) * K + k0 + 8 * kblk) = o; }
    LDS_WAIT(); asm volatile("" ::: "memory");
}

__device__ __forceinline__ void p0_phase(Frame& F, const Args& A) {
    unsigned char* ws = F.ws;
    LAS float* sc = (LAS float*)F.lds;
    const int nada = (F.G > 2 * (6 * D / 64)) ? (6 * D / 64) : 0;
    const int NGW = (F.G - nada) * NWAVES, gw = (F.vcu >= nada) ? (F.vcu - nada) * NWAVES + F.wave : 0x40000000;
    LAS unsigned char* wst = F.lds + 65536 + F.wave * 8192;
    bool sc_ready = false;
    for (int task = F.vcu; task < 6 * D / 64; task += F.G) {
        const int col = task * 64 + F.lane;
        float acc[16];
#pragma unroll
        for (int b = 0; b < 16; ++b) acc[b] = 0.f;
        const GAS float* wp = (const GAS float*)A.in[2] + (size_t)(128 * F.wave) * (6 * D) + col;
#pragma unroll 1
        for (int q = 0; q < 4; ++q) {
#pragma unroll 4
            for (int r = 0; r < 32; ++r)
                __builtin_amdgcn_global_load_lds((const GAS unsigned*)(wp + (size_t)(32 * q + r) * (6 * D)), (LAS unsigned*)(wst + r * 256), 4, 0, 0);
            if (!sc_ready) {
#pragma unroll 1
                for (int i0 = F.tid; i0 < BATCH * D; i0 += 8 * NWAVES * 64) { float v[8];
#pragma unroll
                    for (int u = 0; u < 8; ++u) v[u] = A.in[1][i0 + u * NWAVES * 64];
#pragma unroll
                    for (int u = 0; u < 8; ++u) { const int i = i0 + u * NWAVES * 64, b = i >> 10, k = i & 1023; sc[k * 16 + b] = v[u] * sigm(v[u]); } }
                sc_ready = true; __syncthreads(); }
            asm volatile("s_waitcnt vmcnt(0)" ::: "memory");
            const LAS f32x4* sp = (const LAS f32x4*)(sc + (128 * F.wave + 32 * q) * 16);
#pragma unroll 2
            for (int r = 0; r < 32; ++r) { const float wv = *(const LAS float*)(wst + r * 256 + F.lane * 4);
#pragma unroll
                for (int qq = 0; qq < 4; ++qq) { const f32x4 sv = sp[r * 4 + qq]; acc[4 * qq + 0] += wv * sv.x; acc[4 * qq + 1] += wv * sv.y; acc[4 * qq + 2] += wv * sv.z; acc[4 * qq + 3] += wv * sv.w; } }
            asm volatile("s_waitcnt lgkmcnt(0)" ::: "memory");
        }
        LAS float* part = (LAS float*)wst;
#pragma unroll
        for (int b = 0; b < 16; ++b) part[b * 64 + F.lane] = acc[b];
        __syncthreads();
        for (int i = F.tid; i < 16 * 64; i += NWAVES * 64) { const int b = i >> 6, c = i & 63; float v = A.in[3][task * 64 + c];
#pragma unroll
            for (int w8 = 0; w8 < 8; ++w8) v += *(const LAS float*)(F.lds + 65536 + w8 * 8192 + (b * 64 + c) * 4);
            ((float*)(ws + WS_MOD))[b * (6 * D) + task * 64 + c] = v; }
        __syncthreads();
    }
    __syncthreads();
    LAS float* scr = (LAS float*)(F.lds + F.wave * 16384);
    constexpr int I_SQ = 16 * 16, I_LW = 16 * 4;
    constexpr int NITEMS = 3 * I_SQ + I_LW;
    for (int it = gw; it < NITEMS; it += NGW) {
        int r = it; const float* W; bf16* WT; int Kk, Nn, kb, n0;
        if (r < 3 * I_SQ) { const int which = r / I_SQ; r -= which * I_SQ; W = which == 0 ? A.in[18] : which == 1 ? A.in[19] : A.in[20];
            WT = (bf16*)(ws + (which == 0 ? WS_WR : which == 1 ? WS_WA : WS_WO)); Kk = D; Nn = D; kb = r / 16; n0 = 64 * (r % 16); }
        else { r -= 3 * I_SQ; const int mat = r >> 2, q = r & 3, gate = mat >> 3, n = mat & 7;
            W = (gate ? A.in[10] : A.in[8]) + (size_t)n * 128 * 128; WT = (bf16*)(ws + WS_LW) + (size_t)(n * 2 + gate) * 128 * 128; Kk = 128; Nn = 128; kb = q >> 1; n0 = 64 * (q & 1); }
        transpose_item(W, Kk, Nn, WT, kb, n0, n0, scr, F.lane);
    }
    for (long i = (long)gw * 64 + F.lane; i < D * NEXP; i += NGW * 64) { const int k = i >> 6, e = i & 63; const float wv = A.in[23][i]; const unsigned hb = f2bf(wv); const unsigned lb = f2bf(wv - bf2f(hb));
        ((bf16*)(ws + WS_WRH))[e * D + k] = (bf16)hb; ((bf16*)(ws + WS_WRL))[e * D + k] = (bf16)lb; }
    for (int it = gw; it < (D * W_IN) / 4096; it += NGW) {
        const float* W = A.in[5] + (size_t)it * 4096;
        float mx = 0.f;
#pragma unroll
        for (int i = 0; i < 16; ++i) { const f32x4 v = *((const f32x4*)W + F.lane + 64 * i); mx = fmaxf(mx, fmaxf(fmaxf(fabsf(v.x), fabsf(v.y)), fmaxf(fabsf(v.z), fabsf(v.w)))); }
        mx = wave_max_dpp(mx);
        if (F.lane == 0) atomicMax((unsigned*)(F.ctl + CW_AMAX + 130), __float_as_uint(mx)); }
}

template <bool FP8 = false>
__device__ __forceinline__ void transpose_item_q(const float* W, int K, int N, signed char* WT, int kb, int n0, int drow0, LAS float* scr_, int lane, float inv) {
    LAS unsigned char* scr = (LAS unsigned char*)scr_;
    const int k0 = 64 * kb, lr = lane >> 4, lc = lane & 15;
    f32x4 v[2][8];
#pragma unroll
    for (int hf = 0; hf < 2; ++hf)
#pragma unroll
        for (int r = 0; r < 8; ++r) v[hf][r] = __builtin_nontemporal_load((const f32x4*)(W + (size_t)(k0 + 32 * hf + 4 * r + lr) * N + n0 + 4 * lc));
#pragma unroll
    for (int hf = 0; hf < 2; ++hf)
#pragma unroll
        for (int r = 0; r < 8; ++r) { v2u o; o.x = pk2(v[hf][r].x, v[hf][r].y); o.y = pk2(v[hf][r].z, v[hf][r].w); *(LAS v2u*)(scr + (32 * hf + 4 * r + lr) * 144 + lc * 8) = o; }
    LDS_WAIT(); asm volatile("" ::: "memory");
    const int g = lane >> 4, q = (lane & 15) >> 2, p = lane & 3;
#pragma unroll
    for (int nb = 0; nb < 4; ++nb)
#pragma unroll
        for (int kk = 0; kk < 2; ++kk) { const int kblk = 4 * kk + g;
            const v2u a = tr8(scr + (8 * kblk + q) * 144 + (16 * nb + 4 * p) * 2), b = tr8(scr + (8 * kblk + 4 + q) * 144 + (16 * nb + 4 * p) * 2);
            const unsigned wv[4] = {a.x, a.y, b.x, b.y}; unsigned ob[2] = {0u, 0u};
#pragma unroll
            for (int j = 0; j < 4; ++j) {
                if constexpr (FP8) { const float f0 = __builtin_amdgcn_fmed3f(bflo(wv[j]) * inv, -448.0f, 448.0f), f1 = __builtin_amdgcn_fmed3f(bfhi(wv[j]) * inv, -448.0f, 448.0f);
                    ob[j >> 1] = (j & 1) ? (unsigned)__builtin_amdgcn_cvt_pk_fp8_f32(f0, f1, (int)ob[j >> 1], true) : (unsigned)__builtin_amdgcn_cvt_pk_fp8_f32(f0, f1, 0, false); }
                else { const int q0 = (int)rintf(bflo(wv[j]) * inv), q1 = (int)rintf(bfhi(wv[j]) * inv);
                    ob[j >> 1] |= ((unsigned)(q0 & 0xff) << (16 * (j & 1))) | ((unsigned)(q1 & 0xff) << (16 * (j & 1) + 8)); } }
            v2u o; o.x = ob[0]; o.y = ob[1];
            *(GAS v2u*)(WT + (size_t)(drow0 + 16 * nb + lc) * K + k0 + 8 * kblk) = o; }
    LDS_WAIT(); asm volatile("" ::: "memory");
}

__device__ __forceinline__ void p1_phase(Frame& F, const Args& A) {
    const int gw = F.vcu * NWAVES + F.wave, NGW = F.G * NWAVES;
    const float* mod = (const float*)(F.ws + WS_MOD);
    signed char* H = (signed char*)(F.ws + WS_HQ); float* SH = (float*)(F.ws + WS_SH);
    for (int grp = gw; grp < T / 16; grp += NGW) {
        const int b = (grp * 16) / SEQ;
        f32x4 g[4], sc[4], sh[4];
#pragma unroll
        for (int j = 0; j < 4; ++j) { const int c = 4 * F.lane + 256 * j; g[j] = *(const f32x4*)(A.in[4] + c); sh[j] = *(const f32x4*)(mod + b * 6 * D + c); sc[j] = *(const f32x4*)(mod + b * 6 * D + D + c);
            g[j] = g[j] * (sc[j] + 1.0f); }
        f32x4 vn[4];
        { const GAS f32x4* xr = (const GAS f32x4*)(A.in[0] + (size_t)grp * 16 * D) + F.lane;
#pragma unroll
          for (int j = 0; j < 4; ++j) vn[j] = __builtin_nontemporal_load(&xr[64 * j]); }
#pragma unroll 2
        for (int rr = 0; rr < 16; ++rr) {
            const size_t m = (size_t)grp * 16 + rr;
            f32x4 v[4]; float s = 0.f;
#pragma unroll
            for (int j = 0; j < 4; ++j) v[j] = vn[j];
            if (rr + 1 < 16) { const GAS f32x4* xr = (const GAS f32x4*)(A.in[0] + (m + 1) * D) + F.lane;
#pragma unroll
                for (int j = 0; j < 4; ++j) vn[j] = __builtin_nontemporal_load(&xr[64 * j]); }
#pragma unroll
            for (int j = 0; j < 4; ++j) s += (v[j].x * v[j].x + v[j].y * v[j].y) + (v[j].z * v[j].z + v[j].w * v[j].w);
            const float rstd = 1.f / sqrtf(wave_sum(s) * (1.f / D) + EPS);
            float amx = 0.f;
#pragma unroll
            for (int j = 0; j < 4; ++j) { v[j] = v[j] * rstd * g[j] + sh[j]; amx = fmaxf(amx, fmaxf(fmaxf(fabsf(v[j].x), fabsf(v[j].y)), fmaxf(fabsf(v[j].z), fabsf(v[j].w)))); }
            amx = fmaxf(wave_max_dpp(amx), 1e-20f); const float inv = 127.0f / amx; if (F.lane == 0) SH[m] = amx * (1.0f / 127.0f);
#pragma unroll
            for (int j = 0; j < 4; ++j) { const int q0 = (int)rintf(v[j].x * inv), q1 = (int)rintf(v[j].y * inv), q2 = (int)rintf(v[j].z * inv), q3 = (int)rintf(v[j].w * inv);
                *((GAS unsigned*)(H + m * D) + F.lane + 64 * j) = (unsigned)(q0 & 0xff) | ((unsigned)(q1 & 0xff) << 8) | ((unsigned)(q2 & 0xff) << 16) | ((unsigned)(q3 & 0xff) << 24); }
        }
    }
    { LAS float* scr = (LAS float*)(F.lds + F.wave * 16384);
      const float inv = 127.0f / fmaxf(__uint_as_float(__hip_atomic_load(F.ctl + CW_AMAX + 130, RLX_AGENT)), 1e-30f);
      constexpr int I_IN = 16 * (W_IN / 64);
      for (int it = NGW - 1 - gw; it < I_IN; it += NGW)
          transpose_item_q(A.in[5], D, W_IN, (signed char*)(F.ws + WS_WIN), it / (W_IN / 64), 64 * (it % (W_IN / 64)), 64 * (it % (W_IN / 64)), scr, F.lane, inv); }
}

struct DenseOrder {
    const char* A; const char* Bt; int nM, nN, nwg, G, c; size_t tstep;
    __device__ __forceinline__ void init(const void* A_, const void* Bt_, int M, int N, int K, int G_, int c_) { A = (const char*)A_; Bt = (const char*)Bt_; nM = M / 256; nN = N / 256; nwg = nM * nN; G = G_; c = c_; tstep = (size_t)256 * K * 2; }
    __device__ __forceinline__ bool next(int i, pg8::Unit& u) const {
        const long L = (long)i * G + c; if (L >= nwg) return false;
        int wgid = (int)L; { const int q = nwg / 8, r = nwg % 8, xcd = wgid % 8, off = wgid / 8; wgid = (xcd < r ? xcd * (q + 1) : r * (q + 1) + (xcd - r) * q) + off; }
        const int nig = 8 * nN, gid = wgid / nig, fm = gid * 8, gsz = (nM - fm) < 8 ? (nM - fm) : 8;
        u.pm = fm + ((wgid % nig) % gsz); u.pn = (wgid % nig) / gsz; u.z = i; u.e = 0; return true;
    }
    __device__ __forceinline__ void bases(const pg8::Unit& u, const char*& a, const char*& b) const { a = A + (size_t)u.pm * tstep; b = Bt + (size_t)u.pn * tstep; }
    __device__ __forceinline__ int tok(int, int) const { return 0; }
};
struct MergeOrder {
    DenseOrder d; const char *A1, *B1;
    __device__ __forceinline__ bool next(int i, pg8::Unit& u) const { if (!d.next(i >> 1, u)) return false; u.z = i & 1; return true; }
    __device__ __forceinline__ void bases(const pg8::Unit& u, const char*& a, const char*& b) const { a = (u.z ? A1 : d.A) + (size_t)u.pm * d.tstep; b = (u.z ? B1 : d.Bt) + (size_t)u.pn * d.tstep; }
    __device__ __forceinline__ int tok(int, int) const { return 0; }
};
typedef pg8::f32x4 acc_t[2][2][4][2];
struct EpiProj {
    static constexpr bool PERM = true, TWICE = false; static constexpr int MIN_VM = 16;
    bf16* ws5; bf16* dout2; volatile LAS int* MI; float sB;
    __device__ __forceinline__ void operator()(const acc_t& acc, const pg8::Unit& u, int wr, int wc, int fr, int fq) const {
        const int t = u.pn >> 2, colt = (u.pn & 3) * 256;
        bf16* base = ws5 + (size_t)(t < 5 ? t : 0) * T * D;
        const int row0 = u.pm * 256 + wr * 64 + fr, col0 = colt + wc * 32 + 8 * fq;
#pragma unroll
        for (int ai = 0; ai < 2; ++ai)
#pragma unroll
            for (int m = 0; m < 4; ++m) { bf16* rowp = base + (size_t)(row0 + ai * 128 + m * 16) * D + col0;
                const float sc = __int_as_float(MI[512 + u.z * 256 + wr * 64 + fr + ai * 128 + m * 16]) * sB;
#pragma unroll
                for (int bj = 0; bj < 2; ++bj) { const pg8::i32x4 I0 = __builtin_bit_cast(pg8::i32x4, acc[ai][bj][m][0]), I1 = __builtin_bit_cast(pg8::i32x4, acc[ai][bj][m][1]);
                    pg8::f32x4 v0, v1;
#pragma unroll
                    for (int i = 0; i < 4; ++i) { float a = (float)I0[i] * sc, b = (float)I1[i] * sc; asm volatile("" : "+v"(a), "+v"(b)); v0[i] = a; v1[i] = b; }
                    if (t >= 5) {
                        unsigned tb[8];
#pragma unroll
                        for (int i = 0; i < 4; ++i) { tb[i] = __float_as_uint(__builtin_fmaf(sigm(v0[i]), 255.0f, 8388608.0f)); tb[4 + i] = __float_as_uint(__builtin_fmaf(sigm(v1[i]), 255.0f, 8388608.0f)); }
                        v2u w; w.x = __builtin_amdgcn_perm(__builtin_amdgcn_perm(tb[3], tb[2], 0x0c0c0400u), __builtin_amdgcn_perm(tb[1], tb[0], 0x0c0c0400u), 0x05040100u);
                        w.y = __builtin_amdgcn_perm(__builtin_amdgcn_perm(tb[7], tb[6], 0x0c0c0400u), __builtin_amdgcn_perm(tb[5], tb[4], 0x0c0c0400u), 0x05040100u);
                        *(v2u*)((unsigned char*)dout2 + (size_t)(t - 5) * T * D + (size_t)(row0 + ai * 128 + m * 16) * D + col0 + bj * 128) = w; continue; }
                    if (t == 1) { for (int i = 0; i < 4; ++i) { v0[i] = pg8::gelu_t(v0[i]); v1[i] = pg8::gelu_t(v1[i]); } }
                    else if (t == 2) { v0 = v0 * attn_body::C2; v1 = v1 * attn_body::C2; }
                    v4u w; w.x = pg8::cvt_pk_bf16(v0[0], v0[1]); w.y = pg8::cvt_pk_bf16(v0[2], v0[3]); w.z = pg8::cvt_pk_bf16(v1[0], v1[1]); w.w = pg8::cvt_pk_bf16(v1[2], v1[3]);
                    *(v4u*)(rowp + bj * 128) = w; } }
    }
};
struct EpiGate {
    static constexpr bool PERM = true, TWICE = false; static constexpr int MIN_VM = 16;
    const unsigned char* GA; const unsigned char* GB; bf16* YA; bf16* MG;
    __device__ __forceinline__ void operator()(const acc_t& acc, const pg8::Unit& u, int wr, int wc, int fr, int fq) const {
        const int row0 = u.pm * 256 + wr * 64 + fr, col0 = u.pn * 256 + wc * 32 + 8 * fq;
        const unsigned char* G = u.z ? GB : GA; bf16* O = u.z ? MG : YA;
#pragma unroll
        for (int ai = 0; ai < 2; ++ai)
#pragma unroll
            for (int mp = 0; mp < 2; ++mp) {
                v2u g[2][2]; v4u y[2][2];
#pragma unroll
                for (int mm = 0; mm < 2; ++mm)
#pragma unroll
                    for (int bj = 0; bj < 2; ++bj) { const size_t off = (size_t)(row0 + ai * 128 + (2 * mp + mm) * 16) * D + col0 + bj * 128; g[mm][bj] = *(const v2u*)(G + off);
                        y[mm][bj] = u.z ? *(const v4u*)(YA + off) : (v4u){0u, 0u, 0u, 0u}; }
#pragma unroll
                for (int mm = 0; mm < 2; ++mm)
#pragma unroll
                    for (int bj = 0; bj < 2; ++bj) { const int m = 2 * mp + mm; const size_t off = (size_t)(row0 + ai * 128 + m * 16) * D + col0 + bj * 128; const v2u gg = g[mm][bj]; const v4u yy = y[mm][bj]; constexpr float Q = 1.0f / 255.0f;
                        pg8::f32x4 v0 = acc[ai][bj][m][0], v1 = acc[ai][bj][m][1];
                        v0[0] = v0[0] * ((float)(gg.x & 0xffu) * Q) + bflo(yy.x); v0[1] = v0[1] * ((float)((gg.x >> 8) & 0xffu) * Q) + bfhi(yy.x); v0[2] = v0[2] * ((float)((gg.x >> 16) & 0xffu) * Q) + bflo(yy.y); v0[3] = v0[3] * ((float)(gg.x >> 24) * Q) + bfhi(yy.y);
                        v1[0] = v1[0] * ((float)(gg.y & 0xffu) * Q) + bflo(yy.z); v1[1] = v1[1] * ((float)((gg.y >> 8) & 0xffu) * Q) + bfhi(yy.z); v1[2] = v1[2] * ((float)((gg.y >> 16) & 0xffu) * Q) + bflo(yy.w); v1[3] = v1[3] * ((float)(gg.y >> 24) * Q) + bfhi(yy.w);
                        v4u w; w.x = pg8::cvt_pk_bf16(v0[0], v0[1]); w.y = pg8::cvt_pk_bf16(v0[2], v0[3]); w.z = pg8::cvt_pk_bf16(v1[0], v1[1]); w.w = pg8::cvt_pk_bf16(v1[2], v1[3]);
                        *(v4u*)(O + off) = w; }
                asm volatile("" ::: "memory"); }
    }
};
struct EpiF32 {
    static constexpr bool PERM = true, TWICE = false; static constexpr int MIN_VM = 16;
    bf16* Y;
    __device__ __forceinline__ void operator()(const acc_t& acc, const pg8::Unit& u, int wr, int wc, int fr, int fq) const {
        const int row0 = u.pm * 256 + wr * 64 + fr, col0 = u.pn * 256 + wc * 32 + 8 * fq;
#pragma unroll
        for (int ai = 0; ai < 2; ++ai)
#pragma unroll
            for (int m = 0; m < 4; ++m) { bf16* rowp = Y + (size_t)(row0 + ai * 128 + m * 16) * D + col0;
#pragma unroll
                for (int bj = 0; bj < 2; ++bj) { const pg8::f32x4 v0 = acc[ai][bj][m][0], v1 = acc[ai][bj][m][1];
                    v4u w; w.x = pg8::cvt_pk_bf16(v0[0], v0[1]); w.y = pg8::cvt_pk_bf16(v0[2], v0[3]); w.z = pg8::cvt_pk_bf16(v1[0], v1[1]); w.w = pg8::cvt_pk_bf16(v1[2], v1[3]);
                    *(v4u*)(rowp + bj * 128) = w; } }
    }
};

__device__ __forceinline__ void lru_phase(Frame& F, const Args& A) {
    unsigned char* ws = F.ws;
    const bf16* XR = (const bf16*)(ws + WS_XR); bf16* GR = (bf16*)(ws + WS_GR);
    LAS unsigned char* AT = F.lds;
    LAS unsigned char* BT = F.lds + 34816;
    LAS float* AA = (LAS float*)(F.lds + 69632);
    LAS float* UU = (LAS float*)(F.lds + 102400);
    LAS float* SM = (LAS float*)(F.lds + 135168);
    LAS float* CW = (LAS float*)(F.lds + MISC_OFF + 4096);
    const int tid = F.tid, lane = F.lane, w = F.wave, hi = lane >> 5, l31 = lane & 31;
    for (int item = F.vcu; item < BATCH * 16; item += F.G) {
        const int b = item >> 4, n = (item >> 1) & 7, half = item & 1;
        __syncthreads();
        { const bf16* LW = (const bf16*)(ws + WS_LW) + (size_t)n * 2 * 128 * 128;
#pragma unroll
          for (int p = 0; p < 4; ++p) { const int q = tid + 512 * p, row = q >> 4, pc = q & 15; const int gate = row >> 6, d = 64 * half + (row & 63);
              const v4u v = *(const v4u*)(LW + ((size_t)gate * 128 + d) * 128 + pc * 8); *(LAS v4u*)(BT + row * 272 + pc * 16) = v; }
          for (int i = tid; i < 640; i += NWAVES * 64) { const int k = i >> 7, c = i & 127; CW[i] = (k < 4) ? A.in[6][k * D + 128 * n + c] : A.in[7][128 * n + c]; } }
        const int c8 = (tid & 15) * 8, run = tid >> 4, cg0 = 128 * n + c8;
        const int tg = w & 3, cg = w >> 2, lc = 32 * cg + l31, chg = 128 * n + 64 * half + lc;
        const float ba_c = A.in[9][chg], bx_c = A.in[11][chg];
        const float lam = A.in[12][chg]; const float sp8 = 8.0f * log1pf(expf(-lam)) * LOG2E;
        const int sc_c = tid & 63, seg = tid >> 6;
        float hcarry = 0.f;
        v4u xq[7];
        { const bf16* xp = XR + ((size_t)b * SEQ + 4 * run - 3) * D + cg0;
#pragma unroll
          for (int i = 0; i < 7; ++i) xq[i] = (4 * run - 3 + i >= 0) ? *(const v4u*)(xp + (size_t)i * D) : (v4u){0u, 0u, 0u, 0u}; }
        __syncthreads();
#pragma unroll 1
        for (int ck = 0; ck < SEQ / 128; ++ck) {
            const int t0 = 128 * ck;
            bf16* gp = GR + ((size_t)b * SEQ + t0 + 16 * seg) * D + 128 * n + 64 * half + sc_c;
            { unsigned ow[4][4];
#pragma unroll
              for (int hf = 0; hf < 2; ++hf) { float wv[5][4];
#pragma unroll
                  for (int k = 0; k < 5; ++k) { const f32x4 w0 = *(const LAS f32x4*)(CW + k * 128 + c8 + 4 * hf); wv[k][0] = w0.x; wv[k][1] = w0.y; wv[k][2] = w0.z; wv[k][3] = w0.w; }
#pragma unroll
                  for (int tt = 0; tt < 4; ++tt) { float x0 = wv[4][0], x1 = wv[4][1], x2 = wv[4][2], x3 = wv[4][3];
#pragma unroll
                      for (int k = 0; k < 4; ++k) { const unsigned va = hf ? xq[tt + k].z : xq[tt + k].x, vb = hf ? xq[tt + k].w : xq[tt + k].y;
                          x0 += wv[k][0] * bflo(va); x1 += wv[k][1] * bfhi(va); x2 += wv[k][2] * bflo(vb); x3 += wv[k][3] * bfhi(vb); }
                      ow[tt][2 * hf] = pk2(x0, x1); ow[tt][2 * hf + 1] = pk2(x2, x3); } }
#pragma unroll
              for (int tt = 0; tt < 4; ++tt) { v4u o; o.x = ow[tt][0]; o.y = ow[tt][1]; o.z = ow[tt][2]; o.w = ow[tt][3]; *(LAS v4u*)(AT + (4 * run + tt) * 272 + c8 * 2) = o; } }
            if (ck + 1 < SEQ / 128) { const bf16* xp = XR + ((size_t)b * SEQ + t0 + 128 + 4 * run - 3) * D + cg0;
#pragma unroll
                for (int i = 0; i < 7; ++i) xq[i] = *(const v4u*)(xp + (size_t)i * D); }
            __syncthreads();
            { f32x16 accR = f32x16{}, accI = f32x16{};
              unsigned short xcq[16];
#pragma unroll
              for (int r = 0; r < 16; ++r) xcq[r] = *(const LAS unsigned short*)(AT + (32 * tg + (r & 3) + 8 * (r >> 2) + 4 * hi) * 272 + (64 * half + lc) * 2);
#pragma unroll
              for (int ks = 0; ks < 8; ++ks) {
                  const bf16x8 a = *(const LAS bf16x8*)(AT + (32 * tg + l31) * 272 + (16 * ks + 8 * hi) * 2);
                  const bf16x8 bR = *(const LAS bf16x8*)(BT + (32 * cg + l31) * 272 + (16 * ks + 8 * hi) * 2);
                  const bf16x8 bI = *(const LAS bf16x8*)(BT + (64 + 32 * cg + l31) * 272 + (16 * ks + 8 * hi) * 2);
                  accR = __builtin_amdgcn_mfma_f32_32x32x16_bf16(a, bR, accR, 0, 0, 0);
                  accI = __builtin_amdgcn_mfma_f32_32x32x16_bf16(a, bI, accI, 0, 0, 0); }
#pragma unroll
              for (int r = 0; r < 16; ++r) {
                  const int tok = 32 * tg + (r & 3) + 8 * (r >> 2) + 4 * hi;
                  const float rg = sigm(accR[r] + ba_c), ig = sigm(accI[r] + bx_c);
                  const float la2 = -sp8 * rg;
                  const float a = __builtin_amdgcn_exp2f(la2);
                  float mult = __builtin_amdgcn_sqrtf(fmaxf(1.0f - a * a, 0.f));
                  if (t0 + tok == 0) mult = 1.0f;
                  const float xcv = bf2f(xcq[r]);
                  AA[tok * 64 + lc] = a; UU[tok * 64 + lc] = mult * ig * xcv; } }
            __syncthreads();
            unsigned short gq[16];
#pragma unroll
            for (int j = 0; j < 16; ++j) gq[j] = gp[(size_t)j * D];
            float hl[16], pl[16];
            { float h = 0.f, P = 1.f; float av[16], uv[16];
#pragma unroll
              for (int j = 0; j < 16; ++j) { av[j] = AA[(16 * seg + j) * 64 + sc_c]; uv[j] = UU[(16 * seg + j) * 64 + sc_c]; }
              asm volatile("s_waitcnt lgkmcnt(0)" ::: "memory");
#pragma unroll
              for (int j = 0; j < 16; ++j) { const float a = av[j], u = uv[j]; h = a * h + u; P = P * a; hl[j] = h; pl[j] = P; }
              SM[(seg * 64 + sc_c) * 2] = P; SM[(seg * 64 + sc_c) * 2 + 1] = h; }
            __syncthreads();
            { float cin = hcarry, tot = hcarry;
#pragma unroll
              for (int s = 0; s < 8; ++s) { const float Ps = SM[(s * 64 + sc_c) * 2], hs = SM[(s * 64 + sc_c) * 2 + 1]; tot = Ps * tot + hs; if (s < seg) cin = tot; }
              hcarry = tot;
#pragma unroll
              for (int j = 0; j < 16; ++j) { const float hv = hl[j] + pl[j] * cin; gp[(size_t)j * D] = (bf16)f2bf(hv * bf2f(gq[j])); } }
        }
    }
    __syncthreads();
}

__device__ __forceinline__ void p5_phase(Frame& F, const Args& A) {
    const int gw = F.vcu * NWAVES + F.wave, NGW = F.G * NWAVES;
    float d1 = A.in[13][F.lane] * A.in[14][F.lane], d2 = A.in[15][F.lane] * A.in[16][F.lane];
    const float lam = expf(wave_sum(d1)) - expf(wave_sum(d2)) + LAM_INIT;
    bf16* O0 = (bf16*)(F.ws + WS_H); const bf16* O1 = (const bf16*)(F.ws + WS_O1);
    float g[16];
#pragma unroll
    for (int i = 0; i < 16; ++i) g[i] = A.in[17][(16 * F.lane + i) & 127] * (1.0f - LAM_INIT);
    for (int m = gw; m < T; m += NGW) {
        const v4u a0 = *(const v4u*)(O0 + (size_t)m * D + 16 * F.lane), a1 = *(const v4u*)(O0 + (size_t)m * D + 16 * F.lane + 8);
        const v4u b0 = *(const v4u*)(O1 + (size_t)m * D + 16 * F.lane), b1 = *(const v4u*)(O1 + (size_t)m * D + 16 * F.lane + 8);
        float o[16];
        o[0] = bflo(a0.x) - lam * bflo(b0.x); o[1] = bfhi(a0.x) - lam * bfhi(b0.x); o[2] = bflo(a0.y) - lam * bflo(b0.y); o[3] = bfhi(a0.y) - lam * bfhi(b0.y);
        o[4] = bflo(a0.z) - lam * bflo(b0.z); o[5] = bfhi(a0.z) - lam * bfhi(b0.z); o[6] = bflo(a0.w) - lam * bflo(b0.w); o[7] = bfhi(a0.w) - lam * bfhi(b0.w);
        o[8] = bflo(a1.x) - lam * bflo(b1.x); o[9] = bfhi(a1.x) - lam * bfhi(b1.x); o[10] = bflo(a1.y) - lam * bflo(b1.y); o[11] = bfhi(a1.y) - lam * bfhi(b1.y);
        o[12] = bflo(a1.z) - lam * bflo(b1.z); o[13] = bfhi(a1.z) - lam * bfhi(b1.z); o[14] = bflo(a1.w) - lam * bflo(b1.w); o[15] = bfhi(a1.w) - lam * bfhi(b1.w);
        float s = 0.f;
#pragma unroll
        for (int i = 0; i < 16; ++i) s += o[i] * o[i];
        s += __shfl_xor(s, 1); s += __shfl_xor(s, 2); s += __shfl_xor(s, 4);
        const float rstd = 1.f / sqrtf(s * (1.f / 128.f) + EPS);
        v4u w0, w1;
        w0.x = pk2(o[0] * rstd * g[0], o[1] * rstd * g[1]); w0.y = pk2(o[2] * rstd * g[2], o[3] * rstd * g[3]); w0.z = pk2(o[4] * rstd * g[4], o[5] * rstd * g[5]); w0.w = pk2(o[6] * rstd * g[6], o[7] * rstd * g[7]);
        w1.x = pk2(o[8] * rstd * g[8], o[9] * rstd * g[9]); w1.y = pk2(o[10] * rstd * g[10], o[11] * rstd * g[11]); w1.z = pk2(o[12] * rstd * g[12], o[13] * rstd * g[13]); w1.w = pk2(o[14] * rstd * g[14], o[15] * rstd * g[15]);
        *(v4u*)(O0 + (size_t)m * D + 16 * F.lane) = w0; *(v4u*)(O0 + (size_t)m * D + 16 * F.lane + 8) = w1;
    }
}

#ifndef PROBE_SEG
#define PROBE_SEG 0
#endif
#define SEG_T0() do { if (PROBE_SEG != 0 && F.tid == 0) { volatile LAS unsigned long long* pp_ = (volatile LAS unsigned long long*)(F.MI + 16); pp_[0] = __builtin_amdgcn_s_memrealtime(); } } while (0)
#define SEG_T1(id) do { if (PROBE_SEG != 0 && F.tid == 0) { volatile LAS unsigned long long* pp_ = (volatile LAS unsigned long long*)(F.MI + 16); const unsigned long long t_ = __builtin_amdgcn_s_memrealtime(); if (PROBE_SEG == (id)) pp_[1] += t_ - pp_[0]; pp_[0] = t_; } } while (0)
__device__ __forceinline__ void p8_phase(Frame& F, const Args& A) {
    unsigned char* ws = F.ws;
    const float* mod = (const float*)(ws + WS_MOD); const bf16* Y = (const bf16*)(ws + WS_Y);
    signed char* H2 = (signed char*)(ws + WS_H);
    LAS unsigned char* TH = F.lds; LAS unsigned char* TL = F.lds + 66048;
    LAS float* red = (LAS float*)F.lds;
    LAS int* cntl = (LAS int*)(F.lds + 135168);
    const int tid = F.tid, lane = F.lane, w = F.wave, hi = lane >> 5, l31 = lane & 31;
    int* lists = (int*)(ws + WS_LIST); float* wts = (float*)(ws + WS_WTS);
    v2u yn[2][4]; f32x4 xn[2][4];
    if (F.vcu < T / 32) {
#pragma unroll
        for (int q = 0; q < 2; ++q) { const size_t m = (size_t)F.vcu * 32 + w * 4 + q;
#pragma unroll
            for (int j = 0; j < 4; ++j) { yn[q][j] = __builtin_nontemporal_load((const GAS v2u*)(Y + m * D) + lane + 64 * j); xn[q][j] = __builtin_nontemporal_load((const GAS f32x4*)(A.in[0] + m * D) + lane + 64 * j); } } }
#pragma unroll 1
    for (int tl = F.vcu; tl < T / 32; tl += F.G) {
        const int tok0 = tl * 32, b = tok0 / SEQ, chunk = tok0 / TC;
        if (tid < 64) cntl[tid] = 0;
        SEG_T0();
        f32x4 c_gp[4], c_g2[4], c_sh[4];
#pragma unroll
        for (int j = 0; j < 4; ++j) { const int c = 4 * lane + 256 * j; c_gp[j] = *(const f32x4*)(A.in[21] + c) * *(const f32x4*)(mod + b * 6 * D + 2 * D + c);
            c_g2[j] = *(const f32x4*)(A.in[22] + c) * (*(const f32x4*)(mod + b * 6 * D + 4 * D + c) + 1.0f); c_sh[j] = *(const f32x4*)(mod + b * 6 * D + 3 * D + c); }
#pragma unroll 1
        for (int rp = 0; rp < 2; ++rp) {
            f32x4 y[2][4], x[2][4]; float s[2] = {0.f, 0.f};
#pragma unroll
            for (int q = 0; q < 2; ++q)
#pragma unroll
                for (int j = 0; j < 4; ++j) { const v2u yv = yn[q][j]; y[q][j] = (f32x4){bflo(yv.x), bfhi(yv.x), bflo(yv.y), bfhi(yv.y)}; x[q][j] = xn[q][j]; }
            { const int ntl = rp ? tl + F.G : tl, nrp = rp ^ 1;
              if (ntl < T / 32) {
#pragma unroll
                  for (int q = 0; q < 2; ++q) { const size_t m = (size_t)ntl * 32 + w * 4 + nrp * 2 + q;
#pragma unroll
                      for (int j = 0; j < 4; ++j) { yn[q][j] = __builtin_nontemporal_load((const GAS v2u*)(Y + m * D) + lane + 64 * j); xn[q][j] = __builtin_nontemporal_load((const GAS f32x4*)(A.in[0] + m * D) + lane + 64 * j); } } } }
#pragma unroll
            for (int q = 0; q < 2; ++q)
#pragma unroll
                for (int j = 0; j < 4; ++j) s[q] += (y[q][j].x * y[q][j].x + y[q][j].y * y[q][j].y) + (y[q][j].z * y[q][j].z + y[q][j].w * y[q][j].w);
            float s2[2] = {0.f, 0.f};
#pragma unroll
            for (int q = 0; q < 2; ++q) { const size_t m = (size_t)tok0 + w * 4 + rp * 2 + q; const float rstd = 1.f / sqrtf(wave_sum_dpp(s[q]) * (1.f / D) + EPS);
#pragma unroll
                for (int j = 0; j < 4; ++j) { x[q][j] = x[q][j] + c_gp[j] * (y[q][j] * rstd); { v2u xb; xb.x = pk2(x[q][j].x, x[q][j].y); xb.y = pk2(x[q][j].z, x[q][j].w); *((v2u*)(F.out + m * D) + lane + 64 * j) = xb; }
                    s2[q] += (x[q][j].x * x[q][j].x + x[q][j].y * x[q][j].y) + (x[q][j].z * x[q][j].z + x[q][j].w * x[q][j].w); } }
#pragma unroll
            for (int q = 0; q < 2; ++q) { const size_t m = (size_t)tok0 + w * 4 + rp * 2 + q; const float rstd2 = 1.f / sqrtf(wave_sum_dpp(s2[q]) * (1.f / D) + EPS);
#pragma unroll
                for (int j = 0; j < 4; ++j) { const int c = 4 * lane + 256 * j; const f32x4 h = (x[q][j] * rstd2) * c_g2[j] + c_sh[j];
                    v2u o; o.x = pk2(h.x, h.y); o.y = pk2(h.z, h.w);
                    *(LAS v2u*)(TH + (w * 4 + rp * 2 + q) * 2064 + c * 2) = o;
                    unsigned f8 = (unsigned)__builtin_amdgcn_cvt_pk_fp8_f32(__builtin_amdgcn_fmed3f(h.x, -448.0f, 448.0f), __builtin_amdgcn_fmed3f(h.y, -448.0f, 448.0f), 0, false);
                    f8 = (unsigned)__builtin_amdgcn_cvt_pk_fp8_f32(__builtin_amdgcn_fmed3f(h.z, -448.0f, 448.0f), __builtin_amdgcn_fmed3f(h.w, -448.0f, 448.0f), (int)f8, true);
                    *((GAS unsigned*)(H2 + m * D) + lane + 64 * j) = f8; } }
        }
        bf16x8 bH0[8], bH1[8];
        { const bf16* whp = (const bf16*)(ws + WS_WRH) + (size_t)l31 * D + 128 * w + 8 * hi;
#pragma unroll
          for (int ks = 0; ks < 8; ++ks) { bH0[ks] = *(const GAS bf16x8*)(whp + ks * 16); bH1[ks] = *(const GAS bf16x8*)(whp + 32 * D + ks * 16); } }
        __syncthreads(); SEG_T1(1);
        f32x16 acc0 = f32x16{}, acc1 = f32x16{};
        { const LAS unsigned char* ahp = TH + l31 * 2064 + (128 * w + 8 * hi) * 2;
#pragma unroll
          for (int ks = 0; ks < 8; ++ks) {
              const bf16x8 aH = *(const LAS bf16x8*)(ahp + ks * 32);
              acc0 = __builtin_amdgcn_mfma_f32_32x32x16_bf16(aH, bH0[ks], acc0, 0, 0, 0); acc1 = __builtin_amdgcn_mfma_f32_32x32x16_bf16(aH, bH1[ks], acc1, 0, 0, 0); } }
        __syncthreads(); SEG_T1(2);
#pragma unroll
        for (int r = 0; r < 16; ++r) { const int tk = (r & 3) + 8 * (r >> 2) + 4 * hi; red[(w * 32 + tk) * 64 + l31] = acc0[r]; red[(w * 32 + tk) * 64 + 32 + l31] = acc1[r]; }
        __syncthreads();
        int sel_e[4], sel_lp[4], sel_slot[4]; float sel_wt[4];
        const float eb = A.in[24][lane];
#pragma unroll
        for (int q = 0; q < 4; ++q) {
            const int tk = 4 * w + q; float lg = 0.f;
#pragma unroll
            for (int ww = 0; ww < 8; ++ww) lg += red[(ww * 32 + tk) * 64 + lane];
            const float score = 1.0f / (1.0f + expf(-lg)); const float ch = score + eb;
            const float m1 = max8_dpp(ch);
            const unsigned long long eq = __ballot(ch == m1); const int gsh = lane & ~7; const unsigned ge = (unsigned)((eq >> gsh) & 0xffull);
            const int first = gsh + __builtin_ctz(ge);
            const float m2 = max8_dpp((lane == first) ? -INFINITY : ch);
            const float gs = m1 + m2; const int g = lane >> 3;
            int grank = 0;
#pragma unroll
            for (int gg = 0; gg < 8; ++gg) { const float og = rl_f(gs, gg * 8); grank += (og > gs || (og == gs && gg < g)) ? 1 : 0; }
            float cur = (grank < 4) ? ch : -INFINITY;
            int rank = TOPK;
#pragma unroll
            for (int kk = 0; kk < TOPK; ++kk) { const float mx = wave_max_dpp(cur); const unsigned long long mk = __ballot(cur == mx); const int fl = (int)__builtin_ctzll(mk);
                if (lane == fl) { rank = kk; cur = -INFINITY; } }
            const bool sel = rank < TOPK;
            const float wsum = wave_sum_dpp(sel ? score : 0.f);
            sel_e[q] = sel ? lane : -1; sel_slot[q] = (tok0 + tk) * 8 + rank; sel_wt[q] = score / (wsum + 1e-20f) * 2.5f;
            sel_lp[q] = sel ? atomicAdd((int*)&cntl[lane], 1) : 0;
        }
        __syncthreads(); SEG_T1(3);
        if (tid < 64) { const int c = cntl[tid]; cntl[64 + tid] = c ? (int)__hip_atomic_fetch_add((unsigned*)(F.ctl + CW_CNT + chunk * 64 + tid), (unsigned)c, RLX_AGENT) : 0; }
        __syncthreads();
#pragma unroll
        for (int q = 0; q < 4; ++q) if (sel_e[q] >= 0) { const int pos = cntl[64 + lane] + sel_lp[q]; lists[((size_t)chunk * 64 + lane) * TC + pos] = sel_slot[q]; wts[sel_slot[q]] = sel_wt[q]; }
        __syncthreads(); SEG_T1(4);
    }
    SEG_T0();
    __syncthreads();
    LAS float* scr = (LAS float*)(F.lds + w * 16384);
    const int gw = F.vcu * NWAVES + w, NGW = F.G * NWAVES;
    constexpr int I13 = 16 * 4, I2 = 4 * 16, PER_E = 2 * I13 + I2;
    for (int it = gw; it < (NEXP + 1) * PER_E; it += NGW) {
        const int e = it / PER_E; int r = it % PER_E;
        const bool sh = (e == NEXP);
        if (r < 2 * I13) { const int w3 = r / I13; r %= I13; const int kb = r >> 2, n0 = 64 * (r & 3);
            const float* W = sh ? (w3 ? A.in[29] : A.in[28]) : ((w3 ? A.in[26] : A.in[25]) + (size_t)e * D * DEXP);
            signed char* WT = sh ? (signed char*)(ws + WS_W13S) : (signed char*)(ws + WS_W13) + (size_t)e * 512 * D;
            transpose_item_q<true>(W, D, DEXP, WT, kb, n0, (n0 >> 7) * 256 + (w3 ? 128 : 0) + (n0 & 127), scr, lane, 64.0f); }
        else { r -= 2 * I13; const int kb = r >> 4, n0 = 64 * (r & 15);
            const float* W = sh ? A.in[30] : A.in[27] + (size_t)e * DEXP * D;
            signed char* WT = sh ? (signed char*)(ws + WS_W2S) : (signed char*)(ws + WS_W2) + (size_t)e * D * DEXP;
            transpose_item_q<true>(W, DEXP, D, WT, kb, n0, n0, scr, lane, 16.0f); }
    }
    __syncthreads(); SEG_T1(5);
}

__device__ __forceinline__ int moe_tables(Frame& F, int chunk) {
    __syncthreads();
    if (F.wave == 0) {
        const int cnt = (int)__hip_atomic_load(F.ctl + CW_CNT + chunk * 64 + F.lane, RLX_AGENT);
        const int nt = (cnt + 255) >> 8; int incl = nt;
#pragma unroll
        for (int o = 1; o < 64; o <<= 1) { const int v = __shfl_up(incl, o); if (F.lane >= o) incl += v; }
        const int base = incl - nt;
        F.MI[MI_CNT + F.lane] = cnt; F.MI[MI_TBASE + F.lane] = base; if (F.lane == 63) F.MI[MI_TBASE + NEXP] = incl;
        for (int j = 0; j < nt; ++j) ((volatile LAS unsigned char*)(F.MI + MI_TILE_E))[base + j] = (unsigned char)F.lane; }
    __syncthreads();
    return F.MI[MI_TBASE + NEXP];
}
struct UpOrder {
    const char* ws; volatile LAS int* MI; int nrt_r, nrt, G, c;
    __device__ __forceinline__ bool next(int i, pg8::Unit& u) const { const int L = i * G + c; if (L >= 2 * nrt) return false; u.pm = L >> 1; u.pn = L & 1; u.z = i;
        u.e = (u.pm < nrt_r) ? __builtin_amdgcn_readfirstlane((int)((volatile LAS unsigned char*)(MI + MI_TILE_E))[u.pm]) : NEXP; return true; }
    __device__ __forceinline__ void bases(const pg8::Unit& u, const char*& a, const char*& b) const { a = ws + WS_H; b = (u.e < NEXP ? ws + WS_W13 + (size_t)u.e * 512 * D : ws + WS_W13S) + (size_t)u.pn * 256 * D; }
    __device__ __forceinline__ int tok(int ui, int row) const { return MI[MI_TOK + ui * 256 + row]; }
};
struct EpiSwiglu {
    static constexpr bool PERM = true, TWICE = false; static constexpr int MIN_VM = 8;
    unsigned char* HB;
    __device__ __forceinline__ void operator()(const acc_t& acc, const pg8::Unit& u, int wr, int wc, int fr, int fq) const {
        const int row0 = u.pm * 256 + wr * 64 + fr, col0 = u.pn * 128 + wc * 32 + 8 * fq;
#pragma unroll
        for (int ai = 0; ai < 2; ++ai)
#pragma unroll
            for (int m = 0; m < 4; ++m) { unsigned char* rowp = HB + (size_t)(row0 + ai * 128 + m * 16) * DEXP + col0;
                float v[8];
#pragma unroll
                for (int i = 0; i < 4; ++i) { const float a = acc[ai][0][m][0][i] * 0.015625f, g = acc[ai][1][m][0][i] * 0.015625f; v[i] = a * sigm(a) * g;
                    const float a2 = acc[ai][0][m][1][i] * 0.015625f, g2 = acc[ai][1][m][1][i] * 0.015625f; v[4 + i] = a2 * sigm(a2) * g2; }
#pragma unroll
                for (int i = 0; i < 8; ++i) v[i] = __builtin_amdgcn_fmed3f(v[i], -448.0f, 448.0f);
                v2u w; w.x = (unsigned)__builtin_amdgcn_cvt_pk_fp8_f32(v[0], v[1], 0, false); w.x = (unsigned)__builtin_amdgcn_cvt_pk_fp8_f32(v[2], v[3], (int)w.x, true);
                w.y = (unsigned)__builtin_amdgcn_cvt_pk_fp8_f32(v[4], v[5], 0, false); w.y = (unsigned)__builtin_amdgcn_cvt_pk_fp8_f32(v[6], v[7], (int)w.y, true);
                *(v2u*)rowp = w; asm volatile("" ::: "memory"); }
    }
};
struct DownOrder {
    const char* ws; volatile LAS int* MI; int nrt_r, nrt, G, c;
    __device__ __forceinline__ bool next(int i, pg8::Unit& u) const { const int L = i * G + c; if (L >= 4 * nrt) return false; u.pm = L >> 2; u.pn = L & 3; u.z = i;
        u.e = (u.pm < nrt_r) ? __builtin_amdgcn_readfirstlane((int)((volatile LAS unsigned char*)(MI + MI_TILE_E))[u.pm]) : NEXP; return true; }
    __device__ __forceinline__ void bases(const pg8::Unit& u, const char*& a, const char*& b) const { a = ws + WS_HB + (size_t)u.pm * 256 * DEXP; b = (u.e < NEXP ? ws + WS_W2 + (size_t)u.e * D * DEXP : ws + WS_W2S) + (size_t)u.pn * 256 * DEXP; }
    __device__ __forceinline__ int tok(int, int) const { return 0; }
};
struct EpiScatter {
    static constexpr bool PERM = true, TWICE = true; static constexpr int MIN_VM = 0;
    unsigned char* SL; volatile LAS int* MI;
    __device__ __forceinline__ void operator()(const acc_t& acc, const pg8::Unit& u, int wr, int wc, int fr, int fq) const {
        const int col0 = u.pn * 256 + wc * 32 + 8 * fq;
#pragma unroll
        for (int ai = 0; ai < 2; ++ai)
#pragma unroll
            for (int m = 0; m < 4; ++m) { const int rl = wr * 64 + fr + ai * 128 + m * 16; const int dest = MI[MI_TOK + u.z * 256 + rl]; const float wt = 1.0f;
                if (dest >= 0) { unsigned char* rowp = SL + (size_t)dest * D + col0;
#pragma unroll
                    for (int bj = 0; bj < 2; ++bj) { const pg8::f32x4 v0 = acc[ai][bj][m][0], v1 = acc[ai][bj][m][1];
                        float q[8];
#pragma unroll
                        for (int i = 0; i < 4; ++i) { q[i] = __builtin_amdgcn_fmed3f(v0[i] * wt, -448.0f, 448.0f); q[4 + i] = __builtin_amdgcn_fmed3f(v1[i] * wt, -448.0f, 448.0f); }
                        v2u w; w.x = (unsigned)__builtin_amdgcn_cvt_pk_fp8_f32(q[0], q[1], 0, false); w.x = (unsigned)__builtin_amdgcn_cvt_pk_fp8_f32(q[2], q[3], (int)w.x, true);
                        w.y = (unsigned)__builtin_amdgcn_cvt_pk_fp8_f32(q[4], q[5], 0, false); w.y = (unsigned)__builtin_amdgcn_cvt_pk_fp8_f32(q[6], q[7], (int)w.y, true);
                        *(v2u*)(rowp + bj * 128) = w; asm volatile("" ::: "memory"); } } }
    }
};
__device__ __forceinline__ void p2_phase(Frame& F, const Args& A) {
    unsigned char* ws = F.ws;
    DenseOrder S; S.init(ws + WS_HQ, ws + WS_WIN, T, W_IN, D / 2, F.G, F.cidx);
    const float* SH = (const float*)(ws + WS_SH);
    { float v[7]; int pmv[7];
#pragma unroll
      for (int k = 0; k < 7; ++k) { pg8::Unit u; pmv[k] = S.next((F.tid >> 8) + 2 * k, u) ? u.pm : -1; v[k] = pmv[k] >= 0 ? SH[pmv[k] * 256 + (F.tid & 255)] : 0.f; }
#pragma unroll
      for (int k = 0; k < 7; ++k) if (pmv[k] >= 0) F.MI[512 + ((F.tid >> 8) + 2 * k) * 256 + (F.tid & 255)] = __float_as_int(v[k]); }
    __syncthreads();
    EpiProj E{(bf16*)(ws + WS_XR), (bf16*)F.out, F.MI, fmaxf(__uint_as_float(__hip_atomic_load(F.ctl + CW_AMAX + 130, RLX_AGENT)), 1e-30f) * (1.0f / 127.0f)};
    int Kk = D / 2; asm volatile("" : "+s"(Kk));
    pg8::gemm_phase<EpiProj, DenseOrder, true, false, true>(F.lds, F.tid, Kk, S, E);
}
__device__ __forceinline__ void moe_up(Frame& F, int chunk) {
    unsigned char* ws = F.ws;
    const int nrt_r = moe_tables(F, chunk), nrt = nrt_r + TC / 256;
    const int* lists = (const int*)(ws + WS_LIST);
    int* rdest = (int*)(ws + WS_RDEST);
    { const int r = F.tid & 255; int tokn[5], dest[5], slot[5]; bool act[5]; int rt_[5];
#pragma unroll
      for (int k = 0; k < 5; ++k) { const int i = (F.tid >> 8) + 2 * k, L = i * F.G + F.vcu, rt = L >> 1; act[k] = L < 2 * nrt; rt_[k] = rt; slot[k] = -1; tokn[k] = chunk * TC; dest[k] = -1;
          if (act[k]) { if (rt < nrt_r) { const int e = ((volatile LAS unsigned char*)(F.MI + MI_TILE_E))[rt]; const int idx = (rt - F.MI[MI_TBASE + e]) * 256 + r; if (idx < F.MI[MI_CNT + e]) slot[k] = lists[((size_t)chunk * 64 + e) * TC + idx]; }
              else { tokn[k] = chunk * TC + (rt - nrt_r) * 256 + r; dest[k] = TC * 8 + (rt - nrt_r) * 256 + r; } } }
#pragma unroll
      for (int k = 0; k < 5; ++k) if (slot[k] >= 0) { tokn[k] = slot[k] >> 3; dest[k] = slot[k] - chunk * TC * 8; }
#pragma unroll
      for (int k = 0; k < 5; ++k) if (act[k]) { const int i = (F.tid >> 8) + 2 * k, L = i * F.G + F.vcu;
          F.MI[MI_TOK + i * 256 + r] = tokn[k];
          if ((L & 1) == 0) rdest[rt_[k] * 256 + r] = dest[k]; }
 }
    __syncthreads();
    UpOrder S{(const char*)ws, F.MI, nrt_r, nrt, F.G, F.vcu};
    EpiSwiglu E{ws + WS_HB};
    int Kk = D / 2; asm volatile("" : "+s"(Kk));
    pg8::gemm_phase<EpiSwiglu, UpOrder, true, true, 2>(F.lds, F.tid, Kk, S, E);
}
__device__ __forceinline__ void moe_down(Frame& F, int chunk) {
    unsigned char* ws = F.ws;
    __syncthreads();
    const int nrt_r = F.MI[MI_TBASE + NEXP], nrt = nrt_r + TC / 256;
    { const int* rdest = (const int*)(ws + WS_RDEST) + (F.tid & 255); int v[10];
#pragma unroll
      for (int k = 0; k < 10; ++k) { const int L = ((F.tid >> 8) + 2 * k) * F.G + F.vcu; v[k] = (L < 4 * nrt) ? rdest[(L >> 2) * 256] : -1; }
#pragma unroll
      for (int k = 0; k < 10; ++k) { const int i = (F.tid >> 8) + 2 * k, L = i * F.G + F.vcu; if (L < 4 * nrt) F.MI[MI_TOK + i * 256 + (F.tid & 255)] = v[k]; } }
    __syncthreads();
    DownOrder S{(const char*)ws, F.MI, nrt_r, nrt, F.G, F.vcu};
    EpiScatter E{ws + WS_SLOT, F.MI};
    int Kk = DEXP / 2; asm volatile("" : "+s"(Kk));
    pg8::gemm_phase<EpiScatter, DownOrder, false, false, 2>(F.lds, F.tid, Kk, S, E);
}
__device__ __forceinline__ void moe_combine(Frame& F, const Args& A, int chunk, bool poison) {
    unsigned char* ws = F.ws;
    const float* mod = (const float*)(ws + WS_MOD); const unsigned char* SL = ws + WS_SLOT; const float* wts = (const float*)(ws + WS_WTS);
    const int gw = F.vcu * NWAVES + F.wave, NGW = F.G * NWAVES;
    f32x4 gpv[4];
#pragma unroll
    for (int j = 0; j < 4; ++j) gpv[j] = *(const f32x4*)(A.in[31] + 4 * F.lane + 256 * j);
    unsigned dA[9][4], dB[9][4]; v2u xA[4], xB[4];
#define CB_LOAD(tl_, d_, x_) do { const int t_ = __builtin_amdgcn_readfirstlane(tl_);        \
        _Pragma("unroll") for (int j = 0; j < 4; ++j) x_[j] = __builtin_nontemporal_load((const GAS v2u*)(F.out + ((size_t)chunk * TC + t_) * D) + F.lane + 64 * j); \
        asm volatile("" ::: "memory"); \
        const GAS unsigned* b0_ = (const GAS unsigned*)(SL + (size_t)t_ * 8 * D) + F.lane; const GAS unsigned* b1_ = b0_ + 4 * (D / 4); \
        const GAS unsigned* b2_ = (const GAS unsigned*)(SL + ((size_t)TC * 8 + t_) * D) + F.lane;         \
        _Pragma("unroll") for (int k = 0; k < 9; ++k) \
            _Pragma("unroll") for (int j = 0; j < 4; ++j) d_[k][j] = __builtin_nontemporal_load(&(k < 4 ? b0_ : k < 8 ? b1_ : b2_)[(k < 8 ? (k & 3) : 0) * (D / 4) + 64 * j]); } while (0)
#define CB_REDUCE(tl_, d_, x_) do { const int t_ = __builtin_amdgcn_readfirstlane(tl_); const size_t m = (size_t)chunk * TC + t_; const int b = (int)(m / SEQ); \
        f32x4 gt[4]; _Pragma("unroll") for (int j = 0; j < 4; ++j) gt[j] = *(const f32x4*)(mod + b * 6 * D + 5 * D + 4 * F.lane + 256 * j); \
        const float wl_ = (F.lane < 8) ? wts[m * 8 + F.lane] : 1.0f;        \
        f32x4 y[4]; \
        _Pragma("unroll") for (int j = 0; j < 4; ++j) y[j] = (f32x4){0.f, 0.f, 0.f, 0.f}; \
        _Pragma("unroll") for (int k = 0; k < 9; ++k) { const float wk_ = (k < 8) ? rl_f(wl_, k) : 1.0f; _Pragma("unroll") for (int j = 0; j < 4; ++j) { const int dd = (int)d_[k][j]; \
            const auto lo_ = __builtin_amdgcn_cvt_pk_f32_fp8(dd, false); const auto hi_ = __builtin_amdgcn_cvt_pk_f32_fp8(dd, true); \
            y[j].x = __builtin_fmaf(lo_[0], wk_, y[j].x); y[j].y = __builtin_fmaf(lo_[1], wk_, y[j].y); y[j].z = __builtin_fmaf(hi_[0], wk_, y[j].z); y[j].w = __builtin_fmaf(hi_[1], wk_, y[j].w); } \
            __builtin_amdgcn_sched_barrier(0); } \
        _Pragma("unroll") for (int j = 0; j < 4; ++j) y[j] = y[j] * 0.0625f; \
        float s = 0.f; \
        _Pragma("unroll") for (int j = 0; j < 4; ++j) s += (y[j].x * y[j].x + y[j].y * y[j].y) + (y[j].z * y[j].z + y[j].w * y[j].w); \
        const float rstd = 1.f / sqrtf(wave_sum(s) * (1.f / D) + EPS); \
        asm volatile("" ::: "memory"); \
        _Pragma("unroll") for (int j = 0; j < 4; ++j) { f32x4* op = (f32x4*)(F.out + m * D) + F.lane + 64 * j; const v2u xb = x_[j]; \
            f32x4 o = (f32x4){bflo(xb.x), bfhi(xb.x), bflo(xb.y), bfhi(xb.y)} + gt[j] * (y[j] * rstd * gpv[j]); \
            if (poison) { const float q_ = __builtin_nanf(""); o = (f32x4){q_, q_, q_, q_}; } \
            __builtin_nontemporal_store(o, op); } } while (0)
    for (int tl = gw; tl < TC; tl += NGW) { CB_LOAD(tl, dA, xA); CB_REDUCE(tl, dA, xA); }
#undef CB_LOAD
#undef CB_REDUCE
}

__device__ __forceinline__ void attn_phase(Frame& F, const Args& A, char* lds_generic) {
    const attn_body::bf16* Q = (const attn_body::bf16*)(F.ws + WS_Q); const attn_body::bf16* K = (const attn_body::bf16*)(F.ws + WS_K); const attn_body::bf16* V = (const attn_body::bf16*)(F.ws + WS_V);
    attn_body::bf16* O = (attn_body::bf16*)(F.ws + WS_H);
    const float d1 = A.in[13][F.lane] * A.in[14][F.lane], d2 = A.in[15][F.lane] * A.in[16][F.lane];
    const float lam = expf(wave_sum(d1)) - expf(wave_sum(d2)) + LAM_INIT;
    const int npr = (BATCH * 16 - F.vcu + F.G - 1) / F.G;
#pragma unroll 1
    for (int it = 0; it < npr * 8; ++it) {
        const int pr = F.vcu + (it >> 3) * F.G, qi = (it >> 1) & 3, m = it & 1;
        const int pair = pr >> 1, st = pr & 1, b = pair >> 3, h = pair & 7;
        const int qb = st ? (qi == 0 ? 6 : qi == 1 ? 5 : qi == 2 ? 2 : 1) : (qi == 0 ? 7 : qi == 1 ? 4 : qi == 2 ? 3 : 0);
        const float sl2 = exp2f(-(float)(h + 1)) * LOG2E;
        if (m == 0) attn_body::attn_unit2<8, false>(F.tid, b, h, 0, qb, sl2, lam, A.in[17], Q, K, V, O, lds_generic);
        else        attn_body::attn_unit2<8, true >(F.tid, b, h, 1, qb, sl2, lam, A.in[17], Q, K, V, O, lds_generic);
    }
}

__global__ void __launch_bounds__(NWAVES * 64, 2) hybrid_fwd(Args args) {
    extern __shared__ __attribute__((aligned(16))) unsigned char lds[];
    Frame F;
    F.lds = (LAS unsigned char*)lds;
    F.MI = (volatile LAS int*)(F.lds + MISC_OFF);
    F.tid = threadIdx.x; F.lane = F.tid & 63; F.wave = __builtin_amdgcn_readfirstlane(F.tid >> 6);
    F.G = gridDim.x; { const int bx = blockIdx.x; F.vcu = (F.G % 8 == 0) ? (bx % 8) * (F.G / 8) + bx / 8 : bx; } F.cidx = (int)blockIdx.x;
    unsigned char* ws = args.ws; F.ws = ws; F.out = args.out;
    F.ctl = (gu32*)(ws + WS_CTL);
    for (int u = F.tid; u < MI_WORDS; u += NWAVES * 64) F.MI[u] = 0;
    __syncthreads();
    XcdBarrier bar; bar.bar = (unsigned*)(F.ctl + CW_BAR); bar.x = 0; bar.st = nullptr;
    if (!PER_PHASE) bar = xcd_barrier_post((unsigned*)(F.ctl + CW_BAR), (volatile LAS unsigned*)(F.MI + MI_BARST));
    const int lo = args.ph_lo, hi = args.ph_hi;
#ifndef PH_MASK
#define PH_MASK 0xFFFFFFFFu
#endif
#ifndef PROBE_MASK
#define PROBE_MASK 0u
#endif
#define PSTAMP(k) do { if (PROBE_MASK != 0u && F.tid == 0) { const unsigned long long t_ = __builtin_amdgcn_s_memrealtime(); volatile LAS unsigned long long* pp_ = (volatile LAS unsigned long long*)(F.MI + 16); \
        if ((PROBE_MASK >> (k)) & 1u) pp_[1] += t_ - pp_[0]; pp_[0] = t_; } } while (0)
#define FRESH() do { size_t z_ = 0; asm volatile("" : "+s"(z_)); unsigned char* w_ = args.ws + z_;        F.ws = w_; ws = w_; F.ctl = (gu32*)(w_ + WS_CTL); int t_ = threadIdx.x; asm volatile("" : "+v"(t_)); F.tid = t_; F.lane = t_ & 63; F.wave = __builtin_amdgcn_readfirstlane(t_ >> 6); } while (0)
    if ((PROBE_MASK != 0u || PROBE_SEG != 0) && F.tid == 0) { volatile LAS unsigned long long* pp_ = (volatile LAS unsigned long long*)(F.MI + 16); pp_[0] = __builtin_amdgcn_s_memrealtime(); pp_[1] = 0ull; }
#define IN(k) (((PH_MASK >> (k)) & 1u) && lo <= (k) && (k) < hi)
#define SEAM(k) do { if (IN(k) && IN((k) + 1)) { if (PER_PHASE) { if (F.tid == 0) __hip_atomic_store(F.ctl + CW_TMO, 0xBADBA0u, RLX_AGENT); } else xcd_barrier(bar); } PSTAMP(k); } while (0)
    if (IN(0)) { FRESH(); p0_phase(F, args); } SEAM(0);
    if (IN(1)) { FRESH(); p1_phase(F, args); } SEAM(1);
    bool xlocal = false; unsigned xnloc = 1u;
    if (!PER_PHASE && (F.G % 8) == 0) {
        if (F.tid == 0) { bool ok = true; unsigned* bb_ = bar.bar;
            for (unsigned j = 0; j < 16; ++j) { const unsigned c_ = xb_ld(&bb_[XB_XCNT(j)]); ok = ok && (j < 8 ? c_ == (unsigned)(F.G / 8) : c_ == 0u); }
            ok = ok && bar.x < 8u && bar.st[2] < (unsigned)(F.G / 8);
            bar.st[3] = ok ? 1u : 0u; }
        __syncthreads();
        xlocal = bar.st[3] != 0u; xnloc = (unsigned)(F.G / 8);
        if (xlocal) { const int rank_ = (int)bar.st[2]; F.vcu = (int)bar.x * (F.G / 8) + rank_; F.cidx = rank_ * 8 + (int)bar.x; } }
#define LSEAM(k) do { if (xlocal) { if (IN(k) && IN((k) + 1)) xcd_local_barrier(bar, xnloc); PSTAMP(k); } else SEAM(k); } while (0)
    if (IN(2)) { FRESH(); p2_phase(F, args); } LSEAM(2);
    if (IN(3)) { FRESH(); lru_phase(F, args); } if (PER_PHASE) { SEAM(3); } else { PSTAMP(3); }
    if (IN(4)) { FRESH(); attn_phase(F, args, (char*)lds); } LSEAM(4);
    if (PER_PHASE) { SEAM(5); }
    if (IN(6)) { FRESH(); MergeOrder S; S.d.init(ws + WS_GR, ws + WS_WR, T, D, D, F.G, F.cidx); S.A1 = (const char*)(ws + WS_H); S.B1 = (const char*)(ws + WS_WA);
        EpiGate E{(const unsigned char*)args.out, (const unsigned char*)args.out + (size_t)T * D, (bf16*)(ws + WS_V), (bf16*)(ws + WS_XR)};
        pg8::gemm_phase<EpiGate, MergeOrder, true, false>(F.lds, F.tid, D, S, E); } LSEAM(6);
    if (IN(7)) { FRESH(); DenseOrder S; S.init(ws + WS_XR, ws + WS_WO, T, D, D, F.G, F.cidx); EpiF32 E{(bf16*)(ws + WS_Y)};
        pg8::gemm_phase<EpiF32, DenseOrder, true, false>(F.lds, F.tid, D, S, E); } SEAM(7);
    if (IN(8)) { FRESH(); p8_phase(F, args); } SEAM(8);
#pragma unroll 1
    for (int c = 0; c < NCH; ++c) {
        const int pa = 9 + 2 * c, pb = 10 + 2 * c;
        if (IN(pa)) { FRESH(); if (c > 0) { int cm = c - 1; asm volatile("" : "+s"(cm)); moe_combine(F, args, cm, false); FRESH(); } int cu = c; asm volatile("" : "+s"(cu)); moe_up(F, cu); } SEAM(pa);
        if (IN(pb)) { FRESH(); int cd = c; asm volatile("" : "+s"(cd)); moe_down(F, cd); } SEAM(pb);
    }
    if (IN(9 + 2 * NCH)) { FRESH();
        bool poison = __hip_atomic_load(F.ctl + CW_TMO, RLX_AGENT) != 0u || __hip_atomic_load(F.ctl + CW_BAR + XB_TMO, RLX_AGENT) != 0u;
        moe_combine(F, args, NCH - 1, poison);
    }
    PSTAMP(17);
#undef IN
#undef SEAM
    if (PROBE_MASK != 0u || PROBE_SEG != 0) { __syncthreads(); if (F.tid == 0) { volatile LAS unsigned long long* pp_ = (volatile LAS unsigned long long*)(F.MI + 16);
        unsigned long long acc_ = pp_[1]; const unsigned long long t2_ = __builtin_amdgcn_s_memrealtime();
        while (__builtin_amdgcn_s_memrealtime() - t2_ < acc_) __builtin_amdgcn_s_sleep(8); } __syncthreads(); }
}

extern "C" void kernel_launch(void* const* d_in, const int* in_sizes, int n_in, void* d_out, int out_size, void* d_ws, size_t ws_size, hipStream_t stream) {
    static int grid = 0;
    if (grid == 0) {
        if (n_in != 32 || out_size != T * D || ws_size < WS_TOTAL) { fprintf(stderr, "kernel_launch: unexpected shapes (n_in %d, out %d, ws %zu); nothing launched\n", n_in, out_size, ws_size); grid = -1; return; }
        int dev = 0, cus = 0, per_cu = 0;
        if (hipGetDevice(&dev) != hipSuccess || hipDeviceGetAttribute(&cus, hipDeviceAttributeMultiprocessorCount, dev) != hipSuccess) { grid = -1; return; }
        if (hipFuncSetAttribute((const void*)hybrid_fwd, hipFuncAttributeMaxDynamicSharedMemorySize, LDS_BYTES) != hipSuccess) { fprintf(stderr, "kernel_launch: hipFuncSetAttribute failed\n"); grid = -1; return; }
        if (hipOccupancyMaxActiveBlocksPerMultiprocessor(&per_cu, (const void*)hybrid_fwd, NWAVES * 64, LDS_BYTES) != hipSuccess || per_cu < 1) { fprintf(stderr, "kernel_launch: occupancy query says %d blocks per CU\n", per_cu); per_cu = 1; }
        (void)hipGetLastError();
        grid = cus;
    }
    if (grid < 0) return;
    (void)hipMemsetAsync((char*)d_ws + WS_CTL, 0, CTL_ZERO_BYTES, stream);
    Args a{};
    for (int i = 0; i < 32; ++i) a.in[i] = (const float*)d_in[i];
    a.out = (float*)d_out; a.ws = (unsigned char*)d_ws;
    if (N_LAUNCHES == 1) { a.ph_lo = 0; a.ph_hi = N_PHASES; hipLaunchKernelGGL(hybrid_fwd, dim3(grid), dim3(NWAVES * 64), LDS_BYTES, stream, a); }
    else for (int p = 0; p < N_PHASES; ++p) { a.ph_lo = p; a.ph_hi = p + 1; hipLaunchKernelGGL(hybrid_fwd, dim3(grid), dim3(NWAVES * 64), LDS_BYTES, stream, a); }
}
```
